# Optimizing an MI355X kernel written in HIP

```python
import jax
import jax.numpy as jnp
from jax import lax
import numpy as np

D_MODEL = 1024
BATCH = 2
SEQ = 8192
DEPTH = 4
DEC_BATCH = 8
DEC_SEQ = 16
PAST_LEN = 2048

CHUNK = 64
QBLOCK = 128
RMS_EPS = 1e-6
NEG_BIG = -1e30

RWKV_HEADS = 8
RWKV_HEAD_DIM = 64
RWKV_WIDTH = RWKV_HEADS * RWKV_HEAD_DIM
DECAY_LORA = 64
AAA_LORA = 64
RWKV_SHIFT_WIDTH = 3 * RWKV_WIDTH + DECAY_LORA + AAA_LORA
GN_EPS = 64e-5

MLA_HEADS = 8
MLA_NOPE = 64
MLA_ROPE = 32
MLA_V = 64
MLA_Q_LORA = 384
MLA_KV_LORA = 256
MLA_WIDTH = MLA_HEADS * MLA_V
ROPE_THETA = 10000.0

SB_HEADS = 8
SB_HEAD_DIM = 64
SB_WIDTH = SB_HEADS * SB_HEAD_DIM

N_BRANCH = 3
IN_SIZES = (RWKV_SHIFT_WIDTH, RWKV_WIDTH, MLA_Q_LORA, MLA_KV_LORA, MLA_ROPE, MLA_WIDTH,
            SB_WIDTH, SB_WIDTH, SB_WIDTH, SB_WIDTH, N_BRANCH * D_MODEL)
D_IN = (RWKV_SHIFT_WIDTH + RWKV_WIDTH + MLA_Q_LORA + MLA_KV_LORA + MLA_ROPE + MLA_WIDTH
        + 4 * SB_WIDTH + N_BRANCH * D_MODEL)
RWKV_SIZES = (RWKV_WIDTH, RWKV_WIDTH, RWKV_WIDTH, DECAY_LORA, AAA_LORA)

kernel_name = "hybrid_rwkv7_mla_stickbreaking_stream_step"


def _split(x, sizes):
    return jnp.split(x, np.cumsum(sizes)[:-1].tolist(), axis=-1)


def rms_norm(x, g, eps=RMS_EPS):
    xf = x.astype(jnp.float32)
    return xf * lax.rsqrt(jnp.mean(xf * xf, axis=-1, keepdims=True) + eps) * g.astype(jnp.float32)


def rope(x, pos):
    half = MLA_ROPE // 2
    inv = ROPE_THETA ** (-jnp.arange(half, dtype=jnp.float32) / half)
    ang = pos.astype(jnp.float32)[..., None] * inv
    cos, sin = jnp.cos(ang), jnp.sin(ang)
    x1, x2 = x[..., :half], x[..., half:]
    return jnp.concatenate([x1 * cos - x2 * sin, x1 * sin + x2 * cos], axis=-1)


def sweep_queries(fn, q, q_pos):
    T = q.shape[1]
    if T <= QBLOCK or T % QBLOCK:
        return fn(q, q_pos)
    nb = T // QBLOCK
    qb = jnp.moveaxis(q.reshape(q.shape[0], nb, QBLOCK, *q.shape[2:]), 1, 0)
    pb = q_pos.reshape(nb, QBLOCK)
    ob = lax.map(lambda args: fn(args[0], args[1]), (qb, pb))
    return jnp.moveaxis(ob, 0, 1).reshape(q.shape[0], T, *ob.shape[3:])


def chunk_softmax_attn(q, k, v, q_pos, k_pos):
    s = jnp.einsum('bqhd,bshd->bhqs', q, k).astype(jnp.float32) * (q.shape[-1] ** -0.5)
    mask = (k_pos // CHUNK)[None, :] <= (q_pos // CHUNK)[:, None]
    p = jax.nn.softmax(jnp.where(mask, s, NEG_BIG), axis=-1)
    return jnp.einsum('bhqs,bshd->bqhd', p, v.astype(jnp.float32))


def stick_breaking_attn(q, k, v, q_pos, k_pos):
    z = jnp.einsum('bqhd,bshd->bhqs', q, k).astype(jnp.float32) * (q.shape[-1] ** -0.5)
    mask = k_pos[None, :] < q_pos[:, None]
    log_1mb = jnp.where(mask, jax.nn.log_sigmoid(-z), 0.0)
    suffix = lax.cumsum(log_1mb, axis=3, reverse=True) - log_1mb
    a = jnp.where(mask, jnp.exp(jax.nn.log_sigmoid(z) + suffix), 0.0)
    return jnp.einsum('bhqs,bshd->bqhd', a, v.astype(jnp.float32))


def rwkv7_branch(p_shift, past_shift, S0, P, l):
    B, T, _ = p_shift.shape
    H, N = RWKV_HEADS, RWKV_HEAD_DIM
    prev = jnp.concatenate([past_shift.astype(p_shift.dtype), p_shift[:, :-1]], axis=1)
    xs = p_shift + (prev - p_shift) * P['rwkv_mu'][l]
    r, k, v, wd, ad = _split(xs, RWKV_SIZES)
    w_log = -jax.nn.softplus(-(P['rwkv_w0'][l] + jnp.tanh(wd) @ P['rwkv_w_up'][l])) - 0.5
    a = jax.nn.sigmoid(P['rwkv_a0'][l] + ad @ P['rwkv_a_up'][l])
    hd = lambda t: t.astype(jnp.float32).reshape(B, T, H, N)
    r, k, v, a = hd(r), hd(k), hd(v), hd(a)
    decay = jnp.exp(-jnp.exp(hd(w_log)))
    kk = k * P['rwkv_k_k'][l].reshape(H, N)
    kk = kk / jnp.maximum(jnp.sqrt(jnp.sum(kk * kk, axis=-1, keepdims=True)), 1e-12)
    k = k * (1.0 + (a - 1.0) * P['rwkv_k_a'][l].reshape(H, N))

    def step(S, inp):
        r_t, w_t, k_t, v_t, kk_t, a_t = inp
        sa = jnp.einsum('bhij,bhj->bhi', S, -kk_t)
        S = (S * w_t[:, :, None, :] + sa[..., :, None] * (kk_t * a_t)[..., None, :]
             + v_t[..., :, None] * k_t[..., None, :])
        return S, jnp.einsum('bhij,bhj->bhi', S, r_t)

    S_fin, ys = lax.scan(step, S0.astype(jnp.float32),
                         tuple(jnp.moveaxis(t, 1, 0) for t in (r, decay, k, v, kk, a)))
    y = jnp.moveaxis(ys, 0, 1)
    mu = jnp.mean(y, axis=-1, keepdims=True)
    var = jnp.mean(jnp.square(y - mu), axis=-1, keepdims=True)
    y = ((y - mu) * lax.rsqrt(var + GN_EPS)).reshape(B, T, RWKV_WIDTH) * P['rwkv_gn_g'][l] + P['rwkv_gn_b'][l]
    bonus = jnp.sum(r * k * P['rwkv_r_k'][l].reshape(H, N), axis=-1, keepdims=True) * v
    return y + bonus.reshape(B, T, RWKV_WIDTH), S_fin, p_shift[:, -1:]


def mla_branch(cq_raw, ckv_raw, kr_raw, past_ckv, past_kr, q_pos, k_pos, P, l):
    B, T, _ = cq_raw.shape
    q = (rms_norm(cq_raw, P['mla_q_norm'][l]) @ P['mla_w_uq'][l]).reshape(B, T, MLA_HEADS, MLA_NOPE + MLA_ROPE)
    q_nope = rms_norm(q[..., :MLA_NOPE], P['mla_qn_nope'][l])
    q_rope = rope(rms_norm(q[..., MLA_NOPE:], P['mla_qn_rope'][l]), q_pos[:, None])
    c_kv = rms_norm(ckv_raw, P['mla_kv_norm'][l])
    k_rope = rope(rms_norm(kr_raw, P['mla_kn_rope'][l]), q_pos)
    ckv_all = jnp.concatenate([past_ckv, c_kv], axis=1)
    kr_all = jnp.concatenate([past_kr, k_rope], axis=1)
    S = ckv_all.shape[1]
    kv = (ckv_all @ P['mla_w_ukv'][l]).reshape(B, S, MLA_HEADS, MLA_NOPE + MLA_V)
    k_nope = rms_norm(kv[..., :MLA_NOPE], P['mla_kn_nope'][l])
    v = kv[..., MLA_NOPE:]
    k = jnp.concatenate([k_nope, jnp.broadcast_to(kr_all[:, :, None, :].astype(jnp.float32),
                                                  (B, S, MLA_HEADS, MLA_ROPE))], axis=-1)
    qf = jnp.concatenate([q_nope, q_rope], axis=-1)
    o = sweep_queries(lambda qb, pb: chunk_softmax_attn(qb, k, v, pb, k_pos), qf, q_pos)
    return o.reshape(B, T, MLA_WIDTH), c_kv, k_rope


def sb_branch(q_raw, k_raw, v_raw, past_k, past_v, q_pos, k_pos):
    B, T, _ = q_raw.shape
    q = q_raw.reshape(B, T, SB_HEADS, SB_HEAD_DIM)
    k_new = k_raw.reshape(B, T, SB_HEADS, SB_HEAD_DIM)
    v_new = v_raw.reshape(B, T, SB_HEADS, SB_HEAD_DIM)
    k_all = jnp.concatenate([past_k, k_new], axis=1)
    v_all = jnp.concatenate([past_v, v_new], axis=1)
    o = sweep_queries(lambda qb, pb: stick_breaking_attn(qb, k_all, v_all, pb, k_pos), q, q_pos)
    return o.reshape(B, T, SB_WIDTH), k_new, v_new


def layer(x, c, q_pos, past, P, l):
    S0, shift0, ckv0, kr0, k0, v0 = past
    past_len = ckv0.shape[1]
    k_pos = jnp.concatenate([jnp.arange(past_len, dtype=jnp.int32), q_pos])
    mod = jax.nn.silu(c.astype(jnp.float32)) @ P['w_ada'][l] + P['b_ada'][l]
    shift, scale, gate = jnp.split(mod[:, None, :], 3, axis=-1)
    h = rms_norm(x, P['norm_g'][l]) * (1.0 + scale) + shift
    proj = h @ P['w_in'][l]
    pr, zA, cq, ckv, kr, zB, sq, sk, sv, zC, gates = _split(proj, IN_SIZES)
    yA, S1, shift1 = rwkv7_branch(pr, shift0, S0, P, l)
    yB, ckv1, kr1 = mla_branch(cq, ckv, kr, ckv0, kr0, q_pos, k_pos, P, l)
    yC, k1, v1 = sb_branch(sq, sk, sv, k0, v0, q_pos, k_pos)
    gA, gB, gC = jnp.split(jax.nn.sigmoid(gates), 3, axis=-1)
    merged = (gA * ((yA * jax.nn.silu(zA)) @ P['w_br_rwkv'][l])
              + gB * ((yB * jax.nn.silu(zB)) @ P['w_br_mla'][l])
              + gC * ((yC * jax.nn.silu(zC)) @ P['w_br_sb'][l]))
    x = x + gate * (merged @ P['w_out'][l])
    return x, (S1, shift1, ckv1, kr1, k1, v1)


def trunk(x, c, q_pos, pasts, P):
    new = []
    for l in range(DEPTH):
        x, st = layer(x, c, q_pos, pasts[l], P, l)
        new.append(st)
    stacked = [jnp.stack([st[i] for st in new], axis=0) for i in range(6)]
    return x, stacked


def setup_inputs(seed: int = 0) -> dict:
    key = jax.random.key(seed)
    ks = iter(jax.random.split(key, 48))
    f32 = jnp.float32

    def nrm(shape, scale=1.0):
        return jax.random.normal(next(ks), shape, f32) * scale

    def gain(shape):
        return 1.0 + nrm(shape, 0.05)

    D, L = D_MODEL, DEPTH
    return {
        'x_prompt': nrm((BATCH, SEQ, D)),
        'x_sample': nrm((DEC_BATCH, DEC_SEQ, D)),
        'state_rwkv_wkv': nrm((L, DEC_BATCH, RWKV_HEADS, RWKV_HEAD_DIM, RWKV_HEAD_DIM), 0.5),
        'state_rwkv_shift': nrm((L, DEC_BATCH, 1, RWKV_SHIFT_WIDTH)),
        'cache_mla_ckv': nrm((L, DEC_BATCH, PAST_LEN, MLA_KV_LORA)),
        'cache_mla_krope': nrm((L, DEC_BATCH, PAST_LEN, MLA_ROPE)),
        'cache_sb_k': nrm((L, DEC_BATCH, PAST_LEN, SB_HEADS, SB_HEAD_DIM)),
        'cache_sb_v': nrm((L, DEC_BATCH, PAST_LEN, SB_HEADS, SB_HEAD_DIM)),
        'c_prompt': nrm((BATCH, D)),
        'c_sample': nrm((DEC_BATCH, D)),
        'w_ada': nrm((L, D, 3 * D), 0.5 * D ** -0.5),
        'b_ada': nrm((L, 3 * D), 0.02),
        'norm_g': gain((L, D)),
        'w_in': nrm((L, D, D_IN), D ** -0.5),
        'rwkv_mu': jax.random.uniform(next(ks), (L, RWKV_SHIFT_WIDTH), f32),
        'rwkv_w0': nrm((L, RWKV_WIDTH), 0.5),
        'rwkv_w_up': nrm((L, DECAY_LORA, RWKV_WIDTH), 0.5 * DECAY_LORA ** -0.5),
        'rwkv_a0': nrm((L, RWKV_WIDTH), 0.5),
        'rwkv_a_up': nrm((L, AAA_LORA, RWKV_WIDTH), 0.5 * AAA_LORA ** -0.5),
        'rwkv_k_k': 0.85 + nrm((L, RWKV_WIDTH), 0.05),
        'rwkv_k_a': gain((L, RWKV_WIDTH)),
        'rwkv_r_k': nrm((L, RWKV_WIDTH), 0.1),
        'rwkv_gn_g': gain((L, RWKV_WIDTH)),
        'rwkv_gn_b': nrm((L, RWKV_WIDTH), 0.02),
        'w_br_rwkv': nrm((L, RWKV_WIDTH, D), RWKV_WIDTH ** -0.5),
        'mla_q_norm': gain((L, MLA_Q_LORA)),
        'mla_w_uq': nrm((L, MLA_Q_LORA, MLA_HEADS * (MLA_NOPE + MLA_ROPE)), MLA_Q_LORA ** -0.5),
        'mla_kv_norm': gain((L, MLA_KV_LORA)),
        'mla_w_ukv': nrm((L, MLA_KV_LORA, MLA_HEADS * (MLA_NOPE + MLA_V)), MLA_KV_LORA ** -0.5),
        'mla_qn_nope': gain((L, MLA_NOPE)),
        'mla_qn_rope': gain((L, MLA_ROPE)),
        'mla_kn_nope': gain((L, MLA_NOPE)),
        'mla_kn_rope': gain((L, MLA_ROPE)),
        'w_br_mla': nrm((L, MLA_WIDTH, D), MLA_WIDTH ** -0.5),
        'w_br_sb': nrm((L, SB_WIDTH, D), SB_WIDTH ** -0.5),
        'w_out': nrm((L, D, D), D ** -0.5),
    }


def reference(x_prompt, x_sample, state_rwkv_wkv, state_rwkv_shift, cache_mla_ckv, cache_mla_krope,
              cache_sb_k, cache_sb_v, c_prompt, c_sample, w_ada, b_ada, norm_g, w_in, rwkv_mu, rwkv_w0,
              rwkv_w_up, rwkv_a0, rwkv_a_up, rwkv_k_k, rwkv_k_a, rwkv_r_k, rwkv_gn_g, rwkv_gn_b, w_br_rwkv,
              mla_q_norm, mla_w_uq, mla_kv_norm, mla_w_ukv, mla_qn_nope, mla_qn_rope, mla_kn_nope,
              mla_kn_rope, w_br_mla, w_br_sb, w_out):
    P = dict(w_ada=w_ada, b_ada=b_ada, norm_g=norm_g, w_in=w_in, rwkv_mu=rwkv_mu, rwkv_w0=rwkv_w0,
             rwkv_w_up=rwkv_w_up, rwkv_a0=rwkv_a0, rwkv_a_up=rwkv_a_up, rwkv_k_k=rwkv_k_k,
             rwkv_k_a=rwkv_k_a, rwkv_r_k=rwkv_r_k, rwkv_gn_g=rwkv_gn_g, rwkv_gn_b=rwkv_gn_b,
             w_br_rwkv=w_br_rwkv, mla_q_norm=mla_q_norm, mla_w_uq=mla_w_uq, mla_kv_norm=mla_kv_norm,
             mla_w_ukv=mla_w_ukv, mla_qn_nope=mla_qn_nope, mla_qn_rope=mla_qn_rope,
             mla_kn_nope=mla_kn_nope, mla_kn_rope=mla_kn_rope, w_br_mla=w_br_mla, w_br_sb=w_br_sb,
             w_out=w_out)
    Bp, Tp = x_prompt.shape[0], x_prompt.shape[1]
    Bs, Ts = x_sample.shape[0], x_sample.shape[1]
    past_len = cache_mla_ckv.shape[2]
    dt = x_prompt.dtype

    empty = (jnp.zeros((Bp, RWKV_HEADS, RWKV_HEAD_DIM, RWKV_HEAD_DIM), jnp.float32),
             jnp.zeros((Bp, 1, RWKV_SHIFT_WIDTH), dt),
             jnp.zeros((Bp, 0, MLA_KV_LORA), dt),
             jnp.zeros((Bp, 0, MLA_ROPE), dt),
             jnp.zeros((Bp, 0, SB_HEADS, SB_HEAD_DIM), dt),
             jnp.zeros((Bp, 0, SB_HEADS, SB_HEAD_DIM), dt))
    pos_p = jnp.arange(Tp, dtype=jnp.int32)
    y_prompt, st_p = trunk(x_prompt, c_prompt, pos_p, [empty] * DEPTH, P)
    wkv_p, shift_p, ckv_p, krope_p, sbk_p, sbv_p = st_p

    pasts_s = [(state_rwkv_wkv[l], state_rwkv_shift[l], cache_mla_ckv[l], cache_mla_krope[l],
                cache_sb_k[l], cache_sb_v[l]) for l in range(DEPTH)]
    pos_s = past_len + jnp.arange(Ts, dtype=jnp.int32)
    y_sample, st_s = trunk(x_sample, c_sample, pos_s, pasts_s, P)
    wkv_s, shift_s, ckv_s, krope_s, sbk_s, sbv_s = st_s

    return (y_prompt, y_sample, wkv_p, shift_p, ckv_p, krope_p, sbk_p, sbv_p,
            wkv_s, shift_s, ckv_s, krope_s, sbk_s, sbv_s)
```

```cpp
#include <hip/hip_runtime.h>
#include <hip/hip_cooperative_groups.h>
#include <cstdio>
namespace cg = cooperative_groups;

#ifndef MULTI
#define MULTI 0
#endif

typedef unsigned short u16;
typedef __attribute__((ext_vector_type(8))) short bf16x8;
typedef __attribute__((ext_vector_type(16))) float f32x16;
typedef __attribute__((ext_vector_type(2))) __bf16 bf2_t;
typedef __attribute__((ext_vector_type(2))) float f2_t;
typedef __attribute__((ext_vector_type(4))) unsigned u32x4;
typedef __attribute__((ext_vector_type(2))) unsigned u32x2;
typedef __attribute__((ext_vector_type(4))) float f32x4v;
#define DI __device__ __forceinline__
#define MFMA32(a, b, c) __builtin_amdgcn_mfma_f32_32x32x16_bf16((a), (b), (c), 0, 0, 0)

constexpr int D = 1024, NL = 4, NP = 16384, NS = 128, NT = NP + NS, TP = 8192, TS = 16, PAST = 2048, SK = 2064;
constexpr int NKV = NP + 8 * SK;
constexpr int DIN = 8480;
constexpr float RMS_EPS = 1e-6f, GN_EPS = 64e-5f;
constexpr float LOG2E = 1.4426950408889634f;
constexpr float QSCALE_MLA = 0.10206207261596577f * LOG2E;
constexpr float QSCALE_SB = 0.125f * LOG2E;

constexpr size_t O_Y = 0;
constexpr size_t O_WKV_P = (size_t)NT * D;
constexpr size_t O_SHIFT_P = O_WKV_P + (size_t)NL * 2 * 8 * 4096;
constexpr size_t O_CKV_P = O_SHIFT_P + (size_t)NL * 2 * 1664;
constexpr size_t O_KROPE_P = O_CKV_P + (size_t)NL * NP * 256;
constexpr size_t O_SBK_P = O_KROPE_P + (size_t)NL * NP * 32;
constexpr size_t O_SBV_P = O_SBK_P + (size_t)NL * NP * 512;
constexpr size_t O_WKV_S = O_SBV_P + (size_t)NL * NP * 512;
constexpr size_t O_SHIFT_S = O_WKV_S + (size_t)NL * 8 * 8 * 4096;
constexpr size_t O_CKV_S = O_SHIFT_S + (size_t)NL * 8 * 1664;
constexpr size_t O_KROPE_S = O_CKV_S + (size_t)NL * NS * 256;
constexpr size_t O_SBK_S = O_KROPE_S + (size_t)NL * NS * 32;
constexpr size_t O_SBV_S = O_SBK_S + (size_t)NL * NS * 512;

constexpr size_t al(size_t x) { return (x + 255) & ~(size_t)255; }
constexpr size_t W_WINT = 0;
constexpr size_t W_WBRT = al(W_WINT + (size_t)DIN * 1024 * 2);
constexpr size_t W_WOUTT = al(W_WBRT + (size_t)NL * 3 * 1024 * 512 * 2);
constexpr size_t W_WUQT = al(W_WOUTT + (size_t)NL * 1024 * 1024 * 2);
constexpr size_t W_WUKVT = al(W_WUQT + (size_t)NL * 768 * 384 * 2);
constexpr size_t W_WUPT = al(W_WUKVT + (size_t)NL * 1024 * 256 * 2);
constexpr size_t W_AUPT = al(W_WUPT + (size_t)NL * 512 * 64 * 2);
constexpr size_t W_MOD = al(W_AUPT + (size_t)NL * 512 * 64 * 2);
constexpr size_t W_ROPE = al(W_MOD + (size_t)NL * 10 * 3072 * 4);
constexpr size_t W_CTR = al(W_ROPE + (size_t)8192 * 32 * 4);
constexpr size_t W_XBAR = W_CTR + 256;
constexpr size_t W_H = al(W_XBAR + 3456 * 4);
constexpr size_t W_PR = al(W_H + (size_t)NT * 1024 * 2);
constexpr size_t W_YG = W_PR;
constexpr size_t W_YRAW = al(W_YG + (size_t)3 * NT * 512 * 2);
constexpr size_t W_MG = W_YRAW;
constexpr size_t W_Z = al(W_PR + (size_t)NT * 1664 * 4);
constexpr size_t W_CQ = al(W_Z + (size_t)3 * NT * 512 * 2);
constexpr size_t W_QF = W_CQ;
constexpr size_t W_CKV = al(W_CQ + (size_t)NT * 768 * 2);
constexpr size_t W_KR = al(W_CKV + (size_t)NT * 256 * 4);
constexpr size_t W_QN = al(W_KR + (size_t)NT * 32 * 4);
constexpr size_t W_CKVN = al(W_QN + (size_t)NT * 384 * 2);
constexpr size_t W_SQ = al(W_CKVN + (size_t)(NKV + 64) * 256 * 2);
constexpr size_t W_SBK = al(W_SQ + (size_t)NT * 512 * 2);
constexpr size_t VT_S_OFF = (size_t)16 * 64 * 8192;
constexpr size_t VT_ELEMS = VT_S_OFF + (size_t)64 * 64 * SK + 256;
constexpr size_t W_SBVT = al(W_SBK + (size_t)(NKV + 64) * 512 * 2);
constexpr size_t W_RWW = al(W_SBVT + VT_ELEMS * 2);
constexpr size_t W_RWX = al(W_RWW + (size_t)NT * 512 * 4);
constexpr size_t W_RHO = al(W_RWX + (size_t)NT * 5 * 512 * 2);
constexpr size_t W_KF = al(W_RHO + (size_t)NT * 8 * 4);
constexpr size_t W_MLAVT = al(W_KF + (size_t)(NKV + 64) * 768 * 2);
constexpr size_t W_SLOC = al(W_MLAVT + VT_ELEMS * 2);
constexpr size_t W_PMAT = al(W_SLOC + (size_t)16 * 7 * 4096 * 4);
constexpr size_t W_TOTAL = al(W_PMAT + (size_t)16 * 7 * 4096 * 4);
static_assert((size_t)NT * 384 * 4 <= (size_t)NT * 768 * 2, "alias");
static_assert(W_YRAW + (size_t)NT * 1024 * 2 <= W_Z, "alias overflow");

struct Params {
  const float* in[36];
  float* out;
  unsigned char* ws;
};

constexpr int SMEM_BYTES = 73728;

DI int TIDX() { int t = __builtin_amdgcn_workitem_id_x(); asm volatile("" : "+v"(t)); return t; }
DI u16 f2bf(float x) { return __builtin_bit_cast(u16, (__bf16)x); }
DI unsigned pk2(float a, float b) { f2_t v = {a, b}; return __builtin_bit_cast(unsigned, __builtin_convertvector(v, bf2_t)); }
DI float bf2f(u16 x) { return __uint_as_float((unsigned)x << 16); }
DI float bflo(unsigned x) { return __uint_as_float(x << 16); }
DI float bfhi(unsigned x) { return __uint_as_float(x & 0xffff0000u); }
DI float ex2(float x) { return __builtin_amdgcn_exp2f(x); }
DI float lg2(float x) { return __builtin_amdgcn_logf(x); }
DI float sigmoidf_(float x) { return 1.f / (1.f + __expf(-x)); }
DI float siluf_(float x) { return x / (1.f + __expf(-x)); }
DI float softplusf_(float x) { return fmaxf(x, 0.f) + log1pf(__expf(-fabsf(x))); }
DI int crow(int i, int hl) { return (i & 3) + 8 * (i >> 2) + 4 * hl; }
template <int CTRL> DI float dppf(float x) {
  return __int_as_float(__builtin_amdgcn_update_dpp(__float_as_int(x), __float_as_int(x), CTRL, 0xF, 0xF, false));
}
DI float allreduce16(float x) {
  x += dppf<0xB1>(x); x += dppf<0x4E>(x); x += dppf<0x141>(x); x += dppf<0x140>(x); return x;
}
DI float red32(float x) {
  x += __shfl_xor(x, 1); x += __shfl_xor(x, 2); x += __shfl_xor(x, 4); x += __shfl_xor(x, 8); x += __shfl_xor(x, 16); return x;
}
DI float red64(float x) { x = red32(x); x += __shfl_xor(x, 32); return x; }
DI int bidx_of(int row) { return row < NP ? (row >> 13) : 2 + ((row - NP) >> 4); }
DI int keyrow_of(int row) { return row < NP ? row : NP + ((row - NP) >> 4) * SK + PAST + ((row - NP) & 15); }
DI int pos_of(int row) { return row < NP ? (row & 8191) : PAST + ((row - NP) & 15); }
DI size_t vt_off(int keyrow, int h, int d) {
  if (keyrow < NP) { int b = keyrow >> 13, s = keyrow & 8191; return ((size_t)((b * 8 + h) * 64 + d)) * 8192 + s; }
  int rr = keyrow - NP; int b = rr / SK, s = rr - b * SK; return VT_S_OFF + ((size_t)((b * 8 + h) * 64 + d)) * SK + s;
}

DI void gemm_mainloop(f32x16 (&acc)[2][2], const u16* A, int lda, const u16* Bt, int ldb, int K, unsigned char* smem) {
  u16* s0 = (u16*)smem;
  const int tid = TIDX(), lane = tid & 63, wave = tid >> 6, wm = wave >> 1, wn = wave & 1;
  const int lr = tid >> 3, lc = (tid & 7) * 8;
  const u16* Ap = A + (size_t)lr * lda + lc;
  const u16* Bp = Bt + (size_t)lr * ldb + lc;
  u32x4 ra[4], rb[4];
  const int nk = K >> 6;
  const int r = lane & 31, hl = lane >> 5;
#pragma unroll
  for (int i = 0; i < 4; i++) { ra[i] = *(const u32x4*)(Ap + (size_t)(32 * i) * lda); rb[i] = *(const u32x4*)(Bp + (size_t)(32 * i) * ldb); }
  __syncthreads();
#pragma unroll
  for (int i = 0; i < 4; i++) { *(u32x4*)(s0 + (lr + 32 * i) * 72 + lc) = ra[i]; *(u32x4*)(s0 + 128 * 72 + (lr + 32 * i) * 72 + lc) = rb[i]; }
  if (nk > 1) { Ap += 64; Bp += 64; }
#pragma unroll
  for (int i = 0; i < 4; i++) { ra[i] = *(const u32x4*)(Ap + (size_t)(32 * i) * lda); rb[i] = *(const u32x4*)(Bp + (size_t)(32 * i) * ldb); }
  __syncthreads();
  for (int kt = 0; kt < nk; kt++) {
    u16* sA = s0 + (kt & 1) * (256 * 72); u16* sB = sA + 128 * 72;
    if (kt + 1 < nk) {
      u16* nA = s0 + ((kt + 1) & 1) * (256 * 72); u16* nB = nA + 128 * 72;
#pragma unroll
      for (int i = 0; i < 4; i++) { *(u32x4*)(nA + (lr + 32 * i) * 72 + lc) = ra[i]; *(u32x4*)(nB + (lr + 32 * i) * 72 + lc) = rb[i]; }
    }
    if (kt + 2 < nk) { Ap += 64; Bp += 64; }
#pragma unroll
    for (int i = 0; i < 4; i++) { ra[i] = *(const u32x4*)(Ap + (size_t)(32 * i) * lda); rb[i] = *(const u32x4*)(Bp + (size_t)(32 * i) * ldb); }
#pragma unroll
    for (int ks = 0; ks < 4; ks++) {
      bf16x8 af[2], bfr[2];
#pragma unroll
      for (int b = 0; b < 2; b++) {
        af[b] = *(const bf16x8*)(sA + (wm * 64 + b * 32 + r) * 72 + ks * 16 + hl * 8);
        bfr[b] = *(const bf16x8*)(sB + (wn * 64 + b * 32 + r) * 72 + ks * 16 + hl * 8);
      }
#pragma unroll
      for (int bm = 0; bm < 2; bm++)
#pragma unroll
        for (int bn = 0; bn < 2; bn++) acc[bm][bn] = MFMA32(af[bm], bfr[bn], acc[bm][bn]);
    }
    __syncthreads();
  }
}
DI void zero_acc(f32x16 (&acc)[2][2]) {
#pragma unroll
  for (int a = 0; a < 2; a++)
#pragma unroll
    for (int b = 0; b < 2; b++)
#pragma unroll
      for (int i = 0; i < 16; i++) acc[a][b][i] = 0.f;
}
template <class F> DI void foreach_acc(f32x16 (&acc)[2][2], int m0, int n0, F f) {
  const int lane = TIDX() & 63, wave = TIDX() >> 6, wm = wave >> 1, wn = wave & 1, r = lane & 31, hl = lane >> 5;
#pragma unroll
  for (int bm = 0; bm < 2; bm++)
#pragma unroll
    for (int bn = 0; bn < 2; bn++)
#pragma unroll
      for (int i = 0; i < 16; i++) f(m0 + wm * 64 + bm * 32 + crow(i, hl), n0 + wn * 64 + bn * 32 + r, acc[bm][bn][i]);
}

DI void transpose_tile(const float* __restrict__ src, int K, int N, u16* __restrict__ dst, int kt, int nt, int mode, unsigned char* smem) {
  float* tile = (float*)smem;
  const int tid = TIDX(), tx = tid & 63, ty = tid >> 6;
  const int k0 = kt * 64, n0 = nt * 64;
  __syncthreads();
#pragma unroll 4
  for (int i = 0; i < 16; i++) { int k = i * 4 + ty; int n = n0 + tx; tile[k * 65 + tx] = (n < N) ? src[(size_t)(k0 + k) * N + n] : 0.f; }
  __syncthreads();
#pragma unroll 4
  for (int i = 0; i < 16; i++) {
    int nl = i * 4 + ty; int n = n0 + nl;
    if (n < N) {
      int nd = n;
      if (mode == 1) { int hd = n / 96, d = n - hd * 96; nd = d < 64 ? hd * 64 + d : 512 + hd * 32 + (d - 64); }
      dst[(size_t)nd * K + k0 + tx] = f2bf(tile[tx * 65 + nl]);
    }
  }
}
constexpr int WIN_TT = 16 * 133;
DI void win_transpose_task(const Params& p, int l, int t, unsigned char* smem) {
  int kt = t & 15, nt = t >> 4;
  transpose_tile(p.in[13] + (size_t)l * 1024 * DIN, 1024, DIN, (u16*)(p.ws + W_WINT), kt, nt, 0, smem);
}
constexpr int SMALLW_TT = 384 + 256 + 72 + 64 + 8 + 8;
DI void smallw_transpose_task(const Params& p, int l, int t, unsigned char* smem) {
  if (t < 384) { int g = t / 128, q = t % 128; const float* src = p.in[g == 0 ? 24 : (g == 1 ? 33 : 34)] + (size_t)l * 512 * 1024;
    transpose_tile(src, 512, 1024, (u16*)(p.ws + W_WBRT) + ((size_t)(l * 3 + g)) * 1024 * 512, q & 7, q >> 3, 0, smem); return; }
  t -= 384;
  if (t < 256) { transpose_tile(p.in[35] + (size_t)l * 1024 * 1024, 1024, 1024, (u16*)(p.ws + W_WOUTT) + (size_t)l * 1024 * 1024, t & 15, t >> 4, 0, smem); return; }
  t -= 256;
  if (t < 72) { transpose_tile(p.in[26] + (size_t)l * 384 * 768, 384, 768, (u16*)(p.ws + W_WUQT) + (size_t)l * 768 * 384, t % 6, t / 6, 1, smem); return; }
  t -= 72;
  if (t < 64) { transpose_tile(p.in[28] + (size_t)l * 256 * 1024, 256, 1024, (u16*)(p.ws + W_WUKVT) + (size_t)l * 1024 * 256, t & 3, t >> 2, 0, smem); return; }
  t -= 64;
  if (t < 8) { transpose_tile(p.in[16] + (size_t)l * 64 * 512, 64, 512, (u16*)(p.ws + W_WUPT) + (size_t)l * 512 * 64, 0, t, 0, smem); return; }
  t -= 8;
  transpose_tile(p.in[18] + (size_t)l * 64 * 512, 64, 512, (u16*)(p.ws + W_AUPT) + (size_t)l * 512 * 64, 0, t, 0, smem);
}
DI void mod_task(const Params& p, int task, unsigned char* smem) {
  float* sm = (float*)smem;
  const int tid = TIDX(), l = task / 48, cb = task % 48, kq = tid >> 6, cl = tid & 63, col = cb * 64 + cl;
  __syncthreads();
  for (int e = tid; e < 10240; e += 256) { int r = e >> 10, k = e & 1023; float c = r < 2 ? p.in[8][r * 1024 + k] : p.in[9][(r - 2) * 1024 + k]; sm[e] = siluf_(c); }
  __syncthreads();
  float acc[10];
#pragma unroll
  for (int r = 0; r < 10; r++) acc[r] = 0.f;
  const float* w = p.in[10] + ((size_t)l * 1024 + kq * 256) * 3072 + col;
#pragma unroll 8
  for (int k = 0; k < 256; k++) {
    float wv = w[(size_t)k * 3072];
#pragma unroll
    for (int r = 0; r < 10; r++) acc[r] += sm[r * 1024 + kq * 256 + k] * wv;
  }
  __syncthreads();
#pragma unroll
  for (int r = 0; r < 10; r++) sm[(kq * 10 + r) * 64 + cl] = acc[r];
  __syncthreads();
  if (tid < 64) {
    float* mod = (float*)(p.ws + W_MOD);
    float bb = p.in[11][l * 3072 + col];
#pragma unroll
    for (int r = 0; r < 10; r++) mod[(l * 10 + r) * 3072 + col] = sm[r * 64 + cl] + sm[(10 + r) * 64 + cl] + sm[(20 + r) * 64 + cl] + sm[(30 + r) * 64 + cl] + bb;
  }
}
DI void rope_task(const Params& p, int task) {
  const int tid = TIDX(); const int pos = task * 128 + (tid >> 1);
  float* rope = (float*)(p.ws + W_ROPE);
  for (int ff = 0; ff < 8; ff++) {
    int f = (tid & 1) * 8 + ff;
    double inv = 1.0; for (int j = 0; j < f; j++) inv *= 0.5623413251903491;
    double ang = (double)pos * inv;
    double n = rint(ang * 0.15915494309189535);
    double rr = ang - n * 6.283185307179586 - n * 2.4492935982947064e-16;
    double r2 = rr * rr, sn = rr, cs = 1.0, ts = rr, tc = 1.0;
    for (int k = 1; k <= 15; k++) { tc *= -r2 / (double)((2 * k - 1) * (2 * k)); cs += tc; ts *= -r2 / (double)((2 * k) * (2 * k + 1)); sn += ts; }
    rope[pos * 32 + f] = (float)cs; rope[pos * 32 + 16 + f] = (float)sn;
  }
}
DI void phase0(const Params& p, unsigned char* smem) {
  const int n_tr = WIN_TT + NL * SMALLW_TT, total = n_tr + 192 + 64;
  for (int t = blockIdx.x; t < total; t += gridDim.x) {
    if (t < 192) mod_task(p, t, smem);
    else if (t < 192 + 64) rope_task(p, t - 192);
    else { int q = t - 256; if (q < WIN_TT) win_transpose_task(p, 0, q, smem); else { q -= WIN_TT; smallw_transpose_task(p, q / SMALLW_TT, q % SMALLW_TT, smem); } }
  }
}

DI const float* xrow_ptr(const Params& p, int l, int row) {
  if (l > 0) return p.out + (size_t)row * D;
  return row < NP ? p.in[0] + (size_t)row * D : p.in[1] + (size_t)(row - NP) * D;
}
DI void phase1(const Params& p, int l) {
  const int lane = TIDX() & 63, wave = TIDX() >> 6;
  const float* mod = (const float*)(p.ws + W_MOD);
  const float* g = p.in[12] + l * 1024;
  u16* H = (u16*)(p.ws + W_H);
  for (int task = blockIdx.x; task < NT / 4; task += gridDim.x) {
    int row = task * 4 + wave;
    const float* x = xrow_ptr(p, l, row);
    const float* md = mod + (l * 10 + bidx_of(row)) * 3072;
    float4 v[4]; float ss = 0.f;
#pragma unroll
    for (int j = 0; j < 4; j++) { v[j] = *(const float4*)(x + (j * 64 + lane) * 4); ss += v[j].x * v[j].x + v[j].y * v[j].y + v[j].z * v[j].z + v[j].w * v[j].w; }
    ss = red64(ss);
    float rstd = rsqrtf(ss * (1.f / 1024.f) + RMS_EPS);
#pragma unroll
    for (int j = 0; j < 4; j++) {
      int c = (j * 64 + lane) * 4;
      float4 gg = *(const float4*)(g + c), sh = *(const float4*)(md + c), sc = *(const float4*)(md + 1024 + c);
      float h0 = v[j].x * rstd * gg.x * (1.f + sc.x) + sh.x, h1 = v[j].y * rstd * gg.y * (1.f + sc.y) + sh.y;
      float h2 = v[j].z * rstd * gg.z * (1.f + sc.z) + sh.z, h3 = v[j].w * rstd * gg.w * (1.f + sc.w) + sh.w;
      uint2 o; o.x = pk2(h0, h1); o.y = pk2(h2, h3);
      *(uint2*)(H + (size_t)row * 1024 + c) = o;
    }
  }
}

DI void phase2(const Params& p, int l, unsigned char* smem) {
  const u16* H = (const u16*)(p.ws + W_H);
  const u16* WinT = (const u16*)(p.ws + W_WINT);
  float* PR = (float*)(p.ws + W_PR);
  u16* Z = (u16*)(p.ws + W_Z);
  float* CQ = (float*)(p.ws + W_CQ); float* CKV = (float*)(p.ws + W_CKV); float* KR = (float*)(p.ws + W_KR);
  u16* SQ = (u16*)(p.ws + W_SQ); u16* SBK = (u16*)(p.ws + W_SBK); u16* SBVT = (u16*)(p.ws + W_SBVT);
  float* out = p.out;
  for (int ts = blockIdx.x; ts < 11 * 512; ts += gridDim.x) {
    int mt, nt;
    {
      const int rd = ts >> 9, bq = ts & 511, sm = bq & 7, j = bq >> 3;
      mt = sm * 16 + (j & 15); nt = rd * 4 + (j >> 4);
      if (nt >= 43) { const int e = sm * 16 + (j & 15); if (e >= 43) continue; mt = 128; nt = e; }
    }
    const int m0 = mt * 128;
    int seg, n0, c0;
    if (nt < 13) { seg = 0; c0 = nt * 128; n0 = c0; }
    else if (nt < 17) { seg = 1; c0 = (nt - 13) * 128; n0 = 1664 + c0; }
    else if (nt < 20) { seg = 2; c0 = (nt - 17) * 128; n0 = 2176 + c0; }
    else if (nt < 22) { seg = 3; c0 = (nt - 20) * 128; n0 = 2560 + c0; }
    else if (nt < 26) { seg = 4; c0 = (nt - 22) * 128; n0 = 2848 + c0; }
    else if (nt < 30) { seg = 5; c0 = (nt - 26) * 128; n0 = 3360 + c0; }
    else if (nt < 34) { seg = 6; c0 = (nt - 30) * 128; n0 = 3872 + c0; }
    else if (nt < 38) { seg = 7; c0 = (nt - 34) * 128; n0 = 4384 + c0; }
    else if (nt < 42) { seg = 8; c0 = (nt - 38) * 128; n0 = 4896 + c0; }
    else { seg = 9; c0 = 0; n0 = 2816; }
    f32x16 acc[2][2]; zero_acc(acc);
    gemm_mainloop(acc, H + (size_t)m0 * 1024, 1024, WinT + (size_t)n0 * 1024, 1024, 1024, smem);
    if (seg == 0) {
      foreach_acc(acc, m0, c0, [&](int row, int col, float v) {
        PR[(size_t)row * 1664 + col] = v;
        if (row < NP) { if ((row & 8191) == 8191) out[O_SHIFT_P + (size_t)(l * 2 + (row >> 13)) * 1664 + col] = v; }
        else { int rr = row - NP; if ((rr & 15) == 15) out[O_SHIFT_S + (size_t)(l * 8 + (rr >> 4)) * 1664 + col] = v; }
      });
    } else if (seg == 1 || seg == 4 || seg == 8) {
      const int g = seg == 1 ? 0 : (seg == 4 ? 1 : 2);
      foreach_acc(acc, m0, c0, [&](int row, int col, float v) { Z[((size_t)g * NT + row) * 512 + col] = f2bf(siluf_(v)); });
    } else if (seg == 2) {
      foreach_acc(acc, m0, c0, [&](int row, int col, float v) { CQ[(size_t)row * 384 + col] = v; });
    } else if (seg == 3) {
      foreach_acc(acc, m0, c0, [&](int row, int col, float v) { CKV[(size_t)row * 256 + col] = v; });
    } else if (seg == 9) {
      foreach_acc(acc, m0, c0, [&](int row, int col, float v) { if (col < 32) KR[(size_t)row * 32 + col] = v; });
    } else if (seg == 5) {
      foreach_acc(acc, m0, c0, [&](int row, int col, float v) { SQ[(size_t)row * 512 + col] = f2bf(v * QSCALE_SB); });
    } else if (seg == 6) {
      foreach_acc(acc, m0, c0, [&](int row, int col, float v) {
        size_t oo = row < NP ? O_SBK_P + ((size_t)l * NP + row) * 512 + col : O_SBK_S + ((size_t)l * NS + (row - NP)) * 512 + col;
        out[oo] = v;
        SBK[(size_t)keyrow_of(row) * 512 + col] = f2bf(v);
      });
    } else {
      foreach_acc(acc, m0, c0, [&](int row, int col, float v) {
        size_t oo = row < NP ? O_SBV_P + ((size_t)l * NP + row) * 512 + col : O_SBV_S + ((size_t)l * NS + (row - NP)) * 512 + col;
        out[oo] = v;
      });
      const int lane = TIDX() & 63, wave = TIDX() >> 6, wm = wave >> 1, wn = wave & 1, r = lane & 31, hl = lane >> 5;
#pragma unroll
      for (int bm = 0; bm < 2; bm++)
#pragma unroll
        for (int bn = 0; bn < 2; bn++)
#pragma unroll
          for (int g4 = 0; g4 < 4; g4++) {
            int row = m0 + wm * 64 + bm * 32 + 8 * g4 + 4 * hl, col = c0 + wn * 64 + bn * 32 + r;
            uint2 o; o.x = pk2(acc[bm][bn][4 * g4], acc[bm][bn][4 * g4 + 1]); o.y = pk2(acc[bm][bn][4 * g4 + 2], acc[bm][bn][4 * g4 + 3]);
            *(uint2*)(SBVT + vt_off(keyrow_of(row), col >> 6, col & 63)) = o;
          }
    }
  }
}

DI const float* prev_ptr(const Params& p, int l, const float* PR, int row) {
  if (row < NP) return (row & 8191) ? PR + (size_t)(row - 1) * 1664 : nullptr;
  int rr = row - NP;
  return (rr & 15) ? PR + (size_t)(row - 1) * 1664 : p.in[3] + (size_t)(l * 8 + (rr >> 4)) * 1664;
}
DI void rwkv_prep_task(const Params& p, int l, int task) {
  const int lane = TIDX() & 63, wave = TIDX() >> 6, r = lane & 31, hl = lane >> 5;
  const int tile = task >> 1, hh = (task & 1) * 4 + wave, row0 = tile * 32;
  const float* PR = (const float*)(p.ws + W_PR);
  const float* mu = p.in[14] + l * 1664;
  f32x16 accW[1][2], accA[1][2];
#pragma unroll
  for (int b_ = 0; b_ < 2; b_++)
#pragma unroll
    for (int i_ = 0; i_ < 16; i_++) { accW[0][b_][i_] = 0.f; accA[0][b_][i_] = 0.f; }
  const u16* WupT = (const u16*)(p.ws + W_WUPT) + (size_t)l * 512 * 64;
  const u16* AupT = (const u16*)(p.ws + W_AUPT) + (size_t)l * 512 * 64;
#pragma unroll 1
  for (int ks = 0; ks < 4; ks++) {
    const int k0 = ks * 16 + hl * 8;
    bf16x8 bw[2], ba[2];
#pragma unroll
    for (int bn = 0; bn < 2; bn++) {
      bw[bn] = *(const bf16x8*)(WupT + (size_t)(hh * 64 + bn * 32 + r) * 64 + k0);
      ba[bn] = *(const bf16x8*)(AupT + (size_t)(hh * 64 + bn * 32 + r) * 64 + k0);
    }
#pragma unroll
    for (int bm = 0; bm < 1; bm++) {
      const int row = row0 + bm * 32 + r;
      const float* pp = PR + (size_t)row * 1664;
      const float* pv = prev_ptr(p, l, PR, row);
      float xw[8], xa[8];
#pragma unroll
      for (int q = 0; q < 2; q++) {
        float4 a = *(const float4*)(pp + 1536 + k0 + 4 * q), b = pv ? *(const float4*)(pv + 1536 + k0 + 4 * q) : make_float4(0, 0, 0, 0), m = *(const float4*)(mu + 1536 + k0 + 4 * q);
        xw[4 * q] = tanhf(a.x + (b.x - a.x) * m.x); xw[4 * q + 1] = tanhf(a.y + (b.y - a.y) * m.y); xw[4 * q + 2] = tanhf(a.z + (b.z - a.z) * m.z); xw[4 * q + 3] = tanhf(a.w + (b.w - a.w) * m.w);
        a = *(const float4*)(pp + 1600 + k0 + 4 * q); b = pv ? *(const float4*)(pv + 1600 + k0 + 4 * q) : make_float4(0, 0, 0, 0); m = *(const float4*)(mu + 1600 + k0 + 4 * q);
        xa[4 * q] = a.x + (b.x - a.x) * m.x; xa[4 * q + 1] = a.y + (b.y - a.y) * m.y; xa[4 * q + 2] = a.z + (b.z - a.z) * m.z; xa[4 * q + 3] = a.w + (b.w - a.w) * m.w;
      }
      u32x4 uw, ua;
      uw.x = pk2(xw[0], xw[1]); uw.y = pk2(xw[2], xw[3]); uw.z = pk2(xw[4], xw[5]); uw.w = pk2(xw[6], xw[7]);
      ua.x = pk2(xa[0], xa[1]); ua.y = pk2(xa[2], xa[3]); ua.z = pk2(xa[4], xa[5]); ua.w = pk2(xa[6], xa[7]);
      bf16x8 awf = __builtin_bit_cast(bf16x8, uw), aaf = __builtin_bit_cast(bf16x8, ua);
#pragma unroll
      for (int bn = 0; bn < 2; bn++) { accW[bm][bn] = MFMA32(awf, bw[bn], accW[bm][bn]); accA[bm][bn] = MFMA32(aaf, ba[bn], accA[bm][bn]); }
    }
  }
  float* RWW = (float*)(p.ws + W_RWW); u16* RWX = (u16*)(p.ws + W_RWX); float* RHO = (float*)(p.ws + W_RHO);
  float mur[2], muk[2], muv[2], w0[2], a0[2], kk_[2], ka_[2], rk_[2];
#pragma unroll
  for (int bn = 0; bn < 2; bn++) {
    int col = hh * 64 + bn * 32 + r;
    mur[bn] = mu[col]; muk[bn] = mu[512 + col]; muv[bn] = mu[1024 + col];
    w0[bn] = p.in[15][l * 512 + col]; a0[bn] = p.in[17][l * 512 + col]; kk_[bn] = p.in[19][l * 512 + col]; ka_[bn] = p.in[20][l * 512 + col]; rk_[bn] = p.in[21][l * 512 + col];
  }
#pragma unroll
  for (int bm = 0; bm < 1; bm++)
#pragma unroll
    for (int i = 0; i < 16; i++) {
      const int row = row0 + bm * 32 + crow(i, hl);
      const float* pp = PR + (size_t)row * 1664;
      const float* pv = prev_ptr(p, l, PR, row);
      float xr[2], xv[2], kp[2], kkr[2], av[2], dec[2];
      float ssq = 0.f, rho = 0.f;
#pragma unroll
      for (int bn = 0; bn < 2; bn++) {
        int col = hh * 64 + bn * 32 + r;
        float pr_ = pp[col], pk_ = pp[512 + col], pv_ = pp[1024 + col];
        float qr = pv ? pv[col] : 0.f, qk = pv ? pv[512 + col] : 0.f, qv = pv ? pv[1024 + col] : 0.f;
        xr[bn] = pr_ + (qr - pr_) * mur[bn];
        float xk = pk_ + (qk - pk_) * muk[bn];
        xv[bn] = pv_ + (qv - pv_) * muv[bn];
        float wpre = w0[bn] + accW[bm][bn][i];
        float wlog = -softplusf_(-wpre) - 0.5f;
        dec[bn] = __expf(-__expf(wlog));
        av[bn] = sigmoidf_(a0[bn] + accA[bm][bn][i]);
        kkr[bn] = xk * kk_[bn];
        kp[bn] = xk * (1.f + (av[bn] - 1.f) * ka_[bn]);
        ssq += kkr[bn] * kkr[bn];
        rho += xr[bn] * kp[bn] * rk_[bn];
      }
      ssq = red32(ssq); rho = red32(rho);
      float inv = 1.f / fmaxf(sqrtf(ssq), 1e-12f);
#pragma unroll
      for (int bn = 0; bn < 2; bn++) {
        int col = hh * 64 + bn * 32 + r;
        float kk = kkr[bn] * inv;
        RWW[(size_t)row * 512 + col] = dec[bn];
        u16* rx = RWX + (size_t)row * 2560 + col;
        rx[0] = f2bf(xr[bn]); rx[512] = f2bf(kp[bn]); rx[1024] = f2bf(xv[bn]); rx[1536] = f2bf(kk); rx[2048] = f2bf(kk * av[bn]);
      }
      if (r == 0) RHO[(size_t)row * 8 + hh] = rho;
    }
}
DI void norm_row_task(const Params& p, int l, int task) {
  const int lane = TIDX() & 63, wave = TIDX() >> 6;
  const int row = task * 4 + wave;
  const float* CQ = (const float*)(p.ws + W_CQ); const float* CKV = (const float*)(p.ws + W_CKV); const float* KR = (const float*)(p.ws + W_KR);
  u16* QN = (u16*)(p.ws + W_QN); u16* CKVN = (u16*)(p.ws + W_CKVN); u16* KF = (u16*)(p.ws + W_KF);
  const int keyrow = keyrow_of(row);
  {
    float v[6], ss = 0.f;
#pragma unroll
    for (int j = 0; j < 6; j++) { v[j] = CQ[(size_t)row * 384 + j * 64 + lane]; ss += v[j] * v[j]; }
    ss = red64(ss); float rstd = rsqrtf(ss * (1.f / 384.f) + RMS_EPS);
#pragma unroll
    for (int j = 0; j < 6; j++) QN[(size_t)row * 384 + j * 64 + lane] = f2bf(v[j] * rstd * p.in[25][l * 384 + j * 64 + lane]);
  }
  {
    float4 v = *(const float4*)(CKV + (size_t)row * 256 + lane * 4);
    float ss = red64(v.x * v.x + v.y * v.y + v.z * v.z + v.w * v.w);
    float rstd = rsqrtf(ss * (1.f / 256.f) + RMS_EPS);
    float4 g = *(const float4*)(p.in[27] + l * 256 + lane * 4);
    float4 o = make_float4(v.x * rstd * g.x, v.y * rstd * g.y, v.z * rstd * g.z, v.w * rstd * g.w);
    size_t oo = row < NP ? O_CKV_P + ((size_t)l * NP + row) * 256 : O_CKV_S + ((size_t)l * NS + (row - NP)) * 256;
    *(float4*)(p.out + oo + lane * 4) = o;
    uint2 ob; ob.x = pk2(o.x, o.y); ob.y = pk2(o.z, o.w);
    *(uint2*)(CKVN + (size_t)keyrow * 256 + lane * 4) = ob;
  }
  {
    float x = lane < 32 ? KR[(size_t)row * 32 + lane] : 0.f;
    float ss = red64(x * x); float rstd = rsqrtf(ss * (1.f / 32.f) + RMS_EPS);
    float xn = x * rstd * p.in[32][l * 32 + (lane & 31)];
    float pt = __shfl_xor(xn, 16);
    const float* rp = (const float*)(p.ws + W_ROPE) + pos_of(row) * 32;
    float cs = rp[lane & 15], sn = rp[16 + (lane & 15)];
    float o = (lane & 16) ? (pt * sn + xn * cs) : (xn * cs - pt * sn);
    if (lane < 32) {
      size_t oo = row < NP ? O_KROPE_P + ((size_t)l * NP + row) * 32 : O_KROPE_S + ((size_t)l * NS + (row - NP)) * 32;
      p.out[oo + lane] = o;
      u16 ob = f2bf(o);
#pragma unroll
      for (int hd = 0; hd < 8; hd++) KF[(size_t)keyrow * 768 + hd * 96 + 64 + lane] = ob;
    }
  }
}
DI void past_convert_task(const Params& p, int l, int task) {
  const int tid = TIDX();
  if (task < 2048) {
    size_t e = ((size_t)task * 256 + tid) * 8; int rowp = (int)(e >> 8), c = (int)(e & 255); int b = rowp >> 11, s = rowp & 2047;
    const float* src = p.in[4] + ((size_t)(l * 8 + b) * PAST + s) * 256 + c;
    float4 a = *(const float4*)src, bq = *(const float4*)(src + 4);
    uint4 o; o.x = pk2(a.x, a.y); o.y = pk2(a.z, a.w); o.z = pk2(bq.x, bq.y); o.w = pk2(bq.z, bq.w);
    *(uint4*)((u16*)(p.ws + W_CKVN) + (size_t)(NP + b * SK + s) * 256 + c) = o; return;
  }
  task -= 2048;
  if (task < 4096) {
    size_t e = ((size_t)task * 256 + tid) * 8; int rowp = (int)(e >> 9), c = (int)(e & 511); int b = rowp >> 11, s = rowp & 2047;
    const float* src = p.in[6] + ((size_t)(l * 8 + b) * PAST + s) * 512 + c;
    float4 a = *(const float4*)src, bq = *(const float4*)(src + 4);
    uint4 o; o.x = pk2(a.x, a.y); o.y = pk2(a.z, a.w); o.z = pk2(bq.x, bq.y); o.w = pk2(bq.z, bq.w);
    *(uint4*)((u16*)(p.ws + W_SBK) + (size_t)(NP + b * SK + s) * 512 + c) = o; return;
  }
  task -= 4096;
  if (task < 4096) {
    int id = task * 256 + tid; int c = id & 511, sg = (id >> 9) & 255, b = id >> 17;
    const float* src = p.in[7] + ((size_t)(l * 8 + b) * PAST + sg * 8) * 512 + c;
    float v[8];
#pragma unroll
    for (int j = 0; j < 8; j++) v[j] = src[(size_t)j * 512];
    uint4 o; o.x = pk2(v[0], v[1]); o.y = pk2(v[2], v[3]); o.z = pk2(v[4], v[5]); o.w = pk2(v[6], v[7]);
    *(uint4*)((u16*)(p.ws + W_SBVT) + VT_S_OFF + ((size_t)((b * 8 + (c >> 6)) * 64 + (c & 63))) * SK + sg * 8) = o; return;
  }
  task -= 4096;
  {
    int id = task * 256 + tid; int ch = id & 7, rowp = id >> 3; int b = rowp >> 11, s = rowp & 2047;
    float4 a = *(const float4*)(p.in[5] + ((size_t)(l * 8 + b) * PAST + s) * 32 + ch * 4);
    uint2 o; o.x = pk2(a.x, a.y); o.y = pk2(a.z, a.w);
    u16* dst = (u16*)(p.ws + W_KF) + (size_t)(NP + b * SK + s) * 768 + 64 + ch * 4;
#pragma unroll
    for (int hd = 0; hd < 8; hd++) *(uint2*)(dst + hd * 96) = o;
  }
}
DI void phase3(const Params& p, int l) {
  const int nA = 1032, nB = NT / 4, nC = 2048 + 4096 + 4096 + 512, total = nA + nB + nC;
  for (int t = blockIdx.x; t < total; t += gridDim.x) {
    if (t < nA) rwkv_prep_task(p, l, t);
    else if (t < nA + nB) norm_row_task(p, l, t - nA);
    else past_convert_task(p, l, t - nA - nB);
  }
}

DI void rwkv_pass1_task(const Params& p, int bh, int seg, int rq, unsigned char* smem);
DI void phase4(const Params& p, int l, unsigned char* smem) {
  const int lane = TIDX() & 63, wave = TIDX() >> 6, wm = wave >> 1, wn = wave & 1, r = lane & 31, hl = lane >> 5;
  const float* rope = (const float*)(p.ws + W_ROPE);
  u16* QF = (u16*)(p.ws + W_QF); u16* KF = (u16*)(p.ws + W_KF); u16* VT = (u16*)(p.ws + W_MLAVT);
  const int nQ = 129 * 6, nKV = 257 * 8;
  __shared__ int s_task4;
  int* ctr4 = (int*)(p.ws + W_CTR) + 8 + l;
  while (true) {
    __syncthreads();
    if (TIDX() == 0) s_task4 = atomicAdd(ctr4, 1);
    __syncthreads();
    const int q4 = s_task4;
    if (q4 >= 448 + nQ + nKV) break;
    const int t0 = q4 < 896 ? ((q4 & 1) ? 448 + (q4 >> 1) : (q4 >> 1)) : q4;
    if (t0 < 448) { int bh = t0 / 28, rem = t0 - bh * 28; rwkv_pass1_task(p, bh, rem >> 2, rem & 3, smem); continue; }
    const int t = t0 - 448;
    f32x16 acc[2][2]; zero_acc(acc);
    if (t < nQ) {
      const int mt = t % 129, nt = t / 129, m0 = mt * 128;
      gemm_mainloop(acc, (const u16*)(p.ws + W_QN) + (size_t)m0 * 384, 384, (const u16*)(p.ws + W_WUQT) + ((size_t)l * 768 + nt * 128) * 384, 384, 384, smem);
      if (nt < 4) {
        const int head = nt * 2 + wn;
        float g0 = p.in[29][l * 64 + r] * QSCALE_MLA, g1 = p.in[29][l * 64 + 32 + r] * QSCALE_MLA;
#pragma unroll
        for (int bm = 0; bm < 2; bm++)
#pragma unroll
          for (int i = 0; i < 16; i++) {
            float a = acc[bm][0][i], b = acc[bm][1][i];
            float ss = red32(a * a + b * b); float rstd = rsqrtf(ss * (1.f / 64.f) + RMS_EPS);
            int row = m0 + wm * 64 + bm * 32 + crow(i, hl);
            u16* q = QF + (size_t)row * 768 + head * 96;
            q[r] = f2bf(a * rstd * g0); q[32 + r] = f2bf(b * rstd * g1);
          }
      } else {
        float g = p.in[30][l * 32 + r] * QSCALE_MLA;
#pragma unroll
        for (int bm = 0; bm < 2; bm++)
#pragma unroll
          for (int bn = 0; bn < 2; bn++)
#pragma unroll
            for (int i = 0; i < 16; i++) {
              const int head = (nt - 4) * 4 + wn * 2 + bn;
              float a = acc[bm][bn][i];
              float ss = red32(a * a); float rstd = rsqrtf(ss * (1.f / 32.f) + RMS_EPS);
              float xn = a * rstd * g; float pt = __shfl_xor(xn, 16);
              int row = m0 + wm * 64 + bm * 32 + crow(i, hl);
              const float* rp = rope + pos_of(row) * 32;
              float cs = rp[r & 15], sn = rp[16 + (r & 15)];
              float o = (r & 16) ? (pt * sn + xn * cs) : (xn * cs - pt * sn);
              QF[(size_t)row * 768 + head * 96 + 64 + r] = f2bf(o);
            }
      }
    } else {
      const int q = t - nQ, mt = q % 257, head = q / 257, m0 = mt * 128;
      gemm_mainloop(acc, (const u16*)(p.ws + W_CKVN) + (size_t)m0 * 256, 256, (const u16*)(p.ws + W_WUKVT) + ((size_t)l * 1024 + head * 128) * 256, 256, 256, smem);
      if (wn == 0) {
        float g0 = p.in[31][l * 64 + r], g1 = p.in[31][l * 64 + 32 + r];
#pragma unroll
        for (int bm = 0; bm < 2; bm++)
#pragma unroll
          for (int i = 0; i < 16; i++) {
            float a = acc[bm][0][i], b = acc[bm][1][i];
            float ss = red32(a * a + b * b); float rstd = rsqrtf(ss * (1.f / 64.f) + RMS_EPS);
            int krow = m0 + wm * 64 + bm * 32 + crow(i, hl);
            u16* k = KF + (size_t)krow * 768 + head * 96;
            k[r] = f2bf(a * rstd * g0); k[32 + r] = f2bf(b * rstd * g1);
          }
      } else {
#pragma unroll
        for (int bm = 0; bm < 2; bm++)
#pragma unroll
          for (int bn = 0; bn < 2; bn++)
#pragma unroll
            for (int g4 = 0; g4 < 4; g4++) {
              int krow = m0 + wm * 64 + bm * 32 + 8 * g4 + 4 * hl, d = bn * 32 + r;
              uint2 o; o.x = pk2(acc[bm][bn][4 * g4], acc[bm][bn][4 * g4 + 1]); o.y = pk2(acc[bm][bn][4 * g4 + 2], acc[bm][bn][4 * g4 + 3]);
              *(uint2*)(VT + vt_off(krow, head, d)) = o;
            }
      }
    }
  }
}

template <int DK, bool SB>
DI void attn_task(const u16* __restrict__ Qp, int qstride, int nq_valid, const u16* __restrict__ Kp, int kstride,
                  const u16* __restrict__ Vtp, int vstride, int nkeys, int qpos0,
                  const u16* __restrict__ Zp, u16* __restrict__ Yp, unsigned char* smem) {
  constexpr int KS = DK / 16, KSTR = DK + 8, KCH = DK / 8, NKL = 64 * KCH / 256;
  u16* sK = (u16*)smem; u16* sV = sK + 64 * KSTR;
  const int tid = TIDX(), lane = tid & 63, wave = tid >> 6, r = lane & 31, hl = lane >> 5;
  const int slot = wave * 32 + r;
  const bool wave_active = wave * 32 < nq_valid;
  const int qpos = qpos0 + slot;
  bf16x8 qf[KS];
  {
    const u16* qrow = Qp + (size_t)(slot < nq_valid ? slot : 0) * qstride + hl * 8;
#pragma unroll
    for (int ks = 0; ks < KS; ks++) qf[ks] = *(const bf16x8*)(qrow + ks * 16);
  }
  f32x16 O[2];
#pragma unroll
  for (int b = 0; b < 2; b++)
#pragma unroll
    for (int i = 0; i < 16; i++) O[b][i] = 0.f;
  float m_run = -1e30f, l_run = 0.f, R = 1.f;
  const int last_qpos = qpos0 + nq_valid - 1;
  int ntiles = SB ? (last_qpos - 1) / 64 + 1 : last_qpos / 64 + 1;
  { int mx = (nkeys + 63) >> 6; if (ntiles > mx) ntiles = mx; }
  const int wave_q0 = qpos0 + wave * 32;
  u32x4 rk[NKL], rv[2];
  auto prefetch = [&](int kt) {
#pragma unroll
    for (int i = 0; i < NKL; i++) { int c = tid + 256 * i; int row = c / KCH, ch = c - row * KCH; rk[i] = *(const u32x4*)(Kp + (size_t)(kt * 64 + row) * kstride + ch * 8); }
#pragma unroll
    for (int i = 0; i < 2; i++) { int c = tid + 256 * i; int row = c >> 3, ch = c & 7; rv[i] = *(const u32x4*)(Vtp + (size_t)row * vstride + kt * 64 + ch * 8); }
  };
  prefetch(SB ? ntiles - 1 : 0);
  for (int it = 0; it < ntiles; it++) {
    const int kt = SB ? ntiles - 1 - it : it;
    __syncthreads();
#pragma unroll
    for (int i = 0; i < NKL; i++) { int c = tid + 256 * i; int row = c / KCH, ch = c - row * KCH; *(u32x4*)(sK + row * KSTR + ch * 8) = rk[i]; }
#pragma unroll
    for (int i = 0; i < 2; i++) { int c = tid + 256 * i; int row = c >> 3, ch = c & 7; *(u32x4*)(sV + row * 72 + ch * 8) = rv[i]; }
    __syncthreads();
    { int nx = SB ? kt - 1 : kt + 1; if (it + 1 >= ntiles) nx = kt; prefetch(nx); }
    bool doit;
    if (SB) doit = wave_active && (kt * 64 < wave_q0 + 31);
    else doit = wave_active && (kt <= (wave_q0 >> 6));
    if (doit) {
    f32x16 S[2];
#pragma unroll
    for (int kb = 0; kb < 2; kb++) {
#pragma unroll
      for (int i = 0; i < 16; i++) S[kb][i] = 0.f;
#pragma unroll
      for (int ks = 0; ks < KS; ks++) {
        bf16x8 kf = *(const bf16x8*)(sK + (kb * 32 + r) * KSTR + ks * 16 + hl * 8);
        S[kb] = MFMA32(kf, qf[ks], S[kb]);
      }
    }
    const int key0 = kt * 64 + 4 * hl;
    if (!SB) {
      const bool need_mask = (kt + 1) * 64 > nkeys;
      if (need_mask) {
#pragma unroll
        for (int kb = 0; kb < 2; kb++)
#pragma unroll
          for (int i = 0; i < 16; i++) { int key = key0 + kb * 32 + (i & 3) + 8 * (i >> 2); if (key >= nkeys) S[kb][i] = -1e30f; }
      }
      float tmax = -1e30f;
#pragma unroll
      for (int kb = 0; kb < 2; kb++)
#pragma unroll
        for (int i = 0; i < 16; i++) tmax = fmaxf(tmax, S[kb][i]);
      tmax = fmaxf(tmax, __shfl_xor(tmax, 32));
      float m_new = fmaxf(m_run, tmax);
      float alpha = ex2(m_run - m_new);
      m_run = m_new;
      float ps = 0.f;
#pragma unroll
      for (int kb = 0; kb < 2; kb++)
#pragma unroll
        for (int i = 0; i < 16; i++) { float pv = ex2(S[kb][i] - m_new); S[kb][i] = pv; ps += pv; }
      l_run = l_run * alpha + ps;
#pragma unroll
      for (int b = 0; b < 2; b++)
#pragma unroll
        for (int i = 0; i < 16; i++) O[b][i] *= alpha;
    } else {
      const bool need_mask = (kt * 64 + 63 >= wave_q0) || ((kt + 1) * 64 > nkeys);
#pragma unroll
      for (int kb = 0; kb < 2; kb++)
#pragma unroll
        for (int i = 0; i < 16; i++) {
          float d = __builtin_amdgcn_rcpf(1.f + ex2(S[kb][i]));
          if (need_mask) { int key = key0 + kb * 32 + (i & 3) + 8 * (i >> 2); if (!(key < nkeys && key < qpos)) d = 1.f; }
          S[kb][i] = d;
        }
      float gs[8], pg[8], sa[8];
#pragma unroll
      for (int o = 0; o < 8; o++) { int kb = o >> 2, g = o & 3; gs[o] = (S[kb][4 * g] * S[kb][4 * g + 1]) * (S[kb][4 * g + 2] * S[kb][4 * g + 3]); }
#pragma unroll
      for (int o = 0; o < 8; o++) pg[o] = __shfl_xor(gs[o], 32);
      sa[7] = R;
#pragma unroll
      for (int o = 6; o >= 0; o--) sa[o] = sa[o + 1] * (gs[o + 1] * pg[o + 1]);
      const float total = sa[0] * (gs[0] * pg[0]);
#pragma unroll
      for (int o = 0; o < 8; o++) {
        int kb = o >> 2, g = o & 3;
        float c = hl == 0 ? sa[o] * pg[o] : sa[o];
#pragma unroll
        for (int e = 3; e >= 0; e--) {
          float d = S[kb][4 * g + e];
          S[kb][4 * g + e] = c - d * c;
          c *= d;
        }
      }
      R = total;
    }
#pragma unroll
    for (int kb = 0; kb < 2; kb++)
#pragma unroll
      for (int s2 = 0; s2 < 2; s2++) {
        uint4 u;
        u.x = pk2(S[kb][8 * s2], S[kb][8 * s2 + 1]); u.y = pk2(S[kb][8 * s2 + 2], S[kb][8 * s2 + 3]);
        u.z = pk2(S[kb][8 * s2 + 4], S[kb][8 * s2 + 5]); u.w = pk2(S[kb][8 * s2 + 6], S[kb][8 * s2 + 7]);
        bf16x8 pf = __builtin_bit_cast(bf16x8, u);
#pragma unroll
        for (int bd = 0; bd < 2; bd++) {
          const u16* vp = sV + (bd * 32 + r) * 72 + kb * 32 + s2 * 16 + hl * 4;
          uint2 lo = *(const uint2*)vp, hi = *(const uint2*)(vp + 8);
          uint4 vv; vv.x = lo.x; vv.y = lo.y; vv.z = hi.x; vv.w = hi.y;
          O[bd] = MFMA32(__builtin_bit_cast(bf16x8, vv), pf, O[bd]);
        }
      }
    }
    if (SB) {
      const bool lane_done = !wave_active || slot >= nq_valid || R < 1e-30f;
      const int wdone = __all(lane_done);
      if (__syncthreads_and(wdone)) break;
    }
  }
  if (wave_active && slot < nq_valid) {
    float sc = 1.f;
    if (!SB) { float lt = l_run + __shfl_xor(l_run, 32); sc = 1.f / lt; }
#pragma unroll
    for (int bd = 0; bd < 2; bd++)
#pragma unroll
      for (int g = 0; g < 4; g++) {
        int d0 = bd * 32 + 8 * g + 4 * hl;
        uint2 zz = *(const uint2*)(Zp + (size_t)slot * 512 + d0);
        uint2 o;
        o.x = pk2(O[bd][4 * g] * sc * bflo(zz.x), O[bd][4 * g + 1] * sc * bfhi(zz.x));
        o.y = pk2(O[bd][4 * g + 2] * sc * bflo(zz.y), O[bd][4 * g + 3] * sc * bfhi(zz.y));
        *(uint2*)(Yp + (size_t)slot * 512 + d0) = o;
      }
  }
}

template <int CTRL> DI float dpp_add(float x) {
  return x + __int_as_float(__builtin_amdgcn_update_dpp(0, __float_as_int(x), CTRL, 0xF, 0xF, true));
}
DI void allreduce16x2(float& a, float& b) {
  a = dpp_add<0xB1>(a); b = dpp_add<0xB1>(b); a = dpp_add<0x4E>(a); b = dpp_add<0x4E>(b);
  a = dpp_add<0x141>(a); b = dpp_add<0x141>(b); a = dpp_add<0x140>(a); b = dpp_add<0x140>(b);
}
#define SCAN_PREFETCH(slot, cc) { int c_ = (cc) < nch ? (cc) : nch - 1; size_t row = (size_t)(srow0 + c_ * 16 + lstep); \
    pw[slot] = *(const f32x4v*)(RWW + row * 512 + h * 64 + lpart); \
    _Pragma("unroll") for (int c = 0; c < 5; c++) px[slot][c] = *(const u32x2*)(RWX + row * 2560 + c * 512 + h * 64 + lpart); }
#define SCAN_STAGE(slot, bsel) { float* o = ops + ((bsel) * 16 + lstep) * 384 + lpart; \
    f32x4v r4 = {bflo(px[slot][0].x), bfhi(px[slot][0].x), bflo(px[slot][0].y), bfhi(px[slot][0].y)}; \
    f32x4v k4 = {bflo(px[slot][1].x), bfhi(px[slot][1].x), bflo(px[slot][1].y), bfhi(px[slot][1].y)}; \
    f32x4v v4 = {bflo(px[slot][2].x), bfhi(px[slot][2].x), bflo(px[slot][2].y), bfhi(px[slot][2].y)}; \
    f32x4v kk4 = {bflo(px[slot][3].x), bfhi(px[slot][3].x), bflo(px[slot][3].y), bfhi(px[slot][3].y)}; \
    f32x4v b4 = {bflo(px[slot][4].x), bfhi(px[slot][4].x), bflo(px[slot][4].y), bfhi(px[slot][4].y)}; \
    *(f32x4v*)(o) = pw[slot]; *(f32x4v*)(o + 64) = pw[slot] * r4; *(f32x4v*)(o + 128) = k4; *(f32x4v*)(o + 192) = v4; *(f32x4v*)(o + 256) = kk4; *(f32x4v*)(o + 320) = b4; \
    float br = b4.x * r4.x + b4.y * r4.y + b4.z * r4.z + b4.w * r4.w; \
    float kr = k4.x * r4.x + k4.y * r4.y + k4.z * r4.z + k4.w * r4.w; \
    allreduce16x2(br, kr); \
    if ((tid & 15) == 0) { sc[((bsel) * 16 + lstep) * 2] = br; sc[((bsel) * 16 + lstep) * 2 + 1] = kr; } }

DI void rwkv_pass1_task(const Params& p, int bh, int seg, int rq, unsigned char* smem) {
  float* ops = (float*)smem; float* sc = ops + 2 * 16 * 384;
  const int tid = TIDX(), i = tid >> 4, cg = tid & 15, cg4 = cg * 4;
  const int Rr = rq * 16 + i, h = bh & 7;
  const int srow0 = (bh >> 3) * TP + seg * 1024;
  const float* RWW = (const float*)(p.ws + W_RWW); const u16* RWX = (const u16*)(p.ws + W_RWX);
  float SL[4] = {0.f, 0.f, 0.f, 0.f}, SP[4];
#pragma unroll
  for (int e = 0; e < 4; e++) SP[e] = (cg4 + e == Rr) ? 1.f : 0.f;
  const int lstep = tid >> 4, lpart = (tid & 15) * 4;
  f32x4v pw[4]; u32x2 px[4][5];
  const int nch = 64;
  SCAN_PREFETCH(0, 0) SCAN_PREFETCH(1, 1) SCAN_PREFETCH(2, 2) SCAN_PREFETCH(3, 3)
  __syncthreads();
  SCAN_STAGE(0, 0)
  __syncthreads();
  __builtin_amdgcn_s_setprio(3);
  for (int cb = 0; cb < nch; cb += 4) {
#pragma unroll
    for (int k = 0; k < 4; k++) {
      const int c0 = cb + k;
      const int bsel = k & 1;
      SCAN_PREFETCH(k, c0 + 4)
#pragma unroll
      for (int st = 0; st < 16; st++) {
        const float* o = ops + (bsel * 16 + st) * 384;
        f32x4v w = *(const f32x4v*)(o + cg4), kp = *(const f32x4v*)(o + 128 + cg4);
        f32x4v kkv = *(const f32x4v*)(o + 256 + cg4), bb = *(const f32x4v*)(o + 320 + cg4);
        float v = o[192 + Rr];
        float d1 = SL[0] * kkv.x + SL[1] * kkv.y + SL[2] * kkv.z + SL[3] * kkv.w;
        float d2 = SP[0] * kkv.x + SP[1] * kkv.y + SP[2] * kkv.z + SP[3] * kkv.w;
        allreduce16x2(d1, d2);
        const float saL = -d1, saP = -d2;
        SL[0] = SL[0] * w.x + (saL * bb.x + v * kp.x); SP[0] = SP[0] * w.x + saP * bb.x;
        SL[1] = SL[1] * w.y + (saL * bb.y + v * kp.y); SP[1] = SP[1] * w.y + saP * bb.y;
        SL[2] = SL[2] * w.z + (saL * bb.z + v * kp.z); SP[2] = SP[2] * w.z + saP * bb.z;
        SL[3] = SL[3] * w.w + (saL * bb.w + v * kp.w); SP[3] = SP[3] * w.w + saP * bb.w;
      }
      SCAN_STAGE(((k + 1) & 3), (bsel ^ 1))
      __syncthreads();
    }
  }
  __builtin_amdgcn_s_setprio(0);
  const size_t so = ((size_t)(bh * 7 + seg)) * 4096 + Rr * 64 + cg4;
  *(float4*)((float*)(p.ws + W_SLOC) + so) = make_float4(SL[0], SL[1], SL[2], SL[3]);
  *(float4*)((float*)(p.ws + W_PMAT) + so) = make_float4(SP[0], SP[1], SP[2], SP[3]);
}

DI void rwkv_scan_task(const Params& p, int srow0, int T, int h, int rq, const float* S0, float* Sout, int comb_bh, int comb_seg, unsigned char* smem) {
  float* ops = (float*)smem;
  float* sc = ops + 2 * 16 * 384;
  float* ybuf = sc + 64;
  const int tid = TIDX(), i = tid >> 4, cg = tid & 15, cg4 = cg * 4;
  const int Rr = rq * 16 + i;
  const float* RWW = (const float*)(p.ws + W_RWW); const u16* RWX = (const u16*)(p.ws + W_RWX); float* YRAW = (float*)(p.ws + W_YRAW);
  float S[4];
  if (S0) { float4 s = *(const float4*)(S0 + Rr * 64 + cg4); S[0] = s.x; S[1] = s.y; S[2] = s.z; S[3] = s.w; }
  else { S[0] = S[1] = S[2] = S[3] = 0.f; }
  if (comb_bh >= 0 && comb_seg > 0) {
    const float* SLOC = (const float*)(p.ws + W_SLOC) + (size_t)comb_bh * 7 * 4096;
    const float* PMAT = (const float*)(p.ws + W_PMAT) + (size_t)comb_bh * 7 * 4096;
    float* srow = ops;
    { float4 s = *(const float4*)(SLOC + Rr * 64 + cg4); S[0] = s.x; S[1] = s.y; S[2] = s.z; S[3] = s.w; }
    for (int sp = 1; sp < comb_seg; sp++) {
      __syncthreads();
      *(float4*)(srow + i * 64 + cg4) = make_float4(S[0], S[1], S[2], S[3]);
      __syncthreads();
      float4 a = *(const float4*)(SLOC + (size_t)sp * 4096 + Rr * 64 + cg4);
      const float* P = PMAT + (size_t)sp * 4096 + cg4;
#pragma unroll 8
      for (int k = 0; k < 64; k++) {
        float sv = srow[i * 64 + k]; float4 pv = *(const float4*)(P + k * 64);
        a.x += sv * pv.x; a.y += sv * pv.y; a.z += sv * pv.z; a.w += sv * pv.w;
      }
      S[0] = a.x; S[1] = a.y; S[2] = a.z; S[3] = a.w;
    }
  }
  const int lstep = tid >> 4, lpart = (tid & 15) * 4;
  f32x4v pw[4]; u32x2 px[4][5];
  const int nch = T >> 4;
  SCAN_PREFETCH(0, 0) SCAN_PREFETCH(1, 1) SCAN_PREFETCH(2, 2) SCAN_PREFETCH(3, 3)
  __syncthreads();
  SCAN_STAGE(0, 0)
  __syncthreads();
  __builtin_amdgcn_s_setprio(3);
  for (int cb = 0; cb < nch; cb += 4) {
#pragma unroll
    for (int k = 0; k < 4; k++) {
      const int c0 = cb + k;
      if (c0 < nch) {
        const int bsel = k & 1;
        SCAN_PREFETCH(k, c0 + 4)
        float yk = 0.f;
#pragma unroll
        for (int st = 0; st < 16; st++) {
          const float* o = ops + (bsel * 16 + st) * 384;
          f32x4v w = *(const f32x4v*)(o + cg4), wr = *(const f32x4v*)(o + 64 + cg4), kp = *(const f32x4v*)(o + 128 + cg4);
          f32x4v kkv = *(const f32x4v*)(o + 256 + cg4), bb = *(const f32x4v*)(o + 320 + cg4);
          float v = o[192 + Rr];
          float br = sc[(bsel * 16 + st) * 2], kr = sc[(bsel * 16 + st) * 2 + 1];
          float d1 = S[0] * kkv.x + S[1] * kkv.y + S[2] * kkv.z + S[3] * kkv.w;
          float d2 = S[0] * wr.x + S[1] * wr.y + S[2] * wr.z + S[3] * wr.w;
          allreduce16x2(d1, d2);
          const float sa = -d1;
          S[0] = S[0] * w.x + (sa * bb.x + v * kp.x);
          S[1] = S[1] * w.y + (sa * bb.y + v * kp.y);
          S[2] = S[2] * w.z + (sa * bb.z + v * kp.z);
          S[3] = S[3] * w.w + (sa * bb.w + v * kp.w);
          float y = d2 + sa * br + v * kr;
          yk = (cg == st) ? y : yk;
        }
        ybuf[bsel * 256 + cg * 16 + i] = yk;
        SCAN_STAGE(((k + 1) & 3), (bsel ^ 1))
        __syncthreads();
        YRAW[(size_t)(srow0 + c0 * 16 + (tid >> 4)) * 512 + h * 64 + rq * 16 + (tid & 15)] = ybuf[bsel * 256 + tid];
      }
    }
  }
  __builtin_amdgcn_s_setprio(0);
  if (Sout) *(float4*)(Sout + Rr * 64 + cg4) = make_float4(S[0], S[1], S[2], S[3]);
}
constexpr int PH5_TASKS = 512 + 128 + 2048 + 256;
DI void phase5_task(const Params& p, int l, int task, unsigned char* smem) {
  const u16* Z = (const u16*)(p.ws + W_Z); u16* YG = (u16*)(p.ws + W_YG);
  if (task < 512) {
    int bh = task >> 5, seg = 7 - ((task >> 2) & 7), rq = task & 3, b = bh >> 3, h = bh & 7;
    rwkv_scan_task(p, b * TP + seg * 1024, 1024, h, rq, nullptr, seg == 7 ? p.out + O_WKV_P + ((size_t)((l * 2 + b) * 8 + h)) * 4096 : nullptr, bh, seg, smem);
    return;
  }
  task -= 448;
  if (task < 2240) {
    int which, b, h, row0, nq, qpos0, kbase, nkeys; size_t vto; int vstr;
    if (task < 192) { int j = task - 64; which = j >> 6; int bh = j & 63; b = bh >> 3; h = bh & 7; row0 = NP + b * 16; nq = 16; qpos0 = PAST; kbase = NP + b * SK; nkeys = SK; vto = VT_S_OFF + (size_t)((b * 8 + h) * 64) * SK; vstr = SK; }
    else { int j = task - 192; int qb = 63 - (j >> 5); which = (j >> 4) & 1; int bh = j & 15; b = bh >> 3; h = bh & 7; row0 = b * TP + qb * 128; nq = 128; qpos0 = qb * 128; kbase = b * TP; nkeys = TP; vto = (size_t)((b * 8 + h) * 64) * 8192; vstr = 8192; }
    if (which == 0)
      attn_task<64, true>((const u16*)(p.ws + W_SQ) + (size_t)row0 * 512 + h * 64, 512, nq, (const u16*)(p.ws + W_SBK) + (size_t)kbase * 512 + h * 64, 512,
                          (const u16*)(p.ws + W_SBVT) + vto, vstr, nkeys, qpos0, Z + ((size_t)2 * NT + row0) * 512 + h * 64, YG + ((size_t)2 * NT + row0) * 512 + h * 64, smem);
    else
      attn_task<96, false>((const u16*)(p.ws + W_QF) + (size_t)row0 * 768 + h * 96, 768, nq, (const u16*)(p.ws + W_KF) + (size_t)kbase * 768 + h * 96, 768,
                           (const u16*)(p.ws + W_MLAVT) + vto, vstr, nkeys, qpos0, Z + ((size_t)1 * NT + row0) * 512 + h * 64, YG + ((size_t)1 * NT + row0) * 512 + h * 64, smem);
    return;
  }
  {
    int j = task - 2240; int bh = j >> 2, rq = j & 3, b = bh >> 3, h = bh & 7;
    size_t so = ((size_t)((l * 8 + b) * 8 + h)) * 4096;
    rwkv_scan_task(p, NP + b * 16, 16, h, rq, p.in[2] + so, p.out + O_WKV_S + so, -1, 0, smem);
  }
}
DI void phase5(const Params& p, int l, unsigned char* smem) {
  __shared__ int s_task;
  int* ctr = (int*)(p.ws + W_CTR) + l;
  while (true) {
    __syncthreads();
    if (TIDX() == 0) s_task = atomicAdd(ctr, 1);
    __syncthreads();
    int q = s_task;
    if (q >= PH5_TASKS) break;
    int task = q < 1024 ? ((q & 1) ? 512 + (q >> 1) : (q >> 1)) : q;
    phase5_task(p, l, task, smem);
  }
}
DI void phase5b(const Params& p, int l) {
  const int lane = TIDX() & 63, wave = TIDX() >> 6;
  const float* YRAW = (const float*)(p.ws + W_YRAW); const u16* RWX = (const u16*)(p.ws + W_RWX); const float* RHO = (const float*)(p.ws + W_RHO);
  const u16* Z = (const u16*)(p.ws + W_Z); u16* YG = (u16*)(p.ws + W_YG);
  for (int task = blockIdx.x; task < NT / 4; task += gridDim.x) {
    const int row = task * 4 + wave, c0 = lane * 8;
    float y[8];
    { float4 a = *(const float4*)(YRAW + (size_t)row * 512 + c0), b = *(const float4*)(YRAW + (size_t)row * 512 + c0 + 4);
      y[0] = a.x; y[1] = a.y; y[2] = a.z; y[3] = a.w; y[4] = b.x; y[5] = b.y; y[6] = b.z; y[7] = b.w; }
    float s = 0.f;
#pragma unroll
    for (int j = 0; j < 8; j++) s += y[j];
    s += __shfl_xor(s, 1); s += __shfl_xor(s, 2); s += __shfl_xor(s, 4);
    float mu = s * (1.f / 64.f), vs = 0.f;
#pragma unroll
    for (int j = 0; j < 8; j++) { float d = y[j] - mu; vs += d * d; }
    vs += __shfl_xor(vs, 1); vs += __shfl_xor(vs, 2); vs += __shfl_xor(vs, 4);
    float rstd = rsqrtf(vs * (1.f / 64.f) + GN_EPS);
    float rho = RHO[(size_t)row * 8 + (lane >> 3)];
    uint4 vv = *(const uint4*)(RWX + (size_t)row * 2560 + 1024 + c0);
    uint4 zz = *(const uint4*)(Z + (size_t)row * 512 + c0);
    float vf[8] = {bflo(vv.x), bfhi(vv.x), bflo(vv.y), bfhi(vv.y), bflo(vv.z), bfhi(vv.z), bflo(vv.w), bfhi(vv.w)};
    float zf[8] = {bflo(zz.x), bfhi(zz.x), bflo(zz.y), bfhi(zz.y), bflo(zz.z), bfhi(zz.z), bflo(zz.w), bfhi(zz.w)};
    float o[8];
#pragma unroll
    for (int j = 0; j < 8; j++) o[j] = ((y[j] - mu) * rstd * p.in[22][l * 512 + c0 + j] + p.in[23][l * 512 + c0 + j] + rho * vf[j]) * zf[j];
    uint4 ob; ob.x = pk2(o[0], o[1]); ob.y = pk2(o[2], o[3]); ob.z = pk2(o[4], o[5]); ob.w = pk2(o[6], o[7]);
    *(uint4*)(YG + (size_t)row * 512 + c0) = ob;
  }
}

DI void wave_gemm32(f32x16& acc, const u16* A, int lda, const u16* Bt, int ldb, int K) {
  const int lane = TIDX() & 63, r = lane & 31, hl = lane >> 5;
  const u16* ap = A + (size_t)r * lda + hl * 8; const u16* bp = Bt + (size_t)r * ldb + hl * 8;
#pragma unroll 8
  for (int k = 0; k < K; k += 16) { bf16x8 a = *(const bf16x8*)(ap + k); bf16x8 b = *(const bf16x8*)(bp + k); acc = MFMA32(a, b, acc); }
}
DI void phase6(const Params& p, int l, unsigned char* smem) {
  const u16* H = (const u16*)(p.ws + W_H); const u16* WinT = (const u16*)(p.ws + W_WINT);
  const u16* YG = (const u16*)(p.ws + W_YG); u16* MG = (u16*)(p.ws + W_MG);
  for (int t0 = blockIdx.x; t0 < 32 + 128 * 8; t0 += gridDim.x) {
    if (t0 < 32) {
      const int lane = TIDX() & 63, wave = TIDX() >> 6, r = lane & 31, hl = lane >> 5;
      const int unit = t0 * 4 + wave, row0 = NP + (unit & 3) * 32, n0 = (unit >> 2) * 32;
      f32x16 mm;
#pragma unroll
      for (int i = 0; i < 16; i++) mm[i] = 0.f;
#pragma unroll 1
      for (int g = 0; g < 3; g++) {
        f32x16 ay, ag;
#pragma unroll
        for (int i = 0; i < 16; i++) { ay[i] = 0.f; ag[i] = 0.f; }
        wave_gemm32(ay, YG + ((size_t)g * NT + row0) * 512, 512, (const u16*)(p.ws + W_WBRT) + ((size_t)(l * 3 + g) * 1024 + n0) * 512, 512, 512);
        wave_gemm32(ag, H + (size_t)row0 * 1024, 1024, WinT + (size_t)(5408 + g * 1024 + n0) * 1024, 1024, 1024);
#pragma unroll
        for (int i = 0; i < 16; i++) mm[i] += sigmoidf_(ag[i]) * ay[i];
      }
#pragma unroll
      for (int i = 0; i < 16; i++) MG[(size_t)(row0 + crow(i, hl)) * 1024 + n0 + r] = f2bf(mm[i]);
      continue;
    }
    const int t = t0 - 32;
    const int bq = t & 511, mt = (bq & 7) * 16 + ((bq >> 3) & 15), nt = (t >> 9) * 4 + (bq >> 7), m0 = mt * 128, n0 = nt * 128;

    unsigned mpk[2][2][8];
#pragma unroll
    for (int a = 0; a < 2; a++)
#pragma unroll
      for (int b = 0; b < 2; b++)
#pragma unroll
        for (int j = 0; j < 8; j++) mpk[a][b][j] = 0u;
#pragma unroll 1
    for (int g = 0; g < 3; g++) {
      f32x16 acc[2][2]; zero_acc(acc);
      gemm_mainloop(acc, YG + ((size_t)g * NT + m0) * 512, 512, (const u16*)(p.ws + W_WBRT) + ((size_t)(l * 3 + g) * 1024 + n0) * 512, 512, 512, smem);
      unsigned ypk[2][2][8];
#pragma unroll
      for (int a = 0; a < 2; a++)
#pragma unroll
        for (int b = 0; b < 2; b++)
#pragma unroll
          for (int j = 0; j < 8; j++) ypk[a][b][j] = pk2(acc[a][b][2 * j], acc[a][b][2 * j + 1]);
      zero_acc(acc);
      gemm_mainloop(acc, H + (size_t)m0 * 1024, 1024, WinT + (size_t)(5408 + g * 1024 + n0) * 1024, 1024, 1024, smem);
#pragma unroll
      for (int a = 0; a < 2; a++)
#pragma unroll
        for (int b = 0; b < 2; b++)
#pragma unroll
          for (int j = 0; j < 8; j++) {
            float lo = bflo(mpk[a][b][j]) + sigmoidf_(acc[a][b][2 * j]) * bflo(ypk[a][b][j]);
            float hi = bfhi(mpk[a][b][j]) + sigmoidf_(acc[a][b][2 * j + 1]) * bfhi(ypk[a][b][j]);
            mpk[a][b][j] = pk2(lo, hi);
          }
    }
    {
      const int lane = TIDX() & 63, wave = TIDX() >> 6, wm = wave >> 1, wn = wave & 1, r = lane & 31, hl = lane >> 5;
#pragma unroll
      for (int a = 0; a < 2; a++)
#pragma unroll
        for (int b = 0; b < 2; b++)
#pragma unroll
          for (int j = 0; j < 8; j++) {
            int col = n0 + wn * 64 + b * 32 + r;
            int row0 = m0 + wm * 64 + a * 32;
            MG[(size_t)(row0 + crow(2 * j, hl)) * 1024 + col] = (u16)(mpk[a][b][j] & 0xffffu);
            MG[(size_t)(row0 + crow(2 * j + 1, hl)) * 1024 + col] = (u16)(mpk[a][b][j] >> 16);
          }
    }
  }
}
DI void phase7(const Params& p, int l, unsigned char* smem) {
  const u16* MG = (const u16*)(p.ws + W_MG);
  const float* mod = (const float*)(p.ws + W_MOD);
  const int ntile = 32 + 128 * 8, nextra = (l + 1 < NL) ? WIN_TT : 0;
  for (int t0 = blockIdx.x; t0 < ntile + nextra; t0 += gridDim.x) {
    if (t0 >= ntile) { win_transpose_task(p, l + 1, t0 - ntile, smem); continue; }
    if (t0 < 32) {
      const int lane = TIDX() & 63, wave = TIDX() >> 6, r = lane & 31, hl = lane >> 5;
      const int unit = t0 * 4 + wave, row0 = NP + (unit & 3) * 32, n0 = (unit >> 2) * 32;
      f32x16 a;
#pragma unroll
      for (int i = 0; i < 16; i++) a[i] = 0.f;
      wave_gemm32(a, MG + (size_t)row0 * 1024, 1024, (const u16*)(p.ws + W_WOUTT) + ((size_t)l * 1024 + n0) * 1024, 1024, 1024);
#pragma unroll
      for (int i = 0; i < 16; i++) {
        const int row = row0 + crow(i, hl), col = n0 + r;
        float xo = xrow_ptr(p, l, row)[col];
        float gt = mod[(l * 10 + bidx_of(row)) * 3072 + 2048 + col];
        p.out[(size_t)row * D + col] = xo + gt * a[i];
      }
      continue;
    }
    const int t = t0 - 32;
    const int bq = t & 511, mt = (bq & 7) * 16 + ((bq >> 3) & 15), nt = (t >> 9) * 4 + (bq >> 7), m0 = mt * 128, n0 = nt * 128;

    f32x16 acc[2][2]; zero_acc(acc);
    gemm_mainloop(acc, MG + (size_t)m0 * 1024, 1024, (const u16*)(p.ws + W_WOUTT) + ((size_t)l * 1024 + n0) * 1024, 1024, 1024, smem);
    foreach_acc(acc, m0, n0, [&](int row, int col, float v) {
      float xo = xrow_ptr(p, l, row)[col];
      float gt = mod[(l * 10 + bidx_of(row)) * 3072 + 2048 + col];
      p.out[(size_t)row * D + col] = xo + gt * v;
    });
  }
}

#define XB_TMO      128
#define XB_XCNT(j)  (256  + 64 * (j))
#define XB_XSUB(j)  (1280 + 64 * (j))
#define XB_XGEN(j)  (2304 + 64 * (j))
#define XB_TOP      3328
#define XB_TOPGEN   3392
#define XB_SPIN_CAP (1u << 18)
DI unsigned xb_ld(unsigned* q) { return __hip_atomic_load(q, __ATOMIC_RELAXED, __HIP_MEMORY_SCOPE_AGENT); }
DI unsigned xb_add(unsigned* q, unsigned v) { return __hip_atomic_fetch_add(q, v, __ATOMIC_RELAXED, __HIP_MEMORY_SCOPE_AGENT); }
DI unsigned xb_xcc_id() { return (unsigned)__builtin_amdgcn_s_getreg((3 << 11) | 20) & 0xFu; }
#define XB_SPIN(cond, bar) do { unsigned _sp = 0; while (cond) { __builtin_amdgcn_s_sleep(1); \
    if ((++_sp & 255u) == 0u) { if (xb_ld(&(bar)[XB_TMO])) break; if (_sp > XB_SPIN_CAP) { atomicAdd(&(bar)[XB_TMO], 1u); break; } } } } while (0)
DI void xbar(const Params& p, unsigned* xbst) {
  asm volatile("s_waitcnt vmcnt(0)" ::: "memory");
  __syncthreads();
  if (TIDX() == 0) {
    unsigned* bar = (unsigned*)(p.ws + W_XBAR);
    const unsigned x = xb_xcc_id();
    __builtin_amdgcn_s_waitcnt(0);
    const unsigned nloc = xbst[0], nx = xbst[1];
    const unsigned old = xb_add(&bar[XB_XSUB(x)], 1u);
    const unsigned gen = old / nloc;
    if (old + 1u == (gen + 1u) * nloc) {
      __builtin_amdgcn_fence(__ATOMIC_RELEASE, "agent");
      asm volatile("s_waitcnt vmcnt(0)" ::: "memory");
      const unsigned og = xb_add(&bar[XB_TOP], 1u);
      const unsigned tg = og / nx;
      if (og + 1u == (tg + 1u) * nx) xb_add(&bar[XB_TOPGEN], 1u);
      else XB_SPIN(xb_ld(&bar[XB_TOPGEN]) == tg, bar);
      __builtin_amdgcn_fence(__ATOMIC_ACQUIRE, "agent");
      xb_add(&bar[XB_XGEN(x)], 1u);
      asm volatile("s_waitcnt vmcnt(0)" ::: "memory");
    } else {
      XB_SPIN(xb_ld(&bar[XB_XGEN(x)]) == gen, bar);
      __builtin_amdgcn_fence(__ATOMIC_ACQUIRE, "agent");
      asm volatile("s_waitcnt vmcnt(0)" ::: "memory");
    }
  }
  __syncthreads();
}
DI int opq(int v) { asm volatile("" : "+s"(v)); return v; }
#if MULTI
template <int PH> __global__ void __launch_bounds__(256, 2) phase_kernel(Params p, int l) {
  __shared__ __attribute__((aligned(16))) unsigned char smem[SMEM_BYTES];
  if (PH == 0) phase0(p, smem);
  if (PH == 1) phase1(p, l);
  if (PH == 2) phase2(p, l, smem);
  if (PH == 3) phase3(p, l);
  if (PH == 4) phase4(p, l, smem);
  if (PH == 5) phase5(p, l, smem);
  if (PH == 6) phase5b(p, l);
  if (PH == 7) phase6(p, l, smem);
  if (PH == 8) phase7(p, l, smem);
}
#else
__global__ void __launch_bounds__(256, 2) mega_kernel(Params p_arg) {
  __shared__ __attribute__((aligned(16))) unsigned char smem[SMEM_BYTES];
  const Params& p = *(const Params*)__builtin_amdgcn_kernarg_segment_ptr();
  cg::grid_group grid = cg::this_grid();
  __shared__ unsigned xbst[4];
  if (TIDX() == 0) (void)xb_add((unsigned*)(p.ws + W_XBAR) + XB_XCNT(xb_xcc_id()), 1u);
  phase0(p, smem);
  grid.sync();
  if (TIDX() == 0) {
    unsigned* bar = (unsigned*)(p.ws + W_XBAR);
    const unsigned x = xb_xcc_id();
    unsigned cnt = 0u, mine = 0u;
    for (unsigned j = 0; j < 16; ++j) { const unsigned c = xb_ld(&bar[XB_XCNT(j)]); cnt += (c > 0u) ? 1u : 0u; mine = (j == x) ? c : mine; }
    xbst[0] = mine > 0u ? mine : 1u; xbst[1] = cnt > 0u ? cnt : 1u;
  }
  for (int l = 0; l < NL; l++) {
    phase1(p, opq(l)); xbar(p, xbst);
    phase2(p, opq(l), smem); xbar(p, xbst);
    phase3(p, opq(l)); xbar(p, xbst);
    phase4(p, opq(l), smem); xbar(p, xbst);
    phase5(p, opq(l), smem); xbar(p, xbst);
    phase5b(p, opq(l)); xbar(p, xbst);
    phase6(p, opq(l), smem); xbar(p, xbst);
    phase7(p, opq(l), smem); xbar(p, xbst);
  }
}
#endif

extern "C" void kernel_launch(void* const* d_in, const int* in_sizes, int n_in, void* d_out, int out_size, void* d_ws, size_t ws_size, hipStream_t stream) {
  Params p{};
  for (int i = 0; i < 36; i++) p.in[i] = (const float*)d_in[i];
  p.out = (float*)d_out;
  p.ws = (unsigned char*)d_ws;
  if (ws_size < W_TOTAL) fprintf(stderr, "workspace too small: %zu < %zu\n", ws_size, (size_t)W_TOTAL);
  hipMemsetAsync((unsigned char*)d_ws + W_CTR, 0, 256 + 3456 * 4, stream);
#if MULTI
  const int G = 1024;
  phase_kernel<0><<<G, 256, 0, stream>>>(p, 0);
  for (int l = 0; l < NL; l++) {
    phase_kernel<1><<<G, 256, 0, stream>>>(p, l);
    phase_kernel<2><<<G, 256, 0, stream>>>(p, l);
    phase_kernel<3><<<G, 256, 0, stream>>>(p, l);
    phase_kernel<4><<<G, 256, 0, stream>>>(p, l);
    phase_kernel<5><<<G, 256, 0, stream>>>(p, l);
    phase_kernel<6><<<G, 256, 0, stream>>>(p, l);
    phase_kernel<7><<<G, 256, 0, stream>>>(p, l);
    phase_kernel<8><<<G, 256, 0, stream>>>(p, l);
  }
#else
  static int grid_blocks = 0;
  if (!grid_blocks) {
    int dev = 0, cus = 0, per_cu = 0;
    hipGetDevice(&dev);
    hipDeviceGetAttribute(&cus, hipDeviceAttributeMultiprocessorCount, dev);
    hipOccupancyMaxActiveBlocksPerMultiprocessor(&per_cu, mega_kernel, 256, 0);
    if (per_cu > 2) per_cu = 2;
    grid_blocks = cus * per_cu;
  }
  void* args[] = {&p};
  hipError_t e = hipLaunchCooperativeKernel((void*)mega_kernel, dim3(grid_blocks), dim3(256), args, 0, stream);
  if (e != hipSuccess) fprintf(stderr, "cooperative launch failed: %s (grid %d)\n", hipGetErrorString(e), grid_blocks);
#endif
}
```

```cpp
#include <hip/hip_runtime.h>
#include <hip/hip_cooperative_groups.h>
#include <cstdio>
namespace cg = cooperative_groups;

#ifndef MULTI
#define MULTI 0
#endif

typedef unsigned short u16;
typedef __attribute__((ext_vector_type(8))) short bf16x8;
typedef __attribute__((ext_vector_type(16))) float f32x16;
typedef __attribute__((ext_vector_type(2))) __bf16 bf2_t;
typedef __attribute__((ext_vector_type(2))) float f2_t;
typedef __attribute__((ext_vector_type(4))) unsigned u32x4;
typedef __attribute__((ext_vector_type(2))) unsigned u32x2;
typedef __attribute__((ext_vector_type(4))) float f32x4v;
#define DI __device__ __forceinline__
#define MFMA32(a, b, c) __builtin_amdgcn_mfma_f32_32x32x16_bf16((a), (b), (c), 0, 0, 0)

constexpr int D = 1024, NL = 4, NP = 16384, NS = 128, NT = NP + NS, TP = 8192, TS = 16, PAST = 2048, SK = 2064;
constexpr int NKV = NP + 8 * SK;
constexpr int DIN = 8480;
constexpr float RMS_EPS = 1e-6f, GN_EPS = 64e-5f;
constexpr float LOG2E = 1.4426950408889634f;
constexpr float QSCALE_MLA = 0.10206207261596577f * LOG2E;
constexpr float QSCALE_SB = 0.125f * LOG2E;

constexpr size_t O_Y = 0;
constexpr size_t O_WKV_P = (size_t)NT * D;
constexpr size_t O_SHIFT_P = O_WKV_P + (size_t)NL * 2 * 8 * 4096;
constexpr size_t O_CKV_P = O_SHIFT_P + (size_t)NL * 2 * 1664;
constexpr size_t O_KROPE_P = O_CKV_P + (size_t)NL * NP * 256;
constexpr size_t O_SBK_P = O_KROPE_P + (size_t)NL * NP * 32;
constexpr size_t O_SBV_P = O_SBK_P + (size_t)NL * NP * 512;
constexpr size_t O_WKV_S = O_SBV_P + (size_t)NL * NP * 512;
constexpr size_t O_SHIFT_S = O_WKV_S + (size_t)NL * 8 * 8 * 4096;
constexpr size_t O_CKV_S = O_SHIFT_S + (size_t)NL * 8 * 1664;
constexpr size_t O_KROPE_S = O_CKV_S + (size_t)NL * NS * 256;
constexpr size_t O_SBK_S = O_KROPE_S + (size_t)NL * NS * 32;
constexpr size_t O_SBV_S = O_SBK_S + (size_t)NL * NS * 512;

constexpr size_t al(size_t x) { return (x + 255) & ~(size_t)255; }
constexpr size_t W_WINT = 0;
constexpr size_t W_WBRT = al(W_WINT + (size_t)DIN * 1024 * 2);
constexpr size_t W_WOUTT = al(W_WBRT + (size_t)NL * 3 * 1024 * 512 * 2);
constexpr size_t W_WUQT = al(W_WOUTT + (size_t)NL * 1024 * 1024 * 2);
constexpr size_t W_WUKVT = al(W_WUQT + (size_t)NL * 768 * 384 * 2);
constexpr size_t W_WUPT = al(W_WUKVT + (size_t)NL * 1024 * 256 * 2);
constexpr size_t W_AUPT = al(W_WUPT + (size_t)NL * 512 * 64 * 2);
constexpr size_t W_MOD = al(W_AUPT + (size_t)NL * 512 * 64 * 2);
constexpr size_t W_ROPE = al(W_MOD + (size_t)NL * 10 * 3072 * 4);
constexpr size_t W_CTR = al(W_ROPE + (size_t)8192 * 32 * 4);
constexpr size_t W_XBAR = W_CTR + 256;
constexpr size_t W_H = al(W_XBAR + 3456 * 4);
constexpr size_t W_PR = al(W_H + (size_t)NT * 1024 * 2);
constexpr size_t W_YG = W_PR;
constexpr size_t W_YRAW = al(W_YG + (size_t)3 * NT * 512 * 2);
constexpr size_t W_MG = W_YRAW;
constexpr size_t W_Z = al(W_PR + (size_t)NT * 1664 * 4);
constexpr size_t W_CQ = al(W_Z + (size_t)3 * NT * 512 * 2);
constexpr size_t W_QF = W_CQ;
constexpr size_t W_CKV = al(W_CQ + (size_t)NT * 768 * 2);
constexpr size_t W_KR = al(W_CKV + (size_t)NT * 256 * 4);
constexpr size_t W_QN = al(W_KR + (size_t)NT * 32 * 4);
constexpr size_t W_CKVN = al(W_QN + (size_t)NT * 384 * 2);
constexpr size_t W_SQ = al(W_CKVN + (size_t)(NKV + 64) * 256 * 2);
constexpr size_t W_SBK = al(W_SQ + (size_t)NT * 512 * 2);
constexpr size_t VT_S_OFF = (size_t)16 * 64 * 8192;
constexpr size_t VT_ELEMS = VT_S_OFF + (size_t)64 * 64 * SK + 256;
constexpr size_t W_SBVT = al(W_SBK + (size_t)(NKV + 64) * 512 * 2);
constexpr size_t W_RWW = al(W_SBVT + VT_ELEMS * 2);
constexpr size_t W_RWX = al(W_RWW + (size_t)NT * 512 * 4);
constexpr size_t W_RHO = al(W_RWX + (size_t)NT * 5 * 512 * 2);
constexpr size_t W_KF = al(W_RHO + (size_t)NT * 8 * 4);
constexpr size_t W_MLAVT = al(W_KF + (size_t)(NKV + 64) * 768 * 2);
constexpr size_t W_SLOC = al(W_MLAVT + VT_ELEMS * 2);
constexpr size_t W_PMAT = al(W_SLOC + (size_t)16 * 7 * 4096 * 4);
constexpr size_t W_TOTAL = al(W_PMAT + (size_t)16 * 7 * 4096 * 4);
static_assert((size_t)NT * 384 * 4 <= (size_t)NT * 768 * 2, "alias");
static_assert(W_YRAW + (size_t)NT * 1024 * 2 <= W_Z, "alias overflow");

struct Params {
  const float* in[36];
  float* out;
  unsigned char* ws;
};

constexpr int SMEM_BYTES = 73728;

DI int TIDX() { int t = __builtin_amdgcn_workitem_id_x(); asm volatile("" : "+v"(t)); return t; }
DI u16 f2bf(float x) { return __builtin_bit_cast(u16, (__bf16)x); }
DI unsigned pk2(float a, float b) { f2_t v = {a, b}; return __builtin_bit_cast(unsigned, __builtin_convertvector(v, bf2_t)); }
DI float bf2f(u16 x) { return __uint_as_float((unsigned)x << 16); }
DI float bflo(unsigned x) { return __uint_as_float(x << 16); }
DI float bfhi(unsigned x) { return __uint_as_float(x & 0xffff0000u); }
DI float ex2(float x) { return __builtin_amdgcn_exp2f(x); }
DI float lg2(float x) { return __builtin_amdgcn_logf(x); }
DI float sigmoidf_(float x) { return 1.f / (1.f + __expf(-x)); }
DI float siluf_(float x) { return x / (1.f + __expf(-x)); }
DI float softplusf_(float x) { return fmaxf(x, 0.f) + log1pf(__expf(-fabsf(x))); }
DI int crow(int i, int hl) { return (i & 3) + 8 * (i >> 2) + 4 * hl; }
template <int CTRL> DI float dppf(float x) {
  return __int_as_float(__builtin_amdgcn_update_dpp(__float_as_int(x), __float_as_int(x), CTRL, 0xF, 0xF, false));
}
DI float allreduce16(float x) {
  x += dppf<0xB1>(x); x += dppf<0x4E>(x); x += dppf<0x141>(x); x += dppf<0x140>(x); return x;
}
DI float red32(float x) {
  x += __shfl_xor(x, 1); x += __shfl_xor(x, 2); x += __shfl_xor(x, 4); x += __shfl_xor(x, 8); x += __shfl_xor(x, 16); return x;
}
DI float red64(float x) { x = red32(x); x += __shfl_xor(x, 32); return x; }
DI int bidx_of(int row) { return row < NP ? (row >> 13) : 2 + ((row - NP) >> 4); }
DI int keyrow_of(int row) { return row < NP ? row : NP + ((row - NP) >> 4) * SK + PAST + ((row - NP) & 15); }
DI int pos_of(int row) { return row < NP ? (row & 8191) : PAST + ((row - NP) & 15); }
DI size_t vt_off(int keyrow, int h, int d) {
  if (keyrow < NP) { int b = keyrow >> 13, s = keyrow & 8191; return ((size_t)((b * 8 + h) * 64 + d)) * 8192 + s; }
  int rr = keyrow - NP; int b = rr / SK, s = rr - b * SK; return VT_S_OFF + ((size_t)((b * 8 + h) * 64 + d)) * SK + s;
}

DI void gemm_mainloop(f32x16 (&acc)[2][2], const u16* A, int lda, const u16* Bt, int ldb, int K, unsigned char* smem) {
  u16* s0 = (u16*)smem;
  const int tid = TIDX(), lane = tid & 63, wave = tid >> 6, wm = wave >> 1, wn = wave & 1;
  const int lr = tid >> 3, lc = (tid & 7) * 8;
  const u16* Ap = A + (size_t)lr * lda + lc;
  const u16* Bp = Bt + (size_t)lr * ldb + lc;
  u32x4 ra[4], rb[4];
  const int nk = K >> 6;
  const int r = lane & 31, hl = lane >> 5;
#pragma unroll
  for (int i = 0; i < 4; i++) { ra[i] = *(const u32x4*)(Ap + (size_t)(32 * i) * lda); rb[i] = *(const u32x4*)(Bp + (size_t)(32 * i) * ldb); }
  __syncthreads();
#pragma unroll
  for (int i = 0; i < 4; i++) { *(u32x4*)(s0 + (lr + 32 * i) * 72 + lc) = ra[i]; *(u32x4*)(s0 + 128 * 72 + (lr + 32 * i) * 72 + lc) = rb[i]; }
  if (nk > 1) { Ap += 64; Bp += 64; }
#pragma unroll
  for (int i = 0; i < 4; i++) { ra[i] = *(const u32x4*)(Ap + (size_t)(32 * i) * lda); rb[i] = *(const u32x4*)(Bp + (size_t)(32 * i) * ldb); }
  __syncthreads();
  for (int kt = 0; kt < nk; kt++) {
    u16* sA = s0 + (kt & 1) * (256 * 72); u16* sB = sA + 128 * 72;
    if (kt + 1 < nk) {
      u16* nA = s0 + ((kt + 1) & 1) * (256 * 72); u16* nB = nA + 128 * 72;
#pragma unroll
      for (int i = 0; i < 4; i++) { *(u32x4*)(nA + (lr + 32 * i) * 72 + lc) = ra[i]; *(u32x4*)(nB + (lr + 32 * i) * 72 + lc) = rb[i]; }
    }
    if (kt + 2 < nk) { Ap += 64; Bp += 64; }
#pragma unroll
    for (int i = 0; i < 4; i++) { ra[i] = *(const u32x4*)(Ap + (size_t)(32 * i) * lda); rb[i] = *(const u32x4*)(Bp + (size_t)(32 * i) * ldb); }
#pragma unroll
    for (int ks = 0; ks < 4; ks++) {
      bf16x8 af[2], bfr[2];
#pragma unroll
      for (int b = 0; b < 2; b++) {
        af[b] = *(const bf16x8*)(sA + (wm * 64 + b * 32 + r) * 72 + ks * 16 + hl * 8);
        bfr[b] = *(const bf16x8*)(sB + (wn * 64 + b * 32 + r) * 72 + ks * 16 + hl * 8);
      }
#pragma unroll
      for (int bm = 0; bm < 2; bm++)
#pragma unroll
        for (int bn = 0; bn < 2; bn++) acc[bm][bn] = MFMA32(af[bm], bfr[bn], acc[bm][bn]);
    }
    __syncthreads();
  }
}
DI void zero_acc(f32x16 (&acc)[2][2]) {
#pragma unroll
  for (int a = 0; a < 2; a++)
#pragma unroll
    for (int b = 0; b < 2; b++)
#pragma unroll
      for (int i = 0; i < 16; i++) acc[a][b][i] = 0.f;
}
template <class F> DI void foreach_acc(f32x16 (&acc)[2][2], int m0, int n0, F f) {
  const int lane = TIDX() & 63, wave = TIDX() >> 6, wm = wave >> 1, wn = wave & 1, r = lane & 31, hl = lane >> 5;
#pragma unroll
  for (int bm = 0; bm < 2; bm++)
#pragma unroll
    for (int bn = 0; bn < 2; bn++)
#pragma unroll
      for (int i = 0; i < 16; i++) f(m0 + wm * 64 + bm * 32 + crow(i, hl), n0 + wn * 64 + bn * 32 + r, acc[bm][bn][i]);
}

DI void transpose_tile(const float* __restrict__ src, int K, int N, u16* __restrict__ dst, int kt, int nt, int mode, unsigned char* smem) {
  float* tile = (float*)smem;
  const int tid = TIDX(), tx = tid & 63, ty = tid >> 6;
  const int k0 = kt * 64, n0 = nt * 64;
  __syncthreads();
#pragma unroll 4
  for (int i = 0; i < 16; i++) { int k = i * 4 + ty; int n = n0 + tx; tile[k * 65 + tx] = (n < N) ? src[(size_t)(k0 + k) * N + n] : 0.f; }
  __syncthreads();
#pragma unroll 4
  for (int i = 0; i < 16; i++) {
    int nl = i * 4 + ty; int n = n0 + nl;
    if (n < N) {
      int nd = n;
      if (mode == 1) { int hd = n / 96, d = n - hd * 96; nd = d < 64 ? hd * 64 + d : 512 + hd * 32 + (d - 64); }
      dst[(size_t)nd * K + k0 + tx] = f2bf(tile[tx * 65 + nl]);
    }
  }
}
constexpr int WIN_TT = 16 * 133;
DI void win_transpose_task(const Params& p, int l, int t, unsigned char* smem) {
  int kt = t & 15, nt = t >> 4;
  transpose_tile(p.in[13] + (size_t)l * 1024 * DIN, 1024, DIN, (u16*)(p.ws + W_WINT), kt, nt, 0, smem);
}
constexpr int SMALLW_TT = 384 + 256 + 72 + 64 + 8 + 8;
DI void smallw_transpose_task(const Params& p, int l, int t, unsigned char* smem) {
  if (t < 384) { int g = t / 128, q = t % 128; const float* src = p.in[g == 0 ? 24 : (g == 1 ? 33 : 34)] + (size_t)l * 512 * 1024;
    transpose_tile(src, 512, 1024, (u16*)(p.ws + W_WBRT) + ((size_t)(l * 3 + g)) * 1024 * 512, q & 7, q >> 3, 0, smem); return; }
  t -= 384;
  if (t < 256) { transpose_tile(p.in[35] + (size_t)l * 1024 * 1024, 1024, 1024, (u16*)(p.ws + W_WOUTT) + (size_t)l * 1024 * 1024, t & 15, t >> 4, 0, smem); return; }
  t -= 256;
  if (t < 72) { transpose_tile(p.in[26] + (size_t)l * 384 * 768, 384, 768, (u16*)(p.ws + W_WUQT) + (size_t)l * 768 * 384, t % 6, t / 6, 1, smem); return; }
  t -= 72;
  if (t < 64) { transpose_tile(p.in[28] + (size_t)l * 256 * 1024, 256, 1024, (u16*)(p.ws + W_WUKVT) + (size_t)l * 1024 * 256, t & 3, t >> 2, 0, smem); return; }
  t -= 64;
  if (t < 8) { transpose_tile(p.in[16] + (size_t)l * 64 * 512, 64, 512, (u16*)(p.ws + W_WUPT) + (size_t)l * 512 * 64, 0, t, 0, smem); return; }
  t -= 8;
  transpose_tile(p.in[18] + (size_t)l * 64 * 512, 64, 512, (u16*)(p.ws + W_AUPT) + (size_t)l * 512 * 64, 0, t, 0, smem);
}
DI void mod_task(const Params& p, int task, unsigned char* smem) {
  float* sm = (float*)smem;
  const int tid = TIDX(), l = task / 48, cb = task % 48, kq = tid >> 6, cl = tid & 63, col = cb * 64 + cl;
  __syncthreads();
  for (int e = tid; e < 10240; e += 256) { int r = e >> 10, k = e & 1023; float c = r < 2 ? p.in[8][r * 1024 + k] : p.in[9][(r - 2) * 1024 + k]; sm[e] = siluf_(c); }
  __syncthreads();
  float acc[10];
#pragma unroll
  for (int r = 0; r < 10; r++) acc[r] = 0.f;
  const float* w = p.in[10] + ((size_t)l * 1024 + kq * 256) * 3072 + col;
#pragma unroll 8
  for (int k = 0; k < 256; k++) {
    float wv = w[(size_t)k * 3072];
#pragma unroll
    for (int r = 0; r < 10; r++) acc[r] += sm[r * 1024 + kq * 256 + k] * wv;
  }
  __syncthreads();
#pragma unroll
  for (int r = 0; r < 10; r++) sm[(kq * 10 + r) * 64 + cl] = acc[r];
  __syncthreads();
  if (tid < 64) {
    float* mod = (float*)(p.ws + W_MOD);
    float bb = p.in[11][l * 3072 + col];
#pragma unroll
    for (int r = 0; r < 10; r++) mod[(l * 10 + r) * 3072 + col] = sm[r * 64 + cl] + sm[(10 + r) * 64 + cl] + sm[(20 + r) * 64 + cl] + sm[(30 + r) * 64 + cl] + bb;
  }
}
DI void rope_task(const Params& p, int task) {
  const int tid = TIDX(); const int pos = task * 128 + (tid >> 1);
  float* rope = (float*)(p.ws + W_ROPE);
  for (int ff = 0; ff < 8; ff++) {
    int f = (tid & 1) * 8 + ff;
    double inv = 1.0; for (int j = 0; j < f; j++) inv *= 0.5623413251903491;
    double ang = (double)pos * inv;
    double n = rint(ang * 0.15915494309189535);
    double rr = ang - n * 6.283185307179586 - n * 2.4492935982947064e-16;
    double r2 = rr * rr, sn = rr, cs = 1.0, ts = rr, tc = 1.0;
    for (int k = 1; k <= 15; k++) { tc *= -r2 / (double)((2 * k - 1) * (2 * k)); cs += tc; ts *= -r2 / (double)((2 * k) * (2 * k + 1)); sn += ts; }
    rope[pos * 32 + f] = (float)cs; rope[pos * 32 + 16 + f] = (float)sn;
  }
}
DI void phase0(const Params& p, unsigned char* smem) {
  const int n_tr = WIN_TT + SMALLW_TT, total = n_tr + 192 + 64;
  for (int t = blockIdx.x; t < total; t += gridDim.x) {
    if (t < 192) mod_task(p, t, smem);
    else if (t < 192 + 64) rope_task(p, t - 192);
    else { int q = t - 256; if (q < WIN_TT) win_transpose_task(p, 0, q, smem); else { q -= WIN_TT; smallw_transpose_task(p, 0, q, smem); } }
  }
}

DI const float* xrow_ptr(const Params& p, int l, int row) {
  if (l > 0) return p.out + (size_t)row * D;
  return row < NP ? p.in[0] + (size_t)row * D : p.in[1] + (size_t)(row - NP) * D;
}
DI void phase1(const Params& p, int l) {
  const int lane = TIDX() & 63, wave = TIDX() >> 6;
  const float* mod = (const float*)(p.ws + W_MOD);
  const float* g = p.in[12] + l * 1024;
  u16* H = (u16*)(p.ws + W_H);
  for (int task = blockIdx.x; task < NT / 4; task += gridDim.x) {
    int row = task * 4 + wave;
    const float* x = xrow_ptr(p, l, row);
    const float* md = mod + (l * 10 + bidx_of(row)) * 3072;
    float4 v[4]; float ss = 0.f;
#pragma unroll
    for (int j = 0; j < 4; j++) { v[j] = *(const float4*)(x + (j * 64 + lane) * 4); ss += v[j].x * v[j].x + v[j].y * v[j].y + v[j].z * v[j].z + v[j].w * v[j].w; }
    ss = red64(ss);
    float rstd = rsqrtf(ss * (1.f / 1024.f) + RMS_EPS);
#pragma unroll
    for (int j = 0; j < 4; j++) {
      int c = (j * 64 + lane) * 4;
      float4 gg = *(const float4*)(g + c), sh = *(const float4*)(md + c), sc = *(const float4*)(md + 1024 + c);
      float h0 = v[j].x * rstd * gg.x * (1.f + sc.x) + sh.x, h1 = v[j].y * rstd * gg.y * (1.f + sc.y) + sh.y;
      float h2 = v[j].z * rstd * gg.z * (1.f + sc.z) + sh.z, h3 = v[j].w * rstd * gg.w * (1.f + sc.w) + sh.w;
      uint2 o; o.x = pk2(h0, h1); o.y = pk2(h2, h3);
      *(uint2*)(H + (size_t)row * 1024 + c) = o;
    }
  }
}

DI void phase2(const Params& p, int l, unsigned char* smem) {
  const u16* H = (const u16*)(p.ws + W_H);
  const u16* WinT = (const u16*)(p.ws + W_WINT);
  float* PR = (float*)(p.ws + W_PR);
  u16* Z = (u16*)(p.ws + W_Z);
  float* CQ = (float*)(p.ws + W_CQ); float* CKV = (float*)(p.ws + W_CKV); float* KR = (float*)(p.ws + W_KR);
  u16* SQ = (u16*)(p.ws + W_SQ); u16* SBK = (u16*)(p.ws + W_SBK); u16* SBVT = (u16*)(p.ws + W_SBVT);
  float* out = p.out;
  for (int ts = blockIdx.x; ts < 11 * 512; ts += gridDim.x) {
    int mt, nt;
    {
      const int rd = ts >> 9, bq = ts & 511, sm = bq & 7, j = bq >> 3;
      mt = sm * 16 + (j & 15); nt = rd * 4 + (j >> 4);
      if (nt >= 43) { const int e = sm * 16 + (j & 15); if (e >= 43) continue; mt = 128; nt = e; }
    }
    const int m0 = mt * 128;
    int seg, n0, c0;
    if (nt < 13) { seg = 0; c0 = nt * 128; n0 = c0; }
    else if (nt < 17) { seg = 1; c0 = (nt - 13) * 128; n0 = 1664 + c0; }
    else if (nt < 20) { seg = 2; c0 = (nt - 17) * 128; n0 = 2176 + c0; }
    else if (nt < 22) { seg = 3; c0 = (nt - 20) * 128; n0 = 2560 + c0; }
    else if (nt < 26) { seg = 4; c0 = (nt - 22) * 128; n0 = 2848 + c0; }
    else if (nt < 30) { seg = 5; c0 = (nt - 26) * 128; n0 = 3360 + c0; }
    else if (nt < 34) { seg = 6; c0 = (nt - 30) * 128; n0 = 3872 + c0; }
    else if (nt < 38) { seg = 7; c0 = (nt - 34) * 128; n0 = 4384 + c0; }
    else if (nt < 42) { seg = 8; c0 = (nt - 38) * 128; n0 = 4896 + c0; }
    else { seg = 9; c0 = 0; n0 = 2816; }
    f32x16 acc[2][2]; zero_acc(acc);
    gemm_mainloop(acc, H + (size_t)m0 * 1024, 1024, WinT + (size_t)n0 * 1024, 1024, 1024, smem);
    if (seg == 0) {
      foreach_acc(acc, m0, c0, [&](int row, int col, float v) {
        PR[(size_t)row * 1664 + col] = v;
        if (row < NP) { if ((row & 8191) == 8191) out[O_SHIFT_P + (size_t)(l * 2 + (row >> 13)) * 1664 + col] = v; }
        else { int rr = row - NP; if ((rr & 15) == 15) out[O_SHIFT_S + (size_t)(l * 8 + (rr >> 4)) * 1664 + col] = v; }
      });
    } else if (seg == 1 || seg == 4 || seg == 8) {
      const int g = seg == 1 ? 0 : (seg == 4 ? 1 : 2);
      foreach_acc(acc, m0, c0, [&](int row, int col, float v) { Z[((size_t)g * NT + row) * 512 + col] = f2bf(siluf_(v)); });
    } else if (seg == 2) {
      foreach_acc(acc, m0, c0, [&](int row, int col, float v) { CQ[(size_t)row * 384 + col] = v; });
    } else if (seg == 3) {
      foreach_acc(acc, m0, c0, [&](int row, int col, float v) { CKV[(size_t)row * 256 + col] = v; });
    } else if (seg == 9) {
      foreach_acc(acc, m0, c0, [&](int row, int col, float v) { if (col < 32) KR[(size_t)row * 32 + col] = v; });
    } else if (seg == 5) {
      foreach_acc(acc, m0, c0, [&](int row, int col, float v) { SQ[(size_t)row * 512 + col] = f2bf(v * QSCALE_SB); });
    } else if (seg == 6) {
      foreach_acc(acc, m0, c0, [&](int row, int col, float v) {
        size_t oo = row < NP ? O_SBK_P + ((size_t)l * NP + row) * 512 + col : O_SBK_S + ((size_t)l * NS + (row - NP)) * 512 + col;
        out[oo] = v;
        SBK[(size_t)keyrow_of(row) * 512 + col] = f2bf(v);
      });
    } else {
      foreach_acc(acc, m0, c0, [&](int row, int col, float v) {
        size_t oo = row < NP ? O_SBV_P + ((size_t)l * NP + row) * 512 + col : O_SBV_S + ((size_t)l * NS + (row - NP)) * 512 + col;
        out[oo] = v;
      });
      const int lane = TIDX() & 63, wave = TIDX() >> 6, wm = wave >> 1, wn = wave & 1, r = lane & 31, hl = lane >> 5;
#pragma unroll
      for (int bm = 0; bm < 2; bm++)
#pragma unroll
        for (int bn = 0; bn < 2; bn++)
#pragma unroll
          for (int g4 = 0; g4 < 4; g4++) {
            int row = m0 + wm * 64 + bm * 32 + 8 * g4 + 4 * hl, col = c0 + wn * 64 + bn * 32 + r;
            uint2 o; o.x = pk2(acc[bm][bn][4 * g4], acc[bm][bn][4 * g4 + 1]); o.y = pk2(acc[bm][bn][4 * g4 + 2], acc[bm][bn][4 * g4 + 3]);
            *(uint2*)(SBVT + vt_off(keyrow_of(row), col >> 6, col & 63)) = o;
          }
    }
  }
}

DI const float* prev_ptr(const Params& p, int l, const float* PR, int row) {
  if (row < NP) return (row & 8191) ? PR + (size_t)(row - 1) * 1664 : nullptr;
  int rr = row - NP;
  return (rr & 15) ? PR + (size_t)(row - 1) * 1664 : p.in[3] + (size_t)(l * 8 + (rr >> 4)) * 1664;
}
DI void rwkv_prep_task(const Params& p, int l, int task) {
  const int lane = TIDX() & 63, wave = TIDX() >> 6, r = lane & 31, hl = lane >> 5;
  const int tile = task >> 1, hh = (task & 1) * 4 + wave, row0 = tile * 32;
  const float* PR = (const float*)(p.ws + W_PR);
  const float* mu = p.in[14] + l * 1664;
  f32x16 accW[1][2], accA[1][2];
#pragma unroll
  for (int b_ = 0; b_ < 2; b_++)
#pragma unroll
    for (int i_ = 0; i_ < 16; i_++) { accW[0][b_][i_] = 0.f; accA[0][b_][i_] = 0.f; }
  const u16* WupT = (const u16*)(p.ws + W_WUPT) + (size_t)l * 512 * 64;
  const u16* AupT = (const u16*)(p.ws + W_AUPT) + (size_t)l * 512 * 64;
#pragma unroll 1
  for (int ks = 0; ks < 4; ks++) {
    const int k0 = ks * 16 + hl * 8;
    bf16x8 bw[2], ba[2];
#pragma unroll
    for (int bn = 0; bn < 2; bn++) {
      bw[bn] = *(const bf16x8*)(WupT + (size_t)(hh * 64 + bn * 32 + r) * 64 + k0);
      ba[bn] = *(const bf16x8*)(AupT + (size_t)(hh * 64 + bn * 32 + r) * 64 + k0);
    }
#pragma unroll
    for (int bm = 0; bm < 1; bm++) {
      const int row = row0 + bm * 32 + r;
      const float* pp = PR + (size_t)row * 1664;
      const float* pv = prev_ptr(p, l, PR, row);
      float xw[8], xa[8];
#pragma unroll
      for (int q = 0; q < 2; q++) {
        float4 a = *(const float4*)(pp + 1536 + k0 + 4 * q), b = pv ? *(const float4*)(pv + 1536 + k0 + 4 * q) : make_float4(0, 0, 0, 0), m = *(const float4*)(mu + 1536 + k0 + 4 * q);
        xw[4 * q] = tanhf(a.x + (b.x - a.x) * m.x); xw[4 * q + 1] = tanhf(a.y + (b.y - a.y) * m.y); xw[4 * q + 2] = tanhf(a.z + (b.z - a.z) * m.z); xw[4 * q + 3] = tanhf(a.w + (b.w - a.w) * m.w);
        a = *(const float4*)(pp + 1600 + k0 + 4 * q); b = pv ? *(const float4*)(pv + 1600 + k0 + 4 * q) : make_float4(0, 0, 0, 0); m = *(const float4*)(mu + 1600 + k0 + 4 * q);
        xa[4 * q] = a.x + (b.x - a.x) * m.x; xa[4 * q + 1] = a.y + (b.y - a.y) * m.y; xa[4 * q + 2] = a.z + (b.z - a.z) * m.z; xa[4 * q + 3] = a.w + (b.w - a.w) * m.w;
      }
      u32x4 uw, ua;
      uw.x = pk2(xw[0], xw[1]); uw.y = pk2(xw[2], xw[3]); uw.z = pk2(xw[4], xw[5]); uw.w = pk2(xw[6], xw[7]);
      ua.x = pk2(xa[0], xa[1]); ua.y = pk2(xa[2], xa[3]); ua.z = pk2(xa[4], xa[5]); ua.w = pk2(xa[6], xa[7]);
      bf16x8 awf = __builtin_bit_cast(bf16x8, uw), aaf = __builtin_bit_cast(bf16x8, ua);
#pragma unroll
      for (int bn = 0; bn < 2; bn++) { accW[bm][bn] = MFMA32(awf, bw[bn], accW[bm][bn]); accA[bm][bn] = MFMA32(aaf, ba[bn], accA[bm][bn]); }
    }
  }
  float* RWW = (float*)(p.ws + W_RWW); u16* RWX = (u16*)(p.ws + W_RWX); float* RHO = (float*)(p.ws + W_RHO);
  float mur[2], muk[2], muv[2], w0[2], a0[2], kk_[2], ka_[2], rk_[2];
#pragma unroll
  for (int bn = 0; bn < 2; bn++) {
    int col = hh * 64 + bn * 32 + r;
    mur[bn] = mu[col]; muk[bn] = mu[512 + col]; muv[bn] = mu[1024 + col];
    w0[bn] = p.in[15][l * 512 + col]; a0[bn] = p.in[17][l * 512 + col]; kk_[bn] = p.in[19][l * 512 + col]; ka_[bn] = p.in[20][l * 512 + col]; rk_[bn] = p.in[21][l * 512 + col];
  }
#pragma unroll
  for (int bm = 0; bm < 1; bm++)
#pragma unroll
    for (int i = 0; i < 16; i++) {
      const int row = row0 + bm * 32 + crow(i, hl);
      const float* pp = PR + (size_t)row * 1664;
      const float* pv = prev_ptr(p, l, PR, row);
      float xr[2], xv[2], kp[2], kkr[2], av[2], dec[2];
      float ssq = 0.f, rho = 0.f;
#pragma unroll
      for (int bn = 0; bn < 2; bn++) {
        int col = hh * 64 + bn * 32 + r;
        float pr_ = pp[col], pk_ = pp[512 + col], pv_ = pp[1024 + col];
        float qr = pv ? pv[col] : 0.f, qk = pv ? pv[512 + col] : 0.f, qv = pv ? pv[1024 + col] : 0.f;
        xr[bn] = pr_ + (qr - pr_) * mur[bn];
        float xk = pk_ + (qk - pk_) * muk[bn];
        xv[bn] = pv_ + (qv - pv_) * muv[bn];
        float wpre = w0[bn] + accW[bm][bn][i];
        float wlog = -softplusf_(-wpre) - 0.5f;
        dec[bn] = __expf(-__expf(wlog));
        av[bn] = sigmoidf_(a0[bn] + accA[bm][bn][i]);
        kkr[bn] = xk * kk_[bn];
        kp[bn] = xk * (1.f + (av[bn] - 1.f) * ka_[bn]);
        ssq += kkr[bn] * kkr[bn];
        rho += xr[bn] * kp[bn] * rk_[bn];
      }
      ssq = red32(ssq); rho = red32(rho);
      float inv = 1.f / fmaxf(sqrtf(ssq), 1e-12f);
#pragma unroll
      for (int bn = 0; bn < 2; bn++) {
        int col = hh * 64 + bn * 32 + r;
        float kk = kkr[bn] * inv;
        RWW[(size_t)row * 512 + col] = dec[bn];
        u16* rx = RWX + (size_t)row * 2560 + col;
        rx[0] = f2bf(xr[bn]); rx[512] = f2bf(kp[bn]); rx[1024] = f2bf(xv[bn]); rx[1536] = f2bf(kk); rx[2048] = f2bf(kk * av[bn]);
      }
      if (r == 0) RHO[(size_t)row * 8 + hh] = rho;
    }
}
DI void norm_row_task(const Params& p, int l, int task) {
  const int lane = TIDX() & 63, wave = TIDX() >> 6;
  const int row = task * 4 + wave;
  const float* CQ = (const float*)(p.ws + W_CQ); const float* CKV = (const float*)(p.ws + W_CKV); const float* KR = (const float*)(p.ws + W_KR);
  u16* QN = (u16*)(p.ws + W_QN); u16* CKVN = (u16*)(p.ws + W_CKVN); u16* KF = (u16*)(p.ws + W_KF);
  const int keyrow = keyrow_of(row);
  {
    float v[6], ss = 0.f;
#pragma unroll
    for (int j = 0; j < 6; j++) { v[j] = CQ[(size_t)row * 384 + j * 64 + lane]; ss += v[j] * v[j]; }
    ss = red64(ss); float rstd = rsqrtf(ss * (1.f / 384.f) + RMS_EPS);
#pragma unroll
    for (int j = 0; j < 6; j++) QN[(size_t)row * 384 + j * 64 + lane] = f2bf(v[j] * rstd * p.in[25][l * 384 + j * 64 + lane]);
  }
  {
    float4 v = *(const float4*)(CKV + (size_t)row * 256 + lane * 4);
    float ss = red64(v.x * v.x + v.y * v.y + v.z * v.z + v.w * v.w);
    float rstd = rsqrtf(ss * (1.f / 256.f) + RMS_EPS);
    float4 g = *(const float4*)(p.in[27] + l * 256 + lane * 4);
    float4 o = make_float4(v.x * rstd * g.x, v.y * rstd * g.y, v.z * rstd * g.z, v.w * rstd * g.w);
    size_t oo = row < NP ? O_CKV_P + ((size_t)l * NP + row) * 256 : O_CKV_S + ((size_t)l * NS + (row - NP)) * 256;
    *(float4*)(p.out + oo + lane * 4) = o;
    uint2 ob; ob.x = pk2(o.x, o.y); ob.y = pk2(o.z, o.w);
    *(uint2*)(CKVN + (size_t)keyrow * 256 + lane * 4) = ob;
  }
  {
    float x = lane < 32 ? KR[(size_t)row * 32 + lane] : 0.f;
    float ss = red64(x * x); float rstd = rsqrtf(ss * (1.f / 32.f) + RMS_EPS);
    float xn = x * rstd * p.in[32][l * 32 + (lane & 31)];
    float pt = __shfl_xor(xn, 16);
    const float* rp = (const float*)(p.ws + W_ROPE) + pos_of(row) * 32;
    float cs = rp[lane & 15], sn = rp[16 + (lane & 15)];
    float o = (lane & 16) ? (pt * sn + xn * cs) : (xn * cs - pt * sn);
    if (lane < 32) {
      size_t oo = row < NP ? O_KROPE_P + ((size_t)l * NP + row) * 32 : O_KROPE_S + ((size_t)l * NS + (row - NP)) * 32;
      p.out[oo + lane] = o;
      u16 ob = f2bf(o);
#pragma unroll
      for (int hd = 0; hd < 8; hd++) KF[(size_t)keyrow * 768 + hd * 96 + 64 + lane] = ob;
    }
  }
}
DI void past_convert_task(const Params& p, int l, int task) {
  const int tid = TIDX();
  if (task < 2048) {
    size_t e = ((size_t)task * 256 + tid) * 8; int rowp = (int)(e >> 8), c = (int)(e & 255); int b = rowp >> 11, s = rowp & 2047;
    const float* src = p.in[4] + ((size_t)(l * 8 + b) * PAST + s) * 256 + c;
    float4 a = *(const float4*)src, bq = *(const float4*)(src + 4);
    uint4 o; o.x = pk2(a.x, a.y); o.y = pk2(a.z, a.w); o.z = pk2(bq.x, bq.y); o.w = pk2(bq.z, bq.w);
    *(uint4*)((u16*)(p.ws + W_CKVN) + (size_t)(NP + b * SK + s) * 256 + c) = o; return;
  }
  task -= 2048;
  if (task < 4096) {
    size_t e = ((size_t)task * 256 + tid) * 8; int rowp = (int)(e >> 9), c = (int)(e & 511); int b = rowp >> 11, s = rowp & 2047;
    const float* src = p.in[6] + ((size_t)(l * 8 + b) * PAST + s) * 512 + c;
    float4 a = *(const float4*)src, bq = *(const float4*)(src + 4);
    uint4 o; o.x = pk2(a.x, a.y); o.y = pk2(a.z, a.w); o.z = pk2(bq.x, bq.y); o.w = pk2(bq.z, bq.w);
    *(uint4*)((u16*)(p.ws + W_SBK) + (size_t)(NP + b * SK + s) * 512 + c) = o; return;
  }
  task -= 4096;
  if (task < 4096) {
    int id = task * 256 + tid; int c = id & 511, sg = (id >> 9) & 255, b = id >> 17;
    const float* src = p.in[7] + ((size_t)(l * 8 + b) * PAST + sg * 8) * 512 + c;
    float v[8];
#pragma unroll
    for (int j = 0; j < 8; j++) v[j] = src[(size_t)j * 512];
    uint4 o; o.x = pk2(v[0], v[1]); o.y = pk2(v[2], v[3]); o.z = pk2(v[4], v[5]); o.w = pk2(v[6], v[7]);
    *(uint4*)((u16*)(p.ws + W_SBVT) + VT_S_OFF + ((size_t)((b * 8 + (c >> 6)) * 64 + (c & 63))) * SK + sg * 8) = o; return;
  }
  task -= 4096;
  {
    int id = task * 256 + tid; int ch = id & 7, rowp = id >> 3; int b = rowp >> 11, s = rowp & 2047;
    float4 a = *(const float4*)(p.in[5] + ((size_t)(l * 8 + b) * PAST + s) * 32 + ch * 4);
    uint2 o; o.x = pk2(a.x, a.y); o.y = pk2(a.z, a.w);
    u16* dst = (u16*)(p.ws + W_KF) + (size_t)(NP + b * SK + s) * 768 + 64 + ch * 4;
#pragma unroll
    for (int hd = 0; hd < 8; hd++) *(uint2*)(dst + hd * 96) = o;
  }
}
DI void phase3(const Params& p, int l) {
  const int nA = 1032, nB = NT / 4, nC = 2048 + 4096 + 4096 + 512, total = nA + nB + nC;
  for (int t = blockIdx.x; t < total; t += gridDim.x) {
    if (t < nA) rwkv_prep_task(p, l, t);
    else if (t < nA + nB) norm_row_task(p, l, t - nA);
    else past_convert_task(p, l, t - nA - nB);
  }
}

DI void rwkv_pass1_task(const Params& p, int bh, int seg, int rq, unsigned char* smem);
DI void phase4(const Params& p, int l, unsigned char* smem) {
  const int lane = TIDX() & 63, wave = TIDX() >> 6, wm = wave >> 1, wn = wave & 1, r = lane & 31, hl = lane >> 5;
  const float* rope = (const float*)(p.ws + W_ROPE);
  u16* QF = (u16*)(p.ws + W_QF); u16* KF = (u16*)(p.ws + W_KF); u16* VT = (u16*)(p.ws + W_MLAVT);
  const int nQ = 129 * 6, nKV = 257 * 8;
  __shared__ int s_task4;
  int* ctr4 = (int*)(p.ws + W_CTR) + 8 + l;
  while (true) {
    __syncthreads();
    if (TIDX() == 0) s_task4 = atomicAdd(ctr4, 1);
    __syncthreads();
    const int q4 = s_task4;
    if (q4 >= 448 + nQ + nKV) break;
    const int t0 = q4 < 896 ? ((q4 & 1) ? 448 + (q4 >> 1) : (q4 >> 1)) : q4;
    if (t0 < 448) { int bh = t0 / 28, rem = t0 - bh * 28; rwkv_pass1_task(p, bh, rem >> 2, rem & 3, smem); continue; }
    const int t = t0 - 448;
    f32x16 acc[2][2]; zero_acc(acc);
    if (t < nQ) {
      const int mt = t % 129, nt = t / 129, m0 = mt * 128;
      gemm_mainloop(acc, (const u16*)(p.ws + W_QN) + (size_t)m0 * 384, 384, (const u16*)(p.ws + W_WUQT) + ((size_t)l * 768 + nt * 128) * 384, 384, 384, smem);
      if (nt < 4) {
        const int head = nt * 2 + wn;
        float g0 = p.in[29][l * 64 + r] * QSCALE_MLA, g1 = p.in[29][l * 64 + 32 + r] * QSCALE_MLA;
#pragma unroll
        for (int bm = 0; bm < 2; bm++)
#pragma unroll
          for (int i = 0; i < 16; i++) {
            float a = acc[bm][0][i], b = acc[bm][1][i];
            float ss = red32(a * a + b * b); float rstd = rsqrtf(ss * (1.f / 64.f) + RMS_EPS);
            int row = m0 + wm * 64 + bm * 32 + crow(i, hl);
            u16* q = QF + (size_t)row * 768 + head * 96;
            q[r] = f2bf(a * rstd * g0); q[32 + r] = f2bf(b * rstd * g1);
          }
      } else {
        float g = p.in[30][l * 32 + r] * QSCALE_MLA;
#pragma unroll
        for (int bm = 0; bm < 2; bm++)
#pragma unroll
          for (int bn = 0; bn < 2; bn++)
#pragma unroll
            for (int i = 0; i < 16; i++) {
              const int head = (nt - 4) * 4 + wn * 2 + bn;
              float a = acc[bm][bn][i];
              float ss = red32(a * a); float rstd = rsqrtf(ss * (1.f / 32.f) + RMS_EPS);
              float xn = a * rstd * g; float pt = __shfl_xor(xn, 16);
              int row = m0 + wm * 64 + bm * 32 + crow(i, hl);
              const float* rp = rope + pos_of(row) * 32;
              float cs = rp[r & 15], sn = rp[16 + (r & 15)];
              float o = (r & 16) ? (pt * sn + xn * cs) : (xn * cs - pt * sn);
              QF[(size_t)row * 768 + head * 96 + 64 + r] = f2bf(o);
            }
      }
    } else {
      const int q = t - nQ, mt = q % 257, head = q / 257, m0 = mt * 128;
      gemm_mainloop(acc, (const u16*)(p.ws + W_CKVN) + (size_t)m0 * 256, 256, (const u16*)(p.ws + W_WUKVT) + ((size_t)l * 1024 + head * 128) * 256, 256, 256, smem);
      if (wn == 0) {
        float g0 = p.in[31][l * 64 + r], g1 = p.in[31][l * 64 + 32 + r];
#pragma unroll
        for (int bm = 0; bm < 2; bm++)
#pragma unroll
          for (int i = 0; i < 16; i++) {
            float a = acc[bm][0][i], b = acc[bm][1][i];
            float ss = red32(a * a + b * b); float rstd = rsqrtf(ss * (1.f / 64.f) + RMS_EPS);
            int krow = m0 + wm * 64 + bm * 32 + crow(i, hl);
            u16* k = KF + (size_t)krow * 768 + head * 96;
            k[r] = f2bf(a * rstd * g0); k[32 + r] = f2bf(b * rstd * g1);
          }
      } else {
#pragma unroll
        for (int bm = 0; bm < 2; bm++)
#pragma unroll
          for (int bn = 0; bn < 2; bn++)
#pragma unroll
            for (int g4 = 0; g4 < 4; g4++) {
              int krow = m0 + wm * 64 + bm * 32 + 8 * g4 + 4 * hl, d = bn * 32 + r;
              uint2 o; o.x = pk2(acc[bm][bn][4 * g4], acc[bm][bn][4 * g4 + 1]); o.y = pk2(acc[bm][bn][4 * g4 + 2], acc[bm][bn][4 * g4 + 3]);
              *(uint2*)(VT + vt_off(krow, head, d)) = o;
            }
      }
    }
  }
}

template <int DK, bool SB>
DI void attn_task(const u16* __restrict__ Qp, int qstride, int nq_valid, const u16* __restrict__ Kp, int kstride,
                  const u16* __restrict__ Vtp, int vstride, int nkeys, int qpos0,
                  const u16* __restrict__ Zp, u16* __restrict__ Yp, unsigned char* smem) {
  constexpr int KS = DK / 16, KSTR = DK + 8, KCH = DK / 8, NKL = 64 * KCH / 256;
  u16* sK = (u16*)smem; u16* sV = sK + 64 * KSTR;
  const int tid = TIDX(), lane = tid & 63, wave = tid >> 6, r = lane & 31, hl = lane >> 5;
  const int slot = wave * 32 + r;
  const bool wave_active = wave * 32 < nq_valid;
  const int qpos = qpos0 + slot;
  bf16x8 qf[KS];
  {
    const u16* qrow = Qp + (size_t)(slot < nq_valid ? slot : 0) * qstride + hl * 8;
#pragma unroll
    for (int ks = 0; ks < KS; ks++) qf[ks] = *(const bf16x8*)(qrow + ks * 16);
  }
  f32x16 O[2];
#pragma unroll
  for (int b = 0; b < 2; b++)
#pragma unroll
    for (int i = 0; i < 16; i++) O[b][i] = 0.f;
  float m_run = -1e30f, l_run = 0.f, R = 1.f;
  const int last_qpos = qpos0 + nq_valid - 1;
  int ntiles = SB ? (last_qpos - 1) / 64 + 1 : last_qpos / 64 + 1;
  { int mx = (nkeys + 63) >> 6; if (ntiles > mx) ntiles = mx; }
  const int wave_q0 = qpos0 + wave * 32;
  u32x4 rk[NKL], rv[2];
  auto prefetch = [&](int kt) {
#pragma unroll
    for (int i = 0; i < NKL; i++) { int c = tid + 256 * i; int row = c / KCH, ch = c - row * KCH; rk[i] = *(const u32x4*)(Kp + (size_t)(kt * 64 + row) * kstride + ch * 8); }
#pragma unroll
    for (int i = 0; i < 2; i++) { int c = tid + 256 * i; int row = c >> 3, ch = c & 7; rv[i] = *(const u32x4*)(Vtp + (size_t)row * vstride + kt * 64 + ch * 8); }
  };
  prefetch(SB ? ntiles - 1 : 0);
  for (int it = 0; it < ntiles; it++) {
    const int kt = SB ? ntiles - 1 - it : it;
    __syncthreads();
#pragma unroll
    for (int i = 0; i < NKL; i++) { int c = tid + 256 * i; int row = c / KCH, ch = c - row * KCH; *(u32x4*)(sK + row * KSTR + ch * 8) = rk[i]; }
#pragma unroll
    for (int i = 0; i < 2; i++) { int c = tid + 256 * i; int row = c >> 3, ch = c & 7; *(u32x4*)(sV + row * 72 + ch * 8) = rv[i]; }
    __syncthreads();
    { int nx = SB ? kt - 1 : kt + 1; if (it + 1 >= ntiles) nx = kt; prefetch(nx); }
    bool doit;
    if (SB) doit = wave_active && (kt * 64 < wave_q0 + 31);
    else doit = wave_active && (kt <= (wave_q0 >> 6));
    if (doit) {
    f32x16 S[2];
#pragma unroll
    for (int kb = 0; kb < 2; kb++) {
#pragma unroll
      for (int i = 0; i < 16; i++) S[kb][i] = 0.f;
#pragma unroll
      for (int ks = 0; ks < KS; ks++) {
        bf16x8 kf = *(const bf16x8*)(sK + (kb * 32 + r) * KSTR + ks * 16 + hl * 8);
        S[kb] = MFMA32(kf, qf[ks], S[kb]);
      }
    }
    const int key0 = kt * 64 + 4 * hl;
    if (!SB) {
      const bool need_mask = (kt + 1) * 64 > nkeys;
      if (need_mask) {
#pragma unroll
        for (int kb = 0; kb < 2; kb++)
#pragma unroll
          for (int i = 0; i < 16; i++) { int key = key0 + kb * 32 + (i & 3) + 8 * (i >> 2); if (key >= nkeys) S[kb][i] = -1e30f; }
      }
      float tmax = -1e30f;
#pragma unroll
      for (int kb = 0; kb < 2; kb++)
#pragma unroll
        for (int i = 0; i < 16; i++) tmax = fmaxf(tmax, S[kb][i]);
      tmax = fmaxf(tmax, __shfl_xor(tmax, 32));
      float m_new = fmaxf(m_run, tmax);
      float alpha = ex2(m_run - m_new);
      m_run = m_new;
      float ps = 0.f;
#pragma unroll
      for (int kb = 0; kb < 2; kb++)
#pragma unroll
        for (int i = 0; i < 16; i++) { float pv = ex2(S[kb][i] - m_new); S[kb][i] = pv; ps += pv; }
      l_run = l_run * alpha + ps;
#pragma unroll
      for (int b = 0; b < 2; b++)
#pragma unroll
        for (int i = 0; i < 16; i++) O[b][i] *= alpha;
    } else {
      const bool need_mask = (kt * 64 + 63 >= wave_q0) || ((kt + 1) * 64 > nkeys);
#pragma unroll
      for (int kb = 0; kb < 2; kb++)
#pragma unroll
        for (int i = 0; i < 16; i++) {
          float d = __builtin_amdgcn_rcpf(1.f + ex2(S[kb][i]));
          if (need_mask) { int key = key0 + kb * 32 + (i & 3) + 8 * (i >> 2); if (!(key < nkeys && key < qpos)) d = 1.f; }
          S[kb][i] = d;
        }
      float gs[8], pg[8], sa[8];
#pragma unroll
      for (int o = 0; o < 8; o++) { int kb = o >> 2, g = o & 3; gs[o] = (S[kb][4 * g] * S[kb][4 * g + 1]) * (S[kb][4 * g + 2] * S[kb][4 * g + 3]); }
#pragma unroll
      for (int o = 0; o < 8; o++) pg[o] = __shfl_xor(gs[o], 32);
      sa[7] = R;
#pragma unroll
      for (int o = 6; o >= 0; o--) sa[o] = sa[o + 1] * (gs[o + 1] * pg[o + 1]);
      const float total = sa[0] * (gs[0] * pg[0]);
#pragma unroll
      for (int o = 0; o < 8; o++) {
        int kb = o >> 2, g = o & 3;
        float c = hl == 0 ? sa[o] * pg[o] : sa[o];
#pragma unroll
        for (int e = 3; e >= 0; e--) {
          float d = S[kb][4 * g + e];
          S[kb][4 * g + e] = c - d * c;
          c *= d;
        }
      }
      R = total;
    }
#pragma unroll
    for (int kb = 0; kb < 2; kb++)
#pragma unroll
      for (int s2 = 0; s2 < 2; s2++) {
        uint4 u;
        u.x = pk2(S[kb][8 * s2], S[kb][8 * s2 + 1]); u.y = pk2(S[kb][8 * s2 + 2], S[kb][8 * s2 + 3]);
        u.z = pk2(S[kb][8 * s2 + 4], S[kb][8 * s2 + 5]); u.w = pk2(S[kb][8 * s2 + 6], S[kb][8 * s2 + 7]);
        bf16x8 pf = __builtin_bit_cast(bf16x8, u);
#pragma unroll
        for (int bd = 0; bd < 2; bd++) {
          const u16* vp = sV + (bd * 32 + r) * 72 + kb * 32 + s2 * 16 + hl * 4;
          uint2 lo = *(const uint2*)vp, hi = *(const uint2*)(vp + 8);
          uint4 vv; vv.x = lo.x; vv.y = lo.y; vv.z = hi.x; vv.w = hi.y;
          O[bd] = MFMA32(__builtin_bit_cast(bf16x8, vv), pf, O[bd]);
        }
      }
    }
    if (SB) {
      const bool lane_done = !wave_active || slot >= nq_valid || R < 1e-30f;
      const int wdone = __all(lane_done);
      if (__syncthreads_and(wdone)) break;
    }
  }
  if (wave_active && slot < nq_valid) {
    float sc = 1.f;
    if (!SB) { float lt = l_run + __shfl_xor(l_run, 32); sc = 1.f / lt; }
#pragma unroll
    for (int bd = 0; bd < 2; bd++)
#pragma unroll
      for (int g = 0; g < 4; g++) {
        int d0 = bd * 32 + 8 * g + 4 * hl;
        uint2 zz = *(const uint2*)(Zp + (size_t)slot * 512 + d0);
        uint2 o;
        o.x = pk2(O[bd][4 * g] * sc * bflo(zz.x), O[bd][4 * g + 1] * sc * bfhi(zz.x));
        o.y = pk2(O[bd][4 * g + 2] * sc * bflo(zz.y), O[bd][4 * g + 3] * sc * bfhi(zz.y));
        *(uint2*)(Yp + (size_t)slot * 512 + d0) = o;
      }
  }
}

template <int CTRL> DI float dpp_add(float x) {
  return x + __int_as_float(__builtin_amdgcn_update_dpp(0, __float_as_int(x), CTRL, 0xF, 0xF, true));
}
DI void allreduce16x2(float& a, float& b) {
  a = dpp_add<0xB1>(a); b = dpp_add<0xB1>(b); a = dpp_add<0x4E>(a); b = dpp_add<0x4E>(b);
  a = dpp_add<0x141>(a); b = dpp_add<0x141>(b); a = dpp_add<0x140>(a); b = dpp_add<0x140>(b);
}
#define SCAN_PREFETCH(slot, cc) { int c_ = (cc) < nch ? (cc) : nch - 1; size_t row = (size_t)(srow0 + c_ * 16 + lstep); \
    pw[slot] = *(const f32x4v*)(RWW + row * 512 + h * 64 + lpart); \
    _Pragma("unroll") for (int c = 0; c < 5; c++) px[slot][c] = *(const u32x2*)(RWX + row * 2560 + c * 512 + h * 64 + lpart); }
#define SCAN_STAGE(slot, bsel) { float* o = ops + ((bsel) * 16 + lstep) * 384 + lpart; \
    f32x4v r4 = {bflo(px[slot][0].x), bfhi(px[slot][0].x), bflo(px[slot][0].y), bfhi(px[slot][0].y)}; \
    f32x4v k4 = {bflo(px[slot][1].x), bfhi(px[slot][1].x), bflo(px[slot][1].y), bfhi(px[slot][1].y)}; \
    f32x4v v4 = {bflo(px[slot][2].x), bfhi(px[slot][2].x), bflo(px[slot][2].y), bfhi(px[slot][2].y)}; \
    f32x4v kk4 = {bflo(px[slot][3].x), bfhi(px[slot][3].x), bflo(px[slot][3].y), bfhi(px[slot][3].y)}; \
    f32x4v b4 = {bflo(px[slot][4].x), bfhi(px[slot][4].x), bflo(px[slot][4].y), bfhi(px[slot][4].y)}; \
    *(f32x4v*)(o) = pw[slot]; *(f32x4v*)(o + 64) = pw[slot] * r4; *(f32x4v*)(o + 128) = k4; *(f32x4v*)(o + 192) = v4; *(f32x4v*)(o + 256) = kk4; *(f32x4v*)(o + 320) = b4; \
    float br = b4.x * r4.x + b4.y * r4.y + b4.z * r4.z + b4.w * r4.w; \
    float kr = k4.x * r4.x + k4.y * r4.y + k4.z * r4.z + k4.w * r4.w; \
    allreduce16x2(br, kr); \
    if ((tid & 15) == 0) { sc[((bsel) * 16 + lstep) * 2] = br; sc[((bsel) * 16 + lstep) * 2 + 1] = kr; } }

DI void rwkv_pass1_task(const Params& p, int bh, int seg, int rq, unsigned char* smem) {
  float* ops = (float*)smem; float* sc = ops + 2 * 16 * 384;
  const int tid = TIDX(), i = tid >> 4, cg = tid & 15, cg4 = cg * 4;
  const int Rr = rq * 16 + i, h = bh & 7;
  const int srow0 = (bh >> 3) * TP + seg * 1024;
  const float* RWW = (const float*)(p.ws + W_RWW); const u16* RWX = (const u16*)(p.ws + W_RWX);
  float SL[4] = {0.f, 0.f, 0.f, 0.f}, SP[4];
#pragma unroll
  for (int e = 0; e < 4; e++) SP[e] = (cg4 + e == Rr) ? 1.f : 0.f;
  const int lstep = tid >> 4, lpart = (tid & 15) * 4;
  f32x4v pw[4]; u32x2 px[4][5];
  const int nch = 64;
  SCAN_PREFETCH(0, 0) SCAN_PREFETCH(1, 1) SCAN_PREFETCH(2, 2) SCAN_PREFETCH(3, 3)
  __syncthreads();
  SCAN_STAGE(0, 0)
  __syncthreads();
  __builtin_amdgcn_s_setprio(3);
  for (int cb = 0; cb < nch; cb += 4) {
#pragma unroll
    for (int k = 0; k < 4; k++) {
      const int c0 = cb + k;
      const int bsel = k & 1;
      SCAN_PREFETCH(k, c0 + 4)
#pragma unroll
      for (int st = 0; st < 16; st++) {
        const float* o = ops + (bsel * 16 + st) * 384;
        f32x4v w = *(const f32x4v*)(o + cg4), kp = *(const f32x4v*)(o + 128 + cg4);
        f32x4v kkv = *(const f32x4v*)(o + 256 + cg4), bb = *(const f32x4v*)(o + 320 + cg4);
        float v = o[192 + Rr];
        float d1 = SL[0] * kkv.x + SL[1] * kkv.y + SL[2] * kkv.z + SL[3] * kkv.w;
        float d2 = SP[0] * kkv.x + SP[1] * kkv.y + SP[2] * kkv.z + SP[3] * kkv.w;
        allreduce16x2(d1, d2);
        const float saL = -d1, saP = -d2;
        SL[0] = SL[0] * w.x + (saL * bb.x + v * kp.x); SP[0] = SP[0] * w.x + saP * bb.x;
        SL[1] = SL[1] * w.y + (saL * bb.y + v * kp.y); SP[1] = SP[1] * w.y + saP * bb.y;
        SL[2] = SL[2] * w.z + (saL * bb.z + v * kp.z); SP[2] = SP[2] * w.z + saP * bb.z;
        SL[3] = SL[3] * w.w + (saL * bb.w + v * kp.w); SP[3] = SP[3] * w.w + saP * bb.w;
      }
      SCAN_STAGE(((k + 1) & 3), (bsel ^ 1))
      __syncthreads();
    }
  }
  __builtin_amdgcn_s_setprio(0);
  const size_t so = ((size_t)(bh * 7 + seg)) * 4096 + Rr * 64 + cg4;
  *(float4*)((float*)(p.ws + W_SLOC) + so) = make_float4(SL[0], SL[1], SL[2], SL[3]);
  *(float4*)((float*)(p.ws + W_PMAT) + so) = make_float4(SP[0], SP[1], SP[2], SP[3]);
}

DI void rwkv_scan_task(const Params& p, int srow0, int T, int h, int rq, const float* S0, float* Sout, int comb_bh, int comb_seg, unsigned char* smem) {
  float* ops = (float*)smem;
  float* sc = ops + 2 * 16 * 384;
  float* ybuf = sc + 64;
  const int tid = TIDX(), i = tid >> 4, cg = tid & 15, cg4 = cg * 4;
  const int Rr = rq * 16 + i;
  const float* RWW = (const float*)(p.ws + W_RWW); const u16* RWX = (const u16*)(p.ws + W_RWX); float* YRAW = (float*)(p.ws + W_YRAW);
  float S[4];
  if (S0) { float4 s = *(const float4*)(S0 + Rr * 64 + cg4); S[0] = s.x; S[1] = s.y; S[2] = s.z; S[3] = s.w; }
  else { S[0] = S[1] = S[2] = S[3] = 0.f; }
  if (comb_bh >= 0 && comb_seg > 0) {
    const float* SLOC = (const float*)(p.ws + W_SLOC) + (size_t)comb_bh * 7 * 4096;
    const float* PMAT = (const float*)(p.ws + W_PMAT) + (size_t)comb_bh * 7 * 4096;
    float* srow = ops;
    { float4 s = *(const float4*)(SLOC + Rr * 64 + cg4); S[0] = s.x; S[1] = s.y; S[2] = s.z; S[3] = s.w; }
    for (int sp = 1; sp < comb_seg; sp++) {
      __syncthreads();
      *(float4*)(srow + i * 64 + cg4) = make_float4(S[0], S[1], S[2], S[3]);
      __syncthreads();
      float4 a = *(const float4*)(SLOC + (size_t)sp * 4096 + Rr * 64 + cg4);
      const float* P = PMAT + (size_t)sp * 4096 + cg4;
#pragma unroll 8
      for (int k = 0; k < 64; k++) {
        float sv = srow[i * 64 + k]; float4 pv = *(const float4*)(P + k * 64);
        a.x += sv * pv.x; a.y += sv * pv.y; a.z += sv * pv.z; a.w += sv * pv.w;
      }
      S[0] = a.x; S[1] = a.y; S[2] = a.z; S[3] = a.w;
    }
  }
  const int lstep = tid >> 4, lpart = (tid & 15) * 4;
  f32x4v pw[4]; u32x2 px[4][5];
  const int nch = T >> 4;
  SCAN_PREFETCH(0, 0) SCAN_PREFETCH(1, 1) SCAN_PREFETCH(2, 2) SCAN_PREFETCH(3, 3)
  __syncthreads();
  SCAN_STAGE(0, 0)
  __syncthreads();
  __builtin_amdgcn_s_setprio(3);
  for (int cb = 0; cb < nch; cb += 4) {
#pragma unroll
    for (int k = 0; k < 4; k++) {
      const int c0 = cb + k;
      if (c0 < nch) {
        const int bsel = k & 1;
        SCAN_PREFETCH(k, c0 + 4)
        float yk = 0.f;
#pragma unroll
        for (int st = 0; st < 16; st++) {
          const float* o = ops + (bsel * 16 + st) * 384;
          f32x4v w = *(const f32x4v*)(o + cg4), wr = *(const f32x4v*)(o + 64 + cg4), kp = *(const f32x4v*)(o + 128 + cg4);
          f32x4v kkv = *(const f32x4v*)(o + 256 + cg4), bb = *(const f32x4v*)(o + 320 + cg4);
          float v = o[192 + Rr];
          float br = sc[(bsel * 16 + st) * 2], kr = sc[(bsel * 16 + st) * 2 + 1];
          float d1 = S[0] * kkv.x + S[1] * kkv.y + S[2] * kkv.z + S[3] * kkv.w;
          float d2 = S[0] * wr.x + S[1] * wr.y + S[2] * wr.z + S[3] * wr.w;
          allreduce16x2(d1, d2);
          const float sa = -d1;
          S[0] = S[0] * w.x + (sa * bb.x + v * kp.x);
          S[1] = S[1] * w.y + (sa * bb.y + v * kp.y);
          S[2] = S[2] * w.z + (sa * bb.z + v * kp.z);
          S[3] = S[3] * w.w + (sa * bb.w + v * kp.w);
          float y = d2 + sa * br + v * kr;
          yk = (cg == st) ? y : yk;
        }
        ybuf[bsel * 256 + cg * 16 + i] = yk;
        SCAN_STAGE(((k + 1) & 3), (bsel ^ 1))
        __syncthreads();
        YRAW[(size_t)(srow0 + c0 * 16 + (tid >> 4)) * 512 + h * 64 + rq * 16 + (tid & 15)] = ybuf[bsel * 256 + tid];
      }
    }
  }
  __builtin_amdgcn_s_setprio(0);
  if (Sout) *(float4*)(Sout + Rr * 64 + cg4) = make_float4(S[0], S[1], S[2], S[3]);
}
constexpr int PH5_TASKS = 512 + 128 + 2048 + 256;
DI void phase5_task(const Params& p, int l, int task, unsigned char* smem) {
  const u16* Z = (const u16*)(p.ws + W_Z); u16* YG = (u16*)(p.ws + W_YG);
  if (task < 512) {
    int bh = task >> 5, seg = 7 - ((task >> 2) & 7), rq = task & 3, b = bh >> 3, h = bh & 7;
    rwkv_scan_task(p, b * TP + seg * 1024, 1024, h, rq, nullptr, seg == 7 ? p.out + O_WKV_P + ((size_t)((l * 2 + b) * 8 + h)) * 4096 : nullptr, bh, seg, smem);
    return;
  }
  task -= 448;
  if (task < 2240) {
    int which, b, h, row0, nq, qpos0, kbase, nkeys; size_t vto; int vstr;
    if (task < 192) { int j = task - 64; which = j >> 6; int bh = j & 63; b = bh >> 3; h = bh & 7; row0 = NP + b * 16; nq = 16; qpos0 = PAST; kbase = NP + b * SK; nkeys = SK; vto = VT_S_OFF + (size_t)((b * 8 + h) * 64) * SK; vstr = SK; }
    else { int j = task - 192; int qb = 63 - (j >> 5); which = (j >> 4) & 1; int bh = j & 15; b = bh >> 3; h = bh & 7; row0 = b * TP + qb * 128; nq = 128; qpos0 = qb * 128; kbase = b * TP; nkeys = TP; vto = (size_t)((b * 8 + h) * 64) * 8192; vstr = 8192; }
    if (which == 0)
      attn_task<64, true>((const u16*)(p.ws + W_SQ) + (size_t)row0 * 512 + h * 64, 512, nq, (const u16*)(p.ws + W_SBK) + (size_t)kbase * 512 + h * 64, 512,
                          (const u16*)(p.ws + W_SBVT) + vto, vstr, nkeys, qpos0, Z + ((size_t)2 * NT + row0) * 512 + h * 64, YG + ((size_t)2 * NT + row0) * 512 + h * 64, smem);
    else
      attn_task<96, false>((const u16*)(p.ws + W_QF) + (size_t)row0 * 768 + h * 96, 768, nq, (const u16*)(p.ws + W_KF) + (size_t)kbase * 768 + h * 96, 768,
                           (const u16*)(p.ws + W_MLAVT) + vto, vstr, nkeys, qpos0, Z + ((size_t)1 * NT + row0) * 512 + h * 64, YG + ((size_t)1 * NT + row0) * 512 + h * 64, smem);
    return;
  }
  {
    int j = task - 2240; int bh = j >> 2, rq = j & 3, b = bh >> 3, h = bh & 7;
    size_t so = ((size_t)((l * 8 + b) * 8 + h)) * 4096;
    rwkv_scan_task(p, NP + b * 16, 16, h, rq, p.in[2] + so, p.out + O_WKV_S + so, -1, 0, smem);
  }
}
DI void phase5(const Params& p, int l, unsigned char* smem) {
  __shared__ int s_task;
  int* ctr = (int*)(p.ws + W_CTR) + l;
  while (true) {
    __syncthreads();
    if (TIDX() == 0) s_task = atomicAdd(ctr, 1);
    __syncthreads();
    int q = s_task;
    if (q >= PH5_TASKS) break;
    int task = q < 1024 ? ((q & 1) ? 512 + (q >> 1) : (q >> 1)) : q;
    phase5_task(p, l, task, smem);
  }
}
DI void phase5b(const Params& p, int l) {
  const int lane = TIDX() & 63, wave = TIDX() >> 6;
  const float* YRAW = (const float*)(p.ws + W_YRAW); const u16* RWX = (const u16*)(p.ws + W_RWX); const float* RHO = (const float*)(p.ws + W_RHO);
  const u16* Z = (const u16*)(p.ws + W_Z); u16* YG = (u16*)(p.ws + W_YG);
  for (int task = blockIdx.x; task < NT / 4; task += gridDim.x) {
    const int row = task * 4 + wave, c0 = lane * 8;
    float y[8];
    { float4 a = *(const float4*)(YRAW + (size_t)row * 512 + c0), b = *(const float4*)(YRAW + (size_t)row * 512 + c0 + 4);
      y[0] = a.x; y[1] = a.y; y[2] = a.z; y[3] = a.w; y[4] = b.x; y[5] = b.y; y[6] = b.z; y[7] = b.w; }
    float s = 0.f;
#pragma unroll
    for (int j = 0; j < 8; j++) s += y[j];
    s += __shfl_xor(s, 1); s += __shfl_xor(s, 2); s += __shfl_xor(s, 4);
    float mu = s * (1.f / 64.f), vs = 0.f;
#pragma unroll
    for (int j = 0; j < 8; j++) { float d = y[j] - mu; vs += d * d; }
    vs += __shfl_xor(vs, 1); vs += __shfl_xor(vs, 2); vs += __shfl_xor(vs, 4);
    float rstd = rsqrtf(vs * (1.f / 64.f) + GN_EPS);
    float rho = RHO[(size_t)row * 8 + (lane >> 3)];
    uint4 vv = *(const uint4*)(RWX + (size_t)row * 2560 + 1024 + c0);
    uint4 zz = *(const uint4*)(Z + (size_t)row * 512 + c0);
    float vf[8] = {bflo(vv.x), bfhi(vv.x), bflo(vv.y), bfhi(vv.y), bflo(vv.z), bfhi(vv.z), bflo(vv.w), bfhi(vv.w)};
    float zf[8] = {bflo(zz.x), bfhi(zz.x), bflo(zz.y), bfhi(zz.y), bflo(zz.z), bfhi(zz.z), bflo(zz.w), bfhi(zz.w)};
    float o[8];
#pragma unroll
    for (int j = 0; j < 8; j++) o[j] = ((y[j] - mu) * rstd * p.in[22][l * 512 + c0 + j] + p.in[23][l * 512 + c0 + j] + rho * vf[j]) * zf[j];
    uint4 ob; ob.x = pk2(o[0], o[1]); ob.y = pk2(o[2], o[3]); ob.z = pk2(o[4], o[5]); ob.w = pk2(o[6], o[7]);
    *(uint4*)(YG + (size_t)row * 512 + c0) = ob;
  }
}

DI void wave_gemm32(f32x16& acc, const u16* A, int lda, const u16* Bt, int ldb, int K) {
  const int lane = TIDX() & 63, r = lane & 31, hl = lane >> 5;
  const u16* ap = A + (size_t)r * lda + hl * 8; const u16* bp = Bt + (size_t)r * ldb + hl * 8;
#pragma unroll 8
  for (int k = 0; k < K; k += 16) { bf16x8 a = *(const bf16x8*)(ap + k); bf16x8 b = *(const bf16x8*)(bp + k); acc = MFMA32(a, b, acc); }
}
DI void phase6(const Params& p, int l, unsigned char* smem) {
  const u16* H = (const u16*)(p.ws + W_H); const u16* WinT = (const u16*)(p.ws + W_WINT);
  const u16* YG = (const u16*)(p.ws + W_YG); u16* MG = (u16*)(p.ws + W_MG);
  for (int t0 = blockIdx.x; t0 < 32 + 128 * 8; t0 += gridDim.x) {
    if (t0 < 32) {
      const int lane = TIDX() & 63, wave = TIDX() >> 6, r = lane & 31, hl = lane >> 5;
      const int unit = t0 * 4 + wave, row0 = NP + (unit & 3) * 32, n0 = (unit >> 2) * 32;
      f32x16 mm;
#pragma unroll
      for (int i = 0; i < 16; i++) mm[i] = 0.f;
#pragma unroll 1
      for (int g = 0; g < 3; g++) {
        f32x16 ay, ag;
#pragma unroll
        for (int i = 0; i < 16; i++) { ay[i] = 0.f; ag[i] = 0.f; }
        wave_gemm32(ay, YG + ((size_t)g * NT + row0) * 512, 512, (const u16*)(p.ws + W_WBRT) + ((size_t)(l * 3 + g) * 1024 + n0) * 512, 512, 512);
        wave_gemm32(ag, H + (size_t)row0 * 1024, 1024, WinT + (size_t)(5408 + g * 1024 + n0) * 1024, 1024, 1024);
#pragma unroll
        for (int i = 0; i < 16; i++) mm[i] += sigmoidf_(ag[i]) * ay[i];
      }
#pragma unroll
      for (int i = 0; i < 16; i++) MG[(size_t)(row0 + crow(i, hl)) * 1024 + n0 + r] = f2bf(mm[i]);
      continue;
    }
    const int t = t0 - 32;
    const int bq = t & 511, mt = (bq & 7) * 16 + ((bq >> 3) & 15), nt = (t >> 9) * 4 + (bq >> 7), m0 = mt * 128, n0 = nt * 128;

    unsigned mpk[2][2][8];
#pragma unroll
    for (int a = 0; a < 2; a++)
#pragma unroll
      for (int b = 0; b < 2; b++)
#pragma unroll
        for (int j = 0; j < 8; j++) mpk[a][b][j] = 0u;
#pragma unroll 1
    for (int g = 0; g < 3; g++) {
      f32x16 acc[2][2]; zero_acc(acc);
      gemm_mainloop(acc, YG + ((size_t)g * NT + m0) * 512, 512, (const u16*)(p.ws + W_WBRT) + ((size_t)(l * 3 + g) * 1024 + n0) * 512, 512, 512, smem);
      unsigned ypk[2][2][8];
#pragma unroll
      for (int a = 0; a < 2; a++)
#pragma unroll
        for (int b = 0; b < 2; b++)
#pragma unroll
          for (int j = 0; j < 8; j++) ypk[a][b][j] = pk2(acc[a][b][2 * j], acc[a][b][2 * j + 1]);
      zero_acc(acc);
      gemm_mainloop(acc, H + (size_t)m0 * 1024, 1024, WinT + (size_t)(5408 + g * 1024 + n0) * 1024, 1024, 1024, smem);
#pragma unroll
      for (int a = 0; a < 2; a++)
#pragma unroll
        for (int b = 0; b < 2; b++)
#pragma unroll
          for (int j = 0; j < 8; j++) {
            float lo = bflo(mpk[a][b][j]) + sigmoidf_(acc[a][b][2 * j]) * bflo(ypk[a][b][j]);
            float hi = bfhi(mpk[a][b][j]) + sigmoidf_(acc[a][b][2 * j + 1]) * bfhi(ypk[a][b][j]);
            mpk[a][b][j] = pk2(lo, hi);
          }
    }
    {
      const int lane = TIDX() & 63, wave = TIDX() >> 6, wm = wave >> 1, wn = wave & 1, r = lane & 31, hl = lane >> 5;
#pragma unroll
      for (int a = 0; a < 2; a++)
#pragma unroll
        for (int b = 0; b < 2; b++)
#pragma unroll
          for (int j = 0; j < 8; j++) {
            int col = n0 + wn * 64 + b * 32 + r;
            int row0 = m0 + wm * 64 + a * 32;
            MG[(size_t)(row0 + crow(2 * j, hl)) * 1024 + col] = (u16)(mpk[a][b][j] & 0xffffu);
            MG[(size_t)(row0 + crow(2 * j + 1, hl)) * 1024 + col] = (u16)(mpk[a][b][j] >> 16);
          }
    }
  }
}
DI void phase7(const Params& p, int l, unsigned char* smem) {
  const u16* MG = (const u16*)(p.ws + W_MG);
  const float* mod = (const float*)(p.ws + W_MOD);
  const int ntile = 32 + 128 * 8, nextra = (l + 1 < NL) ? WIN_TT + SMALLW_TT : 0;
  for (int t0 = blockIdx.x; t0 < ntile + nextra; t0 += gridDim.x) {
    if (t0 >= ntile + WIN_TT) { smallw_transpose_task(p, l + 1, t0 - ntile - WIN_TT, smem); continue; }
    if (t0 >= ntile) { win_transpose_task(p, l + 1, t0 - ntile, smem); continue; }
    if (t0 < 32) {
      const int lane = TIDX() & 63, wave = TIDX() >> 6, r = lane & 31, hl = lane >> 5;
      const int unit = t0 * 4 + wave, row0 = NP + (unit & 3) * 32, n0 = (unit >> 2) * 32;
      f32x16 a;
#pragma unroll
      for (int i = 0; i < 16; i++) a[i] = 0.f;
      wave_gemm32(a, MG + (size_t)row0 * 1024, 1024, (const u16*)(p.ws + W_WOUTT) + ((size_t)l * 1024 + n0) * 1024, 1024, 1024);
#pragma unroll
      for (int i = 0; i < 16; i++) {
        const int row = row0 + crow(i, hl), col = n0 + r;
        float xo = xrow_ptr(p, l, row)[col];
        float gt = mod[(l * 10 + bidx_of(row)) * 3072 + 2048 + col];
        p.out[(size_t)row * D + col] = xo + gt * a[i];
      }
      continue;
    }
    const int t = t0 - 32;
    const int bq = t & 511, mt = (bq & 7) * 16 + ((bq >> 3) & 15), nt = (t >> 9) * 4 + (bq >> 7), m0 = mt * 128, n0 = nt * 128;

    f32x16 acc[2][2]; zero_acc(acc);
    gemm_mainloop(acc, MG + (size_t)m0 * 1024, 1024, (const u16*)(p.ws + W_WOUTT) + ((size_t)l * 1024 + n0) * 1024, 1024, 1024, smem);
    foreach_acc(acc, m0, n0, [&](int row, int col, float v) {
      float xo = xrow_ptr(p, l, row)[col];
      float gt = mod[(l * 10 + bidx_of(row)) * 3072 + 2048 + col];
      p.out[(size_t)row * D + col] = xo + gt * v;
    });
  }
}

#define XB_TMO      128
#define XB_XCNT(j)  (256  + 64 * (j))
#define XB_XSUB(j)  (1280 + 64 * (j))
#define XB_XGEN(j)  (2304 + 64 * (j))
#define XB_TOP      3328
#define XB_TOPGEN   3392
#define XB_SPIN_CAP (1u << 18)
DI unsigned xb_ld(unsigned* q) { return __hip_atomic_load(q, __ATOMIC_RELAXED, __HIP_MEMORY_SCOPE_AGENT); }
DI unsigned xb_add(unsigned* q, unsigned v) { return __hip_atomic_fetch_add(q, v, __ATOMIC_RELAXED, __HIP_MEMORY_SCOPE_AGENT); }
DI unsigned xb_xcc_id() { return (unsigned)__builtin_amdgcn_s_getreg((3 << 11) | 20) & 0xFu; }
#define XB_SPIN(cond, bar) do { unsigned _sp = 0; while (cond) { __builtin_amdgcn_s_sleep(1); \
    if ((++_sp & 255u) == 0u) { if (xb_ld(&(bar)[XB_TMO])) break; if (_sp > XB_SPIN_CAP) { atomicAdd(&(bar)[XB_TMO], 1u); break; } } } } while (0)
DI void xbar(const Params& p, unsigned* xbst) {
  asm volatile("s_waitcnt vmcnt(0)" ::: "memory");
  __syncthreads();
  if (TIDX() == 0) {
    unsigned* bar = (unsigned*)(p.ws + W_XBAR);
    const unsigned x = xb_xcc_id();
    __builtin_amdgcn_s_waitcnt(0);
    const unsigned nloc = xbst[0], nx = xbst[1];
    const unsigned old = xb_add(&bar[XB_XSUB(x)], 1u);
    const unsigned gen = old / nloc;
    if (old + 1u == (gen + 1u) * nloc) {
      __builtin_amdgcn_fence(__ATOMIC_RELEASE, "agent");
      asm volatile("s_waitcnt vmcnt(0)" ::: "memory");
      const unsigned og = xb_add(&bar[XB_TOP], 1u);
      const unsigned tg = og / nx;
      if (og + 1u == (tg + 1u) * nx) xb_add(&bar[XB_TOPGEN], 1u);
      else XB_SPIN(xb_ld(&bar[XB_TOPGEN]) == tg, bar);
      __builtin_amdgcn_fence(__ATOMIC_ACQUIRE, "agent");
      xb_add(&bar[XB_XGEN(x)], 1u);
      asm volatile("s_waitcnt vmcnt(0)" ::: "memory");
    } else {
      XB_SPIN(xb_ld(&bar[XB_XGEN(x)]) == gen, bar);
      __builtin_amdgcn_fence(__ATOMIC_ACQUIRE, "agent");
      asm volatile("s_waitcnt vmcnt(0)" ::: "memory");
    }
  }
  __syncthreads();
}
DI int opq(int v) { asm volatile("" : "+s"(v)); return v; }
#if MULTI
template <int PH> __global__ void __launch_bounds__(256, 2) phase_kernel(Params p, int l) {
  __shared__ __attribute__((aligned(16))) unsigned char smem[SMEM_BYTES];
  if (PH == 0) phase0(p, smem);
  if (PH == 1) phase1(p, l);
  if (PH == 2) phase2(p, l, smem);
  if (PH == 3) phase3(p, l);
  if (PH == 4) phase4(p, l, smem);
  if (PH == 5) phase5(p, l, smem);
  if (PH == 6) phase5b(p, l);
  if (PH == 7) phase6(p, l, smem);
  if (PH == 8) phase7(p, l, smem);
}
#else
__global__ void __launch_bounds__(256, 2) mega_kernel(Params p_arg) {
  __shared__ __attribute__((aligned(16))) unsigned char smem[SMEM_BYTES];
  const Params& p = *(const Params*)__builtin_amdgcn_kernarg_segment_ptr();
  cg::grid_group grid = cg::this_grid();
  __shared__ unsigned xbst[4];
  if (TIDX() == 0) (void)xb_add((unsigned*)(p.ws + W_XBAR) + XB_XCNT(xb_xcc_id()), 1u);
  phase0(p, smem);
  grid.sync();
  if (TIDX() == 0) {
    unsigned* bar = (unsigned*)(p.ws + W_XBAR);
    const unsigned x = xb_xcc_id();
    unsigned cnt = 0u, mine = 0u;
    for (unsigned j = 0; j < 16; ++j) { const unsigned c = xb_ld(&bar[XB_XCNT(j)]); cnt += (c > 0u) ? 1u : 0u; mine = (j == x) ? c : mine; }
    xbst[0] = mine > 0u ? mine : 1u; xbst[1] = cnt > 0u ? cnt : 1u;
  }
  for (int l = 0; l < NL; l++) {
    phase1(p, opq(l)); xbar(p, xbst);
    phase2(p, opq(l), smem); xbar(p, xbst);
    phase3(p, opq(l)); xbar(p, xbst);
    phase4(p, opq(l), smem); xbar(p, xbst);
    phase5(p, opq(l), smem); xbar(p, xbst);
    phase5b(p, opq(l)); xbar(p, xbst);
    phase6(p, opq(l), smem); xbar(p, xbst);
    phase7(p, opq(l), smem); xbar(p, xbst);
  }
}
#endif

extern "C" void kernel_launch(void* const* d_in, const int* in_sizes, int n_in, void* d_out, int out_size, void* d_ws, size_t ws_size, hipStream_t stream) {
  Params p{};
  for (int i = 0; i < 36; i++) p.in[i] = (const float*)d_in[i];
  p.out = (float*)d_out;
  p.ws = (unsigned char*)d_ws;
  if (ws_size < W_TOTAL) fprintf(stderr, "workspace too small: %zu < %zu\n", ws_size, (size_t)W_TOTAL);
  hipMemsetAsync((unsigned char*)d_ws + W_CTR, 0, 256 + 3456 * 4, stream);
#if MULTI
  const int G = 1024;
  phase_kernel<0><<<G, 256, 0, stream>>>(p, 0);
  for (int l = 0; l < NL; l++) {
    phase_kernel<1><<<G, 256, 0, stream>>>(p, l);
    phase_kernel<2><<<G, 256, 0, stream>>>(p, l);
    phase_kernel<3><<<G, 256, 0, stream>>>(p, l);
    phase_kernel<4><<<G, 256, 0, stream>>>(p, l);
    phase_kernel<5><<<G, 256, 0, stream>>>(p, l);
    phase_kernel<6><<<G, 256, 0, stream>>>(p, l);
    phase_kernel<7><<<G, 256, 0, stream>>>(p, l);
    phase_kernel<8><<<G, 256, 0, stream>>>(p, l);
  }
#else
  static int grid_blocks = 0;
  if (!grid_blocks) {
    int dev = 0, cus = 0, per_cu = 0;
    hipGetDevice(&dev);
    hipDeviceGetAttribute(&cus, hipDeviceAttributeMultiprocessorCount, dev);
    hipOccupancyMaxActiveBlocksPerMultiprocessor(&per_cu, mega_kernel, 256, 0);
    if (per_cu > 2) per_cu = 2;
    grid_blocks = cus * per_cu;
  }
  void* args[] = {&p};
  hipError_t e = hipLaunchCooperativeKernel((void*)mega_kernel, dim3(grid_blocks), dim3(256), args, 0, stream);
  if (e != hipSuccess) fprintf(stderr, "cooperative launch failed: %s (grid %d)\n", hipGetErrorString(e), grid_blocks);
#endif
}
```

```cpp
#include <hip/hip_runtime.h>
#include <hip/hip_cooperative_groups.h>
#include <cstdio>
namespace cg = cooperative_groups;

#ifndef MULTI
#define MULTI 0
#endif

typedef unsigned short u16;
typedef __attribute__((ext_vector_type(8))) short bf16x8;
typedef __attribute__((ext_vector_type(16))) float f32x16;
typedef __attribute__((ext_vector_type(2))) __bf16 bf2_t;
typedef __attribute__((ext_vector_type(2))) float f2_t;
typedef __attribute__((ext_vector_type(4))) unsigned u32x4;
typedef __attribute__((ext_vector_type(2))) unsigned u32x2;
typedef __attribute__((ext_vector_type(4))) float f32x4v;
#define DI __device__ __forceinline__
#define MFMA32(a, b, c) __builtin_amdgcn_mfma_f32_32x32x16_bf16((a), (b), (c), 0, 0, 0)

constexpr int D = 1024, NL = 4, NP = 16384, NS = 128, NT = NP + NS, TP = 8192, TS = 16, PAST = 2048, SK = 2064;
constexpr int NKV = NP + 8 * SK;
constexpr int DIN = 8480;
constexpr float RMS_EPS = 1e-6f, GN_EPS = 64e-5f;
constexpr float LOG2E = 1.4426950408889634f;
constexpr float QSCALE_MLA = 0.10206207261596577f * LOG2E;
constexpr float QSCALE_SB = 0.125f * LOG2E;

constexpr size_t O_Y = 0;
constexpr size_t O_WKV_P = (size_t)NT * D;
constexpr size_t O_SHIFT_P = O_WKV_P + (size_t)NL * 2 * 8 * 4096;
constexpr size_t O_CKV_P = O_SHIFT_P + (size_t)NL * 2 * 1664;
constexpr size_t O_KROPE_P = O_CKV_P + (size_t)NL * NP * 256;
constexpr size_t O_SBK_P = O_KROPE_P + (size_t)NL * NP * 32;
constexpr size_t O_SBV_P = O_SBK_P + (size_t)NL * NP * 512;
constexpr size_t O_WKV_S = O_SBV_P + (size_t)NL * NP * 512;
constexpr size_t O_SHIFT_S = O_WKV_S + (size_t)NL * 8 * 8 * 4096;
constexpr size_t O_CKV_S = O_SHIFT_S + (size_t)NL * 8 * 1664;
constexpr size_t O_KROPE_S = O_CKV_S + (size_t)NL * NS * 256;
constexpr size_t O_SBK_S = O_KROPE_S + (size_t)NL * NS * 32;
constexpr size_t O_SBV_S = O_SBK_S + (size_t)NL * NS * 512;

constexpr size_t al(size_t x) { return (x + 255) & ~(size_t)255; }
constexpr size_t W_WINT = 0;
constexpr size_t W_WBRT = al(W_WINT + (size_t)DIN * 1024 * 2);
constexpr size_t W_WOUTT = al(W_WBRT + (size_t)NL * 3 * 1024 * 512 * 2);
constexpr size_t W_WUQT = al(W_WOUTT + (size_t)NL * 1024 * 1024 * 2);
constexpr size_t W_WUKVT = al(W_WUQT + (size_t)NL * 768 * 384 * 2);
constexpr size_t W_WUPT = al(W_WUKVT + (size_t)NL * 1024 * 256 * 2);
constexpr size_t W_AUPT = al(W_WUPT + (size_t)NL * 512 * 64 * 2);
constexpr size_t W_MOD = al(W_AUPT + (size_t)NL * 512 * 64 * 2);
constexpr size_t W_ROPE = al(W_MOD + (size_t)NL * 10 * 3072 * 4);
constexpr size_t W_CTR = al(W_ROPE + (size_t)8192 * 32 * 4);
constexpr size_t W_XBAR = W_CTR + 256;
constexpr size_t W_H = al(W_XBAR + 3456 * 4);
constexpr size_t W_PR = al(W_H + (size_t)NT * 1024 * 2);
constexpr size_t W_YG = W_PR;
constexpr size_t W_YRAW = al(W_YG + (size_t)3 * NT * 512 * 2);
constexpr size_t W_MG = W_YRAW;
constexpr size_t W_Z = al(W_PR + (size_t)NT * 1664 * 4);
constexpr size_t W_CQ = al(W_Z + (size_t)3 * NT * 512 * 2);
constexpr size_t W_QF = W_CQ;
constexpr size_t W_CKV = al(W_CQ + (size_t)NT * 768 * 2);
constexpr size_t W_KR = al(W_CKV + (size_t)NT * 256 * 4);
constexpr size_t W_QN = al(W_KR + (size_t)NT * 32 * 4);
constexpr size_t W_CKVN = al(W_QN + (size_t)NT * 384 * 2);
constexpr size_t W_SQ = al(W_CKVN + (size_t)(NKV + 64) * 256 * 2);
constexpr size_t W_SBK = al(W_SQ + (size_t)NT * 512 * 2);
constexpr size_t VT_S_OFF = (size_t)16 * 64 * 8192;
constexpr size_t VT_ELEMS = VT_S_OFF + (size_t)64 * 64 * SK + 256;
constexpr size_t W_SBVT = al(W_SBK + (size_t)(NKV + 64) * 512 * 2);
constexpr size_t W_RWW = al(W_SBVT + VT_ELEMS * 2);
constexpr size_t W_RWX = al(W_RWW + (size_t)NT * 512 * 4);
constexpr size_t W_RHO = al(W_RWX + (size_t)NT * 5 * 512 * 2);
constexpr size_t W_KF = al(W_RHO + (size_t)NT * 8 * 4);
constexpr size_t W_MLAVT = al(W_KF + (size_t)(NKV + 64) * 768 * 2);
constexpr size_t W_SLOC = al(W_MLAVT + VT_ELEMS * 2);
constexpr size_t W_PMAT = al(W_SLOC + (size_t)16 * 7 * 4096 * 4);
constexpr size_t W_TOTAL = al(W_PMAT + (size_t)16 * 7 * 4096 * 4);
static_assert((size_t)NT * 384 * 4 <= (size_t)NT * 768 * 2, "alias");
static_assert(W_YRAW + (size_t)NT * 1024 * 2 <= W_Z, "alias overflow");

struct Params {
  const float* in[36];
  float* out;
  unsigned char* ws;
};

constexpr int SMEM_BYTES = 73728;

DI int TIDX() { int t = __builtin_amdgcn_workitem_id_x(); asm volatile("" : "+v"(t)); return t; }
DI u16 f2bf(float x) { return __builtin_bit_cast(u16, (__bf16)x); }
DI unsigned pk2(float a, float b) { f2_t v = {a, b}; return __builtin_bit_cast(unsigned, __builtin_convertvector(v, bf2_t)); }
DI float bf2f(u16 x) { return __uint_as_float((unsigned)x << 16); }
DI float bflo(unsigned x) { return __uint_as_float(x << 16); }
DI float bfhi(unsigned x) { return __uint_as_float(x & 0xffff0000u); }
DI float ex2(float x) { return __builtin_amdgcn_exp2f(x); }
DI float lg2(float x) { return __builtin_amdgcn_logf(x); }
DI float sigmoidf_(float x) { return 1.f / (1.f + __expf(-x)); }
DI float siluf_(float x) { return x / (1.f + __expf(-x)); }
DI float softplusf_(float x) { return fmaxf(x, 0.f) + log1pf(__expf(-fabsf(x))); }
DI int crow(int i, int hl) { return (i & 3) + 8 * (i >> 2) + 4 * hl; }
template <int CTRL> DI float dppf(float x) {
  return __int_as_float(__builtin_amdgcn_update_dpp(__float_as_int(x), __float_as_int(x), CTRL, 0xF, 0xF, false));
}
DI float allreduce16(float x) {
  x += dppf<0xB1>(x); x += dppf<0x4E>(x); x += dppf<0x141>(x); x += dppf<0x140>(x); return x;
}
DI float red32(float x) {
  x += __shfl_xor(x, 1); x += __shfl_xor(x, 2); x += __shfl_xor(x, 4); x += __shfl_xor(x, 8); x += __shfl_xor(x, 16); return x;
}
DI float red64(float x) { x = red32(x); x += __shfl_xor(x, 32); return x; }
DI int bidx_of(int row) { return row < NP ? (row >> 13) : 2 + ((row - NP) >> 4); }
DI int keyrow_of(int row) { return row < NP ? row : NP + ((row - NP) >> 4) * SK + PAST + ((row - NP) & 15); }
DI int pos_of(int row) { return row < NP ? (row & 8191) : PAST + ((row - NP) & 15); }
DI size_t vt_off(int keyrow, int h, int d) {
  if (keyrow < NP) { int b = keyrow >> 13, s = keyrow & 8191; return ((size_t)((b * 8 + h) * 64 + d)) * 8192 + s; }
  int rr = keyrow - NP; int b = rr / SK, s = rr - b * SK; return VT_S_OFF + ((size_t)((b * 8 + h) * 64 + d)) * SK + s;
}

DI void gemm_mainloop(f32x16 (&acc)[2][2], const u16* A, int lda, const u16* Bt, int ldb, int K, unsigned char* smem) {
  u16* s0 = (u16*)smem;
  const int tid = TIDX(), lane = tid & 63, wave = tid >> 6, wm = wave >> 1, wn = wave & 1;
  const int lr = tid >> 3, lc = (tid & 7) * 8;
  const u16* Ap = A + (size_t)lr * lda + lc;
  const u16* Bp = Bt + (size_t)lr * ldb + lc;
  u32x4 ra[4], rb[4];
  const int nk = K >> 6;
  const int r = lane & 31, hl = lane >> 5;
#pragma unroll
  for (int i = 0; i < 4; i++) { ra[i] = *(const u32x4*)(Ap + (size_t)(32 * i) * lda); rb[i] = *(const u32x4*)(Bp + (size_t)(32 * i) * ldb); }
  __syncthreads();
#pragma unroll
  for (int i = 0; i < 4; i++) { *(u32x4*)(s0 + (lr + 32 * i) * 72 + lc) = ra[i]; *(u32x4*)(s0 + 128 * 72 + (lr + 32 * i) * 72 + lc) = rb[i]; }
  if (nk > 1) { Ap += 64; Bp += 64; }
#pragma unroll
  for (int i = 0; i < 4; i++) { ra[i] = *(const u32x4*)(Ap + (size_t)(32 * i) * lda); rb[i] = *(const u32x4*)(Bp + (size_t)(32 * i) * ldb); }
  __syncthreads();
  for (int kt = 0; kt < nk; kt++) {
    u16* sA = s0 + (kt & 1) * (256 * 72); u16* sB = sA + 128 * 72;
    if (kt + 1 < nk) {
      u16* nA = s0 + ((kt + 1) & 1) * (256 * 72); u16* nB = nA + 128 * 72;
#pragma unroll
      for (int i = 0; i < 4; i++) { *(u32x4*)(nA + (lr + 32 * i) * 72 + lc) = ra[i]; *(u32x4*)(nB + (lr + 32 * i) * 72 + lc) = rb[i]; }
    }
    if (kt + 2 < nk) { Ap += 64; Bp += 64; }
#pragma unroll
    for (int i = 0; i < 4; i++) { ra[i] = *(const u32x4*)(Ap + (size_t)(32 * i) * lda); rb[i] = *(const u32x4*)(Bp + (size_t)(32 * i) * ldb); }
#pragma unroll
    for (int ks = 0; ks < 4; ks++) {
      bf16x8 af[2], bfr[2];
#pragma unroll
      for (int b = 0; b < 2; b++) {
        af[b] = *(const bf16x8*)(sA + (wm * 64 + b * 32 + r) * 72 + ks * 16 + hl * 8);
        bfr[b] = *(const bf16x8*)(sB + (wn * 64 + b * 32 + r) * 72 + ks * 16 + hl * 8);
      }
#pragma unroll
      for (int bm = 0; bm < 2; bm++)
#pragma unroll
        for (int bn = 0; bn < 2; bn++) acc[bm][bn] = MFMA32(af[bm], bfr[bn], acc[bm][bn]);
    }
    __syncthreads();
  }
}
DI void zero_acc(f32x16 (&acc)[2][2]) {
#pragma unroll
  for (int a = 0; a < 2; a++)
#pragma unroll
    for (int b = 0; b < 2; b++)
#pragma unroll
      for (int i = 0; i < 16; i++) acc[a][b][i] = 0.f;
}
template <class F> DI void foreach_acc(f32x16 (&acc)[2][2], int m0, int n0, F f) {
  const int lane = TIDX() & 63, wave = TIDX() >> 6, wm = wave >> 1, wn = wave & 1, r = lane & 31, hl = lane >> 5;
#pragma unroll
  for (int bm = 0; bm < 2; bm++)
#pragma unroll
    for (int bn = 0; bn < 2; bn++)
#pragma unroll
      for (int i = 0; i < 16; i++) f(m0 + wm * 64 + bm * 32 + crow(i, hl), n0 + wn * 64 + bn * 32 + r, acc[bm][bn][i]);
}

DI void transpose_tile(const float* __restrict__ src, int K, int N, u16* __restrict__ dst, int kt, int nt, int mode, unsigned char* smem) {
  float* tile = (float*)smem;
  const int tid = TIDX(), tx = tid & 63, ty = tid >> 6;
  const int k0 = kt * 64, n0 = nt * 64;
  __syncthreads();
#pragma unroll 4
  for (int i = 0; i < 16; i++) { int k = i * 4 + ty; int n = n0 + tx; tile[k * 65 + tx] = (n < N) ? src[(size_t)(k0 + k) * N + n] : 0.f; }
  __syncthreads();
#pragma unroll 4
  for (int i = 0; i < 16; i++) {
    int nl = i * 4 + ty; int n = n0 + nl;
    if (n < N) {
      int nd = n;
      if (mode == 1) { int hd = n / 96, d = n - hd * 96; nd = d < 64 ? hd * 64 + d : 512 + hd * 32 + (d - 64); }
      dst[(size_t)nd * K + k0 + tx] = f2bf(tile[tx * 65 + nl]);
    }
  }
}
constexpr int WIN_TT = 16 * 133;
DI void win_transpose_task(const Params& p, int l, int t, unsigned char* smem) {
  int kt = t & 15, nt = t >> 4;
  transpose_tile(p.in[13] + (size_t)l * 1024 * DIN, 1024, DIN, (u16*)(p.ws + W_WINT), kt, nt, 0, smem);
}
constexpr int SMALLW_TT = 384 + 256 + 72 + 64 + 8 + 8;
DI void smallw_transpose_task(const Params& p, int l, int t, unsigned char* smem) {
  if (t < 384) { int g = t / 128, q = t % 128; const float* src = p.in[g == 0 ? 24 : (g == 1 ? 33 : 34)] + (size_t)l * 512 * 1024;
    transpose_tile(src, 512, 1024, (u16*)(p.ws + W_WBRT) + ((size_t)(l * 3 + g)) * 1024 * 512, q & 7, q >> 3, 0, smem); return; }
  t -= 384;
  if (t < 256) { transpose_tile(p.in[35] + (size_t)l * 1024 * 1024, 1024, 1024, (u16*)(p.ws + W_WOUTT) + (size_t)l * 1024 * 1024, t & 15, t >> 4, 0, smem); return; }
  t -= 256;
  if (t < 72) { transpose_tile(p.in[26] + (size_t)l * 384 * 768, 384, 768, (u16*)(p.ws + W_WUQT) + (size_t)l * 768 * 384, t % 6, t / 6, 1, smem); return; }
  t -= 72;
  if (t < 64) { transpose_tile(p.in[28] + (size_t)l * 256 * 1024, 256, 1024, (u16*)(p.ws + W_WUKVT) + (size_t)l * 1024 * 256, t & 3, t >> 2, 0, smem); return; }
  t -= 64;
  if (t < 8) { transpose_tile(p.in[16] + (size_t)l * 64 * 512, 64, 512, (u16*)(p.ws + W_WUPT) + (size_t)l * 512 * 64, 0, t, 0, smem); return; }
  t -= 8;
  transpose_tile(p.in[18] + (size_t)l * 64 * 512, 64, 512, (u16*)(p.ws + W_AUPT) + (size_t)l * 512 * 64, 0, t, 0, smem);
}
DI void mod_task(const Params& p, int task, unsigned char* smem) {
  float* sm = (float*)smem;
  const int tid = TIDX(), l = task / 48, cb = task % 48, kq = tid >> 6, cl = tid & 63, col = cb * 64 + cl;
  __syncthreads();
  for (int e = tid; e < 10240; e += 256) { int r = e >> 10, k = e & 1023; float c = r < 2 ? p.in[8][r * 1024 + k] : p.in[9][(r - 2) * 1024 + k]; sm[e] = siluf_(c); }
  __syncthreads();
  float acc[10];
#pragma unroll
  for (int r = 0; r < 10; r++) acc[r] = 0.f;
  const float* w = p.in[10] + ((size_t)l * 1024 + kq * 256) * 3072 + col;
#pragma unroll 8
  for (int k = 0; k < 256; k++) {
    float wv = w[(size_t)k * 3072];
#pragma unroll
    for (int r = 0; r < 10; r++) acc[r] += sm[r * 1024 + kq * 256 + k] * wv;
  }
  __syncthreads();
#pragma unroll
  for (int r = 0; r < 10; r++) sm[(kq * 10 + r) * 64 + cl] = acc[r];
  __syncthreads();
  if (tid < 64) {
    float* mod = (float*)(p.ws + W_MOD);
    float bb = p.in[11][l * 3072 + col];
#pragma unroll
    for (int r = 0; r < 10; r++) mod[(l * 10 + r) * 3072 + col] = sm[r * 64 + cl] + sm[(10 + r) * 64 + cl] + sm[(20 + r) * 64 + cl] + sm[(30 + r) * 64 + cl] + bb;
  }
}
DI void rope_task(const Params& p, int task) {
  const int tid = TIDX(); const int pos = task * 128 + (tid >> 1);
  float* rope = (float*)(p.ws + W_ROPE);
  for (int ff = 0; ff < 8; ff++) {
    int f = (tid & 1) * 8 + ff;
    double inv = 1.0; for (int j = 0; j < f; j++) inv *= 0.5623413251903491;
    double ang = (double)pos * inv;
    double n = rint(ang * 0.15915494309189535);
    double rr = ang - n * 6.283185307179586 - n * 2.4492935982947064e-16;
    double r2 = rr * rr, sn = rr, cs = 1.0, ts = rr, tc = 1.0;
    for (int k = 1; k <= 15; k++) { tc *= -r2 / (double)((2 * k - 1) * (2 * k)); cs += tc; ts *= -r2 / (double)((2 * k) * (2 * k + 1)); sn += ts; }
    rope[pos * 32 + f] = (float)cs; rope[pos * 32 + 16 + f] = (float)sn;
  }
}
DI void phase0(const Params& p, unsigned char* smem) {
  const int n_tr = WIN_TT + SMALLW_TT, total = n_tr + 192 + 64;
  for (int t = blockIdx.x; t < total; t += gridDim.x) {
    if (t < 192) mod_task(p, t, smem);
    else if (t < 192 + 64) rope_task(p, t - 192);
    else { int q = t - 256; if (q < WIN_TT) win_transpose_task(p, 0, q, smem); else { q -= WIN_TT; smallw_transpose_task(p, 0, q, smem); } }
  }
}

DI const float* xrow_ptr(const Params& p, int l, int row) {
  if (l > 0) return p.out + (size_t)row * D;
  return row < NP ? p.in[0] + (size_t)row * D : p.in[1] + (size_t)(row - NP) * D;
}
DI void phase1(const Params& p, int l) {
  const int lane = TIDX() & 63, wave = TIDX() >> 6;
  const float* mod = (const float*)(p.ws + W_MOD);
  const float* g = p.in[12] + l * 1024;
  u16* H = (u16*)(p.ws + W_H);
  for (int task = blockIdx.x; task < NT / 4; task += gridDim.x) {
    int row = task * 4 + wave;
    const float* x = xrow_ptr(p, l, row);
    const float* md = mod + (l * 10 + bidx_of(row)) * 3072;
    float4 v[4]; float ss = 0.f;
#pragma unroll
    for (int j = 0; j < 4; j++) { v[j] = *(const float4*)(x + (j * 64 + lane) * 4); ss += v[j].x * v[j].x + v[j].y * v[j].y + v[j].z * v[j].z + v[j].w * v[j].w; }
    ss = red64(ss);
    float rstd = rsqrtf(ss * (1.f / 1024.f) + RMS_EPS);
#pragma unroll
    for (int j = 0; j < 4; j++) {
      int c = (j * 64 + lane) * 4;
      float4 gg = *(const float4*)(g + c), sh = *(const float4*)(md + c), sc = *(const float4*)(md + 1024 + c);
      float h0 = v[j].x * rstd * gg.x * (1.f + sc.x) + sh.x, h1 = v[j].y * rstd * gg.y * (1.f + sc.y) + sh.y;
      float h2 = v[j].z * rstd * gg.z * (1.f + sc.z) + sh.z, h3 = v[j].w * rstd * gg.w * (1.f + sc.w) + sh.w;
      uint2 o; o.x = pk2(h0, h1); o.y = pk2(h2, h3);
      *(uint2*)(H + (size_t)row * 1024 + c) = o;
    }
  }
}

DI void phase2(const Params& p, int l, unsigned char* smem) {
  const u16* H = (const u16*)(p.ws + W_H);
  const u16* WinT = (const u16*)(p.ws + W_WINT);
  float* PR = (float*)(p.ws + W_PR);
  u16* Z = (u16*)(p.ws + W_Z);
  float* CQ = (float*)(p.ws + W_CQ); float* CKV = (float*)(p.ws + W_CKV); float* KR = (float*)(p.ws + W_KR);
  u16* SQ = (u16*)(p.ws + W_SQ); u16* SBK = (u16*)(p.ws + W_SBK); u16* SBVT = (u16*)(p.ws + W_SBVT);
  float* out = p.out;
  for (int ts = blockIdx.x; ts < 11 * 512; ts += gridDim.x) {
    int mt, nt;
    {
      const int rd = ts >> 9, bq = ts & 511, sm = bq & 7, j = bq >> 3;
      mt = sm * 16 + (j & 15); nt = rd * 4 + (j >> 4);
      if (nt >= 43) { const int e = sm * 16 + (j & 15); if (e >= 43) continue; mt = 128; nt = e; }
    }
    const int m0 = mt * 128;
    int seg, n0, c0;
    if (nt < 13) { seg = 0; c0 = nt * 128; n0 = c0; }
    else if (nt < 17) { seg = 1; c0 = (nt - 13) * 128; n0 = 1664 + c0; }
    else if (nt < 20) { seg = 2; c0 = (nt - 17) * 128; n0 = 2176 + c0; }
    else if (nt < 22) { seg = 3; c0 = (nt - 20) * 128; n0 = 2560 + c0; }
    else if (nt < 26) { seg = 4; c0 = (nt - 22) * 128; n0 = 2848 + c0; }
    else if (nt < 30) { seg = 5; c0 = (nt - 26) * 128; n0 = 3360 + c0; }
    else if (nt < 34) { seg = 6; c0 = (nt - 30) * 128; n0 = 3872 + c0; }
    else if (nt < 38) { seg = 7; c0 = (nt - 34) * 128; n0 = 4384 + c0; }
    else if (nt < 42) { seg = 8; c0 = (nt - 38) * 128; n0 = 4896 + c0; }
    else { seg = 9; c0 = 0; n0 = 2816; }
    f32x16 acc[2][2]; zero_acc(acc);
    gemm_mainloop(acc, H + (size_t)m0 * 1024, 1024, WinT + (size_t)n0 * 1024, 1024, 1024, smem);
    if (seg == 0) {
      foreach_acc(acc, m0, c0, [&](int row, int col, float v) {
        PR[(size_t)row * 1664 + col] = v;
        if (row < NP) { if ((row & 8191) == 8191) out[O_SHIFT_P + (size_t)(l * 2 + (row >> 13)) * 1664 + col] = v; }
        else { int rr = row - NP; if ((rr & 15) == 15) out[O_SHIFT_S + (size_t)(l * 8 + (rr >> 4)) * 1664 + col] = v; }
      });
    } else if (seg == 1 || seg == 4 || seg == 8) {
      const int g = seg == 1 ? 0 : (seg == 4 ? 1 : 2);
      foreach_acc(acc, m0, c0, [&](int row, int col, float v) { Z[((size_t)g * NT + row) * 512 + col] = f2bf(siluf_(v)); });
    } else if (seg == 2) {
      foreach_acc(acc, m0, c0, [&](int row, int col, float v) { CQ[(size_t)row * 384 + col] = v; });
    } else if (seg == 3) {
      foreach_acc(acc, m0, c0, [&](int row, int col, float v) { CKV[(size_t)row * 256 + col] = v; });
    } else if (seg == 9) {
      foreach_acc(acc, m0, c0, [&](int row, int col, float v) { if (col < 32) KR[(size_t)row * 32 + col] = v; });
    } else if (seg == 5) {
      foreach_acc(acc, m0, c0, [&](int row, int col, float v) { SQ[(size_t)row * 512 + col] = f2bf(v * QSCALE_SB); });
    } else if (seg == 6) {
      foreach_acc(acc, m0, c0, [&](int row, int col, float v) {
        size_t oo = row < NP ? O_SBK_P + ((size_t)l * NP + row) * 512 + col : O_SBK_S + ((size_t)l * NS + (row - NP)) * 512 + col;
        out[oo] = v;
        SBK[(size_t)keyrow_of(row) * 512 + col] = f2bf(v);
      });
    } else {
      foreach_acc(acc, m0, c0, [&](int row, int col, float v) {
        size_t oo = row < NP ? O_SBV_P + ((size_t)l * NP + row) * 512 + col : O_SBV_S + ((size_t)l * NS + (row - NP)) * 512 + col;
        out[oo] = v;
      });
      const int lane = TIDX() & 63, wave = TIDX() >> 6, wm = wave >> 1, wn = wave & 1, r = lane & 31, hl = lane >> 5;
#pragma unroll
      for (int bm = 0; bm < 2; bm++)
#pragma unroll
        for (int bn = 0; bn < 2; bn++)
#pragma unroll
          for (int g4 = 0; g4 < 4; g4++) {
            int row = m0 + wm * 64 + bm * 32 + 8 * g4 + 4 * hl, col = c0 + wn * 64 + bn * 32 + r;
            uint2 o; o.x = pk2(acc[bm][bn][4 * g4], acc[bm][bn][4 * g4 + 1]); o.y = pk2(acc[bm][bn][4 * g4 + 2], acc[bm][bn][4 * g4 + 3]);
            *(uint2*)(SBVT + vt_off(keyrow_of(row), col >> 6, col & 63)) = o;
          }
    }
  }
}

DI const float* prev_ptr(const Params& p, int l, const float* PR, int row) {
  if (row < NP) return (row & 8191) ? PR + (size_t)(row - 1) * 1664 : nullptr;
  int rr = row - NP;
  return (rr & 15) ? PR + (size_t)(row - 1) * 1664 : p.in[3] + (size_t)(l * 8 + (rr >> 4)) * 1664;
}
DI void rwkv_prep_task(const Params& p, int l, int task) {
  const int lane = TIDX() & 63, wave = TIDX() >> 6, r = lane & 31, hl = lane >> 5;
  const int tile = task >> 1, hh = (task & 1) * 4 + wave, row0 = tile * 32;
  const float* PR = (const float*)(p.ws + W_PR);
  const float* mu = p.in[14] + l * 1664;
  f32x16 accW[1][2], accA[1][2];
#pragma unroll
  for (int b_ = 0; b_ < 2; b_++)
#pragma unroll
    for (int i_ = 0; i_ < 16; i_++) { accW[0][b_][i_] = 0.f; accA[0][b_][i_] = 0.f; }
  const u16* WupT = (const u16*)(p.ws + W_WUPT) + (size_t)l * 512 * 64;
  const u16* AupT = (const u16*)(p.ws + W_AUPT) + (size_t)l * 512 * 64;
#pragma unroll 1
  for (int ks = 0; ks < 4; ks++) {
    const int k0 = ks * 16 + hl * 8;
    bf16x8 bw[2], ba[2];
#pragma unroll
    for (int bn = 0; bn < 2; bn++) {
      bw[bn] = *(const bf16x8*)(WupT + (size_t)(hh * 64 + bn * 32 + r) * 64 + k0);
      ba[bn] = *(const bf16x8*)(AupT + (size_t)(hh * 64 + bn * 32 + r) * 64 + k0);
    }
#pragma unroll
    for (int bm = 0; bm < 1; bm++) {
      const int row = row0 + bm * 32 + r;
      const float* pp = PR + (size_t)row * 1664;
      const float* pv = prev_ptr(p, l, PR, row);
      float xw[8], xa[8];
#pragma unroll
      for (int q = 0; q < 2; q++) {
        float4 a = *(const float4*)(pp + 1536 + k0 + 4 * q), b = pv ? *(const float4*)(pv + 1536 + k0 + 4 * q) : make_float4(0, 0, 0, 0), m = *(const float4*)(mu + 1536 + k0 + 4 * q);
        xw[4 * q] = tanhf(a.x + (b.x - a.x) * m.x); xw[4 * q + 1] = tanhf(a.y + (b.y - a.y) * m.y); xw[4 * q + 2] = tanhf(a.z + (b.z - a.z) * m.z); xw[4 * q + 3] = tanhf(a.w + (b.w - a.w) * m.w);
        a = *(const float4*)(pp + 1600 + k0 + 4 * q); b = pv ? *(const float4*)(pv + 1600 + k0 + 4 * q) : make_float4(0, 0, 0, 0); m = *(const float4*)(mu + 1600 + k0 + 4 * q);
        xa[4 * q] = a.x + (b.x - a.x) * m.x; xa[4 * q + 1] = a.y + (b.y - a.y) * m.y; xa[4 * q + 2] = a.z + (b.z - a.z) * m.z; xa[4 * q + 3] = a.w + (b.w - a.w) * m.w;
      }
      u32x4 uw, ua;
      uw.x = pk2(xw[0], xw[1]); uw.y = pk2(xw[2], xw[3]); uw.z = pk2(xw[4], xw[5]); uw.w = pk2(xw[6], xw[7]);
      ua.x = pk2(xa[0], xa[1]); ua.y = pk2(xa[2], xa[3]); ua.z = pk2(xa[4], xa[5]); ua.w = pk2(xa[6], xa[7]);
      bf16x8 awf = __builtin_bit_cast(bf16x8, uw), aaf = __builtin_bit_cast(bf16x8, ua);
#pragma unroll
      for (int bn = 0; bn < 2; bn++) { accW[bm][bn] = MFMA32(awf, bw[bn], accW[bm][bn]); accA[bm][bn] = MFMA32(aaf, ba[bn], accA[bm][bn]); }
    }
  }
  float* RWW = (float*)(p.ws + W_RWW); u16* RWX = (u16*)(p.ws + W_RWX); float* RHO = (float*)(p.ws + W_RHO);
  float mur[2], muk[2], muv[2], w0[2], a0[2], kk_[2], ka_[2], rk_[2];
#pragma unroll
  for (int bn = 0; bn < 2; bn++) {
    int col = hh * 64 + bn * 32 + r;
    mur[bn] = mu[col]; muk[bn] = mu[512 + col]; muv[bn] = mu[1024 + col];
    w0[bn] = p.in[15][l * 512 + col]; a0[bn] = p.in[17][l * 512 + col]; kk_[bn] = p.in[19][l * 512 + col]; ka_[bn] = p.in[20][l * 512 + col]; rk_[bn] = p.in[21][l * 512 + col];
  }
#pragma unroll
  for (int bm = 0; bm < 1; bm++)
#pragma unroll
    for (int i = 0; i < 16; i++) {
      const int row = row0 + bm * 32 + crow(i, hl);
      const float* pp = PR + (size_t)row * 1664;
      const float* pv = prev_ptr(p, l, PR, row);
      float xr[2], xv[2], kp[2], kkr[2], av[2], dec[2];
      float ssq = 0.f, rho = 0.f;
#pragma unroll
      for (int bn = 0; bn < 2; bn++) {
        int col = hh * 64 + bn * 32 + r;
        float pr_ = pp[col], pk_ = pp[512 + col], pv_ = pp[1024 + col];
        float qr = pv ? pv[col] : 0.f, qk = pv ? pv[512 + col] : 0.f, qv = pv ? pv[1024 + col] : 0.f;
        xr[bn] = pr_ + (qr - pr_) * mur[bn];
        float xk = pk_ + (qk - pk_) * muk[bn];
        xv[bn] = pv_ + (qv - pv_) * muv[bn];
        float wpre = w0[bn] + accW[bm][bn][i];
        float wlog = -softplusf_(-wpre) - 0.5f;
        dec[bn] = __expf(-__expf(wlog));
        av[bn] = sigmoidf_(a0[bn] + accA[bm][bn][i]);
        kkr[bn] = xk * kk_[bn];
        kp[bn] = xk * (1.f + (av[bn] - 1.f) * ka_[bn]);
        ssq += kkr[bn] * kkr[bn];
        rho += xr[bn] * kp[bn] * rk_[bn];
      }
      ssq = red32(ssq); rho = red32(rho);
      float inv = 1.f / fmaxf(sqrtf(ssq), 1e-12f);
#pragma unroll
      for (int bn = 0; bn < 2; bn++) {
        int col = hh * 64 + bn * 32 + r;
        float kk = kkr[bn] * inv;
        RWW[(size_t)row * 512 + col] = dec[bn];
        u16* rx = RWX + (size_t)row * 2560 + col;
        rx[0] = f2bf(xr[bn]); rx[512] = f2bf(kp[bn]); rx[1024] = f2bf(xv[bn]); rx[1536] = f2bf(kk); rx[2048] = f2bf(kk * av[bn]);
      }
      if (r == 0) RHO[(size_t)row * 8 + hh] = rho;
    }
}
DI void norm_row_task(const Params& p, int l, int task) {
  const int lane = TIDX() & 63, wave = TIDX() >> 6;
  const int row = task * 4 + wave;
  const float* CQ = (const float*)(p.ws + W_CQ); const float* CKV = (const float*)(p.ws + W_CKV); const float* KR = (const float*)(p.ws + W_KR);
  u16* QN = (u16*)(p.ws + W_QN); u16* CKVN = (u16*)(p.ws + W_CKVN); u16* KF = (u16*)(p.ws + W_KF);
  const int keyrow = keyrow_of(row);
  {
    float v[6], ss = 0.f;
#pragma unroll
    for (int j = 0; j < 6; j++) { v[j] = CQ[(size_t)row * 384 + j * 64 + lane]; ss += v[j] * v[j]; }
    ss = red64(ss); float rstd = rsqrtf(ss * (1.f / 384.f) + RMS_EPS);
#pragma unroll
    for (int j = 0; j < 6; j++) QN[(size_t)row * 384 + j * 64 + lane] = f2bf(v[j] * rstd * p.in[25][l * 384 + j * 64 + lane]);
  }
  {
    float4 v = *(const float4*)(CKV + (size_t)row * 256 + lane * 4);
    float ss = red64(v.x * v.x + v.y * v.y + v.z * v.z + v.w * v.w);
    float rstd = rsqrtf(ss * (1.f / 256.f) + RMS_EPS);
    float4 g = *(const float4*)(p.in[27] + l * 256 + lane * 4);
    float4 o = make_float4(v.x * rstd * g.x, v.y * rstd * g.y, v.z * rstd * g.z, v.w * rstd * g.w);
    size_t oo = row < NP ? O_CKV_P + ((size_t)l * NP + row) * 256 : O_CKV_S + ((size_t)l * NS + (row - NP)) * 256;
    *(float4*)(p.out + oo + lane * 4) = o;
    uint2 ob; ob.x = pk2(o.x, o.y); ob.y = pk2(o.z, o.w);
    *(uint2*)(CKVN + (size_t)keyrow * 256 + lane * 4) = ob;
  }
  {
    float x = lane < 32 ? KR[(size_t)row * 32 + lane] : 0.f;
    float ss = red64(x * x); float rstd = rsqrtf(ss * (1.f / 32.f) + RMS_EPS);
    float xn = x * rstd * p.in[32][l * 32 + (lane & 31)];
    float pt = __shfl_xor(xn, 16);
    const float* rp = (const float*)(p.ws + W_ROPE) + pos_of(row) * 32;
    float cs = rp[lane & 15], sn = rp[16 + (lane & 15)];
    float o = (lane & 16) ? (pt * sn + xn * cs) : (xn * cs - pt * sn);
    if (lane < 32) {
      size_t oo = row < NP ? O_KROPE_P + ((size_t)l * NP + row) * 32 : O_KROPE_S + ((size_t)l * NS + (row - NP)) * 32;
      p.out[oo + lane] = o;
      u16 ob = f2bf(o);
#pragma unroll
      for (int hd = 0; hd < 8; hd++) KF[(size_t)keyrow * 768 + hd * 96 + 64 + lane] = ob;
    }
  }
}
DI void past_convert_task(const Params& p, int l, int task) {
  const int tid = TIDX();
  if (task < 2048) {
    size_t e = ((size_t)task * 256 + tid) * 8; int rowp = (int)(e >> 8), c = (int)(e & 255); int b = rowp >> 11, s = rowp & 2047;
    const float* src = p.in[4] + ((size_t)(l * 8 + b) * PAST + s) * 256 + c;
    float4 a = *(const float4*)src, bq = *(const float4*)(src + 4);
    uint4 o; o.x = pk2(a.x, a.y); o.y = pk2(a.z, a.w); o.z = pk2(bq.x, bq.y); o.w = pk2(bq.z, bq.w);
    *(uint4*)((u16*)(p.ws + W_CKVN) + (size_t)(NP + b * SK + s) * 256 + c) = o; return;
  }
  task -= 2048;
  if (task < 4096) {
    size_t e = ((size_t)task * 256 + tid) * 8; int rowp = (int)(e >> 9), c = (int)(e & 511); int b = rowp >> 11, s = rowp & 2047;
    const float* src = p.in[6] + ((size_t)(l * 8 + b) * PAST + s) * 512 + c;
    float4 a = *(const float4*)src, bq = *(const float4*)(src + 4);
    uint4 o; o.x = pk2(a.x, a.y); o.y = pk2(a.z, a.w); o.z = pk2(bq.x, bq.y); o.w = pk2(bq.z, bq.w);
    *(uint4*)((u16*)(p.ws + W_SBK) + (size_t)(NP + b * SK + s) * 512 + c) = o; return;
  }
  task -= 4096;
  if (task < 4096) {
    int id = task * 256 + tid; int c = id & 511, sg = (id >> 9) & 255, b = id >> 17;
    const float* src = p.in[7] + ((size_t)(l * 8 + b) * PAST + sg * 8) * 512 + c;
    float v[8];
#pragma unroll
    for (int j = 0; j < 8; j++) v[j] = src[(size_t)j * 512];
    uint4 o; o.x = pk2(v[0], v[1]); o.y = pk2(v[2], v[3]); o.z = pk2(v[4], v[5]); o.w = pk2(v[6], v[7]);
    *(uint4*)((u16*)(p.ws + W_SBVT) + VT_S_OFF + ((size_t)((b * 8 + (c >> 6)) * 64 + (c & 63))) * SK + sg * 8) = o; return;
  }
  task -= 4096;
  {
    int id = task * 256 + tid; int ch = id & 7, rowp = id >> 3; int b = rowp >> 11, s = rowp & 2047;
    float4 a = *(const float4*)(p.in[5] + ((size_t)(l * 8 + b) * PAST + s) * 32 + ch * 4);
    uint2 o; o.x = pk2(a.x, a.y); o.y = pk2(a.z, a.w);
    u16* dst = (u16*)(p.ws + W_KF) + (size_t)(NP + b * SK + s) * 768 + 64 + ch * 4;
#pragma unroll
    for (int hd = 0; hd < 8; hd++) *(uint2*)(dst + hd * 96) = o;
  }
}
DI void phase3(const Params& p, int l) {
  const int nA = 1032, nB = NT / 4, nC = 2048 + 4096 + 4096 + 512, total = nA + nB + nC;
  for (int t = blockIdx.x; t < total; t += gridDim.x) {
    if (t < nA) rwkv_prep_task(p, l, t);
    else if (t < nA + nB) norm_row_task(p, l, t - nA);
    else past_convert_task(p, l, t - nA - nB);
  }
}

DI void rwkv_pass1_task(const Params& p, int bh, int seg, int rq, unsigned char* smem);
DI void phase4(const Params& p, int l, unsigned char* smem) {
  const int lane = TIDX() & 63, wave = TIDX() >> 6, wm = wave >> 1, wn = wave & 1, r = lane & 31, hl = lane >> 5;
  const float* rope = (const float*)(p.ws + W_ROPE);
  u16* QF = (u16*)(p.ws + W_QF); u16* KF = (u16*)(p.ws + W_KF); u16* VT = (u16*)(p.ws + W_MLAVT);
  const int nQ = 129 * 6, nKV = 257 * 8;
  __shared__ int s_task4;
  int* ctr4 = (int*)(p.ws + W_CTR) + 8 + l;
  while (true) {
    __syncthreads();
    if (TIDX() == 0) s_task4 = atomicAdd(ctr4, 1);
    __syncthreads();
    const int q4 = s_task4;
    if (q4 >= 448 + nQ + nKV) break;
    const int t0 = q4 < 896 ? ((q4 & 1) ? 448 + (q4 >> 1) : (q4 >> 1)) : q4;
    if (t0 < 448) { int bh = t0 / 28, rem = t0 - bh * 28; rwkv_pass1_task(p, bh, rem >> 2, rem & 3, smem); continue; }
    const int t = t0 - 448;
    f32x16 acc[2][2]; zero_acc(acc);
    if (t < nQ) {
      const int mt = t % 129, nt = t / 129, m0 = mt * 128;
      gemm_mainloop(acc, (const u16*)(p.ws + W_QN) + (size_t)m0 * 384, 384, (const u16*)(p.ws + W_WUQT) + ((size_t)l * 768 + nt * 128) * 384, 384, 384, smem);
      if (nt < 4) {
        const int head = nt * 2 + wn;
        float g0 = p.in[29][l * 64 + r] * QSCALE_MLA, g1 = p.in[29][l * 64 + 32 + r] * QSCALE_MLA;
#pragma unroll
        for (int bm = 0; bm < 2; bm++)
#pragma unroll
          for (int i = 0; i < 16; i++) {
            float a = acc[bm][0][i], b = acc[bm][1][i];
            float ss = red32(a * a + b * b); float rstd = rsqrtf(ss * (1.f / 64.f) + RMS_EPS);
            int row = m0 + wm * 64 + bm * 32 + crow(i, hl);
            u16* q = QF + (size_t)row * 768 + head * 96;
            q[r] = f2bf(a * rstd * g0); q[32 + r] = f2bf(b * rstd * g1);
          }
      } else {
        float g = p.in[30][l * 32 + r] * QSCALE_MLA;
#pragma unroll
        for (int bm = 0; bm < 2; bm++)
#pragma unroll
          for (int bn = 0; bn < 2; bn++)
#pragma unroll
            for (int i = 0; i < 16; i++) {
              const int head = (nt - 4) * 4 + wn * 2 + bn;
              float a = acc[bm][bn][i];
              float ss = red32(a * a); float rstd = rsqrtf(ss * (1.f / 32.f) + RMS_EPS);
              float xn = a * rstd * g; float pt = __shfl_xor(xn, 16);
              int row = m0 + wm * 64 + bm * 32 + crow(i, hl);
              const float* rp = rope + pos_of(row) * 32;
              float cs = rp[r & 15], sn = rp[16 + (r & 15)];
              float o = (r & 16) ? (pt * sn + xn * cs) : (xn * cs - pt * sn);
              QF[(size_t)row * 768 + head * 96 + 64 + r] = f2bf(o);
            }
      }
    } else {
      const int q = t - nQ, mt = q % 257, head = q / 257, m0 = mt * 128;
      gemm_mainloop(acc, (const u16*)(p.ws + W_CKVN) + (size_t)m0 * 256, 256, (const u16*)(p.ws + W_WUKVT) + ((size_t)l * 1024 + head * 128) * 256, 256, 256, smem);
      if (wn == 0) {
        float g0 = p.in[31][l * 64 + r], g1 = p.in[31][l * 64 + 32 + r];
#pragma unroll
        for (int bm = 0; bm < 2; bm++)
#pragma unroll
          for (int i = 0; i < 16; i++) {
            float a = acc[bm][0][i], b = acc[bm][1][i];
            float ss = red32(a * a + b * b); float rstd = rsqrtf(ss * (1.f / 64.f) + RMS_EPS);
            int krow = m0 + wm * 64 + bm * 32 + crow(i, hl);
            u16* k = KF + (size_t)krow * 768 + head * 96;
            k[r] = f2bf(a * rstd * g0); k[32 + r] = f2bf(b * rstd * g1);
          }
      } else {
#pragma unroll
        for (int bm = 0; bm < 2; bm++)
#pragma unroll
          for (int bn = 0; bn < 2; bn++)
#pragma unroll
            for (int g4 = 0; g4 < 4; g4++) {
              int krow = m0 + wm * 64 + bm * 32 + 8 * g4 + 4 * hl, d = bn * 32 + r;
              uint2 o; o.x = pk2(acc[bm][bn][4 * g4], acc[bm][bn][4 * g4 + 1]); o.y = pk2(acc[bm][bn][4 * g4 + 2], acc[bm][bn][4 * g4 + 3]);
              *(uint2*)(VT + vt_off(krow, head, d)) = o;
            }
      }
    }
  }
}

template <int DK, bool SB>
DI void attn_task(const u16* __restrict__ Qp, int qstride, int nq_valid, const u16* __restrict__ Kp, int kstride,
                  const u16* __restrict__ Vtp, int vstride, int nkeys, int qpos0,
                  const u16* __restrict__ Zp, u16* __restrict__ Yp, unsigned char* smem) {
  constexpr int KS = DK / 16, KSTR = DK + 8, KCH = DK / 8, NKL = 64 * KCH / 256;
  u16* sK = (u16*)smem; u16* sV = sK + 64 * KSTR;
  const int tid = TIDX(), lane = tid & 63, wave = tid >> 6, r = lane & 31, hl = lane >> 5;
  const int slot = wave * 32 + r;
  const bool wave_active = wave * 32 < nq_valid;
  const int qpos = qpos0 + slot;
  bf16x8 qf[KS];
  {
    const u16* qrow = Qp + (size_t)(slot < nq_valid ? slot : 0) * qstride + hl * 8;
#pragma unroll
    for (int ks = 0; ks < KS; ks++) qf[ks] = *(const bf16x8*)(qrow + ks * 16);
  }
  f32x16 O[2];
#pragma unroll
  for (int b = 0; b < 2; b++)
#pragma unroll
    for (int i = 0; i < 16; i++) O[b][i] = 0.f;
  float m_run = -1e30f, l_run = 0.f, R = 1.f;
  const int last_qpos = qpos0 + nq_valid - 1;
  int ntiles = SB ? (last_qpos - 1) / 64 + 1 : last_qpos / 64 + 1;
  { int mx = (nkeys + 63) >> 6; if (ntiles > mx) ntiles = mx; }
  const int wave_q0 = qpos0 + wave * 32;
  u32x4 rk[NKL], rv[2];
  auto prefetch = [&](int kt) {
#pragma unroll
    for (int i = 0; i < NKL; i++) { int c = tid + 256 * i; int row = c / KCH, ch = c - row * KCH; rk[i] = *(const u32x4*)(Kp + (size_t)(kt * 64 + row) * kstride + ch * 8); }
#pragma unroll
    for (int i = 0; i < 2; i++) { int c = tid + 256 * i; int row = c >> 3, ch = c & 7; rv[i] = *(const u32x4*)(Vtp + (size_t)row * vstride + kt * 64 + ch * 8); }
  };
  prefetch(SB ? ntiles - 1 : 0);
  for (int it = 0; it < ntiles; it++) {
    const int kt = SB ? ntiles - 1 - it : it;
    __syncthreads();
#pragma unroll
    for (int i = 0; i < NKL; i++) { int c = tid + 256 * i; int row = c / KCH, ch = c - row * KCH; *(u32x4*)(sK + row * KSTR + ch * 8) = rk[i]; }
#pragma unroll
    for (int i = 0; i < 2; i++) { int c = tid + 256 * i; int row = c >> 3, ch = c & 7; *(u32x4*)(sV + row * 72 + ch * 8) = rv[i]; }
    __syncthreads();
    { int nx = SB ? kt - 1 : kt + 1; if (it + 1 >= ntiles) nx = kt; prefetch(nx); }
    bool doit;
    if (SB) doit = wave_active && (kt * 64 < wave_q0 + 31);
    else doit = wave_active && (kt <= (wave_q0 >> 6));
    if (doit) {
    f32x16 S[2];
#pragma unroll
    for (int kb = 0; kb < 2; kb++) {
#pragma unroll
      for (int i = 0; i < 16; i++) S[kb][i] = 0.f;
#pragma unroll
      for (int ks = 0; ks < KS; ks++) {
        bf16x8 kf = *(const bf16x8*)(sK + (kb * 32 + r) * KSTR + ks * 16 + hl * 8);
        S[kb] = MFMA32(kf, qf[ks], S[kb]);
      }
    }
    const int key0 = kt * 64 + 4 * hl;
    if (!SB) {
      const bool need_mask = (kt + 1) * 64 > nkeys;
      if (need_mask) {
#pragma unroll
        for (int kb = 0; kb < 2; kb++)
#pragma unroll
          for (int i = 0; i < 16; i++) { int key = key0 + kb * 32 + (i & 3) + 8 * (i >> 2); if (key >= nkeys) S[kb][i] = -1e30f; }
      }
      float tmax = -1e30f;
#pragma unroll
      for (int kb = 0; kb < 2; kb++)
#pragma unroll
        for (int i = 0; i < 16; i++) tmax = fmaxf(tmax, S[kb][i]);
      tmax = fmaxf(tmax, __shfl_xor(tmax, 32));
      float m_new = fmaxf(m_run, tmax);
      float alpha = ex2(m_run - m_new);
      m_run = m_new;
      float ps = 0.f;
#pragma unroll
      for (int kb = 0; kb < 2; kb++)
#pragma unroll
        for (int i = 0; i < 16; i++) { float pv = ex2(S[kb][i] - m_new); S[kb][i] = pv; ps += pv; }
      l_run = l_run * alpha + ps;
#pragma unroll
      for (int b = 0; b < 2; b++)
#pragma unroll
        for (int i = 0; i < 16; i++) O[b][i] *= alpha;
    } else {
      const bool need_mask = (kt * 64 + 63 >= wave_q0) || ((kt + 1) * 64 > nkeys);
#pragma unroll
      for (int kb = 0; kb < 2; kb++)
#pragma unroll
        for (int i = 0; i < 16; i++) {
          float d = __builtin_amdgcn_rcpf(1.f + ex2(S[kb][i]));
          if (need_mask) { int key = key0 + kb * 32 + (i & 3) + 8 * (i >> 2); if (!(key < nkeys && key < qpos)) d = 1.f; }
          S[kb][i] = d;
        }
      float gs[8], pg[8], sa[8];
#pragma unroll
      for (int o = 0; o < 8; o++) { int kb = o >> 2, g = o & 3; gs[o] = (S[kb][4 * g] * S[kb][4 * g + 1]) * (S[kb][4 * g + 2] * S[kb][4 * g + 3]); }
#pragma unroll
      for (int o = 0; o < 8; o++) pg[o] = __shfl_xor(gs[o], 32);
      sa[7] = R;
#pragma unroll
      for (int o = 6; o >= 0; o--) sa[o] = sa[o + 1] * (gs[o + 1] * pg[o + 1]);
      const float total = sa[0] * (gs[0] * pg[0]);
#pragma unroll
      for (int o = 0; o < 8; o++) {
        int kb = o >> 2, g = o & 3;
        float c = hl == 0 ? sa[o] * pg[o] : sa[o];
#pragma unroll
        for (int e = 3; e >= 0; e--) {
          float d = S[kb][4 * g + e];
          S[kb][4 * g + e] = c - d * c;
          c *= d;
        }
      }
      R = total;
    }
#pragma unroll
    for (int kb = 0; kb < 2; kb++)
#pragma unroll
      for (int s2 = 0; s2 < 2; s2++) {
        uint4 u;
        u.x = pk2(S[kb][8 * s2], S[kb][8 * s2 + 1]); u.y = pk2(S[kb][8 * s2 + 2], S[kb][8 * s2 + 3]);
        u.z = pk2(S[kb][8 * s2 + 4], S[kb][8 * s2 + 5]); u.w = pk2(S[kb][8 * s2 + 6], S[kb][8 * s2 + 7]);
        bf16x8 pf = __builtin_bit_cast(bf16x8, u);
#pragma unroll
        for (int bd = 0; bd < 2; bd++) {
          const u16* vp = sV + (bd * 32 + r) * 72 + kb * 32 + s2 * 16 + hl * 4;
          uint2 lo = *(const uint2*)vp, hi = *(const uint2*)(vp + 8);
          uint4 vv; vv.x = lo.x; vv.y = lo.y; vv.z = hi.x; vv.w = hi.y;
          O[bd] = MFMA32(__builtin_bit_cast(bf16x8, vv), pf, O[bd]);
        }
      }
    }
    if (SB) {
      const bool lane_done = !wave_active || slot >= nq_valid || R < 1e-30f;
      const int wdone = __all(lane_done);
      if (__syncthreads_and(wdone)) break;
    }
  }
  if (wave_active && slot < nq_valid) {
    float sc = 1.f;
    if (!SB) { float lt = l_run + __shfl_xor(l_run, 32); sc = 1.f / lt; }
#pragma unroll
    for (int bd = 0; bd < 2; bd++)
#pragma unroll
      for (int g = 0; g < 4; g++) {
        int d0 = bd * 32 + 8 * g + 4 * hl;
        uint2 zz = *(const uint2*)(Zp + (size_t)slot * 512 + d0);
        uint2 o;
        o.x = pk2(O[bd][4 * g] * sc * bflo(zz.x), O[bd][4 * g + 1] * sc * bfhi(zz.x));
        o.y = pk2(O[bd][4 * g + 2] * sc * bflo(zz.y), O[bd][4 * g + 3] * sc * bfhi(zz.y));
        *(uint2*)(Yp + (size_t)slot * 512 + d0) = o;
      }
  }
}

template <int CTRL> DI float dpp_add(float x) {
  return x + __int_as_float(__builtin_amdgcn_update_dpp(0, __float_as_int(x), CTRL, 0xF, 0xF, true));
}
DI void allreduce16x2(float& a, float& b) {
  a = dpp_add<0xB1>(a); b = dpp_add<0xB1>(b); a = dpp_add<0x4E>(a); b = dpp_add<0x4E>(b);
  a = dpp_add<0x141>(a); b = dpp_add<0x141>(b); a = dpp_add<0x140>(a); b = dpp_add<0x140>(b);
}
#define SCAN_PREFETCH(slot, cc) { int c_ = (cc) < nch ? (cc) : nch - 1; size_t row = (size_t)(srow0 + c_ * 16 + lstep); \
    pw[slot] = *(const f32x4v*)(RWW + row * 512 + h * 64 + lpart); \
    _Pragma("unroll") for (int c = 0; c < 5; c++) px[slot][c] = *(const u32x2*)(RWX + row * 2560 + c * 512 + h * 64 + lpart); }
#define SCAN_STAGE(slot, bsel) { float* o = ops + ((bsel) * 16 + lstep) * 384 + lpart; \
    f32x4v r4 = {bflo(px[slot][0].x), bfhi(px[slot][0].x), bflo(px[slot][0].y), bfhi(px[slot][0].y)}; \
    f32x4v k4 = {bflo(px[slot][1].x), bfhi(px[slot][1].x), bflo(px[slot][1].y), bfhi(px[slot][1].y)}; \
    f32x4v v4 = {bflo(px[slot][2].x), bfhi(px[slot][2].x), bflo(px[slot][2].y), bfhi(px[slot][2].y)}; \
    f32x4v kk4 = {bflo(px[slot][3].x), bfhi(px[slot][3].x), bflo(px[slot][3].y), bfhi(px[slot][3].y)}; \
    f32x4v b4 = {bflo(px[slot][4].x), bfhi(px[slot][4].x), bflo(px[slot][4].y), bfhi(px[slot][4].y)}; \
    *(f32x4v*)(o) = pw[slot]; *(f32x4v*)(o + 64) = pw[slot] * r4; *(f32x4v*)(o + 128) = k4; *(f32x4v*)(o + 192) = v4; *(f32x4v*)(o + 256) = kk4; *(f32x4v*)(o + 320) = b4; \
    float br = b4.x * r4.x + b4.y * r4.y + b4.z * r4.z + b4.w * r4.w; \
    float kr = k4.x * r4.x + k4.y * r4.y + k4.z * r4.z + k4.w * r4.w; \
    allreduce16x2(br, kr); \
    if ((tid & 15) == 0) { sc[((bsel) * 16 + lstep) * 2] = br; sc[((bsel) * 16 + lstep) * 2 + 1] = kr; } }

DI void rwkv_pass1_task(const Params& p, int bh, int seg, int rq, unsigned char* smem) {
  float* ops = (float*)smem; float* sc = ops + 2 * 16 * 384;
  const int tid = TIDX(), i = tid >> 4, cg = tid & 15, cg4 = cg * 4;
  const int Rr = rq * 16 + i, h = bh & 7;
  const int srow0 = (bh >> 3) * TP + seg * 1024;
  const float* RWW = (const float*)(p.ws + W_RWW); const u16* RWX = (const u16*)(p.ws + W_RWX);
  float SL[4] = {0.f, 0.f, 0.f, 0.f}, SP[4];
#pragma unroll
  for (int e = 0; e < 4; e++) SP[e] = (cg4 + e == Rr) ? 1.f : 0.f;
  const int lstep = tid >> 4, lpart = (tid & 15) * 4;
  f32x4v pw[4]; u32x2 px[4][5];
  const int nch = 64;
  SCAN_PREFETCH(0, 0) SCAN_PREFETCH(1, 1) SCAN_PREFETCH(2, 2) SCAN_PREFETCH(3, 3)
  __syncthreads();
  SCAN_STAGE(0, 0)
  __syncthreads();
  __builtin_amdgcn_s_setprio(3);
  for (int cb = 0; cb < nch; cb += 4) {
#pragma unroll
    for (int k = 0; k < 4; k++) {
      const int c0 = cb + k;
      const int bsel = k & 1;
      SCAN_PREFETCH(k, c0 + 4)
#pragma unroll
      for (int st = 0; st < 16; st++) {
        const float* o = ops + (bsel * 16 + st) * 384;
        f32x4v w = *(const f32x4v*)(o + cg4), kp = *(const f32x4v*)(o + 128 + cg4);
        f32x4v kkv = *(const f32x4v*)(o + 256 + cg4), bb = *(const f32x4v*)(o + 320 + cg4);
        float v = o[192 + Rr];
        float d1 = SL[0] * kkv.x + SL[1] * kkv.y + SL[2] * kkv.z + SL[3] * kkv.w;
        float d2 = SP[0] * kkv.x + SP[1] * kkv.y + SP[2] * kkv.z + SP[3] * kkv.w;
        allreduce16x2(d1, d2);
        const float saL = -d1, saP = -d2;
        SL[0] = SL[0] * w.x + (saL * bb.x + v * kp.x); SP[0] = SP[0] * w.x + saP * bb.x;
        SL[1] = SL[1] * w.y + (saL * bb.y + v * kp.y); SP[1] = SP[1] * w.y + saP * bb.y;
        SL[2] = SL[2] * w.z + (saL * bb.z + v * kp.z); SP[2] = SP[2] * w.z + saP * bb.z;
        SL[3] = SL[3] * w.w + (saL * bb.w + v * kp.w); SP[3] = SP[3] * w.w + saP * bb.w;
      }
      SCAN_STAGE(((k + 1) & 3), (bsel ^ 1))
      __syncthreads();
    }
  }
  __builtin_amdgcn_s_setprio(0);
  const size_t so = ((size_t)(bh * 7 + seg)) * 4096 + Rr * 64 + cg4;
  *(float4*)((float*)(p.ws + W_SLOC) + so) = make_float4(SL[0], SL[1], SL[2], SL[3]);
  *(float4*)((float*)(p.ws + W_PMAT) + so) = make_float4(SP[0], SP[1], SP[2], SP[3]);
}

DI void allreduce16x4(float& a, float& b, float& c, float& d) {
  a = dpp_add<0xB1>(a); b = dpp_add<0xB1>(b); c = dpp_add<0xB1>(c); d = dpp_add<0xB1>(d);
  a = dpp_add<0x4E>(a); b = dpp_add<0x4E>(b); c = dpp_add<0x4E>(c); d = dpp_add<0x4E>(d);
  a = dpp_add<0x141>(a); b = dpp_add<0x141>(b); c = dpp_add<0x141>(c); d = dpp_add<0x141>(d);
  a = dpp_add<0x140>(a); b = dpp_add<0x140>(b); c = dpp_add<0x140>(c); d = dpp_add<0x140>(d);
}
DI void rwkv_scan_task(const Params& p, int srow0, int T, int h, int rq, const float* S0, float* Sout, int comb_bh, int comb_seg, unsigned char* smem) {
  if (rq & 1) return;
  float* ops = (float*)smem;
  float* sc = ops + 2 * 16 * 384;
  float* ybuf = sc + 64;
  const int tid = TIDX(), i = tid >> 4, cg = tid & 15, cg4 = cg * 4;
  const float* RWW = (const float*)(p.ws + W_RWW); const u16* RWX = (const u16*)(p.ws + W_RWX); float* YRAW = (float*)(p.ws + W_YRAW);
  float S[2][4];
#pragma unroll
  for (int g = 0; g < 2; g++) {
    const int Rr = (rq + g) * 16 + i;
    if (S0) { float4 s = *(const float4*)(S0 + Rr * 64 + cg4); S[g][0] = s.x; S[g][1] = s.y; S[g][2] = s.z; S[g][3] = s.w; }
    else { S[g][0] = S[g][1] = S[g][2] = S[g][3] = 0.f; }
  }
  if (comb_bh >= 0 && comb_seg > 0) {
    const float* SLOC = (const float*)(p.ws + W_SLOC) + (size_t)comb_bh * 7 * 4096;
    const float* PMAT = (const float*)(p.ws + W_PMAT) + (size_t)comb_bh * 7 * 4096;
    float* srow = ops;
#pragma unroll
    for (int g = 0; g < 2; g++) { float4 s = *(const float4*)(SLOC + ((rq + g) * 16 + i) * 64 + cg4); S[g][0] = s.x; S[g][1] = s.y; S[g][2] = s.z; S[g][3] = s.w; }
    for (int sp = 1; sp < comb_seg; sp++) {
      __syncthreads();
#pragma unroll
      for (int g = 0; g < 2; g++) *(float4*)(srow + (g * 16 + i) * 64 + cg4) = make_float4(S[g][0], S[g][1], S[g][2], S[g][3]);
      __syncthreads();
      float4 a0 = *(const float4*)(SLOC + (size_t)sp * 4096 + (rq * 16 + i) * 64 + cg4);
      float4 a1 = *(const float4*)(SLOC + (size_t)sp * 4096 + (rq * 16 + 16 + i) * 64 + cg4);
      const float* P = PMAT + (size_t)sp * 4096 + cg4;
#pragma unroll 8
      for (int k = 0; k < 64; k++) {
        float s0 = srow[i * 64 + k], s1 = srow[(16 + i) * 64 + k]; float4 pv = *(const float4*)(P + k * 64);
        a0.x += s0 * pv.x; a0.y += s0 * pv.y; a0.z += s0 * pv.z; a0.w += s0 * pv.w;
        a1.x += s1 * pv.x; a1.y += s1 * pv.y; a1.z += s1 * pv.z; a1.w += s1 * pv.w;
      }
      S[0][0] = a0.x; S[0][1] = a0.y; S[0][2] = a0.z; S[0][3] = a0.w;
      S[1][0] = a1.x; S[1][1] = a1.y; S[1][2] = a1.z; S[1][3] = a1.w;
    }
  }
  const int lstep = tid >> 4, lpart = (tid & 15) * 4;
  f32x4v pw[2]; u32x2 px[2][5];
  const int nch = T >> 4;
  SCAN_PREFETCH(0, 0) SCAN_PREFETCH(1, 1)
  __syncthreads();
  SCAN_STAGE(0, 0)
  __syncthreads();
  __builtin_amdgcn_s_setprio(3);
  for (int cb = 0; cb < nch; cb += 4) {
#pragma unroll
    for (int k = 0; k < 4; k++) {
      const int c0 = cb + k;
      if (c0 < nch) {
        const int bsel = k & 1;
        SCAN_PREFETCH((k & 1), c0 + 2)
        float yk0 = 0.f, yk1 = 0.f;
#pragma unroll 8
        for (int st = 0; st < 16; st++) {
          const float* o = ops + (bsel * 16 + st) * 384;
          f32x4v w = *(const f32x4v*)(o + cg4), wr = *(const f32x4v*)(o + 64 + cg4), kp = *(const f32x4v*)(o + 128 + cg4);
          f32x4v kkv = *(const f32x4v*)(o + 256 + cg4), bb = *(const f32x4v*)(o + 320 + cg4);
          float v0 = o[192 + rq * 16 + i], v1 = o[192 + rq * 16 + 16 + i];
          float br = sc[(bsel * 16 + st) * 2], kr = sc[(bsel * 16 + st) * 2 + 1];
          float da0 = S[0][0] * kkv.x + S[0][1] * kkv.y + S[0][2] * kkv.z + S[0][3] * kkv.w;
          float dy0 = S[0][0] * wr.x + S[0][1] * wr.y + S[0][2] * wr.z + S[0][3] * wr.w;
          float da1 = S[1][0] * kkv.x + S[1][1] * kkv.y + S[1][2] * kkv.z + S[1][3] * kkv.w;
          float dy1 = S[1][0] * wr.x + S[1][1] * wr.y + S[1][2] * wr.z + S[1][3] * wr.w;
          allreduce16x4(da0, dy0, da1, dy1);
          S[0][0] = S[0][0] * w.x + (v0 * kp.x - da0 * bb.x); S[1][0] = S[1][0] * w.x + (v1 * kp.x - da1 * bb.x);
          S[0][1] = S[0][1] * w.y + (v0 * kp.y - da0 * bb.y); S[1][1] = S[1][1] * w.y + (v1 * kp.y - da1 * bb.y);
          S[0][2] = S[0][2] * w.z + (v0 * kp.z - da0 * bb.z); S[1][2] = S[1][2] * w.z + (v1 * kp.z - da1 * bb.z);
          S[0][3] = S[0][3] * w.w + (v0 * kp.w - da0 * bb.w); S[1][3] = S[1][3] * w.w + (v1 * kp.w - da1 * bb.w);
          float y0 = dy0 - da0 * br + v0 * kr, y1 = dy1 - da1 * br + v1 * kr;
          yk0 = (cg == st) ? y0 : yk0; yk1 = (cg == st) ? y1 : yk1;
        }
        ybuf[bsel * 512 + cg * 16 + i] = yk0; ybuf[bsel * 512 + 256 + cg * 16 + i] = yk1;
        SCAN_STAGE(((k + 1) & 1), (bsel ^ 1))
        __syncthreads();
        {
          float* yo = YRAW + (size_t)(srow0 + c0 * 16 + (tid >> 4)) * 512 + h * 64 + rq * 16 + (tid & 15);
          yo[0] = ybuf[bsel * 512 + tid]; yo[16] = ybuf[bsel * 512 + 256 + tid];
        }
      }
    }
  }
  __builtin_amdgcn_s_setprio(0);
  if (Sout) {
#pragma unroll
    for (int g = 0; g < 2; g++) *(float4*)(Sout + ((rq + g) * 16 + i) * 64 + cg4) = make_float4(S[g][0], S[g][1], S[g][2], S[g][3]);
  }
}
constexpr int PH5_TASKS = 512 + 128 + 2048 + 256;
DI void phase5_task(const Params& p, int l, int task, unsigned char* smem) {
  const u16* Z = (const u16*)(p.ws + W_Z); u16* YG = (u16*)(p.ws + W_YG);
  if (task < 512) {
    int bh = task >> 5, seg = 7 - ((task >> 2) & 7), rq = task & 3, b = bh >> 3, h = bh & 7;
    rwkv_scan_task(p, b * TP + seg * 1024, 1024, h, rq, nullptr, seg == 7 ? p.out + O_WKV_P + ((size_t)((l * 2 + b) * 8 + h)) * 4096 : nullptr, bh, seg, smem);
    return;
  }
  task -= 448;
  if (task < 2240) {
    int which, b, h, row0, nq, qpos0, kbase, nkeys; size_t vto; int vstr;
    if (task < 192) { int j = task - 64; which = j >> 6; int bh = j & 63; b = bh >> 3; h = bh & 7; row0 = NP + b * 16; nq = 16; qpos0 = PAST; kbase = NP + b * SK; nkeys = SK; vto = VT_S_OFF + (size_t)((b * 8 + h) * 64) * SK; vstr = SK; }
    else { int j = task - 192; int qb = 63 - (j >> 5); which = (j >> 4) & 1; int bh = j & 15; b = bh >> 3; h = bh & 7; row0 = b * TP + qb * 128; nq = 128; qpos0 = qb * 128; kbase = b * TP; nkeys = TP; vto = (size_t)((b * 8 + h) * 64) * 8192; vstr = 8192; }
    if (which == 0)
      attn_task<64, true>((const u16*)(p.ws + W_SQ) + (size_t)row0 * 512 + h * 64, 512, nq, (const u16*)(p.ws + W_SBK) + (size_t)kbase * 512 + h * 64, 512,
                          (const u16*)(p.ws + W_SBVT) + vto, vstr, nkeys, qpos0, Z + ((size_t)2 * NT + row0) * 512 + h * 64, YG + ((size_t)2 * NT + row0) * 512 + h * 64, smem);
    else
      attn_task<96, false>((const u16*)(p.ws + W_QF) + (size_t)row0 * 768 + h * 96, 768, nq, (const u16*)(p.ws + W_KF) + (size_t)kbase * 768 + h * 96, 768,
                           (const u16*)(p.ws + W_MLAVT) + vto, vstr, nkeys, qpos0, Z + ((size_t)1 * NT + row0) * 512 + h * 64, YG + ((size_t)1 * NT + row0) * 512 + h * 64, smem);
    return;
  }
  {
    int j = task - 2240; int bh = j >> 2, rq = j & 3, b = bh >> 3, h = bh & 7;
    size_t so = ((size_t)((l * 8 + b) * 8 + h)) * 4096;
    rwkv_scan_task(p, NP + b * 16, 16, h, rq, p.in[2] + so, p.out + O_WKV_S + so, -1, 0, smem);
  }
}
DI void phase5(const Params& p, int l, unsigned char* smem) {
  __shared__ int s_task;
  int* ctr = (int*)(p.ws + W_CTR) + l;
  while (true) {
    __syncthreads();
    if (TIDX() == 0) s_task = atomicAdd(ctr, 1);
    __syncthreads();
    int q = s_task;
    if (q >= PH5_TASKS) break;
    int task = q < 1024 ? ((q & 1) ? 512 + (q >> 1) : (q >> 1)) : q;
    phase5_task(p, l, task, smem);
  }
}
DI void phase5b(const Params& p, int l) {
  const int lane = TIDX() & 63, wave = TIDX() >> 6;
  const float* YRAW = (const float*)(p.ws + W_YRAW); const u16* RWX = (const u16*)(p.ws + W_RWX); const float* RHO = (const float*)(p.ws + W_RHO);
  const u16* Z = (const u16*)(p.ws + W_Z); u16* YG = (u16*)(p.ws + W_YG);
  for (int task = blockIdx.x; task < NT / 4; task += gridDim.x) {
    const int row = task * 4 + wave, c0 = lane * 8;
    float y[8];
    { float4 a = *(const float4*)(YRAW + (size_t)row * 512 + c0), b = *(const float4*)(YRAW + (size_t)row * 512 + c0 + 4);
      y[0] = a.x; y[1] = a.y; y[2] = a.z; y[3] = a.w; y[4] = b.x; y[5] = b.y; y[6] = b.z; y[7] = b.w; }
    float s = 0.f;
#pragma unroll
    for (int j = 0; j < 8; j++) s += y[j];
    s += __shfl_xor(s, 1); s += __shfl_xor(s, 2); s += __shfl_xor(s, 4);
    float mu = s * (1.f / 64.f), vs = 0.f;
#pragma unroll
    for (int j = 0; j < 8; j++) { float d = y[j] - mu; vs += d * d; }
    vs += __shfl_xor(vs, 1); vs += __shfl_xor(vs, 2); vs += __shfl_xor(vs, 4);
    float rstd = rsqrtf(vs * (1.f / 64.f) + GN_EPS);
    float rho = RHO[(size_t)row * 8 + (lane >> 3)];
    uint4 vv = *(const uint4*)(RWX + (size_t)row * 2560 + 1024 + c0);
    uint4 zz = *(const uint4*)(Z + (size_t)row * 512 + c0);
    float vf[8] = {bflo(vv.x), bfhi(vv.x), bflo(vv.y), bfhi(vv.y), bflo(vv.z), bfhi(vv.z), bflo(vv.w), bfhi(vv.w)};
    float zf[8] = {bflo(zz.x), bfhi(zz.x), bflo(zz.y), bfhi(zz.y), bflo(zz.z), bfhi(zz.z), bflo(zz.w), bfhi(zz.w)};
    float o[8];
#pragma unroll
    for (int j = 0; j < 8; j++) o[j] = ((y[j] - mu) * rstd * p.in[22][l * 512 + c0 + j] + p.in[23][l * 512 + c0 + j] + rho * vf[j]) * zf[j];
    uint4 ob; ob.x = pk2(o[0], o[1]); ob.y = pk2(o[2], o[3]); ob.z = pk2(o[4], o[5]); ob.w = pk2(o[6], o[7]);
    *(uint4*)(YG + (size_t)row * 512 + c0) = ob;
  }
}

DI void wave_gemm32(f32x16& acc, const u16* A, int lda, const u16* Bt, int ldb, int K) {
  const int lane = TIDX() & 63, r = lane & 31, hl = lane >> 5;
  const u16* ap = A + (size_t)r * lda + hl * 8; const u16* bp = Bt + (size_t)r * ldb + hl * 8;
#pragma unroll 8
  for (int k = 0; k < K; k += 16) { bf16x8 a = *(const bf16x8*)(ap + k); bf16x8 b = *(const bf16x8*)(bp + k); acc = MFMA32(a, b, acc); }
}
DI void phase6(const Params& p, int l, unsigned char* smem) {
  const u16* H = (const u16*)(p.ws + W_H); const u16* WinT = (const u16*)(p.ws + W_WINT);
  const u16* YG = (const u16*)(p.ws + W_YG); u16* MG = (u16*)(p.ws + W_MG);
  for (int t0 = blockIdx.x; t0 < 32 + 128 * 8; t0 += gridDim.x) {
    if (t0 < 32) {
      const int lane = TIDX() & 63, wave = TIDX() >> 6, r = lane & 31, hl = lane >> 5;
      const int unit = t0 * 4 + wave, row0 = NP + (unit & 3) * 32, n0 = (unit >> 2) * 32;
      f32x16 mm;
#pragma unroll
      for (int i = 0; i < 16; i++) mm[i] = 0.f;
#pragma unroll 1
      for (int g = 0; g < 3; g++) {
        f32x16 ay, ag;
#pragma unroll
        for (int i = 0; i < 16; i++) { ay[i] = 0.f; ag[i] = 0.f; }
        wave_gemm32(ay, YG + ((size_t)g * NT + row0) * 512, 512, (const u16*)(p.ws + W_WBRT) + ((size_t)(l * 3 + g) * 1024 + n0) * 512, 512, 512);
        wave_gemm32(ag, H + (size_t)row0 * 1024, 1024, WinT + (size_t)(5408 + g * 1024 + n0) * 1024, 1024, 1024);
#pragma unroll
        for (int i = 0; i < 16; i++) mm[i] += sigmoidf_(ag[i]) * ay[i];
      }
#pragma unroll
      for (int i = 0; i < 16; i++) MG[(size_t)(row0 + crow(i, hl)) * 1024 + n0 + r] = f2bf(mm[i]);
      continue;
    }
    const int t = t0 - 32;
    const int bq = t & 511, mt = (bq & 7) * 16 + ((bq >> 3) & 15), nt = (t >> 9) * 4 + (bq >> 7), m0 = mt * 128, n0 = nt * 128;

    unsigned mpk[2][2][8];
#pragma unroll
    for (int a = 0; a < 2; a++)
#pragma unroll
      for (int b = 0; b < 2; b++)
#pragma unroll
        for (int j = 0; j < 8; j++) mpk[a][b][j] = 0u;
#pragma unroll 1
    for (int g = 0; g < 3; g++) {
      f32x16 acc[2][2]; zero_acc(acc);
      gemm_mainloop(acc, YG + ((size_t)g * NT + m0) * 512, 512, (const u16*)(p.ws + W_WBRT) + ((size_t)(l * 3 + g) * 1024 + n0) * 512, 512, 512, smem);
      unsigned ypk[2][2][8];
#pragma unroll
      for (int a = 0; a < 2; a++)
#pragma unroll
        for (int b = 0; b < 2; b++)
#pragma unroll
          for (int j = 0; j < 8; j++) ypk[a][b][j] = pk2(acc[a][b][2 * j], acc[a][b][2 * j + 1]);
      zero_acc(acc);
      gemm_mainloop(acc, H + (size_t)m0 * 1024, 1024, WinT + (size_t)(5408 + g * 1024 + n0) * 1024, 1024, 1024, smem);
#pragma unroll
      for (int a = 0; a < 2; a++)
#pragma unroll
        for (int b = 0; b < 2; b++)
#pragma unroll
          for (int j = 0; j < 8; j++) {
            float lo = bflo(mpk[a][b][j]) + sigmoidf_(acc[a][b][2 * j]) * bflo(ypk[a][b][j]);
            float hi = bfhi(mpk[a][b][j]) + sigmoidf_(acc[a][b][2 * j + 1]) * bfhi(ypk[a][b][j]);
            mpk[a][b][j] = pk2(lo, hi);
          }
    }
    {
      const int lane = TIDX() & 63, wave = TIDX() >> 6, wm = wave >> 1, wn = wave & 1, r = lane & 31, hl = lane >> 5;
#pragma unroll
      for (int a = 0; a < 2; a++)
#pragma unroll
        for (int b = 0; b < 2; b++)
#pragma unroll
          for (int j = 0; j < 8; j++) {
            int col = n0 + wn * 64 + b * 32 + r;
            int row0 = m0 + wm * 64 + a * 32;
            MG[(size_t)(row0 + crow(2 * j, hl)) * 1024 + col] = (u16)(mpk[a][b][j] & 0xffffu);
            MG[(size_t)(row0 + crow(2 * j + 1, hl)) * 1024 + col] = (u16)(mpk[a][b][j] >> 16);
          }
    }
  }
}
DI void phase7(const Params& p, int l, unsigned char* smem) {
  const u16* MG = (const u16*)(p.ws + W_MG);
  const float* mod = (const float*)(p.ws + W_MOD);
  const int ntile = 32 + 128 * 8, nextra = (l + 1 < NL) ? WIN_TT + SMALLW_TT : 0;
  for (int t0 = blockIdx.x; t0 < ntile + nextra; t0 += gridDim.x) {
    if (t0 >= ntile + WIN_TT) { smallw_transpose_task(p, l + 1, t0 - ntile - WIN_TT, smem); continue; }
    if (t0 >= ntile) { win_transpose_task(p, l + 1, t0 - ntile, smem); continue; }
    if (t0 < 32) {
      const int lane = TIDX() & 63, wave = TIDX() >> 6, r = lane & 31, hl = lane >> 5;
      const int unit = t0 * 4 + wave, row0 = NP + (unit & 3) * 32, n0 = (unit >> 2) * 32;
      f32x16 a;
#pragma unroll
      for (int i = 0; i < 16; i++) a[i] = 0.f;
      wave_gemm32(a, MG + (size_t)row0 * 1024, 1024, (const u16*)(p.ws + W_WOUTT) + ((size_t)l * 1024 + n0) * 1024, 1024, 1024);
#pragma unroll
      for (int i = 0; i < 16; i++) {
        const int row = row0 + crow(i, hl), col = n0 + r;
        float xo = xrow_ptr(p, l, row)[col];
        float gt = mod[(l * 10 + bidx_of(row)) * 3072 + 2048 + col];
        p.out[(size_t)row * D + col] = xo + gt * a[i];
      }
      continue;
    }
    const int t = t0 - 32;
    const int bq = t & 511, mt = (bq & 7) * 16 + ((bq >> 3) & 15), nt = (t >> 9) * 4 + (bq >> 7), m0 = mt * 128, n0 = nt * 128;

    f32x16 acc[2][2]; zero_acc(acc);
    gemm_mainloop(acc, MG + (size_t)m0 * 1024, 1024, (const u16*)(p.ws + W_WOUTT) + ((size_t)l * 1024 + n0) * 1024, 1024, 1024, smem);
    foreach_acc(acc, m0, n0, [&](int row, int col, float v) {
      float xo = xrow_ptr(p, l, row)[col];
      float gt = mod[(l * 10 + bidx_of(row)) * 3072 + 2048 + col];
      p.out[(size_t)row * D + col] = xo + gt * v;
    });
  }
}

#define XB_TMO      128
#define XB_XCNT(j)  (256  + 64 * (j))
#define XB_XSUB(j)  (1280 + 64 * (j))
#define XB_XGEN(j)  (2304 + 64 * (j))
#define XB_TOP      3328
#define XB_TOPGEN   3392
#define XB_SPIN_CAP (1u << 18)
DI unsigned xb_ld(unsigned* q) { return __hip_atomic_load(q, __ATOMIC_RELAXED, __HIP_MEMORY_SCOPE_AGENT); }
DI unsigned xb_add(unsigned* q, unsigned v) { return __hip_atomic_fetch_add(q, v, __ATOMIC_RELAXED, __HIP_MEMORY_SCOPE_AGENT); }
DI unsigned xb_xcc_id() { return (unsigned)__builtin_amdgcn_s_getreg((3 << 11) | 20) & 0xFu; }
#define XB_SPIN(cond, bar) do { unsigned _sp = 0; while (cond) { __builtin_amdgcn_s_sleep(1); \
    if ((++_sp & 255u) == 0u) { if (xb_ld(&(bar)[XB_TMO])) break; if (_sp > XB_SPIN_CAP) { atomicAdd(&(bar)[XB_TMO], 1u); break; } } } } while (0)
DI void xbar(const Params& p, unsigned* xbst) {
  asm volatile("s_waitcnt vmcnt(0)" ::: "memory");
  __syncthreads();
  if (TIDX() == 0) {
    unsigned* bar = (unsigned*)(p.ws + W_XBAR);
    const unsigned x = xb_xcc_id();
    __builtin_amdgcn_s_waitcnt(0);
    const unsigned nloc = xbst[0], nx = xbst[1];
    const unsigned old = xb_add(&bar[XB_XSUB(x)], 1u);
    const unsigned gen = old / nloc;
    if (old + 1u == (gen + 1u) * nloc) {
      __builtin_amdgcn_fence(__ATOMIC_RELEASE, "agent");
      asm volatile("s_waitcnt vmcnt(0)" ::: "memory");
      const unsigned og = xb_add(&bar[XB_TOP], 1u);
      const unsigned tg = og / nx;
      if (og + 1u == (tg + 1u) * nx) xb_add(&bar[XB_TOPGEN], 1u);
      else XB_SPIN(xb_ld(&bar[XB_TOPGEN]) == tg, bar);
      __builtin_amdgcn_fence(__ATOMIC_ACQUIRE, "agent");
      xb_add(&bar[XB_XGEN(x)], 1u);
      asm volatile("s_waitcnt vmcnt(0)" ::: "memory");
    } else {
      XB_SPIN(xb_ld(&bar[XB_XGEN(x)]) == gen, bar);
      __builtin_amdgcn_fence(__ATOMIC_ACQUIRE, "agent");
      asm volatile("s_waitcnt vmcnt(0)" ::: "memory");
    }
  }
  __syncthreads();
}
DI int opq(int v) { asm volatile("" : "+s"(v)); return v; }
#if MULTI
template <int PH> __global__ void __launch_bounds__(256, 2) phase_kernel(Params p, int l) {
  __shared__ __attribute__((aligned(16))) unsigned char smem[SMEM_BYTES];
  if (PH == 0) phase0(p, smem);
  if (PH == 1) phase1(p, l);
  if (PH == 2) phase2(p, l, smem);
  if (PH == 3) phase3(p, l);
  if (PH == 4) phase4(p, l, smem);
  if (PH == 5) phase5(p, l, smem);
  if (PH == 6) phase5b(p, l);
  if (PH == 7) phase6(p, l, smem);
  if (PH == 8) phase7(p, l, smem);
}
#else
__global__ void __launch_bounds__(256, 2) mega_kernel(Params p_arg) {
  __shared__ __attribute__((aligned(16))) unsigned char smem[SMEM_BYTES];
  const Params& p = *(const Params*)__builtin_amdgcn_kernarg_segment_ptr();
  cg::grid_group grid = cg::this_grid();
  __shared__ unsigned xbst[4];
  if (TIDX() == 0) (void)xb_add((unsigned*)(p.ws + W_XBAR) + XB_XCNT(xb_xcc_id()), 1u);
  phase0(p, smem);
  grid.sync();
  if (TIDX() == 0) {
    unsigned* bar = (unsigned*)(p.ws + W_XBAR);
    const unsigned x = xb_xcc_id();
    unsigned cnt = 0u, mine = 0u;
    for (unsigned j = 0; j < 16; ++j) { const unsigned c = xb_ld(&bar[XB_XCNT(j)]); cnt += (c > 0u) ? 1u : 0u; mine = (j == x) ? c : mine; }
    xbst[0] = mine > 0u ? mine : 1u; xbst[1] = cnt > 0u ? cnt : 1u;
  }
  for (int l = 0; l < NL; l++) {
    phase1(p, opq(l)); xbar(p, xbst);
    phase2(p, opq(l), smem); xbar(p, xbst);
    phase3(p, opq(l)); xbar(p, xbst);
    phase4(p, opq(l), smem); xbar(p, xbst);
    phase5(p, opq(l), smem); xbar(p, xbst);
    phase5b(p, opq(l)); xbar(p, xbst);
    phase6(p, opq(l), smem); xbar(p, xbst);
    phase7(p, opq(l), smem); xbar(p, xbst);
  }
}
#endif

extern "C" void kernel_launch(void* const* d_in, const int* in_sizes, int n_in, void* d_out, int out_size, void* d_ws, size_t ws_size, hipStream_t stream) {
  Params p{};
  for (int i = 0; i < 36; i++) p.in[i] = (const float*)d_in[i];
  p.out = (float*)d_out;
  p.ws = (unsigned char*)d_ws;
  if (ws_size < W_TOTAL) fprintf(stderr, "workspace too small: %zu < %zu\n", ws_size, (size_t)W_TOTAL);
  hipMemsetAsync((unsigned char*)d_ws + W_CTR, 0, 256 + 3456 * 4, stream);
#if MULTI
  const int G = 1024;
  phase_kernel<0><<<G, 256, 0, stream>>>(p, 0);
  for (int l = 0; l < NL; l++) {
    phase_kernel<1><<<G, 256, 0, stream>>>(p, l);
    phase_kernel<2><<<G, 256, 0, stream>>>(p, l);
    phase_kernel<3><<<G, 256, 0, stream>>>(p, l);
    phase_kernel<4><<<G, 256, 0, stream>>>(p, l);
    phase_kernel<5><<<G, 256, 0, stream>>>(p, l);
    phase_kernel<6><<<G, 256, 0, stream>>>(p, l);
    phase_kernel<7><<<G, 256, 0, stream>>>(p, l);
    phase_kernel<8><<<G, 256, 0, stream>>>(p, l);
  }
#else
  static int grid_blocks = 0;
  if (!grid_blocks) {
    int dev = 0, cus = 0, per_cu = 0;
    hipGetDevice(&dev);
    hipDeviceGetAttribute(&cus, hipDeviceAttributeMultiprocessorCount, dev);
    hipOccupancyMaxActiveBlocksPerMultiprocessor(&per_cu, mega_kernel, 256, 0);
    if (per_cu > 2) per_cu = 2;
    grid_blocks = cus * per_cu;
  }
  void* args[] = {&p};
  hipError_t e = hipLaunchCooperativeKernel((void*)mega_kernel, dim3(grid_blocks), dim3(256), args, 0, stream);
  if (e != hipSuccess) fprintf(stderr, "cooperative launch failed: %s (grid %d)\n", hipGetErrorString(e), grid_blocks);
#endif
}
```

```cpp
#include <hip/hip_runtime.h>
#include <hip/hip_cooperative_groups.h>
#include <cstdio>
namespace cg = cooperative_groups;

#ifndef MULTI
#define MULTI 0
#endif

typedef unsigned short u16;
typedef __attribute__((ext_vector_type(8))) short bf16x8;
typedef __attribute__((ext_vector_type(16))) float f32x16;
typedef __attribute__((ext_vector_type(2))) __bf16 bf2_t;
typedef __attribute__((ext_vector_type(2))) float f2_t;
typedef __attribute__((ext_vector_type(4))) unsigned u32x4;
typedef __attribute__((ext_vector_type(2))) unsigned u32x2;
typedef __attribute__((ext_vector_type(4))) float f32x4v;
#define DI __device__ __forceinline__
#define MFMA32(a, b, c) __builtin_amdgcn_mfma_f32_32x32x16_bf16((a), (b), (c), 0, 0, 0)

constexpr int D = 1024, NL = 4, NP = 16384, NS = 128, NT = NP + NS, TP = 8192, TS = 16, PAST = 2048, SK = 2064;
constexpr int NKV = NP + 8 * SK;
constexpr int DIN = 8480;
constexpr float RMS_EPS = 1e-6f, GN_EPS = 64e-5f;
constexpr float LOG2E = 1.4426950408889634f;
constexpr float QSCALE_MLA = 0.10206207261596577f * LOG2E;
constexpr float QSCALE_SB = 0.125f * LOG2E;

constexpr size_t O_Y = 0;
constexpr size_t O_WKV_P = (size_t)NT * D;
constexpr size_t O_SHIFT_P = O_WKV_P + (size_t)NL * 2 * 8 * 4096;
constexpr size_t O_CKV_P = O_SHIFT_P + (size_t)NL * 2 * 1664;
constexpr size_t O_KROPE_P = O_CKV_P + (size_t)NL * NP * 256;
constexpr size_t O_SBK_P = O_KROPE_P + (size_t)NL * NP * 32;
constexpr size_t O_SBV_P = O_SBK_P + (size_t)NL * NP * 512;
constexpr size_t O_WKV_S = O_SBV_P + (size_t)NL * NP * 512;
constexpr size_t O_SHIFT_S = O_WKV_S + (size_t)NL * 8 * 8 * 4096;
constexpr size_t O_CKV_S = O_SHIFT_S + (size_t)NL * 8 * 1664;
constexpr size_t O_KROPE_S = O_CKV_S + (size_t)NL * NS * 256;
constexpr size_t O_SBK_S = O_KROPE_S + (size_t)NL * NS * 32;
constexpr size_t O_SBV_S = O_SBK_S + (size_t)NL * NS * 512;

constexpr size_t al(size_t x) { return (x + 255) & ~(size_t)255; }
constexpr size_t W_WINT = 0;
constexpr size_t W_WBRT = al(W_WINT + (size_t)DIN * 1024 * 2);
constexpr size_t W_WOUTT = al(W_WBRT + (size_t)NL * 3 * 1024 * 512 * 2);
constexpr size_t W_WUQT = al(W_WOUTT + (size_t)NL * 1024 * 1024 * 2);
constexpr size_t W_WUKVT = al(W_WUQT + (size_t)NL * 768 * 384 * 2);
constexpr size_t W_WUPT = al(W_WUKVT + (size_t)NL * 1024 * 256 * 2);
constexpr size_t W_AUPT = al(W_WUPT + (size_t)NL * 512 * 64 * 2);
constexpr size_t W_MOD = al(W_AUPT + (size_t)NL * 512 * 64 * 2);
constexpr size_t W_ROPE = al(W_MOD + (size_t)NL * 10 * 3072 * 4);
constexpr size_t W_CTR = al(W_ROPE + (size_t)8192 * 32 * 4);
constexpr size_t W_XBAR = W_CTR + 256;
constexpr size_t W_H = al(W_XBAR + 3456 * 4);
constexpr size_t W_PR = al(W_H + (size_t)NT * 1024 * 2);
constexpr size_t W_YG = W_PR;
constexpr size_t W_YRAW = al(W_YG + (size_t)3 * NT * 512 * 2);
constexpr size_t W_MG = W_YRAW;
constexpr size_t W_Z = al(W_PR + (size_t)NT * 1664 * 4);
constexpr size_t W_CQ = al(W_Z + (size_t)3 * NT * 512 * 2);
constexpr size_t W_QF = W_CQ;
constexpr size_t W_CKV = al(W_CQ + (size_t)NT * 768 * 2);
constexpr size_t W_KR = al(W_CKV + (size_t)NT * 256 * 4);
constexpr size_t W_QN = al(W_KR + (size_t)NT * 32 * 4);
constexpr size_t W_CKVN = al(W_QN + (size_t)NT * 384 * 2);
constexpr size_t W_SQ = al(W_CKVN + (size_t)(NKV + 64) * 256 * 2);
constexpr size_t W_SBK = al(W_SQ + (size_t)NT * 512 * 2);
constexpr size_t VT_S_OFF = (size_t)16 * 64 * 8192;
constexpr size_t VT_ELEMS = VT_S_OFF + (size_t)64 * 64 * SK + 256;
constexpr size_t W_SBVT = al(W_SBK + (size_t)(NKV + 64) * 512 * 2);
constexpr size_t W_RWW = al(W_SBVT + VT_ELEMS * 2);
constexpr size_t W_RWX = al(W_RWW + (size_t)NT * 512 * 4);
constexpr size_t W_RHO = al(W_RWX + (size_t)NT * 5 * 512 * 2);
constexpr size_t W_KF = al(W_RHO + (size_t)NT * 8 * 4);
constexpr size_t W_MLAVT = al(W_KF + (size_t)(NKV + 64) * 768 * 2);
constexpr size_t W_SLOC = al(W_MLAVT + VT_ELEMS * 2);
constexpr size_t W_PMAT = al(W_SLOC + (size_t)16 * 7 * 4096 * 4);
constexpr size_t W_TOTAL = al(W_PMAT + (size_t)16 * 7 * 4096 * 4);
static_assert((size_t)NT * 384 * 4 <= (size_t)NT * 768 * 2, "alias");
static_assert(W_YRAW + (size_t)NT * 1024 * 2 <= W_Z, "alias overflow");

struct Params {
  const float* in[36];
  float* out;
  unsigned char* ws;
};

constexpr int SMEM_BYTES = 73728;

DI int TIDX() { int t = __builtin_amdgcn_workitem_id_x(); asm volatile("" : "+v"(t)); return t; }
DI u16 f2bf(float x) { return __builtin_bit_cast(u16, (__bf16)x); }
DI unsigned pk2(float a, float b) { f2_t v = {a, b}; return __builtin_bit_cast(unsigned, __builtin_convertvector(v, bf2_t)); }
DI float bf2f(u16 x) { return __uint_as_float((unsigned)x << 16); }
DI float bflo(unsigned x) { return __uint_as_float(x << 16); }
DI float bfhi(unsigned x) { return __uint_as_float(x & 0xffff0000u); }
DI float ex2(float x) { return __builtin_amdgcn_exp2f(x); }
DI float lg2(float x) { return __builtin_amdgcn_logf(x); }
DI float frcp(float x) { return __builtin_amdgcn_rcpf(x); }
DI float sigmoidf_(float x) { return frcp(1.f + __expf(-x)); }
DI float siluf_(float x) { return x * frcp(1.f + __expf(-x)); }
DI float softplusf_(float x) { return fmaxf(x, 0.f) + __logf(1.f + __expf(-fabsf(x))); }
DI float tanhf_(float x) { return 1.f - 2.f * frcp(1.f + __expf(2.f * x)); }
DI int crow(int i, int hl) { return (i & 3) + 8 * (i >> 2) + 4 * hl; }
template <int CTRL> DI float dppf(float x) {
  return __int_as_float(__builtin_amdgcn_update_dpp(__float_as_int(x), __float_as_int(x), CTRL, 0xF, 0xF, false));
}
DI float allreduce16(float x) {
  x += dppf<0xB1>(x); x += dppf<0x4E>(x); x += dppf<0x141>(x); x += dppf<0x140>(x); return x;
}
DI float red32(float x) {
  x += __shfl_xor(x, 1); x += __shfl_xor(x, 2); x += __shfl_xor(x, 4); x += __shfl_xor(x, 8); x += __shfl_xor(x, 16); return x;
}
DI float red64(float x) { x = red32(x); x += __shfl_xor(x, 32); return x; }
DI int bidx_of(int row) { return row < NP ? (row >> 13) : 2 + ((row - NP) >> 4); }
DI int keyrow_of(int row) { return row < NP ? row : NP + ((row - NP) >> 4) * SK + PAST + ((row - NP) & 15); }
DI int pos_of(int row) { return row < NP ? (row & 8191) : PAST + ((row - NP) & 15); }
DI size_t vt_off(int keyrow, int h, int d) {
  if (keyrow < NP) { int b = keyrow >> 13, s = keyrow & 8191; return ((size_t)((b * 8 + h) * 64 + d)) * 8192 + s; }
  int rr = keyrow - NP; int b = rr / SK, s = rr - b * SK; return VT_S_OFF + ((size_t)((b * 8 + h) * 64 + d)) * SK + s;
}

DI void gemm_mainloop(f32x16 (&acc)[2][2], const u16* A, int lda, const u16* Bt, int ldb, int K, unsigned char* smem) {
  u16* s0 = (u16*)smem;
  const int tid = TIDX(), lane = tid & 63, wave = tid >> 6, wm = wave >> 1, wn = wave & 1;
  const int lr = tid >> 3, lc = (tid & 7) * 8;
  const u16* Ap = A + (size_t)lr * lda + lc;
  const u16* Bp = Bt + (size_t)lr * ldb + lc;
  u32x4 ra[4], rb[4];
  const int nk = K >> 6;
  const int r = lane & 31, hl = lane >> 5;
#pragma unroll
  for (int i = 0; i < 4; i++) { ra[i] = *(const u32x4*)(Ap + (size_t)(32 * i) * lda); rb[i] = *(const u32x4*)(Bp + (size_t)(32 * i) * ldb); }
  __syncthreads();
#pragma unroll
  for (int i = 0; i < 4; i++) { *(u32x4*)(s0 + (lr + 32 * i) * 72 + lc) = ra[i]; *(u32x4*)(s0 + 128 * 72 + (lr + 32 * i) * 72 + lc) = rb[i]; }
  if (nk > 1) { Ap += 64; Bp += 64; }
#pragma unroll
  for (int i = 0; i < 4; i++) { ra[i] = *(const u32x4*)(Ap + (size_t)(32 * i) * lda); rb[i] = *(const u32x4*)(Bp + (size_t)(32 * i) * ldb); }
  __syncthreads();
  for (int kt = 0; kt < nk; kt++) {
    u16* sA = s0 + (kt & 1) * (256 * 72); u16* sB = sA + 128 * 72;
    if (kt + 1 < nk) {
      u16* nA = s0 + ((kt + 1) & 1) * (256 * 72); u16* nB = nA + 128 * 72;
#pragma unroll
      for (int i = 0; i < 4; i++) { *(u32x4*)(nA + (lr + 32 * i) * 72 + lc) = ra[i]; *(u32x4*)(nB + (lr + 32 * i) * 72 + lc) = rb[i]; }
    }
    if (kt + 2 < nk) { Ap += 64; Bp += 64; }
#pragma unroll
    for (int i = 0; i < 4; i++) { ra[i] = *(const u32x4*)(Ap + (size_t)(32 * i) * lda); rb[i] = *(const u32x4*)(Bp + (size_t)(32 * i) * ldb); }
#pragma unroll
    for (int ks = 0; ks < 4; ks++) {
      bf16x8 af[2], bfr[2];
#pragma unroll
      for (int b = 0; b < 2; b++) {
        af[b] = *(const bf16x8*)(sA + (wm * 64 + b * 32 + r) * 72 + ks * 16 + hl * 8);
        bfr[b] = *(const bf16x8*)(sB + (wn * 64 + b * 32 + r) * 72 + ks * 16 + hl * 8);
      }
#pragma unroll
      for (int bm = 0; bm < 2; bm++)
#pragma unroll
        for (int bn = 0; bn < 2; bn++) acc[bm][bn] = MFMA32(af[bm], bfr[bn], acc[bm][bn]);
    }
    __syncthreads();
  }
}
DI void zero_acc(f32x16 (&acc)[2][2]) {
#pragma unroll
  for (int a = 0; a < 2; a++)
#pragma unroll
    for (int b = 0; b < 2; b++)
#pragma unroll
      for (int i = 0; i < 16; i++) acc[a][b][i] = 0.f;
}
template <class F> DI void foreach_acc(f32x16 (&acc)[2][2], int m0, int n0, F f) {
  const int lane = TIDX() & 63, wave = TIDX() >> 6, wm = wave >> 1, wn = wave & 1, r = lane & 31, hl = lane >> 5;
#pragma unroll
  for (int bm = 0; bm < 2; bm++)
#pragma unroll
    for (int bn = 0; bn < 2; bn++)
#pragma unroll
      for (int i = 0; i < 16; i++) f(m0 + wm * 64 + bm * 32 + crow(i, hl), n0 + wn * 64 + bn * 32 + r, acc[bm][bn][i]);
}

DI void transpose_tile(const float* __restrict__ src, int K, int N, u16* __restrict__ dst, int kt, int nt, int mode, unsigned char* smem) {
  float* tile = (float*)smem;
  const int tid = TIDX(), tx = tid & 63, ty = tid >> 6;
  const int k0 = kt * 64, n0 = nt * 64;
  __syncthreads();
#pragma unroll 4
  for (int i = 0; i < 16; i++) { int k = i * 4 + ty; int n = n0 + tx; tile[k * 65 + tx] = (n < N) ? src[(size_t)(k0 + k) * N + n] : 0.f; }
  __syncthreads();
#pragma unroll 4
  for (int i = 0; i < 16; i++) {
    int nl = i * 4 + ty; int n = n0 + nl;
    if (n < N) {
      int nd = n;
      if (mode == 1) { int hd = n / 96, d = n - hd * 96; nd = d < 64 ? hd * 64 + d : 512 + hd * 32 + (d - 64); }
      dst[(size_t)nd * K + k0 + tx] = f2bf(tile[tx * 65 + nl]);
    }
  }
}
constexpr int WIN_TT = 16 * 133;
DI void win_transpose_task(const Params& p, int l, int t, unsigned char* smem) {
  int kt = t & 15, nt = t >> 4;
  transpose_tile(p.in[13] + (size_t)l * 1024 * DIN, 1024, DIN, (u16*)(p.ws + W_WINT), kt, nt, 0, smem);
}
constexpr int SMALLW_TT = 384 + 256 + 72 + 64 + 8 + 8;
DI void smallw_transpose_task(const Params& p, int l, int t, unsigned char* smem) {
  if (t < 384) { int g = t / 128, q = t % 128; const float* src = p.in[g == 0 ? 24 : (g == 1 ? 33 : 34)] + (size_t)l * 512 * 1024;
    transpose_tile(src, 512, 1024, (u16*)(p.ws + W_WBRT) + ((size_t)(l * 3 + g)) * 1024 * 512, q & 7, q >> 3, 0, smem); return; }
  t -= 384;
  if (t < 256) { transpose_tile(p.in[35] + (size_t)l * 1024 * 1024, 1024, 1024, (u16*)(p.ws + W_WOUTT) + (size_t)l * 1024 * 1024, t & 15, t >> 4, 0, smem); return; }
  t -= 256;
  if (t < 72) { transpose_tile(p.in[26] + (size_t)l * 384 * 768, 384, 768, (u16*)(p.ws + W_WUQT) + (size_t)l * 768 * 384, t % 6, t / 6, 1, smem); return; }
  t -= 72;
  if (t < 64) { transpose_tile(p.in[28] + (size_t)l * 256 * 1024, 256, 1024, (u16*)(p.ws + W_WUKVT) + (size_t)l * 1024 * 256, t & 3, t >> 2, 0, smem); return; }
  t -= 64;
  if (t < 8) { transpose_tile(p.in[16] + (size_t)l * 64 * 512, 64, 512, (u16*)(p.ws + W_WUPT) + (size_t)l * 512 * 64, 0, t, 0, smem); return; }
  t -= 8;
  transpose_tile(p.in[18] + (size_t)l * 64 * 512, 64, 512, (u16*)(p.ws + W_AUPT) + (size_t)l * 512 * 64, 0, t, 0, smem);
}
DI void mod_task(const Params& p, int task, unsigned char* smem) {
  float* sm = (float*)smem;
  const int tid = TIDX(), l = task / 48, cb = task % 48, kq = tid >> 6, cl = tid & 63, col = cb * 64 + cl;
  __syncthreads();
  for (int e = tid; e < 10240; e += 256) { int r = e >> 10, k = e & 1023; float c = r < 2 ? p.in[8][r * 1024 + k] : p.in[9][(r - 2) * 1024 + k]; sm[e] = siluf_(c); }
  __syncthreads();
  float acc[10];
#pragma unroll
  for (int r = 0; r < 10; r++) acc[r] = 0.f;
  const float* w = p.in[10] + ((size_t)l * 1024 + kq * 256) * 3072 + col;
#pragma unroll 8
  for (int k = 0; k < 256; k++) {
    float wv = w[(size_t)k * 3072];
#pragma unroll
    for (int r = 0; r < 10; r++) acc[r] += sm[r * 1024 + kq * 256 + k] * wv;
  }
  __syncthreads();
#pragma unroll
  for (int r = 0; r < 10; r++) sm[(kq * 10 + r) * 64 + cl] = acc[r];
  __syncthreads();
  if (tid < 64) {
    float* mod = (float*)(p.ws + W_MOD);
    float bb = p.in[11][l * 3072 + col];
#pragma unroll
    for (int r = 0; r < 10; r++) mod[(l * 10 + r) * 3072 + col] = sm[r * 64 + cl] + sm[(10 + r) * 64 + cl] + sm[(20 + r) * 64 + cl] + sm[(30 + r) * 64 + cl] + bb;
  }
}
DI void rope_task(const Params& p, int task) {
  const int tid = TIDX(); const int pos = task * 128 + (tid >> 1);
  float* rope = (float*)(p.ws + W_ROPE);
  for (int ff = 0; ff < 8; ff++) {
    int f = (tid & 1) * 8 + ff;
    double inv = 1.0; for (int j = 0; j < f; j++) inv *= 0.5623413251903491;
    double ang = (double)pos * inv;
    double n = rint(ang * 0.15915494309189535);
    double rr = ang - n * 6.283185307179586 - n * 2.4492935982947064e-16;
    double r2 = rr * rr, sn = rr, cs = 1.0, ts = rr, tc = 1.0;
    for (int k = 1; k <= 15; k++) { tc *= -r2 / (double)((2 * k - 1) * (2 * k)); cs += tc; ts *= -r2 / (double)((2 * k) * (2 * k + 1)); sn += ts; }
    rope[pos * 32 + f] = (float)cs; rope[pos * 32 + 16 + f] = (float)sn;
  }
}
DI void phase0(const Params& p, unsigned char* smem) {
  const int n_tr = WIN_TT + SMALLW_TT, total = n_tr + 192 + 64;
  for (int t = blockIdx.x; t < total; t += gridDim.x) {
    if (t < 192) mod_task(p, t, smem);
    else if (t < 192 + 64) rope_task(p, t - 192);
    else { int q = t - 256; if (q < WIN_TT) win_transpose_task(p, 0, q, smem); else { q -= WIN_TT; smallw_transpose_task(p, 0, q, smem); } }
  }
}

DI const float* xrow_ptr(const Params& p, int l, int row) {
  if (l > 0) return p.out + (size_t)row * D;
  return row < NP ? p.in[0] + (size_t)row * D : p.in[1] + (size_t)(row - NP) * D;
}
DI void phase1(const Params& p, int l) {
  const int lane = TIDX() & 63, wave = TIDX() >> 6;
  const float* mod = (const float*)(p.ws + W_MOD);
  const float* g = p.in[12] + l * 1024;
  u16* H = (u16*)(p.ws + W_H);
  for (int task = blockIdx.x; task < NT / 4; task += gridDim.x) {
    int row = task * 4 + wave;
    const float* x = xrow_ptr(p, l, row);
    const float* md = mod + (l * 10 + bidx_of(row)) * 3072;
    float4 v[4]; float ss = 0.f;
#pragma unroll
    for (int j = 0; j < 4; j++) { v[j] = *(const float4*)(x + (j * 64 + lane) * 4); ss += v[j].x * v[j].x + v[j].y * v[j].y + v[j].z * v[j].z + v[j].w * v[j].w; }
    ss = red64(ss);
    float rstd = rsqrtf(ss * (1.f / 1024.f) + RMS_EPS);
#pragma unroll
    for (int j = 0; j < 4; j++) {
      int c = (j * 64 + lane) * 4;
      float4 gg = *(const float4*)(g + c), sh = *(const float4*)(md + c), sc = *(const float4*)(md + 1024 + c);
      float h0 = v[j].x * rstd * gg.x * (1.f + sc.x) + sh.x, h1 = v[j].y * rstd * gg.y * (1.f + sc.y) + sh.y;
      float h2 = v[j].z * rstd * gg.z * (1.f + sc.z) + sh.z, h3 = v[j].w * rstd * gg.w * (1.f + sc.w) + sh.w;
      uint2 o; o.x = pk2(h0, h1); o.y = pk2(h2, h3);
      *(uint2*)(H + (size_t)row * 1024 + c) = o;
    }
  }
}

DI void phase2(const Params& p, int l, unsigned char* smem) {
  const u16* H = (const u16*)(p.ws + W_H);
  const u16* WinT = (const u16*)(p.ws + W_WINT);
  float* PR = (float*)(p.ws + W_PR);
  u16* Z = (u16*)(p.ws + W_Z);
  float* CQ = (float*)(p.ws + W_CQ); float* CKV = (float*)(p.ws + W_CKV); float* KR = (float*)(p.ws + W_KR);
  u16* SQ = (u16*)(p.ws + W_SQ); u16* SBK = (u16*)(p.ws + W_SBK); u16* SBVT = (u16*)(p.ws + W_SBVT);
  float* out = p.out;
  for (int ts = blockIdx.x; ts < 11 * 512; ts += gridDim.x) {
    int mt, nt;
    {
      const int rd = ts >> 9, bq = ts & 511, sm = bq & 7, j = bq >> 3;
      mt = sm * 16 + (j & 15); nt = rd * 4 + (j >> 4);
      if (nt >= 43) { const int e = sm * 16 + (j & 15); if (e >= 43) continue; mt = 128; nt = e; }
    }
    const int m0 = mt * 128;
    int seg, n0, c0;
    if (nt < 13) { seg = 0; c0 = nt * 128; n0 = c0; }
    else if (nt < 17) { seg = 1; c0 = (nt - 13) * 128; n0 = 1664 + c0; }
    else if (nt < 20) { seg = 2; c0 = (nt - 17) * 128; n0 = 2176 + c0; }
    else if (nt < 22) { seg = 3; c0 = (nt - 20) * 128; n0 = 2560 + c0; }
    else if (nt < 26) { seg = 4; c0 = (nt - 22) * 128; n0 = 2848 + c0; }
    else if (nt < 30) { seg = 5; c0 = (nt - 26) * 128; n0 = 3360 + c0; }
    else if (nt < 34) { seg = 6; c0 = (nt - 30) * 128; n0 = 3872 + c0; }
    else if (nt < 38) { seg = 7; c0 = (nt - 34) * 128; n0 = 4384 + c0; }
    else if (nt < 42) { seg = 8; c0 = (nt - 38) * 128; n0 = 4896 + c0; }
    else { seg = 9; c0 = 0; n0 = 2816; }
    f32x16 acc[2][2]; zero_acc(acc);
    gemm_mainloop(acc, H + (size_t)m0 * 1024, 1024, WinT + (size_t)n0 * 1024, 1024, 1024, smem);
    if (seg == 0) {
      foreach_acc(acc, m0, c0, [&](int row, int col, float v) {
        PR[(size_t)row * 1664 + col] = v;
        if (row < NP) { if ((row & 8191) == 8191) out[O_SHIFT_P + (size_t)(l * 2 + (row >> 13)) * 1664 + col] = v; }
        else { int rr = row - NP; if ((rr & 15) == 15) out[O_SHIFT_S + (size_t)(l * 8 + (rr >> 4)) * 1664 + col] = v; }
      });
    } else if (seg == 1 || seg == 4 || seg == 8) {
      const int g = seg == 1 ? 0 : (seg == 4 ? 1 : 2);
      foreach_acc(acc, m0, c0, [&](int row, int col, float v) { Z[((size_t)g * NT + row) * 512 + col] = f2bf(siluf_(v)); });
    } else if (seg == 2) {
      foreach_acc(acc, m0, c0, [&](int row, int col, float v) { CQ[(size_t)row * 384 + col] = v; });
    } else if (seg == 3) {
      foreach_acc(acc, m0, c0, [&](int row, int col, float v) { CKV[(size_t)row * 256 + col] = v; });
    } else if (seg == 9) {
      foreach_acc(acc, m0, c0, [&](int row, int col, float v) { if (col < 32) KR[(size_t)row * 32 + col] = v; });
    } else if (seg == 5) {
      foreach_acc(acc, m0, c0, [&](int row, int col, float v) { SQ[(size_t)row * 512 + col] = f2bf(v * QSCALE_SB); });
    } else if (seg == 6) {
      foreach_acc(acc, m0, c0, [&](int row, int col, float v) {
        size_t oo = row < NP ? O_SBK_P + ((size_t)l * NP + row) * 512 + col : O_SBK_S + ((size_t)l * NS + (row - NP)) * 512 + col;
        out[oo] = v;
        SBK[(size_t)keyrow_of(row) * 512 + col] = f2bf(v);
      });
    } else {
      foreach_acc(acc, m0, c0, [&](int row, int col, float v) {
        size_t oo = row < NP ? O_SBV_P + ((size_t)l * NP + row) * 512 + col : O_SBV_S + ((size_t)l * NS + (row - NP)) * 512 + col;
        out[oo] = v;
      });
      const int lane = TIDX() & 63, wave = TIDX() >> 6, wm = wave >> 1, wn = wave & 1, r = lane & 31, hl = lane >> 5;
#pragma unroll
      for (int bm = 0; bm < 2; bm++)
#pragma unroll
        for (int bn = 0; bn < 2; bn++)
#pragma unroll
          for (int g4 = 0; g4 < 4; g4++) {
            int row = m0 + wm * 64 + bm * 32 + 8 * g4 + 4 * hl, col = c0 + wn * 64 + bn * 32 + r;
            uint2 o; o.x = pk2(acc[bm][bn][4 * g4], acc[bm][bn][4 * g4 + 1]); o.y = pk2(acc[bm][bn][4 * g4 + 2], acc[bm][bn][4 * g4 + 3]);
            *(uint2*)(SBVT + vt_off(keyrow_of(row), col >> 6, col & 63)) = o;
          }
    }
  }
}

DI const float* prev_ptr(const Params& p, int l, const float* PR, int row) {
  if (row < NP) return (row & 8191) ? PR + (size_t)(row - 1) * 1664 : nullptr;
  int rr = row - NP;
  return (rr & 15) ? PR + (size_t)(row - 1) * 1664 : p.in[3] + (size_t)(l * 8 + (rr >> 4)) * 1664;
}
DI void rwkv_prep_task(const Params& p, int l, int task) {
  const int lane = TIDX() & 63, wave = TIDX() >> 6, r = lane & 31, hl = lane >> 5;
  const int tile = task >> 1, hh = (task & 1) * 4 + wave, row0 = tile * 32;
  const float* PR = (const float*)(p.ws + W_PR);
  const float* mu = p.in[14] + l * 1664;
  f32x16 accW[1][2], accA[1][2];
#pragma unroll
  for (int b_ = 0; b_ < 2; b_++)
#pragma unroll
    for (int i_ = 0; i_ < 16; i_++) { accW[0][b_][i_] = 0.f; accA[0][b_][i_] = 0.f; }
  const u16* WupT = (const u16*)(p.ws + W_WUPT) + (size_t)l * 512 * 64;
  const u16* AupT = (const u16*)(p.ws + W_AUPT) + (size_t)l * 512 * 64;
#pragma unroll 1
  for (int ks = 0; ks < 4; ks++) {
    const int k0 = ks * 16 + hl * 8;
    bf16x8 bw[2], ba[2];
#pragma unroll
    for (int bn = 0; bn < 2; bn++) {
      bw[bn] = *(const bf16x8*)(WupT + (size_t)(hh * 64 + bn * 32 + r) * 64 + k0);
      ba[bn] = *(const bf16x8*)(AupT + (size_t)(hh * 64 + bn * 32 + r) * 64 + k0);
    }
#pragma unroll
    for (int bm = 0; bm < 1; bm++) {
      const int row = row0 + bm * 32 + r;
      const float* pp = PR + (size_t)row * 1664;
      const float* pv = prev_ptr(p, l, PR, row);
      float xw[8], xa[8];
#pragma unroll
      for (int q = 0; q < 2; q++) {
        float4 a = *(const float4*)(pp + 1536 + k0 + 4 * q), b = pv ? *(const float4*)(pv + 1536 + k0 + 4 * q) : make_float4(0, 0, 0, 0), m = *(const float4*)(mu + 1536 + k0 + 4 * q);
        xw[4 * q] = tanhf_(a.x + (b.x - a.x) * m.x); xw[4 * q + 1] = tanhf_(a.y + (b.y - a.y) * m.y); xw[4 * q + 2] = tanhf_(a.z + (b.z - a.z) * m.z); xw[4 * q + 3] = tanhf_(a.w + (b.w - a.w) * m.w);
        a = *(const float4*)(pp + 1600 + k0 + 4 * q); b = pv ? *(const float4*)(pv + 1600 + k0 + 4 * q) : make_float4(0, 0, 0, 0); m = *(const float4*)(mu + 1600 + k0 + 4 * q);
        xa[4 * q] = a.x + (b.x - a.x) * m.x; xa[4 * q + 1] = a.y + (b.y - a.y) * m.y; xa[4 * q + 2] = a.z + (b.z - a.z) * m.z; xa[4 * q + 3] = a.w + (b.w - a.w) * m.w;
      }
      u32x4 uw, ua;
      uw.x = pk2(xw[0], xw[1]); uw.y = pk2(xw[2], xw[3]); uw.z = pk2(xw[4], xw[5]); uw.w = pk2(xw[6], xw[7]);
      ua.x = pk2(xa[0], xa[1]); ua.y = pk2(xa[2], xa[3]); ua.z = pk2(xa[4], xa[5]); ua.w = pk2(xa[6], xa[7]);
      bf16x8 awf = __builtin_bit_cast(bf16x8, uw), aaf = __builtin_bit_cast(bf16x8, ua);
#pragma unroll
      for (int bn = 0; bn < 2; bn++) { accW[bm][bn] = MFMA32(awf, bw[bn], accW[bm][bn]); accA[bm][bn] = MFMA32(aaf, ba[bn], accA[bm][bn]); }
    }
  }
  float* RWW = (float*)(p.ws + W_RWW); u16* RWX = (u16*)(p.ws + W_RWX); float* RHO = (float*)(p.ws + W_RHO);
  float mur[2], muk[2], muv[2], w0[2], a0[2], kk_[2], ka_[2], rk_[2];
#pragma unroll
  for (int bn = 0; bn < 2; bn++) {
    int col = hh * 64 + bn * 32 + r;
    mur[bn] = mu[col]; muk[bn] = mu[512 + col]; muv[bn] = mu[1024 + col];
    w0[bn] = p.in[15][l * 512 + col]; a0[bn] = p.in[17][l * 512 + col]; kk_[bn] = p.in[19][l * 512 + col]; ka_[bn] = p.in[20][l * 512 + col]; rk_[bn] = p.in[21][l * 512 + col];
  }
#pragma unroll
  for (int bm = 0; bm < 1; bm++)
#pragma unroll
    for (int i = 0; i < 16; i++) {
      const int row = row0 + bm * 32 + crow(i, hl);
      const float* pp = PR + (size_t)row * 1664;
      const float* pv = prev_ptr(p, l, PR, row);
      float xr[2], xv[2], kp[2], kkr[2], av[2], dec[2];
      float ssq = 0.f, rho = 0.f;
#pragma unroll
      for (int bn = 0; bn < 2; bn++) {
        int col = hh * 64 + bn * 32 + r;
        float pr_ = pp[col], pk_ = pp[512 + col], pv_ = pp[1024 + col];
        float qr = pv ? pv[col] : 0.f, qk = pv ? pv[512 + col] : 0.f, qv = pv ? pv[1024 + col] : 0.f;
        xr[bn] = pr_ + (qr - pr_) * mur[bn];
        float xk = pk_ + (qk - pk_) * muk[bn];
        xv[bn] = pv_ + (qv - pv_) * muv[bn];
        float wpre = w0[bn] + accW[bm][bn][i];
        float wlog = -softplusf_(-wpre) - 0.5f;
        dec[bn] = __expf(-__expf(wlog));
        av[bn] = sigmoidf_(a0[bn] + accA[bm][bn][i]);
        kkr[bn] = xk * kk_[bn];
        kp[bn] = xk * (1.f + (av[bn] - 1.f) * ka_[bn]);
        ssq += kkr[bn] * kkr[bn];
        rho += xr[bn] * kp[bn] * rk_[bn];
      }
      ssq = red32(ssq); rho = red32(rho);
      float inv = rsqrtf(fmaxf(ssq, 1e-24f));
#pragma unroll
      for (int bn = 0; bn < 2; bn++) {
        int col = hh * 64 + bn * 32 + r;
        float kk = kkr[bn] * inv;
        RWW[(size_t)row * 512 + col] = dec[bn];
        u16* rx = RWX + (size_t)row * 2560 + col;
        rx[0] = f2bf(xr[bn]); rx[512] = f2bf(kp[bn]); rx[1024] = f2bf(xv[bn]); rx[1536] = f2bf(kk); rx[2048] = f2bf(kk * av[bn]);
      }
      if (r == 0) RHO[(size_t)row * 8 + hh] = rho;
    }
}
DI void norm_row_task(const Params& p, int l, int task) {
  const int lane = TIDX() & 63, wave = TIDX() >> 6;
  const int row = task * 4 + wave;
  const float* CQ = (const float*)(p.ws + W_CQ); const float* CKV = (const float*)(p.ws + W_CKV); const float* KR = (const float*)(p.ws + W_KR);
  u16* QN = (u16*)(p.ws + W_QN); u16* CKVN = (u16*)(p.ws + W_CKVN); u16* KF = (u16*)(p.ws + W_KF);
  const int keyrow = keyrow_of(row);
  {
    float v[6], ss = 0.f;
#pragma unroll
    for (int j = 0; j < 6; j++) { v[j] = CQ[(size_t)row * 384 + j * 64 + lane]; ss += v[j] * v[j]; }
    ss = red64(ss); float rstd = rsqrtf(ss * (1.f / 384.f) + RMS_EPS);
#pragma unroll
    for (int j = 0; j < 6; j++) QN[(size_t)row * 384 + j * 64 + lane] = f2bf(v[j] * rstd * p.in[25][l * 384 + j * 64 + lane]);
  }
  {
    float4 v = *(const float4*)(CKV + (size_t)row * 256 + lane * 4);
    float ss = red64(v.x * v.x + v.y * v.y + v.z * v.z + v.w * v.w);
    float rstd = rsqrtf(ss * (1.f / 256.f) + RMS_EPS);
    float4 g = *(const float4*)(p.in[27] + l * 256 + lane * 4);
    float4 o = make_float4(v.x * rstd * g.x, v.y * rstd * g.y, v.z * rstd * g.z, v.w * rstd * g.w);
    size_t oo = row < NP ? O_CKV_P + ((size_t)l * NP + row) * 256 : O_CKV_S + ((size_t)l * NS + (row - NP)) * 256;
    *(float4*)(p.out + oo + lane * 4) = o;
    uint2 ob; ob.x = pk2(o.x, o.y); ob.y = pk2(o.z, o.w);
    *(uint2*)(CKVN + (size_t)keyrow * 256 + lane * 4) = ob;
  }
  {
    float x = lane < 32 ? KR[(size_t)row * 32 + lane] : 0.f;
    float ss = red64(x * x); float rstd = rsqrtf(ss * (1.f / 32.f) + RMS_EPS);
    float xn = x * rstd * p.in[32][l * 32 + (lane & 31)];
    float pt = __shfl_xor(xn, 16);
    const float* rp = (const float*)(p.ws + W_ROPE) + pos_of(row) * 32;
    float cs = rp[lane & 15], sn = rp[16 + (lane & 15)];
    float o = (lane & 16) ? (pt * sn + xn * cs) : (xn * cs - pt * sn);
    if (lane < 32) {
      size_t oo = row < NP ? O_KROPE_P + ((size_t)l * NP + row) * 32 : O_KROPE_S + ((size_t)l * NS + (row - NP)) * 32;
      p.out[oo + lane] = o;
      u16 ob = f2bf(o);
#pragma unroll
      for (int hd = 0; hd < 8; hd++) KF[(size_t)keyrow * 768 + hd * 96 + 64 + lane] = ob;
    }
  }
}
DI void past_convert_task(const Params& p, int l, int task) {
  const int tid = TIDX();
  if (task < 2048) {
    size_t e = ((size_t)task * 256 + tid) * 8; int rowp = (int)(e >> 8), c = (int)(e & 255); int b = rowp >> 11, s = rowp & 2047;
    const float* src = p.in[4] + ((size_t)(l * 8 + b) * PAST + s) * 256 + c;
    float4 a = *(const float4*)src, bq = *(const float4*)(src + 4);
    uint4 o; o.x = pk2(a.x, a.y); o.y = pk2(a.z, a.w); o.z = pk2(bq.x, bq.y); o.w = pk2(bq.z, bq.w);
    *(uint4*)((u16*)(p.ws + W_CKVN) + (size_t)(NP + b * SK + s) * 256 + c) = o; return;
  }
  task -= 2048;
  if (task < 4096) {
    size_t e = ((size_t)task * 256 + tid) * 8; int rowp = (int)(e >> 9), c = (int)(e & 511); int b = rowp >> 11, s = rowp & 2047;
    const float* src = p.in[6] + ((size_t)(l * 8 + b) * PAST + s) * 512 + c;
    float4 a = *(const float4*)src, bq = *(const float4*)(src + 4);
    uint4 o; o.x = pk2(a.x, a.y); o.y = pk2(a.z, a.w); o.z = pk2(bq.x, bq.y); o.w = pk2(bq.z, bq.w);
    *(uint4*)((u16*)(p.ws + W_SBK) + (size_t)(NP + b * SK + s) * 512 + c) = o; return;
  }
  task -= 4096;
  if (task < 4096) {
    int id = task * 256 + tid; int c = id & 511, sg = (id >> 9) & 255, b = id >> 17;
    const float* src = p.in[7] + ((size_t)(l * 8 + b) * PAST + sg * 8) * 512 + c;
    float v[8];
#pragma unroll
    for (int j = 0; j < 8; j++) v[j] = src[(size_t)j * 512];
    uint4 o; o.x = pk2(v[0], v[1]); o.y = pk2(v[2], v[3]); o.z = pk2(v[4], v[5]); o.w = pk2(v[6], v[7]);
    *(uint4*)((u16*)(p.ws + W_SBVT) + VT_S_OFF + ((size_t)((b * 8 + (c >> 6)) * 64 + (c & 63))) * SK + sg * 8) = o; return;
  }
  task -= 4096;
  {
    int id = task * 256 + tid; int ch = id & 7, rowp = id >> 3; int b = rowp >> 11, s = rowp & 2047;
    float4 a = *(const float4*)(p.in[5] + ((size_t)(l * 8 + b) * PAST + s) * 32 + ch * 4);
    uint2 o; o.x = pk2(a.x, a.y); o.y = pk2(a.z, a.w);
    u16* dst = (u16*)(p.ws + W_KF) + (size_t)(NP + b * SK + s) * 768 + 64 + ch * 4;
#pragma unroll
    for (int hd = 0; hd < 8; hd++) *(uint2*)(dst + hd * 96) = o;
  }
}
DI void phase3(const Params& p, int l) {
  const int nA = 1032, nB = NT / 4, nC = 2048 + 4096 + 4096 + 512, total = nA + nB + nC;
  for (int t = blockIdx.x; t < total; t += gridDim.x) {
    if (t < nA) rwkv_prep_task(p, l, t);
    else if (t < nA + nB) norm_row_task(p, l, t - nA);
    else past_convert_task(p, l, t - nA - nB);
  }
}

DI void rwkv_pass1_task(const Params& p, int bh, int seg, int rq, unsigned char* smem);
DI void phase4(const Params& p, int l, unsigned char* smem) {
  const int lane = TIDX() & 63, wave = TIDX() >> 6, wm = wave >> 1, wn = wave & 1, r = lane & 31, hl = lane >> 5;
  const float* rope = (const float*)(p.ws + W_ROPE);
  u16* QF = (u16*)(p.ws + W_QF); u16* KF = (u16*)(p.ws + W_KF); u16* VT = (u16*)(p.ws + W_MLAVT);
  const int nQ = 129 * 6, nKV = 257 * 8;
  __shared__ int s_task4;
  int* ctr4 = (int*)(p.ws + W_CTR) + 8 + l;
  while (true) {
    __syncthreads();
    if (TIDX() == 0) s_task4 = atomicAdd(ctr4, 1);
    __syncthreads();
    const int q4 = s_task4;
    if (q4 >= 448 + nQ + nKV) break;
    const int t0 = q4 < 896 ? ((q4 & 1) ? 448 + (q4 >> 1) : (q4 >> 1)) : q4;
    if (t0 < 448) { int bh = t0 / 28, rem = t0 - bh * 28; rwkv_pass1_task(p, bh, rem >> 2, rem & 3, smem); continue; }
    const int t = t0 - 448;
    f32x16 acc[2][2]; zero_acc(acc);
    if (t < nQ) {
      const int mt = t % 129, nt = t / 129, m0 = mt * 128;
      gemm_mainloop(acc, (const u16*)(p.ws + W_QN) + (size_t)m0 * 384, 384, (const u16*)(p.ws + W_WUQT) + ((size_t)l * 768 + nt * 128) * 384, 384, 384, smem);
      if (nt < 4) {
        const int head = nt * 2 + wn;
        float g0 = p.in[29][l * 64 + r] * QSCALE_MLA, g1 = p.in[29][l * 64 + 32 + r] * QSCALE_MLA;
#pragma unroll
        for (int bm = 0; bm < 2; bm++)
#pragma unroll
          for (int i = 0; i < 16; i++) {
            float a = acc[bm][0][i], b = acc[bm][1][i];
            float ss = red32(a * a + b * b); float rstd = rsqrtf(ss * (1.f / 64.f) + RMS_EPS);
            int row = m0 + wm * 64 + bm * 32 + crow(i, hl);
            u16* q = QF + (size_t)row * 768 + head * 96;
            q[r] = f2bf(a * rstd * g0); q[32 + r] = f2bf(b * rstd * g1);
          }
      } else {
        float g = p.in[30][l * 32 + r] * QSCALE_MLA;
#pragma unroll
        for (int bm = 0; bm < 2; bm++)
#pragma unroll
          for (int bn = 0; bn < 2; bn++)
#pragma unroll
            for (int i = 0; i < 16; i++) {
              const int head = (nt - 4) * 4 + wn * 2 + bn;
              float a = acc[bm][bn][i];
              float ss = red32(a * a); float rstd = rsqrtf(ss * (1.f / 32.f) + RMS_EPS);
              float xn = a * rstd * g; float pt = __shfl_xor(xn, 16);
              int row = m0 + wm * 64 + bm * 32 + crow(i, hl);
              const float* rp = rope + pos_of(row) * 32;
              float cs = rp[r & 15], sn = rp[16 + (r & 15)];
              float o = (r & 16) ? (pt * sn + xn * cs) : (xn * cs - pt * sn);
              QF[(size_t)row * 768 + head * 96 + 64 + r] = f2bf(o);
            }
      }
    } else {
      const int q = t - nQ, mt = q % 257, head = q / 257, m0 = mt * 128;
      gemm_mainloop(acc, (const u16*)(p.ws + W_CKVN) + (size_t)m0 * 256, 256, (const u16*)(p.ws + W_WUKVT) + ((size_t)l * 1024 + head * 128) * 256, 256, 256, smem);
      if (wn == 0) {
        float g0 = p.in[31][l * 64 + r], g1 = p.in[31][l * 64 + 32 + r];
#pragma unroll
        for (int bm = 0; bm < 2; bm++)
#pragma unroll
          for (int i = 0; i < 16; i++) {
            float a = acc[bm][0][i], b = acc[bm][1][i];
            float ss = red32(a * a + b * b); float rstd = rsqrtf(ss * (1.f / 64.f) + RMS_EPS);
            int krow = m0 + wm * 64 + bm * 32 + crow(i, hl);
            u16* k = KF + (size_t)krow * 768 + head * 96;
            k[r] = f2bf(a * rstd * g0); k[32 + r] = f2bf(b * rstd * g1);
          }
      } else {
#pragma unroll
        for (int bm = 0; bm < 2; bm++)
#pragma unroll
          for (int bn = 0; bn < 2; bn++)
#pragma unroll
            for (int g4 = 0; g4 < 4; g4++) {
              int krow = m0 + wm * 64 + bm * 32 + 8 * g4 + 4 * hl, d = bn * 32 + r;
              uint2 o; o.x = pk2(acc[bm][bn][4 * g4], acc[bm][bn][4 * g4 + 1]); o.y = pk2(acc[bm][bn][4 * g4 + 2], acc[bm][bn][4 * g4 + 3]);
              *(uint2*)(VT + vt_off(krow, head, d)) = o;
            }
      }
    }
  }
}

template <int DK, bool SB>
DI void attn_task(const u16* __restrict__ Qp, int qstride, int nq_valid, const u16* __restrict__ Kp, int kstride,
                  const u16* __restrict__ Vtp, int vstride, int nkeys, int qpos0,
                  const u16* __restrict__ Zp, u16* __restrict__ Yp, unsigned char* smem) {
  constexpr int KS = DK / 16, KSTR = DK + 8, KCH = DK / 8, NKL = 64 * KCH / 256;
  u16* sK = (u16*)smem; u16* sV = sK + 64 * KSTR;
  const int tid = TIDX(), lane = tid & 63, wave = tid >> 6, r = lane & 31, hl = lane >> 5;
  const int slot = wave * 32 + r;
  const bool wave_active = wave * 32 < nq_valid;
  const int qpos = qpos0 + slot;
  bf16x8 qf[KS];
  {
    const u16* qrow = Qp + (size_t)(slot < nq_valid ? slot : 0) * qstride + hl * 8;
#pragma unroll
    for (int ks = 0; ks < KS; ks++) qf[ks] = *(const bf16x8*)(qrow + ks * 16);
  }
  f32x16 O[2];
#pragma unroll
  for (int b = 0; b < 2; b++)
#pragma unroll
    for (int i = 0; i < 16; i++) O[b][i] = 0.f;
  float m_run = -1e30f, l_run = 0.f, R = 1.f;
  const int last_qpos = qpos0 + nq_valid - 1;
  int ntiles = SB ? (last_qpos - 1) / 64 + 1 : last_qpos / 64 + 1;
  { int mx = (nkeys + 63) >> 6; if (ntiles > mx) ntiles = mx; }
  const int wave_q0 = qpos0 + wave * 32;
  u32x4 rk[NKL], rv[2];
  auto prefetch = [&](int kt) {
#pragma unroll
    for (int i = 0; i < NKL; i++) { int c = tid + 256 * i; int row = c / KCH, ch = c - row * KCH; rk[i] = *(const u32x4*)(Kp + (size_t)(kt * 64 + row) * kstride + ch * 8); }
#pragma unroll
    for (int i = 0; i < 2; i++) { int c = tid + 256 * i; int row = c >> 3, ch = c & 7; rv[i] = *(const u32x4*)(Vtp + (size_t)row * vstride + kt * 64 + ch * 8); }
  };
  prefetch(SB ? ntiles - 1 : 0);
  for (int it = 0; it < ntiles; it++) {
    const int kt = SB ? ntiles - 1 - it : it;
    __syncthreads();
#pragma unroll
    for (int i = 0; i < NKL; i++) { int c = tid + 256 * i; int row = c / KCH, ch = c - row * KCH; *(u32x4*)(sK + row * KSTR + ch * 8) = rk[i]; }
#pragma unroll
    for (int i = 0; i < 2; i++) { int c = tid + 256 * i; int row = c >> 3, ch = c & 7; *(u32x4*)(sV + row * 72 + ch * 8) = rv[i]; }
    __syncthreads();
    { int nx = SB ? kt - 1 : kt + 1; if (it + 1 >= ntiles) nx = kt; prefetch(nx); }
    bool doit;
    if (SB) doit = wave_active && (kt * 64 < wave_q0 + 31);
    else doit = wave_active && (kt <= (wave_q0 >> 6));
    if (doit) {
    f32x16 S[2];
#pragma unroll
    for (int kb = 0; kb < 2; kb++) {
#pragma unroll
      for (int i = 0; i < 16; i++) S[kb][i] = 0.f;
#pragma unroll
      for (int ks = 0; ks < KS; ks++) {
        bf16x8 kf = *(const bf16x8*)(sK + (kb * 32 + r) * KSTR + ks * 16 + hl * 8);
        S[kb] = MFMA32(kf, qf[ks], S[kb]);
      }
    }
    const int key0 = kt * 64 + 4 * hl;
    if (!SB) {
      const bool need_mask = (kt + 1) * 64 > nkeys;
      if (need_mask) {
#pragma unroll
        for (int kb = 0; kb < 2; kb++)
#pragma unroll
          for (int i = 0; i < 16; i++) { int key = key0 + kb * 32 + (i & 3) + 8 * (i >> 2); if (key >= nkeys) S[kb][i] = -1e30f; }
      }
      float tmax = -1e30f;
#pragma unroll
      for (int kb = 0; kb < 2; kb++)
#pragma unroll
        for (int i = 0; i < 16; i++) tmax = fmaxf(tmax, S[kb][i]);
      tmax = fmaxf(tmax, __shfl_xor(tmax, 32));
      float m_new = fmaxf(m_run, tmax);
      float alpha = ex2(m_run - m_new);
      m_run = m_new;
      float ps = 0.f;
#pragma unroll
      for (int kb = 0; kb < 2; kb++)
#pragma unroll
        for (int i = 0; i < 16; i++) { float pv = ex2(S[kb][i] - m_new); S[kb][i] = pv; ps += pv; }
      l_run = l_run * alpha + ps;
#pragma unroll
      for (int b = 0; b < 2; b++)
#pragma unroll
        for (int i = 0; i < 16; i++) O[b][i] *= alpha;
    } else {
      const bool need_mask = (kt * 64 + 63 >= wave_q0) || ((kt + 1) * 64 > nkeys);
#pragma unroll
      for (int kb = 0; kb < 2; kb++)
#pragma unroll
        for (int i = 0; i < 16; i++) {
          float d = __builtin_amdgcn_rcpf(1.f + ex2(S[kb][i]));
          if (need_mask) { int key = key0 + kb * 32 + (i & 3) + 8 * (i >> 2); if (!(key < nkeys && key < qpos)) d = 1.f; }
          S[kb][i] = d;
        }
      float gs[8], pg[8], sa[8];
#pragma unroll
      for (int o = 0; o < 8; o++) { int kb = o >> 2, g = o & 3; gs[o] = (S[kb][4 * g] * S[kb][4 * g + 1]) * (S[kb][4 * g + 2] * S[kb][4 * g + 3]); }
#pragma unroll
      for (int o = 0; o < 8; o++) pg[o] = __shfl_xor(gs[o], 32);
      sa[7] = R;
#pragma unroll
      for (int o = 6; o >= 0; o--) sa[o] = sa[o + 1] * (gs[o + 1] * pg[o + 1]);
      const float total = sa[0] * (gs[0] * pg[0]);
#pragma unroll
      for (int o = 0; o < 8; o++) {
        int kb = o >> 2, g = o & 3;
        float c = hl == 0 ? sa[o] * pg[o] : sa[o];
#pragma unroll
        for (int e = 3; e >= 0; e--) {
          float d = S[kb][4 * g + e];
          S[kb][4 * g + e] = c - d * c;
          c *= d;
        }
      }
      R = total;
    }
#pragma unroll
    for (int kb = 0; kb < 2; kb++)
#pragma unroll
      for (int s2 = 0; s2 < 2; s2++) {
        uint4 u;
        u.x = pk2(S[kb][8 * s2], S[kb][8 * s2 + 1]); u.y = pk2(S[kb][8 * s2 + 2], S[kb][8 * s2 + 3]);
        u.z = pk2(S[kb][8 * s2 + 4], S[kb][8 * s2 + 5]); u.w = pk2(S[kb][8 * s2 + 6], S[kb][8 * s2 + 7]);
        bf16x8 pf = __builtin_bit_cast(bf16x8, u);
#pragma unroll
        for (int bd = 0; bd < 2; bd++) {
          const u16* vp = sV + (bd * 32 + r) * 72 + kb * 32 + s2 * 16 + hl * 4;
          uint2 lo = *(const uint2*)vp, hi = *(const uint2*)(vp + 8);
          uint4 vv; vv.x = lo.x; vv.y = lo.y; vv.z = hi.x; vv.w = hi.y;
          O[bd] = MFMA32(__builtin_bit_cast(bf16x8, vv), pf, O[bd]);
        }
      }
    }
    if (SB) {
      const bool lane_done = !wave_active || slot >= nq_valid || R < 1e-30f;
      const int wdone = __all(lane_done);
      if (__syncthreads_and(wdone)) break;
    }
  }
  if (wave_active && slot < nq_valid) {
    float sc = 1.f;
    if (!SB) { float lt = l_run + __shfl_xor(l_run, 32); sc = 1.f / lt; }
#pragma unroll
    for (int bd = 0; bd < 2; bd++)
#pragma unroll
      for (int g = 0; g < 4; g++) {
        int d0 = bd * 32 + 8 * g + 4 * hl;
        uint2 zz = *(const uint2*)(Zp + (size_t)slot * 512 + d0);
        uint2 o;
        o.x = pk2(O[bd][4 * g] * sc * bflo(zz.x), O[bd][4 * g + 1] * sc * bfhi(zz.x));
        o.y = pk2(O[bd][4 * g + 2] * sc * bflo(zz.y), O[bd][4 * g + 3] * sc * bfhi(zz.y));
        *(uint2*)(Yp + (size_t)slot * 512 + d0) = o;
      }
  }
}

template <int CTRL> DI float dpp_add(float x) {
  return x + __int_as_float(__builtin_amdgcn_update_dpp(0, __float_as_int(x), CTRL, 0xF, 0xF, true));
}
DI void allreduce16x2(float& a, float& b) {
  a = dpp_add<0xB1>(a); b = dpp_add<0xB1>(b); a = dpp_add<0x4E>(a); b = dpp_add<0x4E>(b);
  a = dpp_add<0x141>(a); b = dpp_add<0x141>(b); a = dpp_add<0x140>(a); b = dpp_add<0x140>(b);
}
#define SCAN_PREFETCH(slot, cc) { int c_ = (cc) < nch ? (cc) : nch - 1; size_t row = (size_t)(srow0 + c_ * 16 + lstep); \
    pw[slot] = *(const f32x4v*)(RWW + row * 512 + h * 64 + lpart); \
    _Pragma("unroll") for (int c = 0; c < 5; c++) px[slot][c] = *(const u32x2*)(RWX + row * 2560 + c * 512 + h * 64 + lpart); }
#define SCAN_STAGE(slot, bsel) { float* o = ops + ((bsel) * 16 + lstep) * 384 + lpart; \
    f32x4v r4 = {bflo(px[slot][0].x), bfhi(px[slot][0].x), bflo(px[slot][0].y), bfhi(px[slot][0].y)}; \
    f32x4v k4 = {bflo(px[slot][1].x), bfhi(px[slot][1].x), bflo(px[slot][1].y), bfhi(px[slot][1].y)}; \
    f32x4v v4 = {bflo(px[slot][2].x), bfhi(px[slot][2].x), bflo(px[slot][2].y), bfhi(px[slot][2].y)}; \
    f32x4v kk4 = {bflo(px[slot][3].x), bfhi(px[slot][3].x), bflo(px[slot][3].y), bfhi(px[slot][3].y)}; \
    f32x4v b4 = {bflo(px[slot][4].x), bfhi(px[slot][4].x), bflo(px[slot][4].y), bfhi(px[slot][4].y)}; \
    *(f32x4v*)(o) = pw[slot]; *(f32x4v*)(o + 64) = pw[slot] * r4; *(f32x4v*)(o + 128) = k4; *(f32x4v*)(o + 192) = v4; *(f32x4v*)(o + 256) = kk4; *(f32x4v*)(o + 320) = b4; \
    float br = b4.x * r4.x + b4.y * r4.y + b4.z * r4.z + b4.w * r4.w; \
    float kr = k4.x * r4.x + k4.y * r4.y + k4.z * r4.z + k4.w * r4.w; \
    allreduce16x2(br, kr); \
    if ((tid & 15) == 0) { sc[((bsel) * 16 + lstep) * 2] = br; sc[((bsel) * 16 + lstep) * 2 + 1] = kr; } }

DI void rwkv_pass1_task(const Params& p, int bh, int seg, int rq, unsigned char* smem) {
  float* ops = (float*)smem; float* sc = ops + 2 * 16 * 384;
  const int tid = TIDX(), i = tid >> 4, cg = tid & 15, cg4 = cg * 4;
  const int Rr = rq * 16 + i, h = bh & 7;
  const int srow0 = (bh >> 3) * TP + seg * 1024;
  const float* RWW = (const float*)(p.ws + W_RWW); const u16* RWX = (const u16*)(p.ws + W_RWX);
  float SL[4] = {0.f, 0.f, 0.f, 0.f}, SP[4];
#pragma unroll
  for (int e = 0; e < 4; e++) SP[e] = (cg4 + e == Rr) ? 1.f : 0.f;
  const int lstep = tid >> 4, lpart = (tid & 15) * 4;
  f32x4v pw[4]; u32x2 px[4][5];
  const int nch = 64;
  SCAN_PREFETCH(0, 0) SCAN_PREFETCH(1, 1) SCAN_PREFETCH(2, 2) SCAN_PREFETCH(3, 3)
  __syncthreads();
  SCAN_STAGE(0, 0)
  __syncthreads();
  __builtin_amdgcn_s_setprio(3);
  for (int cb = 0; cb < nch; cb += 4) {
#pragma unroll
    for (int k = 0; k < 4; k++) {
      const int c0 = cb + k;
      const int bsel = k & 1;
      SCAN_PREFETCH(k, c0 + 4)
#pragma unroll
      for (int st = 0; st < 16; st++) {
        const float* o = ops + (bsel * 16 + st) * 384;
        f32x4v w = *(const f32x4v*)(o + cg4), kp = *(const f32x4v*)(o + 128 + cg4);
        f32x4v kkv = *(const f32x4v*)(o + 256 + cg4), bb = *(const f32x4v*)(o + 320 + cg4);
        float v = o[192 + Rr];
        float d1 = SL[0] * kkv.x + SL[1] * kkv.y + SL[2] * kkv.z + SL[3] * kkv.w;
        float d2 = SP[0] * kkv.x + SP[1] * kkv.y + SP[2] * kkv.z + SP[3] * kkv.w;
        allreduce16x2(d1, d2);
        const float saL = -d1, saP = -d2;
        SL[0] = SL[0] * w.x + (saL * bb.x + v * kp.x); SP[0] = SP[0] * w.x + saP * bb.x;
        SL[1] = SL[1] * w.y + (saL * bb.y + v * kp.y); SP[1] = SP[1] * w.y + saP * bb.y;
        SL[2] = SL[2] * w.z + (saL * bb.z + v * kp.z); SP[2] = SP[2] * w.z + saP * bb.z;
        SL[3] = SL[3] * w.w + (saL * bb.w + v * kp.w); SP[3] = SP[3] * w.w + saP * bb.w;
      }
      SCAN_STAGE(((k + 1) & 3), (bsel ^ 1))
      __syncthreads();
    }
  }
  __builtin_amdgcn_s_setprio(0);
  const size_t so = ((size_t)(bh * 7 + seg)) * 4096 + Rr * 64 + cg4;
  *(float4*)((float*)(p.ws + W_SLOC) + so) = make_float4(SL[0], SL[1], SL[2], SL[3]);
  *(float4*)((float*)(p.ws + W_PMAT) + so) = make_float4(SP[0], SP[1], SP[2], SP[3]);
}

DI void allreduce16x4(float& a, float& b, float& c, float& d) {
  a = dpp_add<0xB1>(a); b = dpp_add<0xB1>(b); c = dpp_add<0xB1>(c); d = dpp_add<0xB1>(d);
  a = dpp_add<0x4E>(a); b = dpp_add<0x4E>(b); c = dpp_add<0x4E>(c); d = dpp_add<0x4E>(d);
  a = dpp_add<0x141>(a); b = dpp_add<0x141>(b); c = dpp_add<0x141>(c); d = dpp_add<0x141>(d);
  a = dpp_add<0x140>(a); b = dpp_add<0x140>(b); c = dpp_add<0x140>(c); d = dpp_add<0x140>(d);
}
DI void rwkv_scan_task(const Params& p, int srow0, int T, int h, int rq, const float* S0, float* Sout, int comb_bh, int comb_seg, unsigned char* smem) {
  if (rq & 1) return;
  float* ops = (float*)smem;
  float* sc = ops + 2 * 16 * 384;
  float* ybuf = sc + 64;
  const int tid = TIDX(), i = tid >> 4, cg = tid & 15, cg4 = cg * 4;
  const float* RWW = (const float*)(p.ws + W_RWW); const u16* RWX = (const u16*)(p.ws + W_RWX); float* YRAW = (float*)(p.ws + W_YRAW);
  float S[2][4];
#pragma unroll
  for (int g = 0; g < 2; g++) {
    const int Rr = (rq + g) * 16 + i;
    if (S0) { float4 s = *(const float4*)(S0 + Rr * 64 + cg4); S[g][0] = s.x; S[g][1] = s.y; S[g][2] = s.z; S[g][3] = s.w; }
    else { S[g][0] = S[g][1] = S[g][2] = S[g][3] = 0.f; }
  }
  if (comb_bh >= 0 && comb_seg > 0) {
    const float* SLOC = (const float*)(p.ws + W_SLOC) + (size_t)comb_bh * 7 * 4096;
    const float* PMAT = (const float*)(p.ws + W_PMAT) + (size_t)comb_bh * 7 * 4096;
    float* srow = ops;
#pragma unroll
    for (int g = 0; g < 2; g++) { float4 s = *(const float4*)(SLOC + ((rq + g) * 16 + i) * 64 + cg4); S[g][0] = s.x; S[g][1] = s.y; S[g][2] = s.z; S[g][3] = s.w; }
    for (int sp = 1; sp < comb_seg; sp++) {
      __syncthreads();
#pragma unroll
      for (int g = 0; g < 2; g++) *(float4*)(srow + (g * 16 + i) * 64 + cg4) = make_float4(S[g][0], S[g][1], S[g][2], S[g][3]);
      __syncthreads();
      float4 a0 = *(const float4*)(SLOC + (size_t)sp * 4096 + (rq * 16 + i) * 64 + cg4);
      float4 a1 = *(const float4*)(SLOC + (size_t)sp * 4096 + (rq * 16 + 16 + i) * 64 + cg4);
      const float* P = PMAT + (size_t)sp * 4096 + cg4;
#pragma unroll 8
      for (int k = 0; k < 64; k++) {
        float s0 = srow[i * 64 + k], s1 = srow[(16 + i) * 64 + k]; float4 pv = *(const float4*)(P + k * 64);
        a0.x += s0 * pv.x; a0.y += s0 * pv.y; a0.z += s0 * pv.z; a0.w += s0 * pv.w;
        a1.x += s1 * pv.x; a1.y += s1 * pv.y; a1.z += s1 * pv.z; a1.w += s1 * pv.w;
      }
      S[0][0] = a0.x; S[0][1] = a0.y; S[0][2] = a0.z; S[0][3] = a0.w;
      S[1][0] = a1.x; S[1][1] = a1.y; S[1][2] = a1.z; S[1][3] = a1.w;
    }
  }
  const int lstep = tid >> 4, lpart = (tid & 15) * 4;
  f32x4v pw[2]; u32x2 px[2][5];
  const int nch = T >> 4;
  SCAN_PREFETCH(0, 0) SCAN_PREFETCH(1, 1)
  __syncthreads();
  SCAN_STAGE(0, 0)
  __syncthreads();
  __builtin_amdgcn_s_setprio(3);
  for (int cb = 0; cb < nch; cb += 4) {
#pragma unroll
    for (int k = 0; k < 4; k++) {
      const int c0 = cb + k;
      if (c0 < nch) {
        const int bsel = k & 1;
        SCAN_PREFETCH((k & 1), c0 + 2)
        float yk0 = 0.f, yk1 = 0.f;
#pragma unroll 8
        for (int st = 0; st < 16; st++) {
          const float* o = ops + (bsel * 16 + st) * 384;
          f32x4v w = *(const f32x4v*)(o + cg4), wr = *(const f32x4v*)(o + 64 + cg4), kp = *(const f32x4v*)(o + 128 + cg4);
          f32x4v kkv = *(const f32x4v*)(o + 256 + cg4), bb = *(const f32x4v*)(o + 320 + cg4);
          float v0 = o[192 + rq * 16 + i], v1 = o[192 + rq * 16 + 16 + i];
          float br = sc[(bsel * 16 + st) * 2], kr = sc[(bsel * 16 + st) * 2 + 1];
          float da0 = S[0][0] * kkv.x + S[0][1] * kkv.y + S[0][2] * kkv.z + S[0][3] * kkv.w;
          float dy0 = S[0][0] * wr.x + S[0][1] * wr.y + S[0][2] * wr.z + S[0][3] * wr.w;
          float da1 = S[1][0] * kkv.x + S[1][1] * kkv.y + S[1][2] * kkv.z + S[1][3] * kkv.w;
          float dy1 = S[1][0] * wr.x + S[1][1] * wr.y + S[1][2] * wr.z + S[1][3] * wr.w;
          allreduce16x4(da0, dy0, da1, dy1);
          S[0][0] = S[0][0] * w.x + (v0 * kp.x - da0 * bb.x); S[1][0] = S[1][0] * w.x + (v1 * kp.x - da1 * bb.x);
          S[0][1] = S[0][1] * w.y + (v0 * kp.y - da0 * bb.y); S[1][1] = S[1][1] * w.y + (v1 * kp.y - da1 * bb.y);
          S[0][2] = S[0][2] * w.z + (v0 * kp.z - da0 * bb.z); S[1][2] = S[1][2] * w.z + (v1 * kp.z - da1 * bb.z);
          S[0][3] = S[0][3] * w.w + (v0 * kp.w - da0 * bb.w); S[1][3] = S[1][3] * w.w + (v1 * kp.w - da1 * bb.w);
          float y0 = dy0 - da0 * br + v0 * kr, y1 = dy1 - da1 * br + v1 * kr;
          yk0 = (cg == st) ? y0 : yk0; yk1 = (cg == st) ? y1 : yk1;
        }
        ybuf[bsel * 512 + cg * 16 + i] = yk0; ybuf[bsel * 512 + 256 + cg * 16 + i] = yk1;
        SCAN_STAGE(((k + 1) & 1), (bsel ^ 1))
        __syncthreads();
        {
          float* yo = YRAW + (size_t)(srow0 + c0 * 16 + (tid >> 4)) * 512 + h * 64 + rq * 16 + (tid & 15);
          yo[0] = ybuf[bsel * 512 + tid]; yo[16] = ybuf[bsel * 512 + 256 + tid];
        }
      }
    }
  }
  __builtin_amdgcn_s_setprio(0);
  if (Sout) {
#pragma unroll
    for (int g = 0; g < 2; g++) *(float4*)(Sout + ((rq + g) * 16 + i) * 64 + cg4) = make_float4(S[g][0], S[g][1], S[g][2], S[g][3]);
  }
}
constexpr int PH5_TASKS = 512 + 128 + 2048 + 256;
DI void phase5_task(const Params& p, int l, int task, unsigned char* smem) {
  const u16* Z = (const u16*)(p.ws + W_Z); u16* YG = (u16*)(p.ws + W_YG);
  if (task < 512) {
    int bh = task >> 5, seg = 7 - ((task >> 2) & 7), rq = task & 3, b = bh >> 3, h = bh & 7;
    rwkv_scan_task(p, b * TP + seg * 1024, 1024, h, rq, nullptr, seg == 7 ? p.out + O_WKV_P + ((size_t)((l * 2 + b) * 8 + h)) * 4096 : nullptr, bh, seg, smem);
    return;
  }
  task -= 448;
  if (task < 2240) {
    int which, b, h, row0, nq, qpos0, kbase, nkeys; size_t vto; int vstr;
    if (task < 192) { int j = task - 64; which = j >> 6; int bh = j & 63; b = bh >> 3; h = bh & 7; row0 = NP + b * 16; nq = 16; qpos0 = PAST; kbase = NP + b * SK; nkeys = SK; vto = VT_S_OFF + (size_t)((b * 8 + h) * 64) * SK; vstr = SK; }
    else { int j = task - 192; int qb = 63 - (j >> 5); which = (j >> 4) & 1; int bh = j & 15; b = bh >> 3; h = bh & 7; row0 = b * TP + qb * 128; nq = 128; qpos0 = qb * 128; kbase = b * TP; nkeys = TP; vto = (size_t)((b * 8 + h) * 64) * 8192; vstr = 8192; }
    if (which == 0)
      attn_task<64, true>((const u16*)(p.ws + W_SQ) + (size_t)row0 * 512 + h * 64, 512, nq, (const u16*)(p.ws + W_SBK) + (size_t)kbase * 512 + h * 64, 512,
                          (const u16*)(p.ws + W_SBVT) + vto, vstr, nkeys, qpos0, Z + ((size_t)2 * NT + row0) * 512 + h * 64, YG + ((size_t)2 * NT + row0) * 512 + h * 64, smem);
    else
      attn_task<96, false>((const u16*)(p.ws + W_QF) + (size_t)row0 * 768 + h * 96, 768, nq, (const u16*)(p.ws + W_KF) + (size_t)kbase * 768 + h * 96, 768,
                           (const u16*)(p.ws + W_MLAVT) + vto, vstr, nkeys, qpos0, Z + ((size_t)1 * NT + row0) * 512 + h * 64, YG + ((size_t)1 * NT + row0) * 512 + h * 64, smem);
    return;
  }
  {
    int j = task - 2240; int bh = j >> 2, rq = j & 3, b = bh >> 3, h = bh & 7;
    size_t so = ((size_t)((l * 8 + b) * 8 + h)) * 4096;
    rwkv_scan_task(p, NP + b * 16, 16, h, rq, p.in[2] + so, p.out + O_WKV_S + so, -1, 0, smem);
  }
}
DI void phase5(const Params& p, int l, unsigned char* smem) {
  __shared__ int s_task;
  int* ctr = (int*)(p.ws + W_CTR) + l;
  while (true) {
    __syncthreads();
    if (TIDX() == 0) s_task = atomicAdd(ctr, 1);
    __syncthreads();
    int q = s_task;
    if (q >= PH5_TASKS) break;
    int task = q < 1024 ? ((q & 1) ? 512 + (q >> 1) : (q >> 1)) : q;
    phase5_task(p, l, task, smem);
  }
}
DI void phase5b(const Params& p, int l) {
  const int lane = TIDX() & 63, wave = TIDX() >> 6;
  const float* YRAW = (const float*)(p.ws + W_YRAW); const u16* RWX = (const u16*)(p.ws + W_RWX); const float* RHO = (const float*)(p.ws + W_RHO);
  const u16* Z = (const u16*)(p.ws + W_Z); u16* YG = (u16*)(p.ws + W_YG);
  for (int task = blockIdx.x; task < NT / 4; task += gridDim.x) {
    const int row = task * 4 + wave, c0 = lane * 8;
    float y[8];
    { float4 a = *(const float4*)(YRAW + (size_t)row * 512 + c0), b = *(const float4*)(YRAW + (size_t)row * 512 + c0 + 4);
      y[0] = a.x; y[1] = a.y; y[2] = a.z; y[3] = a.w; y[4] = b.x; y[5] = b.y; y[6] = b.z; y[7] = b.w; }
    float s = 0.f;
#pragma unroll
    for (int j = 0; j < 8; j++) s += y[j];
    s += __shfl_xor(s, 1); s += __shfl_xor(s, 2); s += __shfl_xor(s, 4);
    float mu = s * (1.f / 64.f), vs = 0.f;
#pragma unroll
    for (int j = 0; j < 8; j++) { float d = y[j] - mu; vs += d * d; }
    vs += __shfl_xor(vs, 1); vs += __shfl_xor(vs, 2); vs += __shfl_xor(vs, 4);
    float rstd = rsqrtf(vs * (1.f / 64.f) + GN_EPS);
    float rho = RHO[(size_t)row * 8 + (lane >> 3)];
    uint4 vv = *(const uint4*)(RWX + (size_t)row * 2560 + 1024 + c0);
    uint4 zz = *(const uint4*)(Z + (size_t)row * 512 + c0);
    float vf[8] = {bflo(vv.x), bfhi(vv.x), bflo(vv.y), bfhi(vv.y), bflo(vv.z), bfhi(vv.z), bflo(vv.w), bfhi(vv.w)};
    float zf[8] = {bflo(zz.x), bfhi(zz.x), bflo(zz.y), bfhi(zz.y), bflo(zz.z), bfhi(zz.z), bflo(zz.w), bfhi(zz.w)};
    float o[8];
#pragma unroll
    for (int j = 0; j < 8; j++) o[j] = ((y[j] - mu) * rstd * p.in[22][l * 512 + c0 + j] + p.in[23][l * 512 + c0 + j] + rho * vf[j]) * zf[j];
    uint4 ob; ob.x = pk2(o[0], o[1]); ob.y = pk2(o[2], o[3]); ob.z = pk2(o[4], o[5]); ob.w = pk2(o[6], o[7]);
    *(uint4*)(YG + (size_t)row * 512 + c0) = ob;
  }
}

DI void wave_gemm32(f32x16& acc, const u16* A, int lda, const u16* Bt, int ldb, int K) {
  const int lane = TIDX() & 63, r = lane & 31, hl = lane >> 5;
  const u16* ap = A + (size_t)r * lda + hl * 8; const u16* bp = Bt + (size_t)r * ldb + hl * 8;
#pragma unroll 8
  for (int k = 0; k < K; k += 16) { bf16x8 a = *(const bf16x8*)(ap + k); bf16x8 b = *(const bf16x8*)(bp + k); acc = MFMA32(a, b, acc); }
}
DI void phase6(const Params& p, int l, unsigned char* smem) {
  const u16* H = (const u16*)(p.ws + W_H); const u16* WinT = (const u16*)(p.ws + W_WINT);
  const u16* YG = (const u16*)(p.ws + W_YG); u16* MG = (u16*)(p.ws + W_MG);
  for (int t0 = blockIdx.x; t0 < 32 + 128 * 8; t0 += gridDim.x) {
    if (t0 < 32) {
      const int lane = TIDX() & 63, wave = TIDX() >> 6, r = lane & 31, hl = lane >> 5;
      const int unit = t0 * 4 + wave, row0 = NP + (unit & 3) * 32, n0 = (unit >> 2) * 32;
      f32x16 mm;
#pragma unroll
      for (int i = 0; i < 16; i++) mm[i] = 0.f;
#pragma unroll 1
      for (int g = 0; g < 3; g++) {
        f32x16 ay, ag;
#pragma unroll
        for (int i = 0; i < 16; i++) { ay[i] = 0.f; ag[i] = 0.f; }
        wave_gemm32(ay, YG + ((size_t)g * NT + row0) * 512, 512, (const u16*)(p.ws + W_WBRT) + ((size_t)(l * 3 + g) * 1024 + n0) * 512, 512, 512);
        wave_gemm32(ag, H + (size_t)row0 * 1024, 1024, WinT + (size_t)(5408 + g * 1024 + n0) * 1024, 1024, 1024);
#pragma unroll
        for (int i = 0; i < 16; i++) mm[i] += sigmoidf_(ag[i]) * ay[i];
      }
#pragma unroll
      for (int i = 0; i < 16; i++) MG[(size_t)(row0 + crow(i, hl)) * 1024 + n0 + r] = f2bf(mm[i]);
      continue;
    }
    const int t = t0 - 32;
    const int bq = t & 511, mt = (bq & 7) * 16 + ((bq >> 3) & 15), nt = (t >> 9) * 4 + (bq >> 7), m0 = mt * 128, n0 = nt * 128;

    unsigned mpk[2][2][8];
#pragma unroll
    for (int a = 0; a < 2; a++)
#pragma unroll
      for (int b = 0; b < 2; b++)
#pragma unroll
        for (int j = 0; j < 8; j++) mpk[a][b][j] = 0u;
#pragma unroll 1
    for (int g = 0; g < 3; g++) {
      f32x16 acc[2][2]; zero_acc(acc);
      gemm_mainloop(acc, YG + ((size_t)g * NT + m0) * 512, 512, (const u16*)(p.ws + W_WBRT) + ((size_t)(l * 3 + g) * 1024 + n0) * 512, 512, 512, smem);
      unsigned ypk[2][2][8];
#pragma unroll
      for (int a = 0; a < 2; a++)
#pragma unroll
        for (int b = 0; b < 2; b++)
#pragma unroll
          for (int j = 0; j < 8; j++) ypk[a][b][j] = pk2(acc[a][b][2 * j], acc[a][b][2 * j + 1]);
      zero_acc(acc);
      gemm_mainloop(acc, H + (size_t)m0 * 1024, 1024, WinT + (size_t)(5408 + g * 1024 + n0) * 1024, 1024, 1024, smem);
#pragma unroll
      for (int a = 0; a < 2; a++)
#pragma unroll
        for (int b = 0; b < 2; b++)
#pragma unroll
          for (int j = 0; j < 8; j++) {
            float lo = bflo(mpk[a][b][j]) + sigmoidf_(acc[a][b][2 * j]) * bflo(ypk[a][b][j]);
            float hi = bfhi(mpk[a][b][j]) + sigmoidf_(acc[a][b][2 * j + 1]) * bfhi(ypk[a][b][j]);
            mpk[a][b][j] = pk2(lo, hi);
          }
    }
    {
      const int lane = TIDX() & 63, wave = TIDX() >> 6, wm = wave >> 1, wn = wave & 1, r = lane & 31, hl = lane >> 5;
#pragma unroll
      for (int a = 0; a < 2; a++)
#pragma unroll
        for (int b = 0; b < 2; b++)
#pragma unroll
          for (int j = 0; j < 8; j++) {
            int col = n0 + wn * 64 + b * 32 + r;
            int row0 = m0 + wm * 64 + a * 32;
            MG[(size_t)(row0 + crow(2 * j, hl)) * 1024 + col] = (u16)(mpk[a][b][j] & 0xffffu);
            MG[(size_t)(row0 + crow(2 * j + 1, hl)) * 1024 + col] = (u16)(mpk[a][b][j] >> 16);
          }
    }
  }
}
DI void phase7(const Params& p, int l, unsigned char* smem) {
  const u16* MG = (const u16*)(p.ws + W_MG);
  const float* mod = (const float*)(p.ws + W_MOD);
  const int ntile = 32 + 128 * 8, nextra = (l + 1 < NL) ? WIN_TT + SMALLW_TT : 0;
  for (int t0 = blockIdx.x; t0 < ntile + nextra; t0 += gridDim.x) {
    if (t0 >= ntile + WIN_TT) { smallw_transpose_task(p, l + 1, t0 - ntile - WIN_TT, smem); continue; }
    if (t0 >= ntile) { win_transpose_task(p, l + 1, t0 - ntile, smem); continue; }
    if (t0 < 32) {
      const int lane = TIDX() & 63, wave = TIDX() >> 6, r = lane & 31, hl = lane >> 5;
      const int unit = t0 * 4 + wave, row0 = NP + (unit & 3) * 32, n0 = (unit >> 2) * 32;
      f32x16 a;
#pragma unroll
      for (int i = 0; i < 16; i++) a[i] = 0.f;
      wave_gemm32(a, MG + (size_t)row0 * 1024, 1024, (const u16*)(p.ws + W_WOUTT) + ((size_t)l * 1024 + n0) * 1024, 1024, 1024);
#pragma unroll
      for (int i = 0; i < 16; i++) {
        const int row = row0 + crow(i, hl), col = n0 + r;
        float xo = xrow_ptr(p, l, row)[col];
        float gt = mod[(l * 10 + bidx_of(row)) * 3072 + 2048 + col];
        p.out[(size_t)row * D + col] = xo + gt * a[i];
      }
      continue;
    }
    const int t = t0 - 32;
    const int bq = t & 511, mt = (bq & 7) * 16 + ((bq >> 3) & 15), nt = (t >> 9) * 4 + (bq >> 7), m0 = mt * 128, n0 = nt * 128;

    f32x16 acc[2][2]; zero_acc(acc);
    gemm_mainloop(acc, MG + (size_t)m0 * 1024, 1024, (const u16*)(p.ws + W_WOUTT) + ((size_t)l * 1024 + n0) * 1024, 1024, 1024, smem);
    foreach_acc(acc, m0, n0, [&](int row, int col, float v) {
      float xo = xrow_ptr(p, l, row)[col];
      float gt = mod[(l * 10 + bidx_of(row)) * 3072 + 2048 + col];
      p.out[(size_t)row * D + col] = xo + gt * v;
    });
  }
}

#define XB_TMO      128
#define XB_XCNT(j)  (256  + 64 * (j))
#define XB_XSUB(j)  (1280 + 64 * (j))
#define XB_XGEN(j)  (2304 + 64 * (j))
#define XB_TOP      3328
#define XB_TOPGEN   3392
#define XB_SPIN_CAP (1u << 18)
DI unsigned xb_ld(unsigned* q) { return __hip_atomic_load(q, __ATOMIC_RELAXED, __HIP_MEMORY_SCOPE_AGENT); }
DI unsigned xb_add(unsigned* q, unsigned v) { return __hip_atomic_fetch_add(q, v, __ATOMIC_RELAXED, __HIP_MEMORY_SCOPE_AGENT); }
DI unsigned xb_xcc_id() { return (unsigned)__builtin_amdgcn_s_getreg((3 << 11) | 20) & 0xFu; }
#define XB_SPIN(cond, bar) do { unsigned _sp = 0; while (cond) { __builtin_amdgcn_s_sleep(1); \
    if ((++_sp & 255u) == 0u) { if (xb_ld(&(bar)[XB_TMO])) break; if (_sp > XB_SPIN_CAP) { atomicAdd(&(bar)[XB_TMO], 1u); break; } } } } while (0)
DI void xbar(const Params& p, unsigned* xbst) {
  asm volatile("s_waitcnt vmcnt(0)" ::: "memory");
  __syncthreads();
  if (TIDX() == 0) {
    unsigned* bar = (unsigned*)(p.ws + W_XBAR);
    const unsigned x = xb_xcc_id();
    __builtin_amdgcn_s_waitcnt(0);
    const unsigned nloc = xbst[0], nx = xbst[1];
    const unsigned old = xb_add(&bar[XB_XSUB(x)], 1u);
    const unsigned gen = old / nloc;
    if (old + 1u == (gen + 1u) * nloc) {
      __builtin_amdgcn_fence(__ATOMIC_RELEASE, "agent");
      asm volatile("s_waitcnt vmcnt(0)" ::: "memory");
      const unsigned og = xb_add(&bar[XB_TOP], 1u);
      const unsigned tg = og / nx;
      if (og + 1u == (tg + 1u) * nx) xb_add(&bar[XB_TOPGEN], 1u);
      else XB_SPIN(xb_ld(&bar[XB_TOPGEN]) == tg, bar);
      __builtin_amdgcn_fence(__ATOMIC_ACQUIRE, "agent");
      xb_add(&bar[XB_XGEN(x)], 1u);
      asm volatile("s_waitcnt vmcnt(0)" ::: "memory");
    } else {
      XB_SPIN(xb_ld(&bar[XB_XGEN(x)]) == gen, bar);
      __builtin_amdgcn_fence(__ATOMIC_ACQUIRE, "agent");
      asm volatile("s_waitcnt vmcnt(0)" ::: "memory");
    }
  }
  __syncthreads();
}
DI int opq(int v) { asm volatile("" : "+s"(v)); return v; }
#if MULTI
template <int PH> __global__ void __launch_bounds__(256, 2) phase_kernel(Params p, int l) {
  __shared__ __attribute__((aligned(16))) unsigned char smem[SMEM_BYTES];
  if (PH == 0) phase0(p, smem);
  if (PH == 1) phase1(p, l);
  if (PH == 2) phase2(p, l, smem);
  if (PH == 3) phase3(p, l);
  if (PH == 4) phase4(p, l, smem);
  if (PH == 5) phase5(p, l, smem);
  if (PH == 6) phase5b(p, l);
  if (PH == 7) phase6(p, l, smem);
  if (PH == 8) phase7(p, l, smem);
}
#else
__global__ void __launch_bounds__(256, 2) mega_kernel(Params p_arg) {
  __shared__ __attribute__((aligned(16))) unsigned char smem[SMEM_BYTES];
  const Params& p = *(const Params*)__builtin_amdgcn_kernarg_segment_ptr();
  cg::grid_group grid = cg::this_grid();
  __shared__ unsigned xbst[4];
  if (TIDX() == 0) (void)xb_add((unsigned*)(p.ws + W_XBAR) + XB_XCNT(xb_xcc_id()), 1u);
  phase0(p, smem);
  grid.sync();
  if (TIDX() == 0) {
    unsigned* bar = (unsigned*)(p.ws + W_XBAR);
    const unsigned x = xb_xcc_id();
    unsigned cnt = 0u, mine = 0u;
    for (unsigned j = 0; j < 16; ++j) { const unsigned c = xb_ld(&bar[XB_XCNT(j)]); cnt += (c > 0u) ? 1u : 0u; mine = (j == x) ? c : mine; }
    xbst[0] = mine > 0u ? mine : 1u; xbst[1] = cnt > 0u ? cnt : 1u;
  }
  for (int l = 0; l < NL; l++) {
    phase1(p, opq(l)); xbar(p, xbst);
    phase2(p, opq(l), smem); xbar(p, xbst);
    phase3(p, opq(l)); xbar(p, xbst);
    phase4(p, opq(l), smem); xbar(p, xbst);
    phase5(p, opq(l), smem); xbar(p, xbst);
    phase5b(p, opq(l)); xbar(p, xbst);
    phase6(p, opq(l), smem); xbar(p, xbst);
    phase7(p, opq(l), smem); xbar(p, xbst);
  }
}
#endif

extern "C" void kernel_launch(void* const* d_in, const int* in_sizes, int n_in, void* d_out, int out_size, void* d_ws, size_t ws_size, hipStream_t stream) {
  Params p{};
  for (int i = 0; i < 36; i++) p.in[i] = (const float*)d_in[i];
  p.out = (float*)d_out;
  p.ws = (unsigned char*)d_ws;
  if (ws_size < W_TOTAL) fprintf(stderr, "workspace too small: %zu < %zu\n", ws_size, (size_t)W_TOTAL);
  hipMemsetAsync((unsigned char*)d_ws + W_CTR, 0, 256 + 3456 * 4, stream);
#if MULTI
  const int G = 1024;
  phase_kernel<0><<<G, 256, 0, stream>>>(p, 0);
  for (int l = 0; l < NL; l++) {
    phase_kernel<1><<<G, 256, 0, stream>>>(p, l);
    phase_kernel<2><<<G, 256, 0, stream>>>(p, l);
    phase_kernel<3><<<G, 256, 0, stream>>>(p, l);
    phase_kernel<4><<<G, 256, 0, stream>>>(p, l);
    phase_kernel<5><<<G, 256, 0, stream>>>(p, l);
    phase_kernel<6><<<G, 256, 0, stream>>>(p, l);
    phase_kernel<7><<<G, 256, 0, stream>>>(p, l);
    phase_kernel<8><<<G, 256, 0, stream>>>(p, l);
  }
#else
  static int grid_blocks = 0;
  if (!grid_blocks) {
    int dev = 0, cus = 0, per_cu = 0;
    hipGetDevice(&dev);
    hipDeviceGetAttribute(&cus, hipDeviceAttributeMultiprocessorCount, dev);
    hipOccupancyMaxActiveBlocksPerMultiprocessor(&per_cu, mega_kernel, 256, 0);
    if (per_cu > 2) per_cu = 2;
    grid_blocks = cus * per_cu;
  }
  void* args[] = {&p};
  hipError_t e = hipLaunchCooperativeKernel((void*)mega_kernel, dim3(grid_blocks), dim3(256), args, 0, stream);
  if (e != hipSuccess) fprintf(stderr, "cooperative launch failed: %s (grid %d)\n", hipGetErrorString(e), grid_blocks);
#endif
}
```

```cpp
#include <hip/hip_runtime.h>
#include <hip/hip_cooperative_groups.h>
#include <cstdio>
namespace cg = cooperative_groups;

#ifndef MULTI
#define MULTI 0
#endif

typedef unsigned short u16;
typedef __attribute__((ext_vector_type(8))) short bf16x8;
typedef __attribute__((ext_vector_type(16))) float f32x16;
typedef __attribute__((ext_vector_type(2))) __bf16 bf2_t;
typedef __attribute__((ext_vector_type(2))) float f2_t;
typedef __attribute__((ext_vector_type(4))) unsigned u32x4;
typedef __attribute__((ext_vector_type(2))) unsigned u32x2;
typedef __attribute__((ext_vector_type(4))) float f32x4v;
#define DI __device__ __forceinline__
#define MFMA32(a, b, c) __builtin_amdgcn_mfma_f32_32x32x16_bf16((a), (b), (c), 0, 0, 0)

constexpr int D = 1024, NL = 4, NP = 16384, NS = 128, NT = NP + NS, TP = 8192, TS = 16, PAST = 2048, SK = 2064;
constexpr int NKV = NP + 8 * SK;
constexpr int DIN = 8480;
constexpr float RMS_EPS = 1e-6f, GN_EPS = 64e-5f;
constexpr float LOG2E = 1.4426950408889634f;
constexpr float QSCALE_MLA = 0.10206207261596577f * LOG2E;
constexpr float QSCALE_SB = 0.125f * LOG2E;

constexpr size_t O_Y = 0;
constexpr size_t O_WKV_P = (size_t)NT * D;
constexpr size_t O_SHIFT_P = O_WKV_P + (size_t)NL * 2 * 8 * 4096;
constexpr size_t O_CKV_P = O_SHIFT_P + (size_t)NL * 2 * 1664;
constexpr size_t O_KROPE_P = O_CKV_P + (size_t)NL * NP * 256;
constexpr size_t O_SBK_P = O_KROPE_P + (size_t)NL * NP * 32;
constexpr size_t O_SBV_P = O_SBK_P + (size_t)NL * NP * 512;
constexpr size_t O_WKV_S = O_SBV_P + (size_t)NL * NP * 512;
constexpr size_t O_SHIFT_S = O_WKV_S + (size_t)NL * 8 * 8 * 4096;
constexpr size_t O_CKV_S = O_SHIFT_S + (size_t)NL * 8 * 1664;
constexpr size_t O_KROPE_S = O_CKV_S + (size_t)NL * NS * 256;
constexpr size_t O_SBK_S = O_KROPE_S + (size_t)NL * NS * 32;
constexpr size_t O_SBV_S = O_SBK_S + (size_t)NL * NS * 512;

constexpr size_t al(size_t x) { return (x + 255) & ~(size_t)255; }
constexpr size_t W_WINT = 0;
constexpr size_t W_WBRT = al(W_WINT + (size_t)DIN * 1024 * 2);
constexpr size_t W_WOUTT = al(W_WBRT + (size_t)NL * 3 * 1024 * 512 * 2);
constexpr size_t W_WUQT = al(W_WOUTT + (size_t)NL * 1024 * 1024 * 2);
constexpr size_t W_WUKVT = al(W_WUQT + (size_t)NL * 768 * 384 * 2);
constexpr size_t W_WUPT = al(W_WUKVT + (size_t)NL * 1024 * 256 * 2);
constexpr size_t W_AUPT = al(W_WUPT + (size_t)NL * 512 * 64 * 2);
constexpr size_t W_MOD = al(W_AUPT + (size_t)NL * 512 * 64 * 2);
constexpr size_t W_ROPE = al(W_MOD + (size_t)NL * 10 * 3072 * 4);
constexpr size_t W_CTR = al(W_ROPE + (size_t)8192 * 32 * 4);
constexpr size_t W_XBAR = W_CTR + 256;
constexpr size_t W_H = al(W_XBAR + 3456 * 4);
constexpr size_t W_PR = al(W_H + (size_t)NT * 1024 * 2);
constexpr size_t W_YG = W_PR;
constexpr size_t W_YRAW = al(W_YG + (size_t)3 * NT * 512 * 2);
constexpr size_t W_MG = W_YRAW;
constexpr size_t W_Z = al(W_PR + (size_t)NT * 1664 * 4);
constexpr size_t W_CQ = al(W_Z + (size_t)3 * NT * 512 * 2);
constexpr size_t W_QF = W_CQ;
constexpr size_t W_CKV = al(W_CQ + (size_t)NT * 768 * 2);
constexpr size_t W_KR = al(W_CKV + (size_t)NT * 256 * 4);
constexpr size_t W_QN = al(W_KR + (size_t)NT * 32 * 4);
constexpr size_t W_CKVN = al(W_QN + (size_t)NT * 384 * 2);
constexpr size_t W_SQ = al(W_CKVN + (size_t)(NKV + 64) * 256 * 2);
constexpr size_t W_SBK = al(W_SQ + (size_t)NT * 512 * 2);
constexpr size_t VT_S_OFF = (size_t)16 * 64 * 8192;
constexpr size_t VT_ELEMS = VT_S_OFF + (size_t)64 * 64 * SK + 256;
constexpr size_t W_SBVT = al(W_SBK + (size_t)(NKV + 64) * 512 * 2);
constexpr size_t W_RWW = al(W_SBVT + VT_ELEMS * 2);
constexpr size_t W_RWX = al(W_RWW + (size_t)NT * 512 * 4);
constexpr size_t W_RHO = al(W_RWX + (size_t)NT * 5 * 512 * 2);
constexpr size_t W_KF = al(W_RHO + (size_t)NT * 8 * 4);
constexpr size_t W_MLAVT = al(W_KF + (size_t)(NKV + 64) * 768 * 2);
constexpr size_t W_SLOC = al(W_MLAVT + VT_ELEMS * 2);
constexpr size_t W_PMAT = al(W_SLOC + (size_t)16 * 7 * 4096 * 4);
constexpr size_t W_TOTAL = al(W_PMAT + (size_t)16 * 7 * 4096 * 4);
static_assert((size_t)NT * 384 * 4 <= (size_t)NT * 768 * 2, "alias");
static_assert(W_YRAW + (size_t)NT * 1024 * 2 <= W_Z, "alias overflow");

struct Params {
  const float* in[36];
  float* out;
  unsigned char* ws;
};

constexpr int SMEM_BYTES = 73728;

DI int TIDX() { int t = __builtin_amdgcn_workitem_id_x(); asm volatile("" : "+v"(t)); return t; }
DI u16 f2bf(float x) { return __builtin_bit_cast(u16, (__bf16)x); }
DI unsigned pk2(float a, float b) { f2_t v = {a, b}; return __builtin_bit_cast(unsigned, __builtin_convertvector(v, bf2_t)); }
DI float bf2f(u16 x) { return __uint_as_float((unsigned)x << 16); }
DI float bflo(unsigned x) { return __uint_as_float(x << 16); }
DI float bfhi(unsigned x) { return __uint_as_float(x & 0xffff0000u); }
DI float ex2(float x) { return __builtin_amdgcn_exp2f(x); }
DI float lg2(float x) { return __builtin_amdgcn_logf(x); }
DI float frcp(float x) { return __builtin_amdgcn_rcpf(x); }
DI float sigmoidf_(float x) { return frcp(1.f + __expf(-x)); }
DI float siluf_(float x) { return x * frcp(1.f + __expf(-x)); }
DI float softplusf_(float x) { return fmaxf(x, 0.f) + __logf(1.f + __expf(-fabsf(x))); }
DI float tanhf_(float x) { return 1.f - 2.f * frcp(1.f + __expf(2.f * x)); }
DI int crow(int i, int hl) { return (i & 3) + 8 * (i >> 2) + 4 * hl; }
template <int CTRL> DI float dppf(float x) {
  return __int_as_float(__builtin_amdgcn_update_dpp(__float_as_int(x), __float_as_int(x), CTRL, 0xF, 0xF, false));
}
DI float allreduce16(float x) {
  x += dppf<0xB1>(x); x += dppf<0x4E>(x); x += dppf<0x141>(x); x += dppf<0x140>(x); return x;
}
DI float red32(float x) {
  x += __shfl_xor(x, 1); x += __shfl_xor(x, 2); x += __shfl_xor(x, 4); x += __shfl_xor(x, 8); x += __shfl_xor(x, 16); return x;
}
DI float red64(float x) { x = red32(x); x += __shfl_xor(x, 32); return x; }
DI int bidx_of(int row) { return row < NP ? (row >> 13) : 2 + ((row - NP) >> 4); }
DI int keyrow_of(int row) { return row < NP ? row : NP + ((row - NP) >> 4) * SK + PAST + ((row - NP) & 15); }
DI int pos_of(int row) { return row < NP ? (row & 8191) : PAST + ((row - NP) & 15); }
DI size_t vt_off(int keyrow, int h, int d) {
  if (keyrow < NP) { int b = keyrow >> 13, s = keyrow & 8191; return ((size_t)((b * 8 + h) * 64 + d)) * 8192 + s; }
  int rr = keyrow - NP; int b = rr / SK, s = rr - b * SK; return VT_S_OFF + ((size_t)((b * 8 + h) * 64 + d)) * SK + s;
}

DI void gemm_mainloop(f32x16 (&acc)[2][2], const u16* A, int lda, const u16* Bt, int ldb, int K, unsigned char* smem) {
  u16* s0 = (u16*)smem;
  const int tid = TIDX(), lane = tid & 63, wave = tid >> 6, wm = wave >> 1, wn = wave & 1;
  const int lr = tid >> 3, lc = (tid & 7) * 8;
  unsigned offA[4], offB[4];
#pragma unroll
  for (int i = 0; i < 4; i++) { offA[i] = (unsigned)(((lr + 32 * i) * lda + lc) * 2); offB[i] = (unsigned)(((lr + 32 * i) * ldb + lc) * 2); }
  const char* Ab = (const char*)A;
  const char* Bb = (const char*)Bt;
  u32x4 ra[4], rb[4];
  const int nk = K >> 6;
  const int r = lane & 31, hl = lane >> 5;
#pragma unroll
  for (int i = 0; i < 4; i++) { ra[i] = *(const u32x4*)(Ab + offA[i]); rb[i] = *(const u32x4*)(Bb + offB[i]); }
  __syncthreads();
#pragma unroll
  for (int i = 0; i < 4; i++) { *(u32x4*)(s0 + (lr + 32 * i) * 72 + lc) = ra[i]; *(u32x4*)(s0 + 128 * 72 + (lr + 32 * i) * 72 + lc) = rb[i]; }
  if (nk > 1) { Ab += 128; Bb += 128; }
#pragma unroll
  for (int i = 0; i < 4; i++) { ra[i] = *(const u32x4*)(Ab + offA[i]); rb[i] = *(const u32x4*)(Bb + offB[i]); }
  __syncthreads();
  for (int kt = 0; kt < nk; kt++) {
    u16* sA = s0 + (kt & 1) * (256 * 72); u16* sB = sA + 128 * 72;
    if (kt + 1 < nk) {
      u16* nA = s0 + ((kt + 1) & 1) * (256 * 72); u16* nB = nA + 128 * 72;
#pragma unroll
      for (int i = 0; i < 4; i++) { *(u32x4*)(nA + (lr + 32 * i) * 72 + lc) = ra[i]; *(u32x4*)(nB + (lr + 32 * i) * 72 + lc) = rb[i]; }
    }
    if (kt + 2 < nk) { Ab += 128; Bb += 128; }
#pragma unroll
    for (int i = 0; i < 4; i++) { ra[i] = *(const u32x4*)(Ab + offA[i]); rb[i] = *(const u32x4*)(Bb + offB[i]); }
#pragma unroll
    for (int ks = 0; ks < 4; ks++) {
      bf16x8 af[2], bfr[2];
#pragma unroll
      for (int b = 0; b < 2; b++) {
        af[b] = *(const bf16x8*)(sA + (wm * 64 + b * 32 + r) * 72 + ks * 16 + hl * 8);
        bfr[b] = *(const bf16x8*)(sB + (wn * 64 + b * 32 + r) * 72 + ks * 16 + hl * 8);
      }
#pragma unroll
      for (int bm = 0; bm < 2; bm++)
#pragma unroll
        for (int bn = 0; bn < 2; bn++) acc[bm][bn] = MFMA32(af[bm], bfr[bn], acc[bm][bn]);
    }
    __syncthreads();
  }
}
DI void zero_acc(f32x16 (&acc)[2][2]) {
#pragma unroll
  for (int a = 0; a < 2; a++)
#pragma unroll
    for (int b = 0; b < 2; b++)
#pragma unroll
      for (int i = 0; i < 16; i++) acc[a][b][i] = 0.f;
}
template <class F> DI void foreach_acc(f32x16 (&acc)[2][2], int m0, int n0, F f) {
  const int lane = TIDX() & 63, wave = TIDX() >> 6, wm = wave >> 1, wn = wave & 1, r = lane & 31, hl = lane >> 5;
#pragma unroll
  for (int bm = 0; bm < 2; bm++)
#pragma unroll
    for (int bn = 0; bn < 2; bn++)
#pragma unroll
      for (int i = 0; i < 16; i++) f(m0 + wm * 64 + bm * 32 + crow(i, hl), n0 + wn * 64 + bn * 32 + r, acc[bm][bn][i]);
}

DI void transpose_tile(const float* __restrict__ src, int K, int N, u16* __restrict__ dst, int kt, int nt, int mode, unsigned char* smem) {
  float* tile = (float*)smem;
  const int tid = TIDX(), tx = tid & 63, ty = tid >> 6;
  const int k0 = kt * 64, n0 = nt * 64;
  __syncthreads();
#pragma unroll 4
  for (int i = 0; i < 16; i++) { int k = i * 4 + ty; int n = n0 + tx; tile[k * 65 + tx] = (n < N) ? src[(size_t)(k0 + k) * N + n] : 0.f; }
  __syncthreads();
#pragma unroll 4
  for (int i = 0; i < 16; i++) {
    int nl = i * 4 + ty; int n = n0 + nl;
    if (n < N) {
      int nd = n;
      if (mode == 1) { int hd = n / 96, d = n - hd * 96; nd = d < 64 ? hd * 64 + d : 512 + hd * 32 + (d - 64); }
      dst[(size_t)nd * K + k0 + tx] = f2bf(tile[tx * 65 + nl]);
    }
  }
}
constexpr int WIN_TT = 16 * 133;
DI void win_transpose_task(const Params& p, int l, int t, unsigned char* smem) {
  int kt = t & 15, nt = t >> 4;
  transpose_tile(p.in[13] + (size_t)l * 1024 * DIN, 1024, DIN, (u16*)(p.ws + W_WINT), kt, nt, 0, smem);
}
constexpr int SMALLW_TT = 384 + 256 + 72 + 64 + 8 + 8;
DI void smallw_transpose_task(const Params& p, int l, int t, unsigned char* smem) {
  if (t < 384) { int g = t / 128, q = t % 128; const float* src = p.in[g == 0 ? 24 : (g == 1 ? 33 : 34)] + (size_t)l * 512 * 1024;
    transpose_tile(src, 512, 1024, (u16*)(p.ws + W_WBRT) + ((size_t)(l * 3 + g)) * 1024 * 512, q & 7, q >> 3, 0, smem); return; }
  t -= 384;
  if (t < 256) { transpose_tile(p.in[35] + (size_t)l * 1024 * 1024, 1024, 1024, (u16*)(p.ws + W_WOUTT) + (size_t)l * 1024 * 1024, t & 15, t >> 4, 0, smem); return; }
  t -= 256;
  if (t < 72) { transpose_tile(p.in[26] + (size_t)l * 384 * 768, 384, 768, (u16*)(p.ws + W_WUQT) + (size_t)l * 768 * 384, t % 6, t / 6, 1, smem); return; }
  t -= 72;
  if (t < 64) { transpose_tile(p.in[28] + (size_t)l * 256 * 1024, 256, 1024, (u16*)(p.ws + W_WUKVT) + (size_t)l * 1024 * 256, t & 3, t >> 2, 0, smem); return; }
  t -= 64;
  if (t < 8) { transpose_tile(p.in[16] + (size_t)l * 64 * 512, 64, 512, (u16*)(p.ws + W_WUPT) + (size_t)l * 512 * 64, 0, t, 0, smem); return; }
  t -= 8;
  transpose_tile(p.in[18] + (size_t)l * 64 * 512, 64, 512, (u16*)(p.ws + W_AUPT) + (size_t)l * 512 * 64, 0, t, 0, smem);
}
DI void mod_task(const Params& p, int task, unsigned char* smem) {
  float* sm = (float*)smem;
  const int tid = TIDX(), l = task / 48, cb = task % 48, kq = tid >> 6, cl = tid & 63, col = cb * 64 + cl;
  __syncthreads();
  for (int e = tid; e < 10240; e += 256) { int r = e >> 10, k = e & 1023; float c = r < 2 ? p.in[8][r * 1024 + k] : p.in[9][(r - 2) * 1024 + k]; sm[e] = siluf_(c); }
  __syncthreads();
  float acc[10];
#pragma unroll
  for (int r = 0; r < 10; r++) acc[r] = 0.f;
  const float* w = p.in[10] + ((size_t)l * 1024 + kq * 256) * 3072 + col;
#pragma unroll 8
  for (int k = 0; k < 256; k++) {
    float wv = w[(size_t)k * 3072];
#pragma unroll
    for (int r = 0; r < 10; r++) acc[r] += sm[r * 1024 + kq * 256 + k] * wv;
  }
  __syncthreads();
#pragma unroll
  for (int r = 0; r < 10; r++) sm[(kq * 10 + r) * 64 + cl] = acc[r];
  __syncthreads();
  if (tid < 64) {
    float* mod = (float*)(p.ws + W_MOD);
    float bb = p.in[11][l * 3072 + col];
#pragma unroll
    for (int r = 0; r < 10; r++) mod[(l * 10 + r) * 3072 + col] = sm[r * 64 + cl] + sm[(10 + r) * 64 + cl] + sm[(20 + r) * 64 + cl] + sm[(30 + r) * 64 + cl] + bb;
  }
}
DI void rope_task(const Params& p, int task) {
  const int tid = TIDX(); const int pos = task * 128 + (tid >> 1);
  float* rope = (float*)(p.ws + W_ROPE);
  for (int ff = 0; ff < 8; ff++) {
    int f = (tid & 1) * 8 + ff;
    double inv = 1.0; for (int j = 0; j < f; j++) inv *= 0.5623413251903491;
    double ang = (double)pos * inv;
    double n = rint(ang * 0.15915494309189535);
    double rr = ang - n * 6.283185307179586 - n * 2.4492935982947064e-16;
    double r2 = rr * rr, sn = rr, cs = 1.0, ts = rr, tc = 1.0;
    for (int k = 1; k <= 15; k++) { tc *= -r2 / (double)((2 * k - 1) * (2 * k)); cs += tc; ts *= -r2 / (double)((2 * k) * (2 * k + 1)); sn += ts; }
    rope[pos * 32 + f] = (float)cs; rope[pos * 32 + 16 + f] = (float)sn;
  }
}
DI void phase0(const Params& p, unsigned char* smem) {
  const int n_tr = WIN_TT + SMALLW_TT, total = n_tr + 192 + 64;
  for (int t = blockIdx.x; t < total; t += gridDim.x) {
    if (t < 192) mod_task(p, t, smem);
    else if (t < 192 + 64) rope_task(p, t - 192);
    else { int q = t - 256; if (q < WIN_TT) win_transpose_task(p, 0, q, smem); else { q -= WIN_TT; smallw_transpose_task(p, 0, q, smem); } }
  }
}

DI const float* xrow_ptr(const Params& p, int l, int row) {
  if (l > 0) return p.out + (size_t)row * D;
  return row < NP ? p.in[0] + (size_t)row * D : p.in[1] + (size_t)(row - NP) * D;
}
DI void phase1(const Params& p, int l) {
  const int lane = TIDX() & 63, wave = TIDX() >> 6;
  const float* mod = (const float*)(p.ws + W_MOD);
  const float* g = p.in[12] + l * 1024;
  u16* H = (u16*)(p.ws + W_H);
  for (int task = blockIdx.x; task < NT / 4; task += gridDim.x) {
    int row = task * 4 + wave;
    const float* x = xrow_ptr(p, l, row);
    const float* md = mod + (l * 10 + bidx_of(row)) * 3072;
    float4 v[4]; float ss = 0.f;
#pragma unroll
    for (int j = 0; j < 4; j++) { v[j] = *(const float4*)(x + (j * 64 + lane) * 4); ss += v[j].x * v[j].x + v[j].y * v[j].y + v[j].z * v[j].z + v[j].w * v[j].w; }
    ss = red64(ss);
    float rstd = rsqrtf(ss * (1.f / 1024.f) + RMS_EPS);
#pragma unroll
    for (int j = 0; j < 4; j++) {
      int c = (j * 64 + lane) * 4;
      float4 gg = *(const float4*)(g + c), sh = *(const float4*)(md + c), sc = *(const float4*)(md + 1024 + c);
      float h0 = v[j].x * rstd * gg.x * (1.f + sc.x) + sh.x, h1 = v[j].y * rstd * gg.y * (1.f + sc.y) + sh.y;
      float h2 = v[j].z * rstd * gg.z * (1.f + sc.z) + sh.z, h3 = v[j].w * rstd * gg.w * (1.f + sc.w) + sh.w;
      uint2 o; o.x = pk2(h0, h1); o.y = pk2(h2, h3);
      *(uint2*)(H + (size_t)row * 1024 + c) = o;
    }
  }
}

DI void phase2(const Params& p, int l, unsigned char* smem) {
  const u16* H = (const u16*)(p.ws + W_H);
  const u16* WinT = (const u16*)(p.ws + W_WINT);
  float* PR = (float*)(p.ws + W_PR);
  u16* Z = (u16*)(p.ws + W_Z);
  float* CQ = (float*)(p.ws + W_CQ); float* CKV = (float*)(p.ws + W_CKV); float* KR = (float*)(p.ws + W_KR);
  u16* SQ = (u16*)(p.ws + W_SQ); u16* SBK = (u16*)(p.ws + W_SBK); u16* SBVT = (u16*)(p.ws + W_SBVT);
  float* out = p.out;
  for (int ts = blockIdx.x; ts < 11 * 512; ts += gridDim.x) {
    int mt, nt;
    {
      const int rd = ts >> 9, bq = ts & 511, sm = bq & 7, j = bq >> 3;
      mt = sm * 16 + (j & 15); nt = rd * 4 + (j >> 4);
      if (nt >= 43) { const int e = sm * 16 + (j & 15); if (e >= 43) continue; mt = 128; nt = e; }
    }
    const int m0 = mt * 128;
    int seg, n0, c0;
    if (nt < 13) { seg = 0; c0 = nt * 128; n0 = c0; }
    else if (nt < 17) { seg = 1; c0 = (nt - 13) * 128; n0 = 1664 + c0; }
    else if (nt < 20) { seg = 2; c0 = (nt - 17) * 128; n0 = 2176 + c0; }
    else if (nt < 22) { seg = 3; c0 = (nt - 20) * 128; n0 = 2560 + c0; }
    else if (nt < 26) { seg = 4; c0 = (nt - 22) * 128; n0 = 2848 + c0; }
    else if (nt < 30) { seg = 5; c0 = (nt - 26) * 128; n0 = 3360 + c0; }
    else if (nt < 34) { seg = 6; c0 = (nt - 30) * 128; n0 = 3872 + c0; }
    else if (nt < 38) { seg = 7; c0 = (nt - 34) * 128; n0 = 4384 + c0; }
    else if (nt < 42) { seg = 8; c0 = (nt - 38) * 128; n0 = 4896 + c0; }
    else { seg = 9; c0 = 0; n0 = 2816; }
    f32x16 acc[2][2]; zero_acc(acc);
    gemm_mainloop(acc, H + (size_t)m0 * 1024, 1024, WinT + (size_t)n0 * 1024, 1024, 1024, smem);
    if (seg == 0) {
      foreach_acc(acc, m0, c0, [&](int row, int col, float v) {
        PR[(size_t)row * 1664 + col] = v;
        if (row < NP) { if ((row & 8191) == 8191) out[O_SHIFT_P + (size_t)(l * 2 + (row >> 13)) * 1664 + col] = v; }
        else { int rr = row - NP; if ((rr & 15) == 15) out[O_SHIFT_S + (size_t)(l * 8 + (rr >> 4)) * 1664 + col] = v; }
      });
    } else if (seg == 1 || seg == 4 || seg == 8) {
      const int g = seg == 1 ? 0 : (seg == 4 ? 1 : 2);
      foreach_acc(acc, m0, c0, [&](int row, int col, float v) { Z[((size_t)g * NT + row) * 512 + col] = f2bf(siluf_(v)); });
    } else if (seg == 2) {
      foreach_acc(acc, m0, c0, [&](int row, int col, float v) { CQ[(size_t)row * 384 + col] = v; });
    } else if (seg == 3) {
      foreach_acc(acc, m0, c0, [&](int row, int col, float v) { CKV[(size_t)row * 256 + col] = v; });
    } else if (seg == 9) {
      foreach_acc(acc, m0, c0, [&](int row, int col, float v) { if (col < 32) KR[(size_t)row * 32 + col] = v; });
    } else if (seg == 5) {
      foreach_acc(acc, m0, c0, [&](int row, int col, float v) { SQ[(size_t)row * 512 + col] = f2bf(v * QSCALE_SB); });
    } else if (seg == 6) {
      foreach_acc(acc, m0, c0, [&](int row, int col, float v) {
        size_t oo = row < NP ? O_SBK_P + ((size_t)l * NP + row) * 512 + col : O_SBK_S + ((size_t)l * NS + (row - NP)) * 512 + col;
        out[oo] = v;
        SBK[(size_t)keyrow_of(row) * 512 + col] = f2bf(v);
      });
    } else {
      foreach_acc(acc, m0, c0, [&](int row, int col, float v) {
        size_t oo = row < NP ? O_SBV_P + ((size_t)l * NP + row) * 512 + col : O_SBV_S + ((size_t)l * NS + (row - NP)) * 512 + col;
        out[oo] = v;
      });
      const int lane = TIDX() & 63, wave = TIDX() >> 6, wm = wave >> 1, wn = wave & 1, r = lane & 31, hl = lane >> 5;
#pragma unroll
      for (int bm = 0; bm < 2; bm++)
#pragma unroll
        for (int bn = 0; bn < 2; bn++)
#pragma unroll
          for (int g4 = 0; g4 < 4; g4++) {
            int row = m0 + wm * 64 + bm * 32 + 8 * g4 + 4 * hl, col = c0 + wn * 64 + bn * 32 + r;
            uint2 o; o.x = pk2(acc[bm][bn][4 * g4], acc[bm][bn][4 * g4 + 1]); o.y = pk2(acc[bm][bn][4 * g4 + 2], acc[bm][bn][4 * g4 + 3]);
            *(uint2*)(SBVT + vt_off(keyrow_of(row), col >> 6, col & 63)) = o;
          }
    }
  }
}

DI const float* prev_ptr(const Params& p, int l, const float* PR, int row) {
  if (row < NP) return (row & 8191) ? PR + (size_t)(row - 1) * 1664 : nullptr;
  int rr = row - NP;
  return (rr & 15) ? PR + (size_t)(row - 1) * 1664 : p.in[3] + (size_t)(l * 8 + (rr >> 4)) * 1664;
}
DI void rwkv_prep_task(const Params& p, int l, int task) {
  const int lane = TIDX() & 63, wave = TIDX() >> 6, r = lane & 31, hl = lane >> 5;
  const int tile = task >> 1, hh = (task & 1) * 4 + wave, row0 = tile * 32;
  const float* PR = (const float*)(p.ws + W_PR);
  const float* mu = p.in[14] + l * 1664;
  f32x16 accW[1][2], accA[1][2];
#pragma unroll
  for (int b_ = 0; b_ < 2; b_++)
#pragma unroll
    for (int i_ = 0; i_ < 16; i_++) { accW[0][b_][i_] = 0.f; accA[0][b_][i_] = 0.f; }
  const u16* WupT = (const u16*)(p.ws + W_WUPT) + (size_t)l * 512 * 64;
  const u16* AupT = (const u16*)(p.ws + W_AUPT) + (size_t)l * 512 * 64;
#pragma unroll 1
  for (int ks = 0; ks < 4; ks++) {
    const int k0 = ks * 16 + hl * 8;
    bf16x8 bw[2], ba[2];
#pragma unroll
    for (int bn = 0; bn < 2; bn++) {
      bw[bn] = *(const bf16x8*)(WupT + (size_t)(hh * 64 + bn * 32 + r) * 64 + k0);
      ba[bn] = *(const bf16x8*)(AupT + (size_t)(hh * 64 + bn * 32 + r) * 64 + k0);
    }
#pragma unroll
    for (int bm = 0; bm < 1; bm++) {
      const int row = row0 + bm * 32 + r;
      const float* pp = PR + (size_t)row * 1664;
      const float* pv = prev_ptr(p, l, PR, row);
      float xw[8], xa[8];
#pragma unroll
      for (int q = 0; q < 2; q++) {
        float4 a = *(const float4*)(pp + 1536 + k0 + 4 * q), b = pv ? *(const float4*)(pv + 1536 + k0 + 4 * q) : make_float4(0, 0, 0, 0), m = *(const float4*)(mu + 1536 + k0 + 4 * q);
        xw[4 * q] = tanhf_(a.x + (b.x - a.x) * m.x); xw[4 * q + 1] = tanhf_(a.y + (b.y - a.y) * m.y); xw[4 * q + 2] = tanhf_(a.z + (b.z - a.z) * m.z); xw[4 * q + 3] = tanhf_(a.w + (b.w - a.w) * m.w);
        a = *(const float4*)(pp + 1600 + k0 + 4 * q); b = pv ? *(const float4*)(pv + 1600 + k0 + 4 * q) : make_float4(0, 0, 0, 0); m = *(const float4*)(mu + 1600 + k0 + 4 * q);
        xa[4 * q] = a.x + (b.x - a.x) * m.x; xa[4 * q + 1] = a.y + (b.y - a.y) * m.y; xa[4 * q + 2] = a.z + (b.z - a.z) * m.z; xa[4 * q + 3] = a.w + (b.w - a.w) * m.w;
      }
      u32x4 uw, ua;
      uw.x = pk2(xw[0], xw[1]); uw.y = pk2(xw[2], xw[3]); uw.z = pk2(xw[4], xw[5]); uw.w = pk2(xw[6], xw[7]);
      ua.x = pk2(xa[0], xa[1]); ua.y = pk2(xa[2], xa[3]); ua.z = pk2(xa[4], xa[5]); ua.w = pk2(xa[6], xa[7]);
      bf16x8 awf = __builtin_bit_cast(bf16x8, uw), aaf = __builtin_bit_cast(bf16x8, ua);
#pragma unroll
      for (int bn = 0; bn < 2; bn++) { accW[bm][bn] = MFMA32(awf, bw[bn], accW[bm][bn]); accA[bm][bn] = MFMA32(aaf, ba[bn], accA[bm][bn]); }
    }
  }
  float* RWW = (float*)(p.ws + W_RWW); u16* RWX = (u16*)(p.ws + W_RWX); float* RHO = (float*)(p.ws + W_RHO);
  float mur[2], muk[2], muv[2], w0[2], a0[2], kk_[2], ka_[2], rk_[2];
#pragma unroll
  for (int bn = 0; bn < 2; bn++) {
    int col = hh * 64 + bn * 32 + r;
    mur[bn] = mu[col]; muk[bn] = mu[512 + col]; muv[bn] = mu[1024 + col];
    w0[bn] = p.in[15][l * 512 + col]; a0[bn] = p.in[17][l * 512 + col]; kk_[bn] = p.in[19][l * 512 + col]; ka_[bn] = p.in[20][l * 512 + col]; rk_[bn] = p.in[21][l * 512 + col];
  }
#pragma unroll
  for (int bm = 0; bm < 1; bm++)
#pragma unroll
    for (int i = 0; i < 16; i++) {
      const int row = row0 + bm * 32 + crow(i, hl);
      const float* pp = PR + (size_t)row * 1664;
      const float* pv = prev_ptr(p, l, PR, row);
      float xr[2], xv[2], kp[2], kkr[2], av[2], dec[2];
      float ssq = 0.f, rho = 0.f;
#pragma unroll
      for (int bn = 0; bn < 2; bn++) {
        int col = hh * 64 + bn * 32 + r;
        float pr_ = pp[col], pk_ = pp[512 + col], pv_ = pp[1024 + col];
        float qr = pv ? pv[col] : 0.f, qk = pv ? pv[512 + col] : 0.f, qv = pv ? pv[1024 + col] : 0.f;
        xr[bn] = pr_ + (qr - pr_) * mur[bn];
        float xk = pk_ + (qk - pk_) * muk[bn];
        xv[bn] = pv_ + (qv - pv_) * muv[bn];
        float wpre = w0[bn] + accW[bm][bn][i];
        float wlog = -softplusf_(-wpre) - 0.5f;
        dec[bn] = __expf(-__expf(wlog));
        av[bn] = sigmoidf_(a0[bn] + accA[bm][bn][i]);
        kkr[bn] = xk * kk_[bn];
        kp[bn] = xk * (1.f + (av[bn] - 1.f) * ka_[bn]);
        ssq += kkr[bn] * kkr[bn];
        rho += xr[bn] * kp[bn] * rk_[bn];
      }
      ssq = red32(ssq); rho = red32(rho);
      float inv = rsqrtf(fmaxf(ssq, 1e-24f));
#pragma unroll
      for (int bn = 0; bn < 2; bn++) {
        int col = hh * 64 + bn * 32 + r;
        float kk = kkr[bn] * inv;
        RWW[(size_t)row * 512 + col] = dec[bn];
        u16* rx = RWX + (size_t)row * 2560 + col;
        rx[0] = f2bf(xr[bn]); rx[512] = f2bf(kp[bn]); rx[1024] = f2bf(xv[bn]); rx[1536] = f2bf(kk); rx[2048] = f2bf(kk * av[bn]);
      }
      if (r == 0) RHO[(size_t)row * 8 + hh] = rho;
    }
}
DI void norm_row_task(const Params& p, int l, int task) {
  const int lane = TIDX() & 63, wave = TIDX() >> 6;
  const int row = task * 4 + wave;
  const float* CQ = (const float*)(p.ws + W_CQ); const float* CKV = (const float*)(p.ws + W_CKV); const float* KR = (const float*)(p.ws + W_KR);
  u16* QN = (u16*)(p.ws + W_QN); u16* CKVN = (u16*)(p.ws + W_CKVN); u16* KF = (u16*)(p.ws + W_KF);
  const int keyrow = keyrow_of(row);
  {
    float v[6], ss = 0.f;
#pragma unroll
    for (int j = 0; j < 6; j++) { v[j] = CQ[(size_t)row * 384 + j * 64 + lane]; ss += v[j] * v[j]; }
    ss = red64(ss); float rstd = rsqrtf(ss * (1.f / 384.f) + RMS_EPS);
#pragma unroll
    for (int j = 0; j < 6; j++) QN[(size_t)row * 384 + j * 64 + lane] = f2bf(v[j] * rstd * p.in[25][l * 384 + j * 64 + lane]);
  }
  {
    float4 v = *(const float4*)(CKV + (size_t)row * 256 + lane * 4);
    float ss = red64(v.x * v.x + v.y * v.y + v.z * v.z + v.w * v.w);
    float rstd = rsqrtf(ss * (1.f / 256.f) + RMS_EPS);
    float4 g = *(const float4*)(p.in[27] + l * 256 + lane * 4);
    float4 o = make_float4(v.x * rstd * g.x, v.y * rstd * g.y, v.z * rstd * g.z, v.w * rstd * g.w);
    size_t oo = row < NP ? O_CKV_P + ((size_t)l * NP + row) * 256 : O_CKV_S + ((size_t)l * NS + (row - NP)) * 256;
    *(float4*)(p.out + oo + lane * 4) = o;
    uint2 ob; ob.x = pk2(o.x, o.y); ob.y = pk2(o.z, o.w);
    *(uint2*)(CKVN + (size_t)keyrow * 256 + lane * 4) = ob;
  }
  {
    float x = lane < 32 ? KR[(size_t)row * 32 + lane] : 0.f;
    float ss = red64(x * x); float rstd = rsqrtf(ss * (1.f / 32.f) + RMS_EPS);
    float xn = x * rstd * p.in[32][l * 32 + (lane & 31)];
    float pt = __shfl_xor(xn, 16);
    const float* rp = (const float*)(p.ws + W_ROPE) + pos_of(row) * 32;
    float cs = rp[lane & 15], sn = rp[16 + (lane & 15)];
    float o = (lane & 16) ? (pt * sn + xn * cs) : (xn * cs - pt * sn);
    if (lane < 32) {
      size_t oo = row < NP ? O_KROPE_P + ((size_t)l * NP + row) * 32 : O_KROPE_S + ((size_t)l * NS + (row - NP)) * 32;
      p.out[oo + lane] = o;
      u16 ob = f2bf(o);
#pragma unroll
      for (int hd = 0; hd < 8; hd++) KF[(size_t)keyrow * 768 + hd * 96 + 64 + lane] = ob;
    }
  }
}
DI void past_convert_task(const Params& p, int l, int task) {
  const int tid = TIDX();
  if (task < 2048) {
    size_t e = ((size_t)task * 256 + tid) * 8; int rowp = (int)(e >> 8), c = (int)(e & 255); int b = rowp >> 11, s = rowp & 2047;
    const float* src = p.in[4] + ((size_t)(l * 8 + b) * PAST + s) * 256 + c;
    float4 a = *(const float4*)src, bq = *(const float4*)(src + 4);
    uint4 o; o.x = pk2(a.x, a.y); o.y = pk2(a.z, a.w); o.z = pk2(bq.x, bq.y); o.w = pk2(bq.z, bq.w);
    *(uint4*)((u16*)(p.ws + W_CKVN) + (size_t)(NP + b * SK + s) * 256 + c) = o; return;
  }
  task -= 2048;
  if (task < 4096) {
    size_t e = ((size_t)task * 256 + tid) * 8; int rowp = (int)(e >> 9), c = (int)(e & 511); int b = rowp >> 11, s = rowp & 2047;
    const float* src = p.in[6] + ((size_t)(l * 8 + b) * PAST + s) * 512 + c;
    float4 a = *(const float4*)src, bq = *(const float4*)(src + 4);
    uint4 o; o.x = pk2(a.x, a.y); o.y = pk2(a.z, a.w); o.z = pk2(bq.x, bq.y); o.w = pk2(bq.z, bq.w);
    *(uint4*)((u16*)(p.ws + W_SBK) + (size_t)(NP + b * SK + s) * 512 + c) = o; return;
  }
  task -= 4096;
  if (task < 4096) {
    int id = task * 256 + tid; int c = id & 511, sg = (id >> 9) & 255, b = id >> 17;
    const float* src = p.in[7] + ((size_t)(l * 8 + b) * PAST + sg * 8) * 512 + c;
    float v[8];
#pragma unroll
    for (int j = 0; j < 8; j++) v[j] = src[(size_t)j * 512];
    uint4 o; o.x = pk2(v[0], v[1]); o.y = pk2(v[2], v[3]); o.z = pk2(v[4], v[5]); o.w = pk2(v[6], v[7]);
    *(uint4*)((u16*)(p.ws + W_SBVT) + VT_S_OFF + ((size_t)((b * 8 + (c >> 6)) * 64 + (c & 63))) * SK + sg * 8) = o; return;
  }
  task -= 4096;
  {
    int id = task * 256 + tid; int ch = id & 7, rowp = id >> 3; int b = rowp >> 11, s = rowp & 2047;
    float4 a = *(const float4*)(p.in[5] + ((size_t)(l * 8 + b) * PAST + s) * 32 + ch * 4);
    uint2 o; o.x = pk2(a.x, a.y); o.y = pk2(a.z, a.w);
    u16* dst = (u16*)(p.ws + W_KF) + (size_t)(NP + b * SK + s) * 768 + 64 + ch * 4;
#pragma unroll
    for (int hd = 0; hd < 8; hd++) *(uint2*)(dst + hd * 96) = o;
  }
}
DI void phase3(const Params& p, int l) {
  const int nA = 1032, nB = NT / 4, nC = 2048 + 4096 + 4096 + 512, total = nA + nB + nC;
  for (int t = blockIdx.x; t < total; t += gridDim.x) {
    if (t < nA) rwkv_prep_task(p, l, t);
    else if (t < nA + nB) norm_row_task(p, l, t - nA);
    else past_convert_task(p, l, t - nA - nB);
  }
}

DI void rwkv_pass1_task(const Params& p, int bh, int seg, int rq, unsigned char* smem);
DI void phase4(const Params& p, int l, unsigned char* smem) {
  const int lane = TIDX() & 63, wave = TIDX() >> 6, wm = wave >> 1, wn = wave & 1, r = lane & 31, hl = lane >> 5;
  const float* rope = (const float*)(p.ws + W_ROPE);
  u16* QF = (u16*)(p.ws + W_QF); u16* KF = (u16*)(p.ws + W_KF); u16* VT = (u16*)(p.ws + W_MLAVT);
  const int nQ = 129 * 6, nKV = 257 * 8;
  __shared__ int s_task4;
  int* ctr4 = (int*)(p.ws + W_CTR) + 8 + l;
  while (true) {
    __syncthreads();
    if (TIDX() == 0) s_task4 = atomicAdd(ctr4, 1);
    __syncthreads();
    const int q4 = s_task4;
    if (q4 >= 448 + nQ + nKV) break;
    const int t0 = q4 < 896 ? ((q4 & 1) ? 448 + (q4 >> 1) : (q4 >> 1)) : q4;
    if (t0 < 448) { int bh = t0 / 28, rem = t0 - bh * 28; rwkv_pass1_task(p, bh, rem >> 2, rem & 3, smem); continue; }
    const int t = t0 - 448;
    f32x16 acc[2][2]; zero_acc(acc);
    if (t < nQ) {
      const int mt = t % 129, nt = t / 129, m0 = mt * 128;
      gemm_mainloop(acc, (const u16*)(p.ws + W_QN) + (size_t)m0 * 384, 384, (const u16*)(p.ws + W_WUQT) + ((size_t)l * 768 + nt * 128) * 384, 384, 384, smem);
      if (nt < 4) {
        const int head = nt * 2 + wn;
        float g0 = p.in[29][l * 64 + r] * QSCALE_MLA, g1 = p.in[29][l * 64 + 32 + r] * QSCALE_MLA;
#pragma unroll
        for (int bm = 0; bm < 2; bm++)
#pragma unroll
          for (int i = 0; i < 16; i++) {
            float a = acc[bm][0][i], b = acc[bm][1][i];
            float ss = red32(a * a + b * b); float rstd = rsqrtf(ss * (1.f / 64.f) + RMS_EPS);
            int row = m0 + wm * 64 + bm * 32 + crow(i, hl);
            u16* q = QF + (size_t)row * 768 + head * 96;
            q[r] = f2bf(a * rstd * g0); q[32 + r] = f2bf(b * rstd * g1);
          }
      } else {
        float g = p.in[30][l * 32 + r] * QSCALE_MLA;
#pragma unroll
        for (int bm = 0; bm < 2; bm++)
#pragma unroll
          for (int bn = 0; bn < 2; bn++)
#pragma unroll
            for (int i = 0; i < 16; i++) {
              const int head = (nt - 4) * 4 + wn * 2 + bn;
              float a = acc[bm][bn][i];
              float ss = red32(a * a); float rstd = rsqrtf(ss * (1.f / 32.f) + RMS_EPS);
              float xn = a * rstd * g; float pt = __shfl_xor(xn, 16);
              int row = m0 + wm * 64 + bm * 32 + crow(i, hl);
              const float* rp = rope + pos_of(row) * 32;
              float cs = rp[r & 15], sn = rp[16 + (r & 15)];
              float o = (r & 16) ? (pt * sn + xn * cs) : (xn * cs - pt * sn);
              QF[(size_t)row * 768 + head * 96 + 64 + r] = f2bf(o);
            }
      }
    } else {
      const int q = t - nQ, mt = q % 257, head = q / 257, m0 = mt * 128;
      gemm_mainloop(acc, (const u16*)(p.ws + W_CKVN) + (size_t)m0 * 256, 256, (const u16*)(p.ws + W_WUKVT) + ((size_t)l * 1024 + head * 128) * 256, 256, 256, smem);
      if (wn == 0) {
        float g0 = p.in[31][l * 64 + r], g1 = p.in[31][l * 64 + 32 + r];
#pragma unroll
        for (int bm = 0; bm < 2; bm++)
#pragma unroll
          for (int i = 0; i < 16; i++) {
            float a = acc[bm][0][i], b = acc[bm][1][i];
            float ss = red32(a * a + b * b); float rstd = rsqrtf(ss * (1.f / 64.f) + RMS_EPS);
            int krow = m0 + wm * 64 + bm * 32 + crow(i, hl);
            u16* k = KF + (size_t)krow * 768 + head * 96;
            k[r] = f2bf(a * rstd * g0); k[32 + r] = f2bf(b * rstd * g1);
          }
      } else {
#pragma unroll
        for (int bm = 0; bm < 2; bm++)
#pragma unroll
          for (int bn = 0; bn < 2; bn++)
#pragma unroll
            for (int g4 = 0; g4 < 4; g4++) {
              int krow = m0 + wm * 64 + bm * 32 + 8 * g4 + 4 * hl, d = bn * 32 + r;
              uint2 o; o.x = pk2(acc[bm][bn][4 * g4], acc[bm][bn][4 * g4 + 1]); o.y = pk2(acc[bm][bn][4 * g4 + 2], acc[bm][bn][4 * g4 + 3]);
              *(uint2*)(VT + vt_off(krow, head, d)) = o;
            }
      }
    }
  }
}

template <int DK, bool SB>
DI void attn_task(const u16* __restrict__ Qp, int qstride, int nq_valid, const u16* __restrict__ Kp, int kstride,
                  const u16* __restrict__ Vtp, int vstride, int nkeys, int qpos0,
                  const u16* __restrict__ Zp, u16* __restrict__ Yp, unsigned char* smem) {
  constexpr int KS = DK / 16, KSTR = DK + 8, KCH = DK / 8, NKL = 64 * KCH / 256;
  u16* sK = (u16*)smem; u16* sV = sK + 64 * KSTR;
  const int tid = TIDX(), lane = tid & 63, wave = tid >> 6, r = lane & 31, hl = lane >> 5;
  const int slot = wave * 32 + r;
  const bool wave_active = wave * 32 < nq_valid;
  const int qpos = qpos0 + slot;
  bf16x8 qf[KS];
  {
    const u16* qrow = Qp + (size_t)(slot < nq_valid ? slot : 0) * qstride + hl * 8;
#pragma unroll
    for (int ks = 0; ks < KS; ks++) qf[ks] = *(const bf16x8*)(qrow + ks * 16);
  }
  f32x16 O[2];
#pragma unroll
  for (int b = 0; b < 2; b++)
#pragma unroll
    for (int i = 0; i < 16; i++) O[b][i] = 0.f;
  float m_run = -1e30f, l_run = 0.f, R = 1.f;
  const int last_qpos = qpos0 + nq_valid - 1;
  int ntiles = SB ? (last_qpos - 1) / 64 + 1 : last_qpos / 64 + 1;
  { int mx = (nkeys + 63) >> 6; if (ntiles > mx) ntiles = mx; }
  const int wave_q0 = qpos0 + wave * 32;
  u32x4 rk[NKL], rv[2];
  auto prefetch = [&](int kt) {
#pragma unroll
    for (int i = 0; i < NKL; i++) { int c = tid + 256 * i; int row = c / KCH, ch = c - row * KCH; rk[i] = *(const u32x4*)(Kp + (size_t)(kt * 64 + row) * kstride + ch * 8); }
#pragma unroll
    for (int i = 0; i < 2; i++) { int c = tid + 256 * i; int row = c >> 3, ch = c & 7; rv[i] = *(const u32x4*)(Vtp + (size_t)row * vstride + kt * 64 + ch * 8); }
  };
  prefetch(SB ? ntiles - 1 : 0);
  for (int it = 0; it < ntiles; it++) {
    const int kt = SB ? ntiles - 1 - it : it;
    __syncthreads();
#pragma unroll
    for (int i = 0; i < NKL; i++) { int c = tid + 256 * i; int row = c / KCH, ch = c - row * KCH; *(u32x4*)(sK + row * KSTR + ch * 8) = rk[i]; }
#pragma unroll
    for (int i = 0; i < 2; i++) { int c = tid + 256 * i; int row = c >> 3, ch = c & 7; *(u32x4*)(sV + row * 72 + ch * 8) = rv[i]; }
    __syncthreads();
    { int nx = SB ? kt - 1 : kt + 1; if (it + 1 >= ntiles) nx = kt; prefetch(nx); }
    bool doit;
    if (SB) doit = wave_active && (kt * 64 < wave_q0 + 31);
    else doit = wave_active && (kt <= (wave_q0 >> 6));
    if (doit) {
    f32x16 S[2];
#pragma unroll
    for (int kb = 0; kb < 2; kb++) {
#pragma unroll
      for (int i = 0; i < 16; i++) S[kb][i] = 0.f;
#pragma unroll
      for (int ks = 0; ks < KS; ks++) {
        bf16x8 kf = *(const bf16x8*)(sK + (kb * 32 + r) * KSTR + ks * 16 + hl * 8);
        S[kb] = MFMA32(kf, qf[ks], S[kb]);
      }
    }
    const int key0 = kt * 64 + 4 * hl;
    if (!SB) {
      const bool need_mask = (kt + 1) * 64 > nkeys;
      if (need_mask) {
#pragma unroll
        for (int kb = 0; kb < 2; kb++)
#pragma unroll
          for (int i = 0; i < 16; i++) { int key = key0 + kb * 32 + (i & 3) + 8 * (i >> 2); if (key >= nkeys) S[kb][i] = -1e30f; }
      }
      float tmax = -1e30f;
#pragma unroll
      for (int kb = 0; kb < 2; kb++)
#pragma unroll
        for (int i = 0; i < 16; i++) tmax = fmaxf(tmax, S[kb][i]);
      tmax = fmaxf(tmax, __shfl_xor(tmax, 32));
      float m_new = fmaxf(m_run, tmax);
      float alpha = ex2(m_run - m_new);
      m_run = m_new;
      float ps = 0.f;
#pragma unroll
      for (int kb = 0; kb < 2; kb++)
#pragma unroll
        for (int i = 0; i < 16; i++) { float pv = ex2(S[kb][i] - m_new); S[kb][i] = pv; ps += pv; }
      l_run = l_run * alpha + ps;
#pragma unroll
      for (int b = 0; b < 2; b++)
#pragma unroll
        for (int i = 0; i < 16; i++) O[b][i] *= alpha;
    } else {
      const bool need_mask = (kt * 64 + 63 >= wave_q0) || ((kt + 1) * 64 > nkeys);
#pragma unroll
      for (int kb = 0; kb < 2; kb++)
#pragma unroll
        for (int i = 0; i < 16; i++) {
          float d = __builtin_amdgcn_rcpf(1.f + ex2(S[kb][i]));
          if (need_mask) { int key = key0 + kb * 32 + (i & 3) + 8 * (i >> 2); if (!(key < nkeys && key < qpos)) d = 1.f; }
          S[kb][i] = d;
        }
      float gs[8], pg[8], sa[8];
#pragma unroll
      for (int o = 0; o < 8; o++) { int kb = o >> 2, g = o & 3; gs[o] = (S[kb][4 * g] * S[kb][4 * g + 1]) * (S[kb][4 * g + 2] * S[kb][4 * g + 3]); }
#pragma unroll
      for (int o = 0; o < 8; o++) pg[o] = __shfl_xor(gs[o], 32);
      sa[7] = R;
#pragma unroll
      for (int o = 6; o >= 0; o--) sa[o] = sa[o + 1] * (gs[o + 1] * pg[o + 1]);
      const float total = sa[0] * (gs[0] * pg[0]);
#pragma unroll
      for (int o = 0; o < 8; o++) {
        int kb = o >> 2, g = o & 3;
        float c = hl == 0 ? sa[o] * pg[o] : sa[o];
#pragma unroll
        for (int e = 3; e >= 0; e--) {
          float d = S[kb][4 * g + e];
          S[kb][4 * g + e] = c - d * c;
          c *= d;
        }
      }
      R = total;
    }
#pragma unroll
    for (int kb = 0; kb < 2; kb++)
#pragma unroll
      for (int s2 = 0; s2 < 2; s2++) {
        uint4 u;
        u.x = pk2(S[kb][8 * s2], S[kb][8 * s2 + 1]); u.y = pk2(S[kb][8 * s2 + 2], S[kb][8 * s2 + 3]);
        u.z = pk2(S[kb][8 * s2 + 4], S[kb][8 * s2 + 5]); u.w = pk2(S[kb][8 * s2 + 6], S[kb][8 * s2 + 7]);
        bf16x8 pf = __builtin_bit_cast(bf16x8, u);
#pragma unroll
        for (int bd = 0; bd < 2; bd++) {
          const u16* vp = sV + (bd * 32 + r) * 72 + kb * 32 + s2 * 16 + hl * 4;
          uint2 lo = *(const uint2*)vp, hi = *(const uint2*)(vp + 8);
          uint4 vv; vv.x = lo.x; vv.y = lo.y; vv.z = hi.x; vv.w = hi.y;
          O[bd] = MFMA32(__builtin_bit_cast(bf16x8, vv), pf, O[bd]);
        }
      }
    }
    if (SB) {
      const bool lane_done = !wave_active || slot >= nq_valid || R < 1e-30f;
      const int wdone = __all(lane_done);
      if (__syncthreads_and(wdone)) break;
    }
  }
  if (wave_active && slot < nq_valid) {
    float sc = 1.f;
    if (!SB) { float lt = l_run + __shfl_xor(l_run, 32); sc = 1.f / lt; }
#pragma unroll
    for (int bd = 0; bd < 2; bd++)
#pragma unroll
      for (int g = 0; g < 4; g++) {
        int d0 = bd * 32 + 8 * g + 4 * hl;
        uint2 zz = *(const uint2*)(Zp + (size_t)slot * 512 + d0);
        uint2 o;
        o.x = pk2(O[bd][4 * g] * sc * bflo(zz.x), O[bd][4 * g + 1] * sc * bfhi(zz.x));
        o.y = pk2(O[bd][4 * g + 2] * sc * bflo(zz.y), O[bd][4 * g + 3] * sc * bfhi(zz.y));
        *(uint2*)(Yp + (size_t)slot * 512 + d0) = o;
      }
  }
}

template <int CTRL> DI float dpp_add(float x) {
  return x + __int_as_float(__builtin_amdgcn_update_dpp(0, __float_as_int(x), CTRL, 0xF, 0xF, true));
}
DI void allreduce16x2(float& a, float& b) {
  a = dpp_add<0xB1>(a); b = dpp_add<0xB1>(b); a = dpp_add<0x4E>(a); b = dpp_add<0x4E>(b);
  a = dpp_add<0x141>(a); b = dpp_add<0x141>(b); a = dpp_add<0x140>(a); b = dpp_add<0x140>(b);
}
#define SCAN_PREFETCH(slot, cc) { int c_ = (cc) < nch ? (cc) : nch - 1; size_t row = (size_t)(srow0 + c_ * 16 + lstep); \
    pw[slot] = *(const f32x4v*)(RWW + row * 512 + h * 64 + lpart); \
    _Pragma("unroll") for (int c = 0; c < 5; c++) px[slot][c] = *(const u32x2*)(RWX + row * 2560 + c * 512 + h * 64 + lpart); }
#define SCAN_STAGE(slot, bsel) { float* o = ops + ((bsel) * 16 + lstep) * 384 + lpart; \
    f32x4v r4 = {bflo(px[slot][0].x), bfhi(px[slot][0].x), bflo(px[slot][0].y), bfhi(px[slot][0].y)}; \
    f32x4v k4 = {bflo(px[slot][1].x), bfhi(px[slot][1].x), bflo(px[slot][1].y), bfhi(px[slot][1].y)}; \
    f32x4v v4 = {bflo(px[slot][2].x), bfhi(px[slot][2].x), bflo(px[slot][2].y), bfhi(px[slot][2].y)}; \
    f32x4v kk4 = {bflo(px[slot][3].x), bfhi(px[slot][3].x), bflo(px[slot][3].y), bfhi(px[slot][3].y)}; \
    f32x4v b4 = {bflo(px[slot][4].x), bfhi(px[slot][4].x), bflo(px[slot][4].y), bfhi(px[slot][4].y)}; \
    *(f32x4v*)(o) = pw[slot]; *(f32x4v*)(o + 64) = pw[slot] * r4; *(f32x4v*)(o + 128) = k4; *(f32x4v*)(o + 192) = v4; *(f32x4v*)(o + 256) = kk4; *(f32x4v*)(o + 320) = b4; \
    float br = b4.x * r4.x + b4.y * r4.y + b4.z * r4.z + b4.w * r4.w; \
    float kr = k4.x * r4.x + k4.y * r4.y + k4.z * r4.z + k4.w * r4.w; \
    allreduce16x2(br, kr); \
    if ((tid & 15) == 0) { sc[((bsel) * 16 + lstep) * 2] = br; sc[((bsel) * 16 + lstep) * 2 + 1] = kr; } }

DI void rwkv_pass1_task(const Params& p, int bh, int seg, int rq, unsigned char* smem) {
  float* ops = (float*)smem; float* sc = ops + 2 * 16 * 384;
  const int tid = TIDX(), i = tid >> 4, cg = tid & 15, cg4 = cg * 4;
  const int Rr = rq * 16 + i, h = bh & 7;
  const int srow0 = (bh >> 3) * TP + seg * 1024;
  const float* RWW = (const float*)(p.ws + W_RWW); const u16* RWX = (const u16*)(p.ws + W_RWX);
  float SL[4] = {0.f, 0.f, 0.f, 0.f}, SP[4];
#pragma unroll
  for (int e = 0; e < 4; e++) SP[e] = (cg4 + e == Rr) ? 1.f : 0.f;
  const int lstep = tid >> 4, lpart = (tid & 15) * 4;
  f32x4v pw[4]; u32x2 px[4][5];
  const int nch = 64;
  SCAN_PREFETCH(0, 0) SCAN_PREFETCH(1, 1) SCAN_PREFETCH(2, 2) SCAN_PREFETCH(3, 3)
  __syncthreads();
  SCAN_STAGE(0, 0)
  __syncthreads();
  __builtin_amdgcn_s_setprio(3);
  for (int cb = 0; cb < nch; cb += 4) {
#pragma unroll
    for (int k = 0; k < 4; k++) {
      const int c0 = cb + k;
      const int bsel = k & 1;
      SCAN_PREFETCH(k, c0 + 4)
#pragma unroll
      for (int st = 0; st < 16; st++) {
        const float* o = ops + (bsel * 16 + st) * 384;
        f32x4v w = *(const f32x4v*)(o + cg4), kp = *(const f32x4v*)(o + 128 + cg4);
        f32x4v kkv = *(const f32x4v*)(o + 256 + cg4), bb = *(const f32x4v*)(o + 320 + cg4);
        float v = o[192 + Rr];
        float d1 = SL[0] * kkv.x + SL[1] * kkv.y + SL[2] * kkv.z + SL[3] * kkv.w;
        float d2 = SP[0] * kkv.x + SP[1] * kkv.y + SP[2] * kkv.z + SP[3] * kkv.w;
        allreduce16x2(d1, d2);
        const float saL = -d1, saP = -d2;
        SL[0] = SL[0] * w.x + (saL * bb.x + v * kp.x); SP[0] = SP[0] * w.x + saP * bb.x;
        SL[1] = SL[1] * w.y + (saL * bb.y + v * kp.y); SP[1] = SP[1] * w.y + saP * bb.y;
        SL[2] = SL[2] * w.z + (saL * bb.z + v * kp.z); SP[2] = SP[2] * w.z + saP * bb.z;
        SL[3] = SL[3] * w.w + (saL * bb.w + v * kp.w); SP[3] = SP[3] * w.w + saP * bb.w;
      }
      SCAN_STAGE(((k + 1) & 3), (bsel ^ 1))
      __syncthreads();
    }
  }
  __builtin_amdgcn_s_setprio(0);
  const size_t so = ((size_t)(bh * 7 + seg)) * 4096 + Rr * 64 + cg4;
  *(float4*)((float*)(p.ws + W_SLOC) + so) = make_float4(SL[0], SL[1], SL[2], SL[3]);
  *(float4*)((float*)(p.ws + W_PMAT) + so) = make_float4(SP[0], SP[1], SP[2], SP[3]);
}

DI void allreduce16x4(float& a, float& b, float& c, float& d) {
  a = dpp_add<0xB1>(a); b = dpp_add<0xB1>(b); c = dpp_add<0xB1>(c); d = dpp_add<0xB1>(d);
  a = dpp_add<0x4E>(a); b = dpp_add<0x4E>(b); c = dpp_add<0x4E>(c); d = dpp_add<0x4E>(d);
  a = dpp_add<0x141>(a); b = dpp_add<0x141>(b); c = dpp_add<0x141>(c); d = dpp_add<0x141>(d);
  a = dpp_add<0x140>(a); b = dpp_add<0x140>(b); c = dpp_add<0x140>(c); d = dpp_add<0x140>(d);
}
DI void rwkv_scan_task(const Params& p, int srow0, int T, int h, int rq, const float* S0, float* Sout, int comb_bh, int comb_seg, unsigned char* smem) {
  if (rq & 1) return;
  float* ops = (float*)smem;
  float* sc = ops + 2 * 16 * 384;
  float* ybuf = sc + 64;
  const int tid = TIDX(), i = tid >> 4, cg = tid & 15, cg4 = cg * 4;
  const float* RWW = (const float*)(p.ws + W_RWW); const u16* RWX = (const u16*)(p.ws + W_RWX); float* YRAW = (float*)(p.ws + W_YRAW);
  float S[2][4];
#pragma unroll
  for (int g = 0; g < 2; g++) {
    const int Rr = (rq + g) * 16 + i;
    if (S0) { float4 s = *(const float4*)(S0 + Rr * 64 + cg4); S[g][0] = s.x; S[g][1] = s.y; S[g][2] = s.z; S[g][3] = s.w; }
    else { S[g][0] = S[g][1] = S[g][2] = S[g][3] = 0.f; }
  }
  if (comb_bh >= 0 && comb_seg > 0) {
    const float* SLOC = (const float*)(p.ws + W_SLOC) + (size_t)comb_bh * 7 * 4096;
    const float* PMAT = (const float*)(p.ws + W_PMAT) + (size_t)comb_bh * 7 * 4096;
    float* srow = ops;
#pragma unroll
    for (int g = 0; g < 2; g++) { float4 s = *(const float4*)(SLOC + ((rq + g) * 16 + i) * 64 + cg4); S[g][0] = s.x; S[g][1] = s.y; S[g][2] = s.z; S[g][3] = s.w; }
    for (int sp = 1; sp < comb_seg; sp++) {
      __syncthreads();
#pragma unroll
      for (int g = 0; g < 2; g++) *(float4*)(srow + (g * 16 + i) * 64 + cg4) = make_float4(S[g][0], S[g][1], S[g][2], S[g][3]);
      __syncthreads();
      float4 a0 = *(const float4*)(SLOC + (size_t)sp * 4096 + (rq * 16 + i) * 64 + cg4);
      float4 a1 = *(const float4*)(SLOC + (size_t)sp * 4096 + (rq * 16 + 16 + i) * 64 + cg4);
      const float* P = PMAT + (size_t)sp * 4096 + cg4;
#pragma unroll 8
      for (int k = 0; k < 64; k++) {
        float s0 = srow[i * 64 + k], s1 = srow[(16 + i) * 64 + k]; float4 pv = *(const float4*)(P + k * 64);
        a0.x += s0 * pv.x; a0.y += s0 * pv.y; a0.z += s0 * pv.z; a0.w += s0 * pv.w;
        a1.x += s1 * pv.x; a1.y += s1 * pv.y; a1.z += s1 * pv.z; a1.w += s1 * pv.w;
      }
      S[0][0] = a0.x; S[0][1] = a0.y; S[0][2] = a0.z; S[0][3] = a0.w;
      S[1][0] = a1.x; S[1][1] = a1.y; S[1][2] = a1.z; S[1][3] = a1.w;
    }
  }
  const int lstep = tid >> 4, lpart = (tid & 15) * 4;
  f32x4v pw[2]; u32x2 px[2][5];
  const int nch = T >> 4;
  SCAN_PREFETCH(0, 0) SCAN_PREFETCH(1, 1)
  __syncthreads();
  SCAN_STAGE(0, 0)
  __syncthreads();
  __builtin_amdgcn_s_setprio(3);
  for (int cb = 0; cb < nch; cb += 4) {
#pragma unroll
    for (int k = 0; k < 4; k++) {
      const int c0 = cb + k;
      if (c0 < nch) {
        const int bsel = k & 1;
        SCAN_PREFETCH((k & 1), c0 + 2)
        float yk0 = 0.f, yk1 = 0.f;
#pragma unroll 8
        for (int st = 0; st < 16; st++) {
          const float* o = ops + (bsel * 16 + st) * 384;
          f32x4v w = *(const f32x4v*)(o + cg4), wr = *(const f32x4v*)(o + 64 + cg4), kp = *(const f32x4v*)(o + 128 + cg4);
          f32x4v kkv = *(const f32x4v*)(o + 256 + cg4), bb = *(const f32x4v*)(o + 320 + cg4);
          float v0 = o[192 + rq * 16 + i], v1 = o[192 + rq * 16 + 16 + i];
          float br = sc[(bsel * 16 + st) * 2], kr = sc[(bsel * 16 + st) * 2 + 1];
          float da0 = S[0][0] * kkv.x + S[0][1] * kkv.y + S[0][2] * kkv.z + S[0][3] * kkv.w;
          float dy0 = S[0][0] * wr.x + S[0][1] * wr.y + S[0][2] * wr.z + S[0][3] * wr.w;
          float da1 = S[1][0] * kkv.x + S[1][1] * kkv.y + S[1][2] * kkv.z + S[1][3] * kkv.w;
          float dy1 = S[1][0] * wr.x + S[1][1] * wr.y + S[1][2] * wr.z + S[1][3] * wr.w;
          allreduce16x4(da0, dy0, da1, dy1);
          S[0][0] = S[0][0] * w.x + (v0 * kp.x - da0 * bb.x); S[1][0] = S[1][0] * w.x + (v1 * kp.x - da1 * bb.x);
          S[0][1] = S[0][1] * w.y + (v0 * kp.y - da0 * bb.y); S[1][1] = S[1][1] * w.y + (v1 * kp.y - da1 * bb.y);
          S[0][2] = S[0][2] * w.z + (v0 * kp.z - da0 * bb.z); S[1][2] = S[1][2] * w.z + (v1 * kp.z - da1 * bb.z);
          S[0][3] = S[0][3] * w.w + (v0 * kp.w - da0 * bb.w); S[1][3] = S[1][3] * w.w + (v1 * kp.w - da1 * bb.w);
          float y0 = dy0 - da0 * br + v0 * kr, y1 = dy1 - da1 * br + v1 * kr;
          yk0 = (cg == st) ? y0 : yk0; yk1 = (cg == st) ? y1 : yk1;
        }
        ybuf[bsel * 512 + cg * 16 + i] = yk0; ybuf[bsel * 512 + 256 + cg * 16 + i] = yk1;
        SCAN_STAGE(((k + 1) & 1), (bsel ^ 1))
        __syncthreads();
        {
          float* yo = YRAW + (size_t)(srow0 + c0 * 16 + (tid >> 4)) * 512 + h * 64 + rq * 16 + (tid & 15);
          yo[0] = ybuf[bsel * 512 + tid]; yo[16] = ybuf[bsel * 512 + 256 + tid];
        }
      }
    }
  }
  __builtin_amdgcn_s_setprio(0);
  if (Sout) {
#pragma unroll
    for (int g = 0; g < 2; g++) *(float4*)(Sout + ((rq + g) * 16 + i) * 64 + cg4) = make_float4(S[g][0], S[g][1], S[g][2], S[g][3]);
  }
}
constexpr int PH5_TASKS = 512 + 128 + 2048 + 256;
DI void phase5_task(const Params& p, int l, int task, unsigned char* smem) {
  const u16* Z = (const u16*)(p.ws + W_Z); u16* YG = (u16*)(p.ws + W_YG);
  if (task < 512) {
    int bh = task >> 5, seg = 7 - ((task >> 2) & 7), rq = task & 3, b = bh >> 3, h = bh & 7;
    rwkv_scan_task(p, b * TP + seg * 1024, 1024, h, rq, nullptr, seg == 7 ? p.out + O_WKV_P + ((size_t)((l * 2 + b) * 8 + h)) * 4096 : nullptr, bh, seg, smem);
    return;
  }
  task -= 448;
  if (task < 2240) {
    int which, b, h, row0, nq, qpos0, kbase, nkeys; size_t vto; int vstr;
    if (task < 192) { int j = task - 64; which = j >> 6; int bh = j & 63; b = bh >> 3; h = bh & 7; row0 = NP + b * 16; nq = 16; qpos0 = PAST; kbase = NP + b * SK; nkeys = SK; vto = VT_S_OFF + (size_t)((b * 8 + h) * 64) * SK; vstr = SK; }
    else { int j = task - 192; int qb = 63 - (j >> 5); which = (j >> 4) & 1; int bh = j & 15; b = bh >> 3; h = bh & 7; row0 = b * TP + qb * 128; nq = 128; qpos0 = qb * 128; kbase = b * TP; nkeys = TP; vto = (size_t)((b * 8 + h) * 64) * 8192; vstr = 8192; }
    if (which == 0)
      attn_task<64, true>((const u16*)(p.ws + W_SQ) + (size_t)row0 * 512 + h * 64, 512, nq, (const u16*)(p.ws + W_SBK) + (size_t)kbase * 512 + h * 64, 512,
                          (const u16*)(p.ws + W_SBVT) + vto, vstr, nkeys, qpos0, Z + ((size_t)2 * NT + row0) * 512 + h * 64, YG + ((size_t)2 * NT + row0) * 512 + h * 64, smem);
    else
      attn_task<96, false>((const u16*)(p.ws + W_QF) + (size_t)row0 * 768 + h * 96, 768, nq, (const u16*)(p.ws + W_KF) + (size_t)kbase * 768 + h * 96, 768,
                           (const u16*)(p.ws + W_MLAVT) + vto, vstr, nkeys, qpos0, Z + ((size_t)1 * NT + row0) * 512 + h * 64, YG + ((size_t)1 * NT + row0) * 512 + h * 64, smem);
    return;
  }
  {
    int j = task - 2240; int bh = j >> 2, rq = j & 3, b = bh >> 3, h = bh & 7;
    size_t so = ((size_t)((l * 8 + b) * 8 + h)) * 4096;
    rwkv_scan_task(p, NP + b * 16, 16, h, rq, p.in[2] + so, p.out + O_WKV_S + so, -1, 0, smem);
  }
}
DI void phase5(const Params& p, int l, unsigned char* smem) {
  __shared__ int s_task;
  int* ctr = (int*)(p.ws + W_CTR) + l;
  while (true) {
    __syncthreads();
    if (TIDX() == 0) s_task = atomicAdd(ctr, 1);
    __syncthreads();
    int q = s_task;
    if (q >= PH5_TASKS) break;
    int task = q < 1024 ? ((q & 1) ? 512 + (q >> 1) : (q >> 1)) : q;
    phase5_task(p, l, task, smem);
  }
}
DI void phase5b(const Params& p, int l) {
  const int lane = TIDX() & 63, wave = TIDX() >> 6;
  const float* YRAW = (const float*)(p.ws + W_YRAW); const u16* RWX = (const u16*)(p.ws + W_RWX); const float* RHO = (const float*)(p.ws + W_RHO);
  const u16* Z = (const u16*)(p.ws + W_Z); u16* YG = (u16*)(p.ws + W_YG);
  for (int task = blockIdx.x; task < NT / 4; task += gridDim.x) {
    const int row = task * 4 + wave, c0 = lane * 8;
    float y[8];
    { float4 a = *(const float4*)(YRAW + (size_t)row * 512 + c0), b = *(const float4*)(YRAW + (size_t)row * 512 + c0 + 4);
      y[0] = a.x; y[1] = a.y; y[2] = a.z; y[3] = a.w; y[4] = b.x; y[5] = b.y; y[6] = b.z; y[7] = b.w; }
    float s = 0.f;
#pragma unroll
    for (int j = 0; j < 8; j++) s += y[j];
    s += __shfl_xor(s, 1); s += __shfl_xor(s, 2); s += __shfl_xor(s, 4);
    float mu = s * (1.f / 64.f), vs = 0.f;
#pragma unroll
    for (int j = 0; j < 8; j++) { float d = y[j] - mu; vs += d * d; }
    vs += __shfl_xor(vs, 1); vs += __shfl_xor(vs, 2); vs += __shfl_xor(vs, 4);
    float rstd = rsqrtf(vs * (1.f / 64.f) + GN_EPS);
    float rho = RHO[(size_t)row * 8 + (lane >> 3)];
    uint4 vv = *(const uint4*)(RWX + (size_t)row * 2560 + 1024 + c0);
    uint4 zz = *(const uint4*)(Z + (size_t)row * 512 + c0);
    float vf[8] = {bflo(vv.x), bfhi(vv.x), bflo(vv.y), bfhi(vv.y), bflo(vv.z), bfhi(vv.z), bflo(vv.w), bfhi(vv.w)};
    float zf[8] = {bflo(zz.x), bfhi(zz.x), bflo(zz.y), bfhi(zz.y), bflo(zz.z), bfhi(zz.z), bflo(zz.w), bfhi(zz.w)};
    float o[8];
#pragma unroll
    for (int j = 0; j < 8; j++) o[j] = ((y[j] - mu) * rstd * p.in[22][l * 512 + c0 + j] + p.in[23][l * 512 + c0 + j] + rho * vf[j]) * zf[j];
    uint4 ob; ob.x = pk2(o[0], o[1]); ob.y = pk2(o[2], o[3]); ob.z = pk2(o[4], o[5]); ob.w = pk2(o[6], o[7]);
    *(uint4*)(YG + (size_t)row * 512 + c0) = ob;
  }
}

DI void wave_gemm32(f32x16& acc, const u16* A, int lda, const u16* Bt, int ldb, int K) {
  const int lane = TIDX() & 63, r = lane & 31, hl = lane >> 5;
  const u16* ap = A + (size_t)r * lda + hl * 8; const u16* bp = Bt + (size_t)r * ldb + hl * 8;
#pragma unroll 8
  for (int k = 0; k < K; k += 16) { bf16x8 a = *(const bf16x8*)(ap + k); bf16x8 b = *(const bf16x8*)(bp + k); acc = MFMA32(a, b, acc); }
}
DI void phase6(const Params& p, int l, unsigned char* smem) {
  const u16* H = (const u16*)(p.ws + W_H); const u16* WinT = (const u16*)(p.ws + W_WINT);
  const u16* YG = (const u16*)(p.ws + W_YG); u16* MG = (u16*)(p.ws + W_MG);
  for (int t0 = blockIdx.x; t0 < 32 + 128 * 8; t0 += gridDim.x) {
    if (t0 < 32) {
      const int lane = TIDX() & 63, wave = TIDX() >> 6, r = lane & 31, hl = lane >> 5;
      const int unit = t0 * 4 + wave, row0 = NP + (unit & 3) * 32, n0 = (unit >> 2) * 32;
      f32x16 mm;
#pragma unroll
      for (int i = 0; i < 16; i++) mm[i] = 0.f;
#pragma unroll 1
      for (int g = 0; g < 3; g++) {
        f32x16 ay, ag;
#pragma unroll
        for (int i = 0; i < 16; i++) { ay[i] = 0.f; ag[i] = 0.f; }
        wave_gemm32(ay, YG + ((size_t)g * NT + row0) * 512, 512, (const u16*)(p.ws + W_WBRT) + ((size_t)(l * 3 + g) * 1024 + n0) * 512, 512, 512);
        wave_gemm32(ag, H + (size_t)row0 * 1024, 1024, WinT + (size_t)(5408 + g * 1024 + n0) * 1024, 1024, 1024);
#pragma unroll
        for (int i = 0; i < 16; i++) mm[i] += sigmoidf_(ag[i]) * ay[i];
      }
#pragma unroll
      for (int i = 0; i < 16; i++) MG[(size_t)(row0 + crow(i, hl)) * 1024 + n0 + r] = f2bf(mm[i]);
      continue;
    }
    const int t = t0 - 32;
    const int bq = t & 511, mt = (bq & 7) * 16 + ((bq >> 3) & 15), nt = (t >> 9) * 4 + (bq >> 7), m0 = mt * 128, n0 = nt * 128;

    unsigned mpk[2][2][8];
#pragma unroll
    for (int a = 0; a < 2; a++)
#pragma unroll
      for (int b = 0; b < 2; b++)
#pragma unroll
        for (int j = 0; j < 8; j++) mpk[a][b][j] = 0u;
#pragma unroll 1
    for (int g = 0; g < 3; g++) {
      f32x16 acc[2][2]; zero_acc(acc);
      gemm_mainloop(acc, YG + ((size_t)g * NT + m0) * 512, 512, (const u16*)(p.ws + W_WBRT) + ((size_t)(l * 3 + g) * 1024 + n0) * 512, 512, 512, smem);
      unsigned ypk[2][2][8];
#pragma unroll
      for (int a = 0; a < 2; a++)
#pragma unroll
        for (int b = 0; b < 2; b++)
#pragma unroll
          for (int j = 0; j < 8; j++) ypk[a][b][j] = pk2(acc[a][b][2 * j], acc[a][b][2 * j + 1]);
      zero_acc(acc);
      gemm_mainloop(acc, H + (size_t)m0 * 1024, 1024, WinT + (size_t)(5408 + g * 1024 + n0) * 1024, 1024, 1024, smem);
#pragma unroll
      for (int a = 0; a < 2; a++)
#pragma unroll
        for (int b = 0; b < 2; b++)
#pragma unroll
          for (int j = 0; j < 8; j++) {
            float lo = bflo(mpk[a][b][j]) + sigmoidf_(acc[a][b][2 * j]) * bflo(ypk[a][b][j]);
            float hi = bfhi(mpk[a][b][j]) + sigmoidf_(acc[a][b][2 * j + 1]) * bfhi(ypk[a][b][j]);
            mpk[a][b][j] = pk2(lo, hi);
          }
    }
    {
      const int lane = TIDX() & 63, wave = TIDX() >> 6, wm = wave >> 1, wn = wave & 1, r = lane & 31, hl = lane >> 5;
#pragma unroll
      for (int a = 0; a < 2; a++)
#pragma unroll
        for (int b = 0; b < 2; b++)
#pragma unroll
          for (int j = 0; j < 8; j++) {
            int col = n0 + wn * 64 + b * 32 + r;
            int row0 = m0 + wm * 64 + a * 32;
            MG[(size_t)(row0 + crow(2 * j, hl)) * 1024 + col] = (u16)(mpk[a][b][j] & 0xffffu);
            MG[(size_t)(row0 + crow(2 * j + 1, hl)) * 1024 + col] = (u16)(mpk[a][b][j] >> 16);
          }
    }
  }
}
DI void phase7(const Params& p, int l, unsigned char* smem) {
  const u16* MG = (const u16*)(p.ws + W_MG);
  const float* mod = (const float*)(p.ws + W_MOD);
  const int ntile = 32 + 128 * 8, nextra = (l + 1 < NL) ? WIN_TT + SMALLW_TT : 0;
  for (int t0 = blockIdx.x; t0 < ntile + nextra; t0 += gridDim.x) {
    if (t0 >= ntile + WIN_TT) { smallw_transpose_task(p, l + 1, t0 - ntile - WIN_TT, smem); continue; }
    if (t0 >= ntile) { win_transpose_task(p, l + 1, t0 - ntile, smem); continue; }
    if (t0 < 32) {
      const int lane = TIDX() & 63, wave = TIDX() >> 6, r = lane & 31, hl = lane >> 5;
      const int unit = t0 * 4 + wave, row0 = NP + (unit & 3) * 32, n0 = (unit >> 2) * 32;
      f32x16 a;
#pragma unroll
      for (int i = 0; i < 16; i++) a[i] = 0.f;
      wave_gemm32(a, MG + (size_t)row0 * 1024, 1024, (const u16*)(p.ws + W_WOUTT) + ((size_t)l * 1024 + n0) * 1024, 1024, 1024);
#pragma unroll
      for (int i = 0; i < 16; i++) {
        const int row = row0 + crow(i, hl), col = n0 + r;
        float xo = xrow_ptr(p, l, row)[col];
        float gt = mod[(l * 10 + bidx_of(row)) * 3072 + 2048 + col];
        p.out[(size_t)row * D + col] = xo + gt * a[i];
      }
      continue;
    }
    const int t = t0 - 32;
    const int bq = t & 511, mt = (bq & 7) * 16 + ((bq >> 3) & 15), nt = (t >> 9) * 4 + (bq >> 7), m0 = mt * 128, n0 = nt * 128;

    f32x16 acc[2][2]; zero_acc(acc);
    gemm_mainloop(acc, MG + (size_t)m0 * 1024, 1024, (const u16*)(p.ws + W_WOUTT) + ((size_t)l * 1024 + n0) * 1024, 1024, 1024, smem);
    foreach_acc(acc, m0, n0, [&](int row, int col, float v) {
      float xo = xrow_ptr(p, l, row)[col];
      float gt = mod[(l * 10 + bidx_of(row)) * 3072 + 2048 + col];
      p.out[(size_t)row * D + col] = xo + gt * v;
    });
  }
}

#define XB_TMO      128
#define XB_XCNT(j)  (256  + 64 * (j))
#define XB_XSUB(j)  (1280 + 64 * (j))
#define XB_XGEN(j)  (2304 + 64 * (j))
#define XB_TOP      3328
#define XB_TOPGEN   3392
#define XB_SPIN_CAP (1u << 18)
DI unsigned xb_ld(unsigned* q) { return __hip_atomic_load(q, __ATOMIC_RELAXED, __HIP_MEMORY_SCOPE_AGENT); }
DI unsigned xb_add(unsigned* q, unsigned v) { return __hip_atomic_fetch_add(q, v, __ATOMIC_RELAXED, __HIP_MEMORY_SCOPE_AGENT); }
DI unsigned xb_xcc_id() { return (unsigned)__builtin_amdgcn_s_getreg((3 << 11) | 20) & 0xFu; }
#define XB_SPIN(cond, bar) do { unsigned _sp = 0; while (cond) { __builtin_amdgcn_s_sleep(1); \
    if ((++_sp & 255u) == 0u) { if (xb_ld(&(bar)[XB_TMO])) break; if (_sp > XB_SPIN_CAP) { atomicAdd(&(bar)[XB_TMO], 1u); break; } } } } while (0)
DI void xbar(const Params& p, unsigned* xbst) {
  asm volatile("s_waitcnt vmcnt(0)" ::: "memory");
  __syncthreads();
  if (TIDX() == 0) {
    unsigned* bar = (unsigned*)(p.ws + W_XBAR);
    const unsigned x = xb_xcc_id();
    __builtin_amdgcn_s_waitcnt(0);
    const unsigned nloc = xbst[0], nx = xbst[1];
    const unsigned old = xb_add(&bar[XB_XSUB(x)], 1u);
    const unsigned gen = old / nloc;
    if (old + 1u == (gen + 1u) * nloc) {
      __builtin_amdgcn_fence(__ATOMIC_RELEASE, "agent");
      asm volatile("s_waitcnt vmcnt(0)" ::: "memory");
      const unsigned og = xb_add(&bar[XB_TOP], 1u);
      const unsigned tg = og / nx;
      if (og + 1u == (tg + 1u) * nx) xb_add(&bar[XB_TOPGEN], 1u);
      else XB_SPIN(xb_ld(&bar[XB_TOPGEN]) == tg, bar);
      __builtin_amdgcn_fence(__ATOMIC_ACQUIRE, "agent");
      xb_add(&bar[XB_XGEN(x)], 1u);
      asm volatile("s_waitcnt vmcnt(0)" ::: "memory");
    } else {
      XB_SPIN(xb_ld(&bar[XB_XGEN(x)]) == gen, bar);
      __builtin_amdgcn_fence(__ATOMIC_ACQUIRE, "agent");
      asm volatile("s_waitcnt vmcnt(0)" ::: "memory");
    }
  }
  __syncthreads();
}
DI int opq(int v) { asm volatile("" : "+s"(v)); return v; }
#if MULTI
template <int PH> __global__ void __launch_bounds__(256, 2) phase_kernel(Params p, int l) {
  __shared__ __attribute__((aligned(16))) unsigned char smem[SMEM_BYTES];
  if (PH == 0) phase0(p, smem);
  if (PH == 1) phase1(p, l);
  if (PH == 2) phase2(p, l, smem);
  if (PH == 3) phase3(p, l);
  if (PH == 4) phase4(p, l, smem);
  if (PH == 5) phase5(p, l, smem);
  if (PH == 6) phase5b(p, l);
  if (PH == 7) phase6(p, l, smem);
  if (PH == 8) phase7(p, l, smem);
}
#else
__global__ void __launch_bounds__(256, 2) mega_kernel(Params p_arg) {
  __shared__ __attribute__((aligned(16))) unsigned char smem[SMEM_BYTES];
  const Params& p = *(const Params*)__builtin_amdgcn_kernarg_segment_ptr();
  cg::grid_group grid = cg::this_grid();
  __shared__ unsigned xbst[4];
  if (TIDX() == 0) (void)xb_add((unsigned*)(p.ws + W_XBAR) + XB_XCNT(xb_xcc_id()), 1u);
  phase0(p, smem);
  grid.sync();
  if (TIDX() == 0) {
    unsigned* bar = (unsigned*)(p.ws + W_XBAR);
    const unsigned x = xb_xcc_id();
    unsigned cnt = 0u, mine = 0u;
    for (unsigned j = 0; j < 16; ++j) { const unsigned c = xb_ld(&bar[XB_XCNT(j)]); cnt += (c > 0u) ? 1u : 0u; mine = (j == x) ? c : mine; }
    xbst[0] = mine > 0u ? mine : 1u; xbst[1] = cnt > 0u ? cnt : 1u;
  }
  for (int l = 0; l < NL; l++) {
    phase1(p, opq(l)); xbar(p, xbst);
    phase2(p, opq(l), smem); xbar(p, xbst);
    phase3(p, opq(l)); xbar(p, xbst);
    phase4(p, opq(l), smem); xbar(p, xbst);
    phase5(p, opq(l), smem); xbar(p, xbst);
    phase5b(p, opq(l)); xbar(p, xbst);
    phase6(p, opq(l), smem); xbar(p, xbst);
    phase7(p, opq(l), smem); xbar(p, xbst);
  }
}
#endif

extern "C" void kernel_launch(void* const* d_in, const int* in_sizes, int n_in, void* d_out, int out_size, void* d_ws, size_t ws_size, hipStream_t stream) {
  Params p{};
  for (int i = 0; i < 36; i++) p.in[i] = (const float*)d_in[i];
  p.out = (float*)d_out;
  p.ws = (unsigned char*)d_ws;
  if (ws_size < W_TOTAL) fprintf(stderr, "workspace too small: %zu < %zu\n", ws_size, (size_t)W_TOTAL);
  hipMemsetAsync((unsigned char*)d_ws + W_CTR, 0, 256 + 3456 * 4, stream);
#if MULTI
  const int G = 1024;
  phase_kernel<0><<<G, 256, 0, stream>>>(p, 0);
  for (int l = 0; l < NL; l++) {
    phase_kernel<1><<<G, 256, 0, stream>>>(p, l);
    phase_kernel<2><<<G, 256, 0, stream>>>(p, l);
    phase_kernel<3><<<G, 256, 0, stream>>>(p, l);
    phase_kernel<4><<<G, 256, 0, stream>>>(p, l);
    phase_kernel<5><<<G, 256, 0, stream>>>(p, l);
    phase_kernel<6><<<G, 256, 0, stream>>>(p, l);
    phase_kernel<7><<<G, 256, 0, stream>>>(p, l);
    phase_kernel<8><<<G, 256, 0, stream>>>(p, l);
  }
#else
  static int grid_blocks = 0;
  if (!grid_blocks) {
    int dev = 0, cus = 0, per_cu = 0;
    hipGetDevice(&dev);
    hipDeviceGetAttribute(&cus, hipDeviceAttributeMultiprocessorCount, dev);
    hipOccupancyMaxActiveBlocksPerMultiprocessor(&per_cu, mega_kernel, 256, 0);
    if (per_cu > 2) per_cu = 2;
    grid_blocks = cus * per_cu;
  }
  void* args[] = {&p};
  hipError_t e = hipLaunchCooperativeKernel((void*)mega_kernel, dim3(grid_blocks), dim3(256), args, 0, stream);
  if (e != hipSuccess) fprintf(stderr, "cooperative launch failed: %s (grid %d)\n", hipGetErrorString(e), grid_blocks);
#endif
}
```

```cpp
#include <hip/hip_runtime.h>
#include <hip/hip_cooperative_groups.h>
#include <cstdio>
namespace cg = cooperative_groups;

#ifndef MULTI
#define MULTI 0
#endif

typedef unsigned short u16;
typedef __attribute__((ext_vector_type(8))) short bf16x8;
typedef __attribute__((ext_vector_type(16))) float f32x16;
typedef __attribute__((ext_vector_type(2))) __bf16 bf2_t;
typedef __attribute__((ext_vector_type(2))) float f2_t;
typedef __attribute__((ext_vector_type(4))) unsigned u32x4;
typedef __attribute__((ext_vector_type(2))) unsigned u32x2;
typedef __attribute__((ext_vector_type(4))) float f32x4v;
#define DI __device__ __forceinline__
#define MFMA32(a, b, c) __builtin_amdgcn_mfma_f32_32x32x16_bf16((a), (b), (c), 0, 0, 0)

constexpr int D = 1024, NL = 4, NP = 16384, NS = 128, NT = NP + NS, TP = 8192, TS = 16, PAST = 2048, SK = 2064;
constexpr int NKV = NP + 8 * SK;
constexpr int DIN = 8480;
constexpr float RMS_EPS = 1e-6f, GN_EPS = 64e-5f;
constexpr float LOG2E = 1.4426950408889634f;
constexpr float QSCALE_MLA = 0.10206207261596577f * LOG2E;
constexpr float QSCALE_SB = 0.125f * LOG2E;

constexpr size_t O_Y = 0;
constexpr size_t O_WKV_P = (size_t)NT * D;
constexpr size_t O_SHIFT_P = O_WKV_P + (size_t)NL * 2 * 8 * 4096;
constexpr size_t O_CKV_P = O_SHIFT_P + (size_t)NL * 2 * 1664;
constexpr size_t O_KROPE_P = O_CKV_P + (size_t)NL * NP * 256;
constexpr size_t O_SBK_P = O_KROPE_P + (size_t)NL * NP * 32;
constexpr size_t O_SBV_P = O_SBK_P + (size_t)NL * NP * 512;
constexpr size_t O_WKV_S = O_SBV_P + (size_t)NL * NP * 512;
constexpr size_t O_SHIFT_S = O_WKV_S + (size_t)NL * 8 * 8 * 4096;
constexpr size_t O_CKV_S = O_SHIFT_S + (size_t)NL * 8 * 1664;
constexpr size_t O_KROPE_S = O_CKV_S + (size_t)NL * NS * 256;
constexpr size_t O_SBK_S = O_KROPE_S + (size_t)NL * NS * 32;
constexpr size_t O_SBV_S = O_SBK_S + (size_t)NL * NS * 512;

constexpr size_t al(size_t x) { return (x + 255) & ~(size_t)255; }
constexpr size_t W_WINT = 0;
constexpr size_t W_WBRT = al(W_WINT + (size_t)DIN * 1024 * 2);
constexpr size_t W_WOUTT = al(W_WBRT + (size_t)NL * 3 * 1024 * 512 * 2);
constexpr size_t W_WUQT = al(W_WOUTT + (size_t)NL * 1024 * 1024 * 2);
constexpr size_t W_WUKVT = al(W_WUQT + (size_t)NL * 768 * 384 * 2);
constexpr size_t W_WUPT = al(W_WUKVT + (size_t)NL * 1024 * 256 * 2);
constexpr size_t W_AUPT = al(W_WUPT + (size_t)NL * 512 * 64 * 2);
constexpr size_t W_MOD = al(W_AUPT + (size_t)NL * 512 * 64 * 2);
constexpr size_t W_ROPE = al(W_MOD + (size_t)NL * 10 * 3072 * 4);
constexpr size_t W_CTR = al(W_ROPE + (size_t)8192 * 32 * 4);
constexpr size_t W_XBAR = W_CTR + 256;
constexpr size_t W_H = al(W_XBAR + 3456 * 4);
constexpr size_t W_PR = al(W_H + (size_t)NT * 1024 * 2);
constexpr size_t W_YG = W_PR;
constexpr size_t W_YRAW = al(W_YG + (size_t)3 * NT * 512 * 2);
constexpr size_t W_MG = W_YRAW;
constexpr size_t W_Z = al(W_PR + (size_t)NT * 1664 * 4);
constexpr size_t W_CQ = al(W_Z + (size_t)3 * NT * 512 * 2);
constexpr size_t W_QF = W_CQ;
constexpr size_t W_CKV = al(W_CQ + (size_t)NT * 768 * 2);
constexpr size_t W_KR = al(W_CKV + (size_t)NT * 256 * 4);
constexpr size_t W_QN = al(W_KR + (size_t)NT * 32 * 4);
constexpr size_t W_CKVN = al(W_QN + (size_t)NT * 384 * 2);
constexpr size_t W_SQ = al(W_CKVN + (size_t)(NKV + 64) * 256 * 2);
constexpr size_t W_SBK = al(W_SQ + (size_t)NT * 512 * 2);
constexpr size_t VT_S_OFF = (size_t)16 * 64 * 8192;
constexpr size_t VT_ELEMS = VT_S_OFF + (size_t)64 * 64 * SK + 256;
constexpr size_t W_SBVT = al(W_SBK + (size_t)(NKV + 64) * 512 * 2);
constexpr size_t W_RWW = al(W_SBVT + VT_ELEMS * 2);
constexpr size_t W_RWX = al(W_RWW + (size_t)NT * 512 * 4);
constexpr size_t W_RHO = al(W_RWX + (size_t)NT * 5 * 512 * 2);
constexpr size_t W_KF = al(W_RHO + (size_t)NT * 8 * 4);
constexpr size_t W_MLAVT = al(W_KF + (size_t)(NKV + 64) * 768 * 2);
constexpr size_t W_SLOC = al(W_MLAVT + VT_ELEMS * 2);
constexpr size_t W_PMAT = al(W_SLOC + (size_t)16 * 7 * 4096 * 4);
constexpr size_t W_TOTAL = al(W_PMAT + (size_t)16 * 7 * 4096 * 4);
static_assert((size_t)NT * 384 * 4 <= (size_t)NT * 768 * 2, "alias");
static_assert(W_YRAW + (size_t)NT * 1024 * 2 <= W_Z, "alias overflow");

struct Params {
  const float* in[36];
  float* out;
  unsigned char* ws;
};

constexpr int SMEM_BYTES = 73728;

DI int TIDX() { int t = __builtin_amdgcn_workitem_id_x(); asm volatile("" : "+v"(t)); return t; }
DI u16 f2bf(float x) { return __builtin_bit_cast(u16, (__bf16)x); }
DI unsigned pk2(float a, float b) { f2_t v = {a, b}; return __builtin_bit_cast(unsigned, __builtin_convertvector(v, bf2_t)); }
DI float bf2f(u16 x) { return __uint_as_float((unsigned)x << 16); }
DI float bflo(unsigned x) { return __uint_as_float(x << 16); }
DI float bfhi(unsigned x) { return __uint_as_float(x & 0xffff0000u); }
DI float ex2(float x) { return __builtin_amdgcn_exp2f(x); }
DI float lg2(float x) { return __builtin_amdgcn_logf(x); }
DI float frcp(float x) { return __builtin_amdgcn_rcpf(x); }
DI float sigmoidf_(float x) { return frcp(1.f + __expf(-x)); }
DI float siluf_(float x) { return x * frcp(1.f + __expf(-x)); }
DI float softplusf_(float x) { return fmaxf(x, 0.f) + __logf(1.f + __expf(-fabsf(x))); }
DI float tanhf_(float x) { return 1.f - 2.f * frcp(1.f + __expf(2.f * x)); }
DI int crow(int i, int hl) { return (i & 3) + 8 * (i >> 2) + 4 * hl; }
template <int CTRL> DI float dppf(float x) {
  return __int_as_float(__builtin_amdgcn_update_dpp(__float_as_int(x), __float_as_int(x), CTRL, 0xF, 0xF, false));
}
DI float allreduce16(float x) {
  x += dppf<0xB1>(x); x += dppf<0x4E>(x); x += dppf<0x141>(x); x += dppf<0x140>(x); return x;
}
DI float red32(float x) {
  x += __shfl_xor(x, 1); x += __shfl_xor(x, 2); x += __shfl_xor(x, 4); x += __shfl_xor(x, 8); x += __shfl_xor(x, 16); return x;
}
DI float red64(float x) { x = red32(x); x += __shfl_xor(x, 32); return x; }
DI int bidx_of(int row) { return row < NP ? (row >> 13) : 2 + ((row - NP) >> 4); }
DI int keyrow_of(int row) { return row < NP ? row : NP + ((row - NP) >> 4) * SK + PAST + ((row - NP) & 15); }
DI int pos_of(int row) { return row < NP ? (row & 8191) : PAST + ((row - NP) & 15); }
DI size_t vt_off(int keyrow, int h, int d) {
  if (keyrow < NP) { int b = keyrow >> 13, s = keyrow & 8191; return ((size_t)((b * 8 + h) * 64 + d)) * 8192 + s; }
  int rr = keyrow - NP; int b = rr / SK, s = rr - b * SK; return VT_S_OFF + ((size_t)((b * 8 + h) * 64 + d)) * SK + s;
}

DI void gemm_mainloop(f32x16 (&acc)[2][2], const u16* A, int lda, const u16* Bt, int ldb, int K, unsigned char* smem) {
  u16* s0 = (u16*)smem;
  const int tid = TIDX(), lane = tid & 63, wave = tid >> 6, wm = wave >> 1, wn = wave & 1;
  const int lr = tid >> 3, lc = (tid & 7) * 8;
  unsigned offA[4], offB[4];
#pragma unroll
  for (int i = 0; i < 4; i++) { offA[i] = (unsigned)(((lr + 32 * i) * lda + lc) * 2); offB[i] = (unsigned)(((lr + 32 * i) * ldb + lc) * 2); }
  const char* Ab = (const char*)A;
  const char* Bb = (const char*)Bt;
  u32x4 ra[4], rb[4];
  const int nk = K >> 6;
  const int r = lane & 31, hl = lane >> 5;
#pragma unroll
  for (int i = 0; i < 4; i++) { ra[i] = *(const u32x4*)(Ab + offA[i]); rb[i] = *(const u32x4*)(Bb + offB[i]); }
  __syncthreads();
#pragma unroll
  for (int i = 0; i < 4; i++) { *(u32x4*)(s0 + (lr + 32 * i) * 72 + lc) = ra[i]; *(u32x4*)(s0 + 128 * 72 + (lr + 32 * i) * 72 + lc) = rb[i]; }
  if (nk > 1) { Ab += 128; Bb += 128; }
#pragma unroll
  for (int i = 0; i < 4; i++) { ra[i] = *(const u32x4*)(Ab + offA[i]); rb[i] = *(const u32x4*)(Bb + offB[i]); }
  __syncthreads();
  for (int kt = 0; kt < nk; kt++) {
    u16* sA = s0 + (kt & 1) * (256 * 72); u16* sB = sA + 128 * 72;
    if (kt + 1 < nk) {
      u16* nA = s0 + ((kt + 1) & 1) * (256 * 72); u16* nB = nA + 128 * 72;
#pragma unroll
      for (int i = 0; i < 4; i++) { *(u32x4*)(nA + (lr + 32 * i) * 72 + lc) = ra[i]; *(u32x4*)(nB + (lr + 32 * i) * 72 + lc) = rb[i]; }
    }
    if (kt + 2 < nk) { Ab += 128; Bb += 128; }
#pragma unroll
    for (int i = 0; i < 4; i++) { ra[i] = *(const u32x4*)(Ab + offA[i]); rb[i] = *(const u32x4*)(Bb + offB[i]); }
#pragma unroll
    for (int ks = 0; ks < 4; ks++) {
      bf16x8 af[2], bfr[2];
#pragma unroll
      for (int b = 0; b < 2; b++) {
        af[b] = *(const bf16x8*)(sA + (wm * 64 + b * 32 + r) * 72 + ks * 16 + hl * 8);
        bfr[b] = *(const bf16x8*)(sB + (wn * 64 + b * 32 + r) * 72 + ks * 16 + hl * 8);
      }
#pragma unroll
      for (int bm = 0; bm < 2; bm++)
#pragma unroll
        for (int bn = 0; bn < 2; bn++) acc[bm][bn] = MFMA32(af[bm], bfr[bn], acc[bm][bn]);
    }
    __syncthreads();
  }
}
DI void zero_acc(f32x16 (&acc)[2][2]) {
#pragma unroll
  for (int a = 0; a < 2; a++)
#pragma unroll
    for (int b = 0; b < 2; b++)
#pragma unroll
      for (int i = 0; i < 16; i++) acc[a][b][i] = 0.f;
}
template <class F> DI void foreach_acc(f32x16 (&acc)[2][2], int m0, int n0, F f) {
  const int lane = TIDX() & 63, wave = TIDX() >> 6, wm = wave >> 1, wn = wave & 1, r = lane & 31, hl = lane >> 5;
#pragma unroll
  for (int bm = 0; bm < 2; bm++)
#pragma unroll
    for (int bn = 0; bn < 2; bn++)
#pragma unroll
      for (int i = 0; i < 16; i++) f(m0 + wm * 64 + bm * 32 + crow(i, hl), n0 + wn * 64 + bn * 32 + r, acc[bm][bn][i]);
}

DI void transpose_tile(const float* __restrict__ src, int K, int N, u16* __restrict__ dst, int kt, int nt, int mode, unsigned char* smem) {
  float* tile = (float*)smem;
  const int tid = TIDX(), tx = tid & 63, ty = tid >> 6;
  const int k0 = kt * 64, n0 = nt * 64;
  __syncthreads();
#pragma unroll 4
  for (int i = 0; i < 16; i++) { int k = i * 4 + ty; int n = n0 + tx; tile[k * 65 + tx] = (n < N) ? src[(size_t)(k0 + k) * N + n] : 0.f; }
  __syncthreads();
#pragma unroll 4
  for (int i = 0; i < 16; i++) {
    int nl = i * 4 + ty; int n = n0 + nl;
    if (n < N) {
      int nd = n;
      if (mode == 1) { int hd = n / 96, d = n - hd * 96; nd = d < 64 ? hd * 64 + d : 512 + hd * 32 + (d - 64); }
      dst[(size_t)nd * K + k0 + tx] = f2bf(tile[tx * 65 + nl]);
    }
  }
}
constexpr int WIN_TT = 16 * 133;
DI void win_transpose_task(const Params& p, int l, int t, unsigned char* smem) {
  int kt = t & 15, nt = t >> 4;
  transpose_tile(p.in[13] + (size_t)l * 1024 * DIN, 1024, DIN, (u16*)(p.ws + W_WINT), kt, nt, 0, smem);
}
constexpr int SMALLW_TT = 384 + 256 + 72 + 64 + 8 + 8;
DI void smallw_transpose_task(const Params& p, int l, int t, unsigned char* smem) {
  if (t < 384) { int g = t / 128, q = t % 128; const float* src = p.in[g == 0 ? 24 : (g == 1 ? 33 : 34)] + (size_t)l * 512 * 1024;
    transpose_tile(src, 512, 1024, (u16*)(p.ws + W_WBRT) + ((size_t)(l * 3 + g)) * 1024 * 512, q & 7, q >> 3, 0, smem); return; }
  t -= 384;
  if (t < 256) { transpose_tile(p.in[35] + (size_t)l * 1024 * 1024, 1024, 1024, (u16*)(p.ws + W_WOUTT) + (size_t)l * 1024 * 1024, t & 15, t >> 4, 0, smem); return; }
  t -= 256;
  if (t < 72) { transpose_tile(p.in[26] + (size_t)l * 384 * 768, 384, 768, (u16*)(p.ws + W_WUQT) + (size_t)l * 768 * 384, t % 6, t / 6, 1, smem); return; }
  t -= 72;
  if (t < 64) { transpose_tile(p.in[28] + (size_t)l * 256 * 1024, 256, 1024, (u16*)(p.ws + W_WUKVT) + (size_t)l * 1024 * 256, t & 3, t >> 2, 0, smem); return; }
  t -= 64;
  if (t < 8) { transpose_tile(p.in[16] + (size_t)l * 64 * 512, 64, 512, (u16*)(p.ws + W_WUPT) + (size_t)l * 512 * 64, 0, t, 0, smem); return; }
  t -= 8;
  transpose_tile(p.in[18] + (size_t)l * 64 * 512, 64, 512, (u16*)(p.ws + W_AUPT) + (size_t)l * 512 * 64, 0, t, 0, smem);
}
DI void mod_task(const Params& p, int task, unsigned char* smem) {
  float* sm = (float*)smem;
  const int tid = TIDX(), l = task / 48, cb = task % 48, kq = tid >> 6, cl = tid & 63, col = cb * 64 + cl;
  __syncthreads();
  for (int e = tid; e < 10240; e += 256) { int r = e >> 10, k = e & 1023; float c = r < 2 ? p.in[8][r * 1024 + k] : p.in[9][(r - 2) * 1024 + k]; sm[e] = siluf_(c); }
  __syncthreads();
  float acc[10];
#pragma unroll
  for (int r = 0; r < 10; r++) acc[r] = 0.f;
  const float* w = p.in[10] + ((size_t)l * 1024 + kq * 256) * 3072 + col;
#pragma unroll 8
  for (int k = 0; k < 256; k++) {
    float wv = w[(size_t)k * 3072];
#pragma unroll
    for (int r = 0; r < 10; r++) acc[r] += sm[r * 1024 + kq * 256 + k] * wv;
  }
  __syncthreads();
#pragma unroll
  for (int r = 0; r < 10; r++) sm[(kq * 10 + r) * 64 + cl] = acc[r];
  __syncthreads();
  if (tid < 64) {
    float* mod = (float*)(p.ws + W_MOD);
    float bb = p.in[11][l * 3072 + col];
#pragma unroll
    for (int r = 0; r < 10; r++) mod[(l * 10 + r) * 3072 + col] = sm[r * 64 + cl] + sm[(10 + r) * 64 + cl] + sm[(20 + r) * 64 + cl] + sm[(30 + r) * 64 + cl] + bb;
  }
}
DI void rope_task(const Params& p, int task) {
  const int tid = TIDX(); const int pos = task * 128 + (tid >> 1);
  float* rope = (float*)(p.ws + W_ROPE);
  for (int ff = 0; ff < 8; ff++) {
    int f = (tid & 1) * 8 + ff;
    double inv = 1.0; for (int j = 0; j < f; j++) inv *= 0.5623413251903491;
    double ang = (double)pos * inv;
    double n = rint(ang * 0.15915494309189535);
    double rr = ang - n * 6.283185307179586 - n * 2.4492935982947064e-16;
    double r2 = rr * rr, sn = rr, cs = 1.0, ts = rr, tc = 1.0;
    for (int k = 1; k <= 15; k++) { tc *= -r2 / (double)((2 * k - 1) * (2 * k)); cs += tc; ts *= -r2 / (double)((2 * k) * (2 * k + 1)); sn += ts; }
    rope[pos * 32 + f] = (float)cs; rope[pos * 32 + 16 + f] = (float)sn;
  }
}
DI void phase0(const Params& p, unsigned char* smem) {
  const int n_tr = WIN_TT + SMALLW_TT, total = n_tr + 192 + 64;
  for (int t = blockIdx.x; t < total; t += gridDim.x) {
    if (t < 192) mod_task(p, t, smem);
    else if (t < 192 + 64) rope_task(p, t - 192);
    else { int q = t - 256; if (q < WIN_TT) win_transpose_task(p, 0, q, smem); else { q -= WIN_TT; smallw_transpose_task(p, 0, q, smem); } }
  }
}

DI const float* xrow_ptr(const Params& p, int l, int row) {
  if (l > 0) return p.out + (size_t)row * D;
  return row < NP ? p.in[0] + (size_t)row * D : p.in[1] + (size_t)(row - NP) * D;
}
DI void phase1(const Params& p, int l) {
  const int lane = TIDX() & 63, wave = TIDX() >> 6;
  const float* mod = (const float*)(p.ws + W_MOD);
  const float* g = p.in[12] + l * 1024;
  u16* H = (u16*)(p.ws + W_H);
  for (int task = blockIdx.x; task < NT / 4; task += gridDim.x) {
    int row = task * 4 + wave;
    const float* x = xrow_ptr(p, l, row);
    const float* md = mod + (l * 10 + bidx_of(row)) * 3072;
    float4 v[4]; float ss = 0.f;
#pragma unroll
    for (int j = 0; j < 4; j++) { v[j] = *(const float4*)(x + (j * 64 + lane) * 4); ss += v[j].x * v[j].x + v[j].y * v[j].y + v[j].z * v[j].z + v[j].w * v[j].w; }
    ss = red64(ss);
    float rstd = rsqrtf(ss * (1.f / 1024.f) + RMS_EPS);
#pragma unroll
    for (int j = 0; j < 4; j++) {
      int c = (j * 64 + lane) * 4;
      float4 gg = *(const float4*)(g + c), sh = *(const float4*)(md + c), sc = *(const float4*)(md + 1024 + c);
      float h0 = v[j].x * rstd * gg.x * (1.f + sc.x) + sh.x, h1 = v[j].y * rstd * gg.y * (1.f + sc.y) + sh.y;
      float h2 = v[j].z * rstd * gg.z * (1.f + sc.z) + sh.z, h3 = v[j].w * rstd * gg.w * (1.f + sc.w) + sh.w;
      uint2 o; o.x = pk2(h0, h1); o.y = pk2(h2, h3);
      *(uint2*)(H + (size_t)row * 1024 + c) = o;
    }
  }
}

DI void phase2(const Params& p, int l, unsigned char* smem) {
  const u16* H = (const u16*)(p.ws + W_H);
  const u16* WinT = (const u16*)(p.ws + W_WINT);
  float* PR = (float*)(p.ws + W_PR);
  u16* Z = (u16*)(p.ws + W_Z);
  float* CQ = (float*)(p.ws + W_CQ); float* CKV = (float*)(p.ws + W_CKV); float* KR = (float*)(p.ws + W_KR);
  u16* SQ = (u16*)(p.ws + W_SQ); u16* SBK = (u16*)(p.ws + W_SBK); u16* SBVT = (u16*)(p.ws + W_SBVT);
  float* out = p.out;
  for (int ts = blockIdx.x; ts < 11 * 512; ts += gridDim.x) {
    int mt, nt;
    {
      const int rd = ts >> 9, bq = ts & 511, sm = bq & 7, j = bq >> 3;
      mt = sm * 16 + (j & 15); nt = rd * 4 + (j >> 4);
      if (nt >= 43) { const int e = sm * 16 + (j & 15); if (e >= 43) continue; mt = 128; nt = e; }
    }
    const int m0 = mt * 128;
    int seg, n0, c0;
    if (nt < 13) { seg = 0; c0 = nt * 128; n0 = c0; }
    else if (nt < 17) { seg = 1; c0 = (nt - 13) * 128; n0 = 1664 + c0; }
    else if (nt < 20) { seg = 2; c0 = (nt - 17) * 128; n0 = 2176 + c0; }
    else if (nt < 22) { seg = 3; c0 = (nt - 20) * 128; n0 = 2560 + c0; }
    else if (nt < 26) { seg = 4; c0 = (nt - 22) * 128; n0 = 2848 + c0; }
    else if (nt < 30) { seg = 5; c0 = (nt - 26) * 128; n0 = 3360 + c0; }
    else if (nt < 34) { seg = 6; c0 = (nt - 30) * 128; n0 = 3872 + c0; }
    else if (nt < 38) { seg = 7; c0 = (nt - 34) * 128; n0 = 4384 + c0; }
    else if (nt < 42) { seg = 8; c0 = (nt - 38) * 128; n0 = 4896 + c0; }
    else { seg = 9; c0 = 0; n0 = 2816; }
    f32x16 acc[2][2]; zero_acc(acc);
    gemm_mainloop(acc, H + (size_t)m0 * 1024, 1024, WinT + (size_t)n0 * 1024, 1024, 1024, smem);
    if (seg == 0) {
      foreach_acc(acc, m0, c0, [&](int row, int col, float v) {
        PR[(size_t)row * 1664 + col] = v;
        if (row < NP) { if ((row & 8191) == 8191) out[O_SHIFT_P + (size_t)(l * 2 + (row >> 13)) * 1664 + col] = v; }
        else { int rr = row - NP; if ((rr & 15) == 15) out[O_SHIFT_S + (size_t)(l * 8 + (rr >> 4)) * 1664 + col] = v; }
      });
    } else if (seg == 1 || seg == 4 || seg == 8) {
      const int g = seg == 1 ? 0 : (seg == 4 ? 1 : 2);
      foreach_acc(acc, m0, c0, [&](int row, int col, float v) { Z[((size_t)g * NT + row) * 512 + col] = f2bf(siluf_(v)); });
    } else if (seg == 2) {
      foreach_acc(acc, m0, c0, [&](int row, int col, float v) { CQ[(size_t)row * 384 + col] = v; });
    } else if (seg == 3) {
      foreach_acc(acc, m0, c0, [&](int row, int col, float v) { CKV[(size_t)row * 256 + col] = v; });
    } else if (seg == 9) {
      foreach_acc(acc, m0, c0, [&](int row, int col, float v) { if (col < 32) KR[(size_t)row * 32 + col] = v; });
    } else if (seg == 5) {
      foreach_acc(acc, m0, c0, [&](int row, int col, float v) { SQ[(size_t)row * 512 + col] = f2bf(v * QSCALE_SB); });
    } else if (seg == 6) {
      foreach_acc(acc, m0, c0, [&](int row, int col, float v) {
        size_t oo = row < NP ? O_SBK_P + ((size_t)l * NP + row) * 512 + col : O_SBK_S + ((size_t)l * NS + (row - NP)) * 512 + col;
        out[oo] = v;
        SBK[(size_t)keyrow_of(row) * 512 + col] = f2bf(v);
      });
    } else {
      foreach_acc(acc, m0, c0, [&](int row, int col, float v) {
        size_t oo = row < NP ? O_SBV_P + ((size_t)l * NP + row) * 512 + col : O_SBV_S + ((size_t)l * NS + (row - NP)) * 512 + col;
        out[oo] = v;
      });
      const int lane = TIDX() & 63, wave = TIDX() >> 6, wm = wave >> 1, wn = wave & 1, r = lane & 31, hl = lane >> 5;
#pragma unroll
      for (int bm = 0; bm < 2; bm++)
#pragma unroll
        for (int bn = 0; bn < 2; bn++)
#pragma unroll
          for (int g4 = 0; g4 < 4; g4++) {
            int row = m0 + wm * 64 + bm * 32 + 8 * g4 + 4 * hl, col = c0 + wn * 64 + bn * 32 + r;
            uint2 o; o.x = pk2(acc[bm][bn][4 * g4], acc[bm][bn][4 * g4 + 1]); o.y = pk2(acc[bm][bn][4 * g4 + 2], acc[bm][bn][4 * g4 + 3]);
            *(uint2*)(SBVT + vt_off(keyrow_of(row), col >> 6, col & 63)) = o;
          }
    }
  }
}

DI const float* prev_ptr(const Params& p, int l, const float* PR, int row) {
  if (row < NP) return (row & 8191) ? PR + (size_t)(row - 1) * 1664 : nullptr;
  int rr = row - NP;
  return (rr & 15) ? PR + (size_t)(row - 1) * 1664 : p.in[3] + (size_t)(l * 8 + (rr >> 4)) * 1664;
}
DI void rwkv_prep_task(const Params& p, int l, int task) {
  const int lane = TIDX() & 63, wave = TIDX() >> 6, r = lane & 31, hl = lane >> 5;
  const int tile = task >> 1, hh = (task & 1) * 4 + wave, row0 = tile * 32;
  const float* PR = (const float*)(p.ws + W_PR);
  const float* mu = p.in[14] + l * 1664;
  f32x16 accW[1][2], accA[1][2];
#pragma unroll
  for (int b_ = 0; b_ < 2; b_++)
#pragma unroll
    for (int i_ = 0; i_ < 16; i_++) { accW[0][b_][i_] = 0.f; accA[0][b_][i_] = 0.f; }
  const u16* WupT = (const u16*)(p.ws + W_WUPT) + (size_t)l * 512 * 64;
  const u16* AupT = (const u16*)(p.ws + W_AUPT) + (size_t)l * 512 * 64;
#pragma unroll 1
  for (int ks = 0; ks < 4; ks++) {
    const int k0 = ks * 16 + hl * 8;
    bf16x8 bw[2], ba[2];
#pragma unroll
    for (int bn = 0; bn < 2; bn++) {
      bw[bn] = *(const bf16x8*)(WupT + (size_t)(hh * 64 + bn * 32 + r) * 64 + k0);
      ba[bn] = *(const bf16x8*)(AupT + (size_t)(hh * 64 + bn * 32 + r) * 64 + k0);
    }
#pragma unroll
    for (int bm = 0; bm < 1; bm++) {
      const int row = row0 + bm * 32 + r;
      const float* pp = PR + (size_t)row * 1664;
      const float* pv = prev_ptr(p, l, PR, row);
      float xw[8], xa[8];
#pragma unroll
      for (int q = 0; q < 2; q++) {
        float4 a = *(const float4*)(pp + 1536 + k0 + 4 * q), b = pv ? *(const float4*)(pv + 1536 + k0 + 4 * q) : make_float4(0, 0, 0, 0), m = *(const float4*)(mu + 1536 + k0 + 4 * q);
        xw[4 * q] = tanhf_(a.x + (b.x - a.x) * m.x); xw[4 * q + 1] = tanhf_(a.y + (b.y - a.y) * m.y); xw[4 * q + 2] = tanhf_(a.z + (b.z - a.z) * m.z); xw[4 * q + 3] = tanhf_(a.w + (b.w - a.w) * m.w);
        a = *(const float4*)(pp + 1600 + k0 + 4 * q); b = pv ? *(const float4*)(pv + 1600 + k0 + 4 * q) : make_float4(0, 0, 0, 0); m = *(const float4*)(mu + 1600 + k0 + 4 * q);
        xa[4 * q] = a.x + (b.x - a.x) * m.x; xa[4 * q + 1] = a.y + (b.y - a.y) * m.y; xa[4 * q + 2] = a.z + (b.z - a.z) * m.z; xa[4 * q + 3] = a.w + (b.w - a.w) * m.w;
      }
      u32x4 uw, ua;
      uw.x = pk2(xw[0], xw[1]); uw.y = pk2(xw[2], xw[3]); uw.z = pk2(xw[4], xw[5]); uw.w = pk2(xw[6], xw[7]);
      ua.x = pk2(xa[0], xa[1]); ua.y = pk2(xa[2], xa[3]); ua.z = pk2(xa[4], xa[5]); ua.w = pk2(xa[6], xa[7]);
      bf16x8 awf = __builtin_bit_cast(bf16x8, uw), aaf = __builtin_bit_cast(bf16x8, ua);
#pragma unroll
      for (int bn = 0; bn < 2; bn++) { accW[bm][bn] = MFMA32(awf, bw[bn], accW[bm][bn]); accA[bm][bn] = MFMA32(aaf, ba[bn], accA[bm][bn]); }
    }
  }
  float* RWW = (float*)(p.ws + W_RWW); u16* RWX = (u16*)(p.ws + W_RWX); float* RHO = (float*)(p.ws + W_RHO);
  float mur[2], muk[2], muv[2], w0[2], a0[2], kk_[2], ka_[2], rk_[2];
#pragma unroll
  for (int bn = 0; bn < 2; bn++) {
    int col = hh * 64 + bn * 32 + r;
    mur[bn] = mu[col]; muk[bn] = mu[512 + col]; muv[bn] = mu[1024 + col];
    w0[bn] = p.in[15][l * 512 + col]; a0[bn] = p.in[17][l * 512 + col]; kk_[bn] = p.in[19][l * 512 + col]; ka_[bn] = p.in[20][l * 512 + col]; rk_[bn] = p.in[21][l * 512 + col];
  }
#pragma unroll
  for (int bm = 0; bm < 1; bm++)
#pragma unroll
    for (int i = 0; i < 16; i++) {
      const int row = row0 + bm * 32 + crow(i, hl);
      const float* pp = PR + (size_t)row * 1664;
      const float* pv = prev_ptr(p, l, PR, row);
      float xr[2], xv[2], kp[2], kkr[2], av[2], dec[2];
      float ssq = 0.f, rho = 0.f;
#pragma unroll
      for (int bn = 0; bn < 2; bn++) {
        int col = hh * 64 + bn * 32 + r;
        float pr_ = pp[col], pk_ = pp[512 + col], pv_ = pp[1024 + col];
        float qr = pv ? pv[col] : 0.f, qk = pv ? pv[512 + col] : 0.f, qv = pv ? pv[1024 + col] : 0.f;
        xr[bn] = pr_ + (qr - pr_) * mur[bn];
        float xk = pk_ + (qk - pk_) * muk[bn];
        xv[bn] = pv_ + (qv - pv_) * muv[bn];
        float wpre = w0[bn] + accW[bm][bn][i];
        float wlog = -softplusf_(-wpre) - 0.5f;
        dec[bn] = __expf(-__expf(wlog));
        av[bn] = sigmoidf_(a0[bn] + accA[bm][bn][i]);
        kkr[bn] = xk * kk_[bn];
        kp[bn] = xk * (1.f + (av[bn] - 1.f) * ka_[bn]);
        ssq += kkr[bn] * kkr[bn];
        rho += xr[bn] * kp[bn] * rk_[bn];
      }
      ssq = red32(ssq); rho = red32(rho);
      float inv = rsqrtf(fmaxf(ssq, 1e-24f));
#pragma unroll
      for (int bn = 0; bn < 2; bn++) {
        int col = hh * 64 + bn * 32 + r;
        float kk = kkr[bn] * inv;
        RWW[(size_t)row * 512 + col] = dec[bn];
        u16* rx = RWX + (size_t)row * 2560 + col;
        rx[0] = f2bf(xr[bn]); rx[512] = f2bf(kp[bn]); rx[1024] = f2bf(xv[bn]); rx[1536] = f2bf(kk); rx[2048] = f2bf(kk * av[bn]);
      }
      if (r == 0) RHO[(size_t)row * 8 + hh] = rho;
    }
}
DI void norm_row_task(const Params& p, int l, int task) {
  const int lane = TIDX() & 63, wave = TIDX() >> 6;
  const int row = task * 4 + wave;
  const float* CQ = (const float*)(p.ws + W_CQ); const float* CKV = (const float*)(p.ws + W_CKV); const float* KR = (const float*)(p.ws + W_KR);
  u16* QN = (u16*)(p.ws + W_QN); u16* CKVN = (u16*)(p.ws + W_CKVN); u16* KF = (u16*)(p.ws + W_KF);
  const int keyrow = keyrow_of(row);
  {
    float v[6], ss = 0.f;
#pragma unroll
    for (int j = 0; j < 6; j++) { v[j] = CQ[(size_t)row * 384 + j * 64 + lane]; ss += v[j] * v[j]; }
    ss = red64(ss); float rstd = rsqrtf(ss * (1.f / 384.f) + RMS_EPS);
#pragma unroll
    for (int j = 0; j < 6; j++) QN[(size_t)row * 384 + j * 64 + lane] = f2bf(v[j] * rstd * p.in[25][l * 384 + j * 64 + lane]);
  }
  {
    float4 v = *(const float4*)(CKV + (size_t)row * 256 + lane * 4);
    float ss = red64(v.x * v.x + v.y * v.y + v.z * v.z + v.w * v.w);
    float rstd = rsqrtf(ss * (1.f / 256.f) + RMS_EPS);
    float4 g = *(const float4*)(p.in[27] + l * 256 + lane * 4);
    float4 o = make_float4(v.x * rstd * g.x, v.y * rstd * g.y, v.z * rstd * g.z, v.w * rstd * g.w);
    size_t oo = row < NP ? O_CKV_P + ((size_t)l * NP + row) * 256 : O_CKV_S + ((size_t)l * NS + (row - NP)) * 256;
    *(float4*)(p.out + oo + lane * 4) = o;
    uint2 ob; ob.x = pk2(o.x, o.y); ob.y = pk2(o.z, o.w);
    *(uint2*)(CKVN + (size_t)keyrow * 256 + lane * 4) = ob;
  }
  {
    float x = lane < 32 ? KR[(size_t)row * 32 + lane] : 0.f;
    float ss = red64(x * x); float rstd = rsqrtf(ss * (1.f / 32.f) + RMS_EPS);
    float xn = x * rstd * p.in[32][l * 32 + (lane & 31)];
    float pt = __shfl_xor(xn, 16);
    const float* rp = (const float*)(p.ws + W_ROPE) + pos_of(row) * 32;
    float cs = rp[lane & 15], sn = rp[16 + (lane & 15)];
    float o = (lane & 16) ? (pt * sn + xn * cs) : (xn * cs - pt * sn);
    if (lane < 32) {
      size_t oo = row < NP ? O_KROPE_P + ((size_t)l * NP + row) * 32 : O_KROPE_S + ((size_t)l * NS + (row - NP)) * 32;
      p.out[oo + lane] = o;
      u16 ob = f2bf(o);
#pragma unroll
      for (int hd = 0; hd < 8; hd++) KF[(size_t)keyrow * 768 + hd * 96 + 64 + lane] = ob;
    }
  }
}
DI void past_convert_task(const Params& p, int l, int task) {
  const int tid = TIDX();
  if (task < 2048) {
    size_t e = ((size_t)task * 256 + tid) * 8; int rowp = (int)(e >> 8), c = (int)(e & 255); int b = rowp >> 11, s = rowp & 2047;
    const float* src = p.in[4] + ((size_t)(l * 8 + b) * PAST + s) * 256 + c;
    float4 a = *(const float4*)src, bq = *(const float4*)(src + 4);
    uint4 o; o.x = pk2(a.x, a.y); o.y = pk2(a.z, a.w); o.z = pk2(bq.x, bq.y); o.w = pk2(bq.z, bq.w);
    *(uint4*)((u16*)(p.ws + W_CKVN) + (size_t)(NP + b * SK + s) * 256 + c) = o; return;
  }
  task -= 2048;
  if (task < 4096) {
    size_t e = ((size_t)task * 256 + tid) * 8; int rowp = (int)(e >> 9), c = (int)(e & 511); int b = rowp >> 11, s = rowp & 2047;
    const float* src = p.in[6] + ((size_t)(l * 8 + b) * PAST + s) * 512 + c;
    float4 a = *(const float4*)src, bq = *(const float4*)(src + 4);
    uint4 o; o.x = pk2(a.x, a.y); o.y = pk2(a.z, a.w); o.z = pk2(bq.x, bq.y); o.w = pk2(bq.z, bq.w);
    *(uint4*)((u16*)(p.ws + W_SBK) + (size_t)(NP + b * SK + s) * 512 + c) = o; return;
  }
  task -= 4096;
  if (task < 4096) {
    int id = task * 256 + tid; int c = id & 511, sg = (id >> 9) & 255, b = id >> 17;
    const float* src = p.in[7] + ((size_t)(l * 8 + b) * PAST + sg * 8) * 512 + c;
    float v[8];
#pragma unroll
    for (int j = 0; j < 8; j++) v[j] = src[(size_t)j * 512];
    uint4 o; o.x = pk2(v[0], v[1]); o.y = pk2(v[2], v[3]); o.z = pk2(v[4], v[5]); o.w = pk2(v[6], v[7]);
    *(uint4*)((u16*)(p.ws + W_SBVT) + VT_S_OFF + ((size_t)((b * 8 + (c >> 6)) * 64 + (c & 63))) * SK + sg * 8) = o; return;
  }
  task -= 4096;
  {
    int id = task * 256 + tid; int ch = id & 7, rowp = id >> 3; int b = rowp >> 11, s = rowp & 2047;
    float4 a = *(const float4*)(p.in[5] + ((size_t)(l * 8 + b) * PAST + s) * 32 + ch * 4);
    uint2 o; o.x = pk2(a.x, a.y); o.y = pk2(a.z, a.w);
    u16* dst = (u16*)(p.ws + W_KF) + (size_t)(NP + b * SK + s) * 768 + 64 + ch * 4;
#pragma unroll
    for (int hd = 0; hd < 8; hd++) *(uint2*)(dst + hd * 96) = o;
  }
}
DI void phase3(const Params& p, int l) {
  const int nA = 1032, nB = NT / 4, nC = 2048 + 4096 + 4096 + 512, total = nA + nB + nC;
  for (int t = blockIdx.x; t < total; t += gridDim.x) {
    if (t < nA) rwkv_prep_task(p, l, t);
    else if (t < nA + nB) norm_row_task(p, l, t - nA);
    else past_convert_task(p, l, t - nA - nB);
  }
}

DI void rwkv_pass1_task(const Params& p, int bh, int seg, int rq, unsigned char* smem);
DI void phase4(const Params& p, int l, unsigned char* smem) {
  const int lane = TIDX() & 63, wave = TIDX() >> 6, wm = wave >> 1, wn = wave & 1, r = lane & 31, hl = lane >> 5;
  const float* rope = (const float*)(p.ws + W_ROPE);
  u16* QF = (u16*)(p.ws + W_QF); u16* KF = (u16*)(p.ws + W_KF); u16* VT = (u16*)(p.ws + W_MLAVT);
  const int nQ = 129 * 6, nKV = 257 * 8;
  __shared__ int s_task4;
  int* ctr4 = (int*)(p.ws + W_CTR) + 8 + l;
  while (true) {
    __syncthreads();
    if (TIDX() == 0) s_task4 = atomicAdd(ctr4, 1);
    __syncthreads();
    const int q4 = s_task4;
    if (q4 >= 448 + nQ + nKV) break;
    const int t0 = q4 < 896 ? ((q4 & 1) ? 448 + (q4 >> 1) : (q4 >> 1)) : q4;
    if (t0 < 448) { int bh = t0 / 28, rem = t0 - bh * 28; rwkv_pass1_task(p, bh, rem >> 2, rem & 3, smem); continue; }
    const int t = t0 - 448;
    f32x16 acc[2][2]; zero_acc(acc);
    if (t < nQ) {
      const int mt = t % 129, nt = t / 129, m0 = mt * 128;
      gemm_mainloop(acc, (const u16*)(p.ws + W_QN) + (size_t)m0 * 384, 384, (const u16*)(p.ws + W_WUQT) + ((size_t)l * 768 + nt * 128) * 384, 384, 384, smem);
      if (nt < 4) {
        const int head = nt * 2 + wn;
        float g0 = p.in[29][l * 64 + r] * QSCALE_MLA, g1 = p.in[29][l * 64 + 32 + r] * QSCALE_MLA;
#pragma unroll
        for (int bm = 0; bm < 2; bm++)
#pragma unroll
          for (int i = 0; i < 16; i++) {
            float a = acc[bm][0][i], b = acc[bm][1][i];
            float ss = red32(a * a + b * b); float rstd = rsqrtf(ss * (1.f / 64.f) + RMS_EPS);
            int row = m0 + wm * 64 + bm * 32 + crow(i, hl);
            u16* q = QF + (size_t)row * 768 + head * 96;
            q[r] = f2bf(a * rstd * g0); q[32 + r] = f2bf(b * rstd * g1);
          }
      } else {
        float g = p.in[30][l * 32 + r] * QSCALE_MLA;
#pragma unroll
        for (int bm = 0; bm < 2; bm++)
#pragma unroll
          for (int bn = 0; bn < 2; bn++)
#pragma unroll
            for (int i = 0; i < 16; i++) {
              const int head = (nt - 4) * 4 + wn * 2 + bn;
              float a = acc[bm][bn][i];
              float ss = red32(a * a); float rstd = rsqrtf(ss * (1.f / 32.f) + RMS_EPS);
              float xn = a * rstd * g; float pt = __shfl_xor(xn, 16);
              int row = m0 + wm * 64 + bm * 32 + crow(i, hl);
              const float* rp = rope + pos_of(row) * 32;
              float cs = rp[r & 15], sn = rp[16 + (r & 15)];
              float o = (r & 16) ? (pt * sn + xn * cs) : (xn * cs - pt * sn);
              QF[(size_t)row * 768 + head * 96 + 64 + r] = f2bf(o);
            }
      }
    } else {
      const int q = t - nQ, mt = q % 257, head = q / 257, m0 = mt * 128;
      gemm_mainloop(acc, (const u16*)(p.ws + W_CKVN) + (size_t)m0 * 256, 256, (const u16*)(p.ws + W_WUKVT) + ((size_t)l * 1024 + head * 128) * 256, 256, 256, smem);
      if (wn == 0) {
        float g0 = p.in[31][l * 64 + r], g1 = p.in[31][l * 64 + 32 + r];
#pragma unroll
        for (int bm = 0; bm < 2; bm++)
#pragma unroll
          for (int i = 0; i < 16; i++) {
            float a = acc[bm][0][i], b = acc[bm][1][i];
            float ss = red32(a * a + b * b); float rstd = rsqrtf(ss * (1.f / 64.f) + RMS_EPS);
            int krow = m0 + wm * 64 + bm * 32 + crow(i, hl);
            u16* k = KF + (size_t)krow * 768 + head * 96;
            k[r] = f2bf(a * rstd * g0); k[32 + r] = f2bf(b * rstd * g1);
          }
      } else {
#pragma unroll
        for (int bm = 0; bm < 2; bm++)
#pragma unroll
          for (int bn = 0; bn < 2; bn++)
#pragma unroll
            for (int g4 = 0; g4 < 4; g4++) {
              int krow = m0 + wm * 64 + bm * 32 + 8 * g4 + 4 * hl, d = bn * 32 + r;
              uint2 o; o.x = pk2(acc[bm][bn][4 * g4], acc[bm][bn][4 * g4 + 1]); o.y = pk2(acc[bm][bn][4 * g4 + 2], acc[bm][bn][4 * g4 + 3]);
              *(uint2*)(VT + vt_off(krow, head, d)) = o;
            }
      }
    }
  }
}

template <int DK, bool SB>
DI void attn_task(const u16* __restrict__ Qp, int qstride, int nq_valid, const u16* __restrict__ Kp, int kstride,
                  const u16* __restrict__ Vtp, int vstride, int nkeys, int qpos0,
                  const u16* __restrict__ Zp, u16* __restrict__ Yp, unsigned char* smem) {
  constexpr int KS = DK / 16, KSTR = DK + 8, KCH = DK / 8, NKL = 64 * KCH / 256;
  u16* sK = (u16*)smem; u16* sV = sK + 64 * KSTR;
  const int tid = TIDX(), lane = tid & 63, wave = tid >> 6, r = lane & 31, hl = lane >> 5;
  const int slot = wave * 32 + r;
  const bool wave_active = wave * 32 < nq_valid;
  const int qpos = qpos0 + slot;
  bf16x8 qf[KS];
  {
    const u16* qrow = Qp + (size_t)(slot < nq_valid ? slot : 0) * qstride + hl * 8;
#pragma unroll
    for (int ks = 0; ks < KS; ks++) qf[ks] = *(const bf16x8*)(qrow + ks * 16);
  }
  f32x16 O[2];
#pragma unroll
  for (int b = 0; b < 2; b++)
#pragma unroll
    for (int i = 0; i < 16; i++) O[b][i] = 0.f;
  float m_run = -1e30f, l_run = 0.f, R = 1.f;
  const int last_qpos = qpos0 + nq_valid - 1;
  int ntiles = SB ? (last_qpos - 1) / 64 + 1 : last_qpos / 64 + 1;
  { int mx = (nkeys + 63) >> 6; if (ntiles > mx) ntiles = mx; }
  const int wave_q0 = qpos0 + wave * 32;
  u32x4 rk[NKL], rv[2];
  auto prefetch = [&](int kt) {
#pragma unroll
    for (int i = 0; i < NKL; i++) { int c = tid + 256 * i; int row = c / KCH, ch = c - row * KCH; rk[i] = *(const u32x4*)(Kp + (size_t)(kt * 64 + row) * kstride + ch * 8); }
#pragma unroll
    for (int i = 0; i < 2; i++) { int c = tid + 256 * i; int row = c >> 3, ch = c & 7; rv[i] = *(const u32x4*)(Vtp + (size_t)row * vstride + kt * 64 + ch * 8); }
  };
  prefetch(SB ? ntiles - 1 : 0);
  for (int it = 0; it < ntiles; it++) {
    const int kt = SB ? ntiles - 1 - it : it;
    __syncthreads();
#pragma unroll
    for (int i = 0; i < NKL; i++) { int c = tid + 256 * i; int row = c / KCH, ch = c - row * KCH; *(u32x4*)(sK + row * KSTR + ch * 8) = rk[i]; }
#pragma unroll
    for (int i = 0; i < 2; i++) { int c = tid + 256 * i; int row = c >> 3, ch = c & 7; *(u32x4*)(sV + row * 72 + ch * 8) = rv[i]; }
    __syncthreads();
    { int nx = SB ? kt - 1 : kt + 1; if (it + 1 >= ntiles) nx = kt; prefetch(nx); }
    bool doit;
    if (SB) doit = wave_active && (kt * 64 < wave_q0 + 31);
    else doit = wave_active && (kt <= (wave_q0 >> 6));
    if (doit) {
    f32x16 S[2];
#pragma unroll
    for (int kb = 0; kb < 2; kb++) {
#pragma unroll
      for (int i = 0; i < 16; i++) S[kb][i] = 0.f;
#pragma unroll
      for (int ks = 0; ks < KS; ks++) {
        bf16x8 kf = *(const bf16x8*)(sK + (kb * 32 + r) * KSTR + ks * 16 + hl * 8);
        S[kb] = MFMA32(kf, qf[ks], S[kb]);
      }
    }
    const int key0 = kt * 64 + 4 * hl;
    if (!SB) {
      const bool need_mask = (kt + 1) * 64 > nkeys;
      if (need_mask) {
#pragma unroll
        for (int kb = 0; kb < 2; kb++)
#pragma unroll
          for (int i = 0; i < 16; i++) { int key = key0 + kb * 32 + (i & 3) + 8 * (i >> 2); if (key >= nkeys) S[kb][i] = -1e30f; }
      }
      float tmax = -1e30f;
#pragma unroll
      for (int kb = 0; kb < 2; kb++)
#pragma unroll
        for (int i = 0; i < 16; i++) tmax = fmaxf(tmax, S[kb][i]);
      tmax = fmaxf(tmax, __shfl_xor(tmax, 32));
      float m_new = fmaxf(m_run, tmax);
      float alpha = ex2(m_run - m_new);
      m_run = m_new;
      float ps = 0.f;
#pragma unroll
      for (int kb = 0; kb < 2; kb++)
#pragma unroll
        for (int i = 0; i < 16; i++) { float pv = ex2(S[kb][i] - m_new); S[kb][i] = pv; ps += pv; }
      l_run = l_run * alpha + ps;
#pragma unroll
      for (int b = 0; b < 2; b++)
#pragma unroll
        for (int i = 0; i < 16; i++) O[b][i] *= alpha;
    } else {
      const bool need_mask = (kt * 64 + 63 >= wave_q0) || ((kt + 1) * 64 > nkeys);
#pragma unroll
      for (int kb = 0; kb < 2; kb++)
#pragma unroll
        for (int i = 0; i < 16; i++) {
          float d = __builtin_amdgcn_rcpf(1.f + ex2(S[kb][i]));
          if (need_mask) { int key = key0 + kb * 32 + (i & 3) + 8 * (i >> 2); if (!(key < nkeys && key < qpos)) d = 1.f; }
          S[kb][i] = d;
        }
      float gs[8], pg[8], sa[8];
#pragma unroll
      for (int o = 0; o < 8; o++) { int kb = o >> 2, g = o & 3; gs[o] = (S[kb][4 * g] * S[kb][4 * g + 1]) * (S[kb][4 * g + 2] * S[kb][4 * g + 3]); }
#pragma unroll
      for (int o = 0; o < 8; o++) pg[o] = __shfl_xor(gs[o], 32);
      sa[7] = R;
#pragma unroll
      for (int o = 6; o >= 0; o--) sa[o] = sa[o + 1] * (gs[o + 1] * pg[o + 1]);
      const float total = sa[0] * (gs[0] * pg[0]);
#pragma unroll
      for (int o = 0; o < 8; o++) {
        int kb = o >> 2, g = o & 3;
        float c = hl == 0 ? sa[o] * pg[o] : sa[o];
#pragma unroll
        for (int e = 3; e >= 0; e--) {
          float d = S[kb][4 * g + e];
          S[kb][4 * g + e] = c - d * c;
          c *= d;
        }
      }
      R = total;
    }
#pragma unroll
    for (int kb = 0; kb < 2; kb++)
#pragma unroll
      for (int s2 = 0; s2 < 2; s2++) {
        uint4 u;
        u.x = pk2(S[kb][8 * s2], S[kb][8 * s2 + 1]); u.y = pk2(S[kb][8 * s2 + 2], S[kb][8 * s2 + 3]);
        u.z = pk2(S[kb][8 * s2 + 4], S[kb][8 * s2 + 5]); u.w = pk2(S[kb][8 * s2 + 6], S[kb][8 * s2 + 7]);
        bf16x8 pf = __builtin_bit_cast(bf16x8, u);
#pragma unroll
        for (int bd = 0; bd < 2; bd++) {
          const u16* vp = sV + (bd * 32 + r) * 72 + kb * 32 + s2 * 16 + hl * 4;
          uint2 lo = *(const uint2*)vp, hi = *(const uint2*)(vp + 8);
          uint4 vv; vv.x = lo.x; vv.y = lo.y; vv.z = hi.x; vv.w = hi.y;
          O[bd] = MFMA32(__builtin_bit_cast(bf16x8, vv), pf, O[bd]);
        }
      }
    }
    if (SB) {
      const bool lane_done = !wave_active || slot >= nq_valid || R < 1e-30f;
      const int wdone = __all(lane_done);
      if (__syncthreads_and(wdone)) break;
    }
  }
  if (wave_active && slot < nq_valid) {
    float sc = 1.f;
    if (!SB) { float lt = l_run + __shfl_xor(l_run, 32); sc = 1.f / lt; }
#pragma unroll
    for (int bd = 0; bd < 2; bd++)
#pragma unroll
      for (int g = 0; g < 4; g++) {
        int d0 = bd * 32 + 8 * g + 4 * hl;
        uint2 zz = *(const uint2*)(Zp + (size_t)slot * 512 + d0);
        uint2 o;
        o.x = pk2(O[bd][4 * g] * sc * bflo(zz.x), O[bd][4 * g + 1] * sc * bfhi(zz.x));
        o.y = pk2(O[bd][4 * g + 2] * sc * bflo(zz.y), O[bd][4 * g + 3] * sc * bfhi(zz.y));
        *(uint2*)(Yp + (size_t)slot * 512 + d0) = o;
      }
  }
}

template <int CTRL> DI float dpp_add(float x) {
  return x + __int_as_float(__builtin_amdgcn_update_dpp(0, __float_as_int(x), CTRL, 0xF, 0xF, true));
}
DI void allreduce16x2(float& a, float& b) {
  a = dpp_add<0xB1>(a); b = dpp_add<0xB1>(b); a = dpp_add<0x4E>(a); b = dpp_add<0x4E>(b);
  a = dpp_add<0x141>(a); b = dpp_add<0x141>(b); a = dpp_add<0x140>(a); b = dpp_add<0x140>(b);
}
#define SCAN_PREFETCH(slot, cc) { int c_ = (cc) < nch ? (cc) : nch - 1; size_t row = (size_t)(srow0 + c_ * 16 + lstep); \
    pw[slot] = *(const f32x4v*)(RWW + row * 512 + h * 64 + lpart); \
    _Pragma("unroll") for (int c = 0; c < 5; c++) px[slot][c] = *(const u32x2*)(RWX + row * 2560 + c * 512 + h * 64 + lpart); }
#define SCAN_STAGE(slot, bsel) { float* o = ops + ((bsel) * 16 + lstep) * 384 + lpart; \
    f32x4v r4 = {bflo(px[slot][0].x), bfhi(px[slot][0].x), bflo(px[slot][0].y), bfhi(px[slot][0].y)}; \
    f32x4v k4 = {bflo(px[slot][1].x), bfhi(px[slot][1].x), bflo(px[slot][1].y), bfhi(px[slot][1].y)}; \
    f32x4v v4 = {bflo(px[slot][2].x), bfhi(px[slot][2].x), bflo(px[slot][2].y), bfhi(px[slot][2].y)}; \
    f32x4v kk4 = {bflo(px[slot][3].x), bfhi(px[slot][3].x), bflo(px[slot][3].y), bfhi(px[slot][3].y)}; \
    f32x4v b4 = {bflo(px[slot][4].x), bfhi(px[slot][4].x), bflo(px[slot][4].y), bfhi(px[slot][4].y)}; \
    *(f32x4v*)(o) = pw[slot]; *(f32x4v*)(o + 64) = pw[slot] * r4; *(f32x4v*)(o + 128) = k4; *(f32x4v*)(o + 192) = v4; *(f32x4v*)(o + 256) = kk4; *(f32x4v*)(o + 320) = b4; \
    float br = b4.x * r4.x + b4.y * r4.y + b4.z * r4.z + b4.w * r4.w; \
    float kr = k4.x * r4.x + k4.y * r4.y + k4.z * r4.z + k4.w * r4.w; \
    allreduce16x2(br, kr); \
    if ((tid & 15) == 0) { sc[((bsel) * 16 + lstep) * 2] = br; sc[((bsel) * 16 + lstep) * 2 + 1] = kr; } }

DI void rwkv_pass1_task(const Params& p, int bh, int seg, int rq, unsigned char* smem) {
  float* ops = (float*)smem; float* sc = ops + 2 * 16 * 384;
  const int tid = TIDX(), i = tid >> 4, cg = tid & 15, cg4 = cg * 4;
  const int Rr = rq * 16 + i, h = bh & 7;
  const int srow0 = (bh >> 3) * TP + seg * 1024;
  const float* RWW = (const float*)(p.ws + W_RWW); const u16* RWX = (const u16*)(p.ws + W_RWX);
  float SL[4] = {0.f, 0.f, 0.f, 0.f}, SP[4];
#pragma unroll
  for (int e = 0; e < 4; e++) SP[e] = (cg4 + e == Rr) ? 1.f : 0.f;
  const int lstep = tid >> 4, lpart = (tid & 15) * 4;
  f32x4v pw[4]; u32x2 px[4][5];
  const int nch = 64;
  SCAN_PREFETCH(0, 0) SCAN_PREFETCH(1, 1) SCAN_PREFETCH(2, 2) SCAN_PREFETCH(3, 3)
  __syncthreads();
  SCAN_STAGE(0, 0)
  __syncthreads();
  __builtin_amdgcn_s_setprio(3);
  for (int cb = 0; cb < nch; cb += 4) {
#pragma unroll
    for (int k = 0; k < 4; k++) {
      const int c0 = cb + k;
      const int bsel = k & 1;
      SCAN_PREFETCH(k, c0 + 4)
#pragma unroll
      for (int st = 0; st < 16; st++) {
        const float* o = ops + (bsel * 16 + st) * 384;
        f32x4v w = *(const f32x4v*)(o + cg4), kp = *(const f32x4v*)(o + 128 + cg4);
        f32x4v kkv = *(const f32x4v*)(o + 256 + cg4), bb = *(const f32x4v*)(o + 320 + cg4);
        float v = o[192 + Rr];
        float d1 = SL[0] * kkv.x + SL[1] * kkv.y + SL[2] * kkv.z + SL[3] * kkv.w;
        float d2 = SP[0] * kkv.x + SP[1] * kkv.y + SP[2] * kkv.z + SP[3] * kkv.w;
        allreduce16x2(d1, d2);
        const float saL = -d1, saP = -d2;
        SL[0] = SL[0] * w.x + (saL * bb.x + v * kp.x); SP[0] = SP[0] * w.x + saP * bb.x;
        SL[1] = SL[1] * w.y + (saL * bb.y + v * kp.y); SP[1] = SP[1] * w.y + saP * bb.y;
        SL[2] = SL[2] * w.z + (saL * bb.z + v * kp.z); SP[2] = SP[2] * w.z + saP * bb.z;
        SL[3] = SL[3] * w.w + (saL * bb.w + v * kp.w); SP[3] = SP[3] * w.w + saP * bb.w;
      }
      SCAN_STAGE(((k + 1) & 3), (bsel ^ 1))
      __syncthreads();
    }
  }
  __builtin_amdgcn_s_setprio(0);
  const size_t so = ((size_t)(bh * 7 + seg)) * 4096 + Rr * 64 + cg4;
  *(float4*)((float*)(p.ws + W_SLOC) + so) = make_float4(SL[0], SL[1], SL[2], SL[3]);
  *(float4*)((float*)(p.ws + W_PMAT) + so) = make_float4(SP[0], SP[1], SP[2], SP[3]);
}

DI void allreduce16x4(float& a, float& b, float& c, float& d) {
  a = dpp_add<0xB1>(a); b = dpp_add<0xB1>(b); c = dpp_add<0xB1>(c); d = dpp_add<0xB1>(d);
  a = dpp_add<0x4E>(a); b = dpp_add<0x4E>(b); c = dpp_add<0x4E>(c); d = dpp_add<0x4E>(d);
  a = dpp_add<0x141>(a); b = dpp_add<0x141>(b); c = dpp_add<0x141>(c); d = dpp_add<0x141>(d);
  a = dpp_add<0x140>(a); b = dpp_add<0x140>(b); c = dpp_add<0x140>(c); d = dpp_add<0x140>(d);
}
DI void rwkv_scan_task(const Params& p, int srow0, int T, int h, int rq, const float* S0, float* Sout, int comb_bh, int comb_seg, unsigned char* smem) {
  if (rq & 1) return;
  float* ops = (float*)smem;
  float* sc = ops + 2 * 16 * 384;
  float* ybuf = sc + 64;
  const int tid = TIDX(), i = tid >> 3, c8 = tid & 7, c0 = c8 * 8;
  const int Rr = rq * 16 + i;
  const float* RWW = (const float*)(p.ws + W_RWW); const u16* RWX = (const u16*)(p.ws + W_RWX); float* YRAW = (float*)(p.ws + W_YRAW);
  f32x4v S[2];
  if (S0) { S[0] = *(const f32x4v*)(S0 + Rr * 64 + c0); S[1] = *(const f32x4v*)(S0 + Rr * 64 + c0 + 4); }
  else { S[0] = (f32x4v){0.f, 0.f, 0.f, 0.f}; S[1] = S[0]; }
  if (comb_bh >= 0 && comb_seg > 0) {
    const float* SLOC = (const float*)(p.ws + W_SLOC) + (size_t)comb_bh * 7 * 4096;
    const float* PMAT = (const float*)(p.ws + W_PMAT) + (size_t)comb_bh * 7 * 4096;
    float* srow = ops;
    S[0] = *(const f32x4v*)(SLOC + Rr * 64 + c0); S[1] = *(const f32x4v*)(SLOC + Rr * 64 + c0 + 4);
    for (int sp = 1; sp < comb_seg; sp++) {
      __syncthreads();
      *(f32x4v*)(srow + i * 64 + c0) = S[0]; *(f32x4v*)(srow + i * 64 + c0 + 4) = S[1];
      __syncthreads();
      f32x4v a0 = *(const f32x4v*)(SLOC + (size_t)sp * 4096 + Rr * 64 + c0), a1 = *(const f32x4v*)(SLOC + (size_t)sp * 4096 + Rr * 64 + c0 + 4);
      const float* P = PMAT + (size_t)sp * 4096 + c0;
#pragma unroll 8
      for (int k = 0; k < 64; k++) {
        const float sv = srow[i * 64 + k];
        a0 += sv * *(const f32x4v*)(P + k * 64); a1 += sv * *(const f32x4v*)(P + k * 64 + 4);
      }
      S[0] = a0; S[1] = a1;
    }
  }
  const int lstep = tid >> 4, lpart = (tid & 15) * 4;
  f32x4v pw[2]; u32x2 px[2][5];
  const int nch = T >> 4;
  SCAN_PREFETCH(0, 0) SCAN_PREFETCH(1, 1)
  __syncthreads();
  SCAN_STAGE(0, 0)
  __syncthreads();
  __builtin_amdgcn_s_setprio(3);
  for (int cb = 0; cb < nch; cb += 4) {
#pragma unroll
    for (int k = 0; k < 4; k++) {
      const int cc = cb + k;
      if (cc < nch) {
        const int bsel = k & 1;
        SCAN_PREFETCH((k & 1), cc + 2)
#pragma unroll
        for (int j = 0; j < 2; j++) {
          float yk = 0.f;
#pragma unroll
          for (int u = 0; u < 8; u++) {
            const float* o = ops + (bsel * 16 + j * 8 + u) * 384;
            const float v = o[192 + Rr];
            const float br = sc[(bsel * 16 + j * 8 + u) * 2], kr = sc[(bsel * 16 + j * 8 + u) * 2 + 1];
            f32x4v d1v = S[0] * *(const f32x4v*)(o + 256 + c0) + S[1] * *(const f32x4v*)(o + 256 + c0 + 4);
            f32x4v d2v = S[0] * *(const f32x4v*)(o + 64 + c0) + S[1] * *(const f32x4v*)(o + 64 + c0 + 4);
            float d1 = (d1v.x + d1v.y) + (d1v.z + d1v.w), d2 = (d2v.x + d2v.y) + (d2v.z + d2v.w);
            d1 = dpp_add<0xB1>(d1); d2 = dpp_add<0xB1>(d2); d1 = dpp_add<0x4E>(d1); d2 = dpp_add<0x4E>(d2);
            d1 = dpp_add<0x141>(d1); d2 = dpp_add<0x141>(d2);
#pragma unroll
            for (int m = 0; m < 2; m++) {
              const f32x4v w = *(const f32x4v*)(o + c0 + 4 * m), kp = *(const f32x4v*)(o + 128 + c0 + 4 * m), bb = *(const f32x4v*)(o + 320 + c0 + 4 * m);
              S[m] = S[m] * w + (kp * v - bb * d1);
            }
            const float y = d2 - d1 * br + v * kr;
            yk = (u == c8) ? y : yk;
          }
          ybuf[bsel * 512 + (j * 8 + c8) * 32 + i] = yk;
        }
        SCAN_STAGE(((k + 1) & 1), (bsel ^ 1))
        __syncthreads();
        if (tid < 128) {
          const int st = tid >> 3, i4 = (tid & 7) * 4;
          *(f32x4v*)(YRAW + (size_t)(srow0 + cc * 16 + st) * 512 + h * 64 + rq * 16 + i4) = *(const f32x4v*)(ybuf + bsel * 512 + st * 32 + i4);
        }
      }
    }
  }
  __builtin_amdgcn_s_setprio(0);
  if (Sout) { *(f32x4v*)(Sout + Rr * 64 + c0) = S[0]; *(f32x4v*)(Sout + Rr * 64 + c0 + 4) = S[1]; }
}
constexpr int PH5_TASKS = 512 + 128 + 2048 + 256;
DI void phase5_task(const Params& p, int l, int task, unsigned char* smem) {
  const u16* Z = (const u16*)(p.ws + W_Z); u16* YG = (u16*)(p.ws + W_YG);
  if (task < 512) {
    int bh = task >> 5, seg = 7 - ((task >> 2) & 7), rq = task & 3, b = bh >> 3, h = bh & 7;
    rwkv_scan_task(p, b * TP + seg * 1024, 1024, h, rq, nullptr, seg == 7 ? p.out + O_WKV_P + ((size_t)((l * 2 + b) * 8 + h)) * 4096 : nullptr, bh, seg, smem);
    return;
  }
  task -= 448;
  if (task < 2240) {
    int which, b, h, row0, nq, qpos0, kbase, nkeys; size_t vto; int vstr;
    if (task < 192) { int j = task - 64; which = j >> 6; int bh = j & 63; b = bh >> 3; h = bh & 7; row0 = NP + b * 16; nq = 16; qpos0 = PAST; kbase = NP + b * SK; nkeys = SK; vto = VT_S_OFF + (size_t)((b * 8 + h) * 64) * SK; vstr = SK; }
    else { int j = task - 192; int qb = 63 - (j >> 5); which = (j >> 4) & 1; int bh = j & 15; b = bh >> 3; h = bh & 7; row0 = b * TP + qb * 128; nq = 128; qpos0 = qb * 128; kbase = b * TP; nkeys = TP; vto = (size_t)((b * 8 + h) * 64) * 8192; vstr = 8192; }
    if (which == 0)
      attn_task<64, true>((const u16*)(p.ws + W_SQ) + (size_t)row0 * 512 + h * 64, 512, nq, (const u16*)(p.ws + W_SBK) + (size_t)kbase * 512 + h * 64, 512,
                          (const u16*)(p.ws + W_SBVT) + vto, vstr, nkeys, qpos0, Z + ((size_t)2 * NT + row0) * 512 + h * 64, YG + ((size_t)2 * NT + row0) * 512 + h * 64, smem);
    else
      attn_task<96, false>((const u16*)(p.ws + W_QF) + (size_t)row0 * 768 + h * 96, 768, nq, (const u16*)(p.ws + W_KF) + (size_t)kbase * 768 + h * 96, 768,
                           (const u16*)(p.ws + W_MLAVT) + vto, vstr, nkeys, qpos0, Z + ((size_t)1 * NT + row0) * 512 + h * 64, YG + ((size_t)1 * NT + row0) * 512 + h * 64, smem);
    return;
  }
  {
    int j = task - 2240; int bh = j >> 2, rq = j & 3, b = bh >> 3, h = bh & 7;
    size_t so = ((size_t)((l * 8 + b) * 8 + h)) * 4096;
    rwkv_scan_task(p, NP + b * 16, 16, h, rq, p.in[2] + so, p.out + O_WKV_S + so, -1, 0, smem);
  }
}
DI void phase5(const Params& p, int l, unsigned char* smem) {
  __shared__ int s_task;
  int* ctr = (int*)(p.ws + W_CTR) + l;
  while (true) {
    __syncthreads();
    if (TIDX() == 0) s_task = atomicAdd(ctr, 1);
    __syncthreads();
    int q = s_task;
    if (q >= PH5_TASKS) break;
    int task = q < 1024 ? ((q & 1) ? 512 + (q >> 1) : (q >> 1)) : q;
    phase5_task(p, l, task, smem);
  }
}
DI void phase5b(const Params& p, int l) {
  const int lane = TIDX() & 63, wave = TIDX() >> 6;
  const float* YRAW = (const float*)(p.ws + W_YRAW); const u16* RWX = (const u16*)(p.ws + W_RWX); const float* RHO = (const float*)(p.ws + W_RHO);
  const u16* Z = (const u16*)(p.ws + W_Z); u16* YG = (u16*)(p.ws + W_YG);
  for (int task = blockIdx.x; task < NT / 4; task += gridDim.x) {
    const int row = task * 4 + wave, c0 = lane * 8;
    float y[8];
    { float4 a = *(const float4*)(YRAW + (size_t)row * 512 + c0), b = *(const float4*)(YRAW + (size_t)row * 512 + c0 + 4);
      y[0] = a.x; y[1] = a.y; y[2] = a.z; y[3] = a.w; y[4] = b.x; y[5] = b.y; y[6] = b.z; y[7] = b.w; }
    float s = 0.f;
#pragma unroll
    for (int j = 0; j < 8; j++) s += y[j];
    s += __shfl_xor(s, 1); s += __shfl_xor(s, 2); s += __shfl_xor(s, 4);
    float mu = s * (1.f / 64.f), vs = 0.f;
#pragma unroll
    for (int j = 0; j < 8; j++) { float d = y[j] - mu; vs += d * d; }
    vs += __shfl_xor(vs, 1); vs += __shfl_xor(vs, 2); vs += __shfl_xor(vs, 4);
    float rstd = rsqrtf(vs * (1.f / 64.f) + GN_EPS);
    float rho = RHO[(size_t)row * 8 + (lane >> 3)];
    uint4 vv = *(const uint4*)(RWX + (size_t)row * 2560 + 1024 + c0);
    uint4 zz = *(const uint4*)(Z + (size_t)row * 512 + c0);
    float vf[8] = {bflo(vv.x), bfhi(vv.x), bflo(vv.y), bfhi(vv.y), bflo(vv.z), bfhi(vv.z), bflo(vv.w), bfhi(vv.w)};
    float zf[8] = {bflo(zz.x), bfhi(zz.x), bflo(zz.y), bfhi(zz.y), bflo(zz.z), bfhi(zz.z), bflo(zz.w), bfhi(zz.w)};
    float o[8];
#pragma unroll
    for (int j = 0; j < 8; j++) o[j] = ((y[j] - mu) * rstd * p.in[22][l * 512 + c0 + j] + p.in[23][l * 512 + c0 + j] + rho * vf[j]) * zf[j];
    uint4 ob; ob.x = pk2(o[0], o[1]); ob.y = pk2(o[2], o[3]); ob.z = pk2(o[4], o[5]); ob.w = pk2(o[6], o[7]);
    *(uint4*)(YG + (size_t)row * 512 + c0) = ob;
  }
}

DI void wave_gemm32(f32x16& acc, const u16* A, int lda, const u16* Bt, int ldb, int K) {
  const int lane = TIDX() & 63, r = lane & 31, hl = lane >> 5;
  const u16* ap = A + (size_t)r * lda + hl * 8; const u16* bp = Bt + (size_t)r * ldb + hl * 8;
#pragma unroll 8
  for (int k = 0; k < K; k += 16) { bf16x8 a = *(const bf16x8*)(ap + k); bf16x8 b = *(const bf16x8*)(bp + k); acc = MFMA32(a, b, acc); }
}
DI void phase6(const Params& p, int l, unsigned char* smem) {
  const u16* H = (const u16*)(p.ws + W_H); const u16* WinT = (const u16*)(p.ws + W_WINT);
  const u16* YG = (const u16*)(p.ws + W_YG); u16* MG = (u16*)(p.ws + W_MG);
  for (int t0 = blockIdx.x; t0 < 32 + 128 * 8; t0 += gridDim.x) {
    if (t0 < 32) {
      const int lane = TIDX() & 63, wave = TIDX() >> 6, r = lane & 31, hl = lane >> 5;
      const int unit = t0 * 4 + wave, row0 = NP + (unit & 3) * 32, n0 = (unit >> 2) * 32;
      f32x16 mm;
#pragma unroll
      for (int i = 0; i < 16; i++) mm[i] = 0.f;
#pragma unroll 1
      for (int g = 0; g < 3; g++) {
        f32x16 ay, ag;
#pragma unroll
        for (int i = 0; i < 16; i++) { ay[i] = 0.f; ag[i] = 0.f; }
        wave_gemm32(ay, YG + ((size_t)g * NT + row0) * 512, 512, (const u16*)(p.ws + W_WBRT) + ((size_t)(l * 3 + g) * 1024 + n0) * 512, 512, 512);
        wave_gemm32(ag, H + (size_t)row0 * 1024, 1024, WinT + (size_t)(5408 + g * 1024 + n0) * 1024, 1024, 1024);
#pragma unroll
        for (int i = 0; i < 16; i++) mm[i] += sigmoidf_(ag[i]) * ay[i];
      }
#pragma unroll
      for (int i = 0; i < 16; i++) MG[(size_t)(row0 + crow(i, hl)) * 1024 + n0 + r] = f2bf(mm[i]);
      continue;
    }
    const int t = t0 - 32;
    const int bq = t & 511, mt = (bq & 7) * 16 + ((bq >> 3) & 15), nt = (t >> 9) * 4 + (bq >> 7), m0 = mt * 128, n0 = nt * 128;

    unsigned mpk[2][2][8];
#pragma unroll
    for (int a = 0; a < 2; a++)
#pragma unroll
      for (int b = 0; b < 2; b++)
#pragma unroll
        for (int j = 0; j < 8; j++) mpk[a][b][j] = 0u;
#pragma unroll 1
    for (int g = 0; g < 3; g++) {
      f32x16 acc[2][2]; zero_acc(acc);
      gemm_mainloop(acc, YG + ((size_t)g * NT + m0) * 512, 512, (const u16*)(p.ws + W_WBRT) + ((size_t)(l * 3 + g) * 1024 + n0) * 512, 512, 512, smem);
      unsigned ypk[2][2][8];
#pragma unroll
      for (int a = 0; a < 2; a++)
#pragma unroll
        for (int b = 0; b < 2; b++)
#pragma unroll
          for (int j = 0; j < 8; j++) ypk[a][b][j] = pk2(acc[a][b][2 * j], acc[a][b][2 * j + 1]);
      zero_acc(acc);
      gemm_mainloop(acc, H + (size_t)m0 * 1024, 1024, WinT + (size_t)(5408 + g * 1024 + n0) * 1024, 1024, 1024, smem);
#pragma unroll
      for (int a = 0; a < 2; a++)
#pragma unroll
        for (int b = 0; b < 2; b++)
#pragma unroll
          for (int j = 0; j < 8; j++) {
            float lo = bflo(mpk[a][b][j]) + sigmoidf_(acc[a][b][2 * j]) * bflo(ypk[a][b][j]);
            float hi = bfhi(mpk[a][b][j]) + sigmoidf_(acc[a][b][2 * j + 1]) * bfhi(ypk[a][b][j]);
            mpk[a][b][j] = pk2(lo, hi);
          }
    }
    {
      const int lane = TIDX() & 63, wave = TIDX() >> 6, wm = wave >> 1, wn = wave & 1, r = lane & 31, hl = lane >> 5;
#pragma unroll
      for (int a = 0; a < 2; a++)
#pragma unroll
        for (int b = 0; b < 2; b++)
#pragma unroll
          for (int j = 0; j < 8; j++) {
            int col = n0 + wn * 64 + b * 32 + r;
            int row0 = m0 + wm * 64 + a * 32;
            MG[(size_t)(row0 + crow(2 * j, hl)) * 1024 + col] = (u16)(mpk[a][b][j] & 0xffffu);
            MG[(size_t)(row0 + crow(2 * j + 1, hl)) * 1024 + col] = (u16)(mpk[a][b][j] >> 16);
          }
    }
  }
}
DI void phase7(const Params& p, int l, unsigned char* smem) {
  const u16* MG = (const u16*)(p.ws + W_MG);
  const float* mod = (const float*)(p.ws + W_MOD);
  const int ntile = 32 + 128 * 8, nextra = (l + 1 < NL) ? WIN_TT + SMALLW_TT : 0;
  for (int t0 = blockIdx.x; t0 < ntile + nextra; t0 += gridDim.x) {
    if (t0 >= ntile + WIN_TT) { smallw_transpose_task(p, l + 1, t0 - ntile - WIN_TT, smem); continue; }
    if (t0 >= ntile) { win_transpose_task(p, l + 1, t0 - ntile, smem); continue; }
    if (t0 < 32) {
      const int lane = TIDX() & 63, wave = TIDX() >> 6, r = lane & 31, hl = lane >> 5;
      const int unit = t0 * 4 + wave, row0 = NP + (unit & 3) * 32, n0 = (unit >> 2) * 32;
      f32x16 a;
#pragma unroll
      for (int i = 0; i < 16; i++) a[i] = 0.f;
      wave_gemm32(a, MG + (size_t)row0 * 1024, 1024, (const u16*)(p.ws + W_WOUTT) + ((size_t)l * 1024 + n0) * 1024, 1024, 1024);
#pragma unroll
      for (int i = 0; i < 16; i++) {
        const int row = row0 + crow(i, hl), col = n0 + r;
        float xo = xrow_ptr(p, l, row)[col];
        float gt = mod[(l * 10 + bidx_of(row)) * 3072 + 2048 + col];
        p.out[(size_t)row * D + col] = xo + gt * a[i];
      }
      continue;
    }
    const int t = t0 - 32;
    const int bq = t & 511, mt = (bq & 7) * 16 + ((bq >> 3) & 15), nt = (t >> 9) * 4 + (bq >> 7), m0 = mt * 128, n0 = nt * 128;

    f32x16 acc[2][2]; zero_acc(acc);
    gemm_mainloop(acc, MG + (size_t)m0 * 1024, 1024, (const u16*)(p.ws + W_WOUTT) + ((size_t)l * 1024 + n0) * 1024, 1024, 1024, smem);
    foreach_acc(acc, m0, n0, [&](int row, int col, float v) {
      float xo = xrow_ptr(p, l, row)[col];
      float gt = mod[(l * 10 + bidx_of(row)) * 3072 + 2048 + col];
      p.out[(size_t)row * D + col] = xo + gt * v;
    });
  }
}

#define XB_TMO      128
#define XB_XCNT(j)  (256  + 64 * (j))
#define XB_XSUB(j)  (1280 + 64 * (j))
#define XB_XGEN(j)  (2304 + 64 * (j))
#define XB_TOP      3328
#define XB_TOPGEN   3392
#define XB_SPIN_CAP (1u << 18)
DI unsigned xb_ld(unsigned* q) { return __hip_atomic_load(q, __ATOMIC_RELAXED, __HIP_MEMORY_SCOPE_AGENT); }
DI unsigned xb_add(unsigned* q, unsigned v) { return __hip_atomic_fetch_add(q, v, __ATOMIC_RELAXED, __HIP_MEMORY_SCOPE_AGENT); }
DI unsigned xb_xcc_id() { return (unsigned)__builtin_amdgcn_s_getreg((3 << 11) | 20) & 0xFu; }
#define XB_SPIN(cond, bar) do { unsigned _sp = 0; while (cond) { __builtin_amdgcn_s_sleep(1); \
    if ((++_sp & 255u) == 0u) { if (xb_ld(&(bar)[XB_TMO])) break; if (_sp > XB_SPIN_CAP) { atomicAdd(&(bar)[XB_TMO], 1u); break; } } } } while (0)
DI void xbar(const Params& p, unsigned* xbst) {
  asm volatile("s_waitcnt vmcnt(0)" ::: "memory");
  __syncthreads();
  if (TIDX() == 0) {
    unsigned* bar = (unsigned*)(p.ws + W_XBAR);
    const unsigned x = xb_xcc_id();
    __builtin_amdgcn_s_waitcnt(0);
    const unsigned nloc = xbst[0], nx = xbst[1];
    const unsigned old = xb_add(&bar[XB_XSUB(x)], 1u);
    const unsigned gen = old / nloc;
    if (old + 1u == (gen + 1u) * nloc) {
      __builtin_amdgcn_fence(__ATOMIC_RELEASE, "agent");
      asm volatile("s_waitcnt vmcnt(0)" ::: "memory");
      const unsigned og = xb_add(&bar[XB_TOP], 1u);
      const unsigned tg = og / nx;
      if (og + 1u == (tg + 1u) * nx) xb_add(&bar[XB_TOPGEN], 1u);
      else XB_SPIN(xb_ld(&bar[XB_TOPGEN]) == tg, bar);
      __builtin_amdgcn_fence(__ATOMIC_ACQUIRE, "agent");
      xb_add(&bar[XB_XGEN(x)], 1u);
      asm volatile("s_waitcnt vmcnt(0)" ::: "memory");
    } else {
      XB_SPIN(xb_ld(&bar[XB_XGEN(x)]) == gen, bar);
      __builtin_amdgcn_fence(__ATOMIC_ACQUIRE, "agent");
      asm volatile("s_waitcnt vmcnt(0)" ::: "memory");
    }
  }
  __syncthreads();
}
DI int opq(int v) { asm volatile("" : "+s"(v)); return v; }
#if MULTI
template <int PH> __global__ void __launch_bounds__(256, 2) phase_kernel(Params p, int l) {
  __shared__ __attribute__((aligned(16))) unsigned char smem[SMEM_BYTES];
  if (PH == 0) phase0(p, smem);
  if (PH == 1) phase1(p, l);
  if (PH == 2) phase2(p, l, smem);
  if (PH == 3) phase3(p, l);
  if (PH == 4) phase4(p, l, smem);
  if (PH == 5) phase5(p, l, smem);
  if (PH == 6) phase5b(p, l);
  if (PH == 7) phase6(p, l, smem);
  if (PH == 8) phase7(p, l, smem);
}
#else
__global__ void __launch_bounds__(256, 2) mega_kernel(Params p_arg) {
  __shared__ __attribute__((aligned(16))) unsigned char smem[SMEM_BYTES];
  const Params& p = *(const Params*)__builtin_amdgcn_kernarg_segment_ptr();
  cg::grid_group grid = cg::this_grid();
  __shared__ unsigned xbst[4];
  if (TIDX() == 0) (void)xb_add((unsigned*)(p.ws + W_XBAR) + XB_XCNT(xb_xcc_id()), 1u);
  phase0(p, smem);
  grid.sync();
  if (TIDX() == 0) {
    unsigned* bar = (unsigned*)(p.ws + W_XBAR);
    const unsigned x = xb_xcc_id();
    unsigned cnt = 0u, mine = 0u;
    for (unsigned j = 0; j < 16; ++j) { const unsigned c = xb_ld(&bar[XB_XCNT(j)]); cnt += (c > 0u) ? 1u : 0u; mine = (j == x) ? c : mine; }
    xbst[0] = mine > 0u ? mine : 1u; xbst[1] = cnt > 0u ? cnt : 1u;
  }
  for (int l = 0; l < NL; l++) {
    phase1(p, opq(l)); xbar(p, xbst);
    phase2(p, opq(l), smem); xbar(p, xbst);
    phase3(p, opq(l)); xbar(p, xbst);
    phase4(p, opq(l), smem); xbar(p, xbst);
    phase5(p, opq(l), smem); xbar(p, xbst);
    phase5b(p, opq(l)); xbar(p, xbst);
    phase6(p, opq(l), smem); xbar(p, xbst);
    phase7(p, opq(l), smem); xbar(p, xbst);
  }
}
#endif

extern "C" void kernel_launch(void* const* d_in, const int* in_sizes, int n_in, void* d_out, int out_size, void* d_ws, size_t ws_size, hipStream_t stream) {
  Params p{};
  for (int i = 0; i < 36; i++) p.in[i] = (const float*)d_in[i];
  p.out = (float*)d_out;
  p.ws = (unsigned char*)d_ws;
  if (ws_size < W_TOTAL) fprintf(stderr, "workspace too small: %zu < %zu\n", ws_size, (size_t)W_TOTAL);
  hipMemsetAsync((unsigned char*)d_ws + W_CTR, 0, 256 + 3456 * 4, stream);
#if MULTI
  const int G = 1024;
  phase_kernel<0><<<G, 256, 0, stream>>>(p, 0);
  for (int l = 0; l < NL; l++) {
    phase_kernel<1><<<G, 256, 0, stream>>>(p, l);
    phase_kernel<2><<<G, 256, 0, stream>>>(p, l);
    phase_kernel<3><<<G, 256, 0, stream>>>(p, l);
    phase_kernel<4><<<G, 256, 0, stream>>>(p, l);
    phase_kernel<5><<<G, 256, 0, stream>>>(p, l);
    phase_kernel<6><<<G, 256, 0, stream>>>(p, l);
    phase_kernel<7><<<G, 256, 0, stream>>>(p, l);
    phase_kernel<8><<<G, 256, 0, stream>>>(p, l);
  }
#else
  static int grid_blocks = 0;
  if (!grid_blocks) {
    int dev = 0, cus = 0, per_cu = 0;
    hipGetDevice(&dev);
    hipDeviceGetAttribute(&cus, hipDeviceAttributeMultiprocessorCount, dev);
    hipOccupancyMaxActiveBlocksPerMultiprocessor(&per_cu, mega_kernel, 256, 0);
    if (per_cu > 2) per_cu = 2;
    grid_blocks = cus * per_cu;
  }
  void* args[] = {&p};
  hipError_t e = hipLaunchCooperativeKernel((void*)mega_kernel, dim3(grid_blocks), dim3(256), args, 0, stream);
  if (e != hipSuccess) fprintf(stderr, "cooperative launch failed: %s (grid %d)\n", hipGetErrorString(e), grid_blocks);
#endif
}
```

```cpp
#include <hip/hip_runtime.h>
#include <hip/hip_cooperative_groups.h>
#include <cstdio>
namespace cg = cooperative_groups;

#ifndef MULTI
#define MULTI 0
#endif

typedef unsigned short u16;
typedef __attribute__((ext_vector_type(8))) short bf16x8;
typedef __attribute__((ext_vector_type(16))) float f32x16;
typedef __attribute__((ext_vector_type(2))) __bf16 bf2_t;
typedef __attribute__((ext_vector_type(2))) float f2_t;
typedef __attribute__((ext_vector_type(4))) unsigned u32x4;
typedef __attribute__((ext_vector_type(2))) unsigned u32x2;
typedef __attribute__((ext_vector_type(4))) float f32x4v;
#define DI __device__ __forceinline__
#define MFMA32(a, b, c) __builtin_amdgcn_mfma_f32_32x32x16_bf16((a), (b), (c), 0, 0, 0)

constexpr int D = 1024, NL = 4, NP = 16384, NS = 128, NT = NP + NS, TP = 8192, TS = 16, PAST = 2048, SK = 2064;
constexpr int NKV = NP + 8 * SK;
constexpr int DIN = 8480;
constexpr float RMS_EPS = 1e-6f, GN_EPS = 64e-5f;
constexpr float LOG2E = 1.4426950408889634f;
constexpr float QSCALE_MLA = 0.10206207261596577f * LOG2E;
constexpr float QSCALE_SB = 0.125f * LOG2E;

constexpr size_t O_Y = 0;
constexpr size_t O_WKV_P = (size_t)NT * D;
constexpr size_t O_SHIFT_P = O_WKV_P + (size_t)NL * 2 * 8 * 4096;
constexpr size_t O_CKV_P = O_SHIFT_P + (size_t)NL * 2 * 1664;
constexpr size_t O_KROPE_P = O_CKV_P + (size_t)NL * NP * 256;
constexpr size_t O_SBK_P = O_KROPE_P + (size_t)NL * NP * 32;
constexpr size_t O_SBV_P = O_SBK_P + (size_t)NL * NP * 512;
constexpr size_t O_WKV_S = O_SBV_P + (size_t)NL * NP * 512;
constexpr size_t O_SHIFT_S = O_WKV_S + (size_t)NL * 8 * 8 * 4096;
constexpr size_t O_CKV_S = O_SHIFT_S + (size_t)NL * 8 * 1664;
constexpr size_t O_KROPE_S = O_CKV_S + (size_t)NL * NS * 256;
constexpr size_t O_SBK_S = O_KROPE_S + (size_t)NL * NS * 32;
constexpr size_t O_SBV_S = O_SBK_S + (size_t)NL * NS * 512;

constexpr size_t al(size_t x) { return (x + 255) & ~(size_t)255; }
constexpr size_t W_WINT = 0;
constexpr size_t W_WBRT = al(W_WINT + (size_t)DIN * 1024 * 2);
constexpr size_t W_WOUTT = al(W_WBRT + (size_t)NL * 3 * 1024 * 512 * 2);
constexpr size_t W_WUQT = al(W_WOUTT + (size_t)NL * 1024 * 1024 * 2);
constexpr size_t W_WUKVT = al(W_WUQT + (size_t)NL * 768 * 384 * 2);
constexpr size_t W_WUPT = al(W_WUKVT + (size_t)NL * 1024 * 256 * 2);
constexpr size_t W_AUPT = al(W_WUPT + (size_t)NL * 512 * 64 * 2);
constexpr size_t W_MOD = al(W_AUPT + (size_t)NL * 512 * 64 * 2);
constexpr size_t W_ROPE = al(W_MOD + (size_t)NL * 10 * 3072 * 4);
constexpr size_t W_CTR = al(W_ROPE + (size_t)8192 * 32 * 4);
constexpr size_t W_XBAR = W_CTR + 256;
constexpr size_t W_H = al(W_XBAR + 3456 * 4);
constexpr size_t W_PR = al(W_H + (size_t)NT * 1024 * 2);
constexpr size_t W_YG = W_PR;
constexpr size_t W_YRAW = al(W_YG + (size_t)3 * NT * 512 * 2);
constexpr size_t W_MG = W_YRAW;
constexpr size_t W_Z = al(W_PR + (size_t)NT * 1664 * 4);
constexpr size_t W_CQ = al(W_Z + (size_t)3 * NT * 512 * 2);
constexpr size_t W_QF = W_CQ;
constexpr size_t W_CKV = al(W_CQ + (size_t)NT * 768 * 2);
constexpr size_t W_KR = al(W_CKV + (size_t)NT * 256 * 4);
constexpr size_t W_QN = al(W_KR + (size_t)NT * 32 * 4);
constexpr size_t W_CKVN = al(W_QN + (size_t)NT * 384 * 2);
constexpr size_t W_SQ = al(W_CKVN + (size_t)(NKV + 64) * 256 * 2);
constexpr size_t W_SBK = al(W_SQ + (size_t)NT * 512 * 2);
constexpr size_t VT_S_OFF = (size_t)16 * 64 * 8192;
constexpr size_t VT_ELEMS = VT_S_OFF + (size_t)64 * 64 * SK + 256;
constexpr size_t W_SBVT = al(W_SBK + (size_t)(NKV + 64) * 512 * 2);
constexpr size_t W_RWW = al(W_SBVT + VT_ELEMS * 2);
constexpr size_t W_RWX = al(W_RWW + (size_t)NT * 512 * 4);
constexpr size_t W_RHO = al(W_RWX + (size_t)NT * 5 * 512 * 2);
constexpr size_t W_KF = al(W_RHO + (size_t)NT * 8 * 4);
constexpr size_t W_MLAVT = al(W_KF + (size_t)(NKV + 64) * 768 * 2);
constexpr size_t W_SLOC = al(W_MLAVT + VT_ELEMS * 2);
constexpr size_t W_PMAT = al(W_SLOC + (size_t)16 * 7 * 4096 * 4);
constexpr size_t W_TOTAL = al(W_PMAT + (size_t)16 * 7 * 4096 * 4);
static_assert((size_t)NT * 384 * 4 <= (size_t)NT * 768 * 2, "alias");
static_assert(W_YRAW + (size_t)NT * 1024 * 2 <= W_Z, "alias overflow");

struct Params {
  const float* in[36];
  float* out;
  unsigned char* ws;
};

constexpr int SMEM_BYTES = 73728;

DI int TIDX() { int t = __builtin_amdgcn_workitem_id_x(); asm volatile("" : "+v"(t)); return t; }
DI u16 f2bf(float x) { return __builtin_bit_cast(u16, (__bf16)x); }
DI unsigned pk2(float a, float b) { f2_t v = {a, b}; return __builtin_bit_cast(unsigned, __builtin_convertvector(v, bf2_t)); }
DI float bf2f(u16 x) { return __uint_as_float((unsigned)x << 16); }
DI float bflo(unsigned x) { return __uint_as_float(x << 16); }
DI float bfhi(unsigned x) { return __uint_as_float(x & 0xffff0000u); }
DI float ex2(float x) { return __builtin_amdgcn_exp2f(x); }
DI float lg2(float x) { return __builtin_amdgcn_logf(x); }
DI float frcp(float x) { return __builtin_amdgcn_rcpf(x); }
DI float sigmoidf_(float x) { return frcp(1.f + __expf(-x)); }
DI float siluf_(float x) { return x * frcp(1.f + __expf(-x)); }
DI float softplusf_(float x) { return fmaxf(x, 0.f) + __logf(1.f + __expf(-fabsf(x))); }
DI float tanhf_(float x) { return 1.f - 2.f * frcp(1.f + __expf(2.f * x)); }
DI int crow(int i, int hl) { return (i & 3) + 8 * (i >> 2) + 4 * hl; }
template <int CTRL> DI float dppf(float x) {
  return __int_as_float(__builtin_amdgcn_update_dpp(__float_as_int(x), __float_as_int(x), CTRL, 0xF, 0xF, false));
}
DI float allreduce16(float x) {
  x += dppf<0xB1>(x); x += dppf<0x4E>(x); x += dppf<0x141>(x); x += dppf<0x140>(x); return x;
}
DI float red32(float x) {
  x += __shfl_xor(x, 1); x += __shfl_xor(x, 2); x += __shfl_xor(x, 4); x += __shfl_xor(x, 8); x += __shfl_xor(x, 16); return x;
}
DI float red64(float x) { x = red32(x); x += __shfl_xor(x, 32); return x; }
DI int bidx_of(int row) { return row < NP ? (row >> 13) : 2 + ((row - NP) >> 4); }
DI int keyrow_of(int row) { return row < NP ? row : NP + ((row - NP) >> 4) * SK + PAST + ((row - NP) & 15); }
DI int pos_of(int row) { return row < NP ? (row & 8191) : PAST + ((row - NP) & 15); }
DI size_t vt_off(int keyrow, int h, int d) {
  if (keyrow < NP) { int b = keyrow >> 13, s = keyrow & 8191; return ((size_t)((b * 8 + h) * 64 + d)) * 8192 + s; }
  int rr = keyrow - NP; int b = rr / SK, s = rr - b * SK; return VT_S_OFF + ((size_t)((b * 8 + h) * 64 + d)) * SK + s;
}

DI void gemm_mainloop(f32x16 (&acc)[2][2], const u16* A, int lda, const u16* Bt, int ldb, int K, unsigned char* smem) {
  u16* s0 = (u16*)smem;
  const int tid = TIDX(), lane = tid & 63, wave = tid >> 6, wm = wave >> 1, wn = wave & 1;
  const int lr = tid >> 3, lc = (tid & 7) * 8;
  unsigned offA[4], offB[4];
#pragma unroll
  for (int i = 0; i < 4; i++) { offA[i] = (unsigned)(((lr + 32 * i) * lda + lc) * 2); offB[i] = (unsigned)(((lr + 32 * i) * ldb + lc) * 2); }
  const char* Ab = (const char*)A;
  const char* Bb = (const char*)Bt;
  u32x4 ra[4], rb[4];
  const int nk = K >> 6;
  const int r = lane & 31, hl = lane >> 5;
#pragma unroll
  for (int i = 0; i < 4; i++) { ra[i] = *(const u32x4*)(Ab + offA[i]); rb[i] = *(const u32x4*)(Bb + offB[i]); }
  __syncthreads();
#pragma unroll
  for (int i = 0; i < 4; i++) { *(u32x4*)(s0 + (lr + 32 * i) * 72 + lc) = ra[i]; *(u32x4*)(s0 + 128 * 72 + (lr + 32 * i) * 72 + lc) = rb[i]; }
  if (nk > 1) { Ab += 128; Bb += 128; }
#pragma unroll
  for (int i = 0; i < 4; i++) { ra[i] = *(const u32x4*)(Ab + offA[i]); rb[i] = *(const u32x4*)(Bb + offB[i]); }
  __syncthreads();
  for (int kt = 0; kt < nk; kt++) {
    u16* sA = s0 + (kt & 1) * (256 * 72); u16* sB = sA + 128 * 72;
    if (kt + 1 < nk) {
      u16* nA = s0 + ((kt + 1) & 1) * (256 * 72); u16* nB = nA + 128 * 72;
#pragma unroll
      for (int i = 0; i < 4; i++) { *(u32x4*)(nA + (lr + 32 * i) * 72 + lc) = ra[i]; *(u32x4*)(nB + (lr + 32 * i) * 72 + lc) = rb[i]; }
    }
    if (kt + 2 < nk) { Ab += 128; Bb += 128; }
#pragma unroll
    for (int i = 0; i < 4; i++) { ra[i] = *(const u32x4*)(Ab + offA[i]); rb[i] = *(const u32x4*)(Bb + offB[i]); }
#pragma unroll
    for (int ks = 0; ks < 4; ks++) {
      bf16x8 af[2], bfr[2];
#pragma unroll
      for (int b = 0; b < 2; b++) {
        af[b] = *(const bf16x8*)(sA + (wm * 64 + b * 32 + r) * 72 + ks * 16 + hl * 8);
        bfr[b] = *(const bf16x8*)(sB + (wn * 64 + b * 32 + r) * 72 + ks * 16 + hl * 8);
      }
#pragma unroll
      for (int bm = 0; bm < 2; bm++)
#pragma unroll
        for (int bn = 0; bn < 2; bn++) acc[bm][bn] = MFMA32(af[bm], bfr[bn], acc[bm][bn]);
    }
    __syncthreads();
  }
}
DI void zero_acc(f32x16 (&acc)[2][2]) {
#pragma unroll
  for (int a = 0; a < 2; a++)
#pragma unroll
    for (int b = 0; b < 2; b++)
#pragma unroll
      for (int i = 0; i < 16; i++) acc[a][b][i] = 0.f;
}
template <class F> DI void foreach_acc(f32x16 (&acc)[2][2], int m0, int n0, F f) {
  const int lane = TIDX() & 63, wave = TIDX() >> 6, wm = wave >> 1, wn = wave & 1, r = lane & 31, hl = lane >> 5;
#pragma unroll
  for (int bm = 0; bm < 2; bm++)
#pragma unroll
    for (int bn = 0; bn < 2; bn++)
#pragma unroll
      for (int i = 0; i < 16; i++) f(m0 + wm * 64 + bm * 32 + crow(i, hl), n0 + wn * 64 + bn * 32 + r, acc[bm][bn][i]);
}

DI void transpose_tile(const float* __restrict__ src, int K, int N, u16* __restrict__ dst, int kt, int nt, int mode, unsigned char* smem) {
  float* tile = (float*)smem;
  const int tid = TIDX(), tx = tid & 63, ty = tid >> 6;
  const int k0 = kt * 64, n0 = nt * 64;
  __syncthreads();
#pragma unroll 4
  for (int i = 0; i < 16; i++) { int k = i * 4 + ty; int n = n0 + tx; tile[k * 65 + tx] = (n < N) ? src[(size_t)(k0 + k) * N + n] : 0.f; }
  __syncthreads();
#pragma unroll 4
  for (int i = 0; i < 16; i++) {
    int nl = i * 4 + ty; int n = n0 + nl;
    if (n < N) {
      int nd = n;
      if (mode == 1) { int hd = n / 96, d = n - hd * 96; nd = d < 64 ? hd * 64 + d : 512 + hd * 32 + (d - 64); }
      dst[(size_t)nd * K + k0 + tx] = f2bf(tile[tx * 65 + nl]);
    }
  }
}
constexpr int WIN_TT = 16 * 133;
DI void win_transpose_task(const Params& p, int l, int t, unsigned char* smem) {
  int kt = t & 15, nt = t >> 4;
  transpose_tile(p.in[13] + (size_t)l * 1024 * DIN, 1024, DIN, (u16*)(p.ws + W_WINT), kt, nt, 0, smem);
}
constexpr int SMALLW_TT = 384 + 256 + 72 + 64 + 8 + 8;
DI void smallw_transpose_task(const Params& p, int l, int t, unsigned char* smem) {
  if (t < 384) { int g = t / 128, q = t % 128; const float* src = p.in[g == 0 ? 24 : (g == 1 ? 33 : 34)] + (size_t)l * 512 * 1024;
    transpose_tile(src, 512, 1024, (u16*)(p.ws + W_WBRT) + ((size_t)(l * 3 + g)) * 1024 * 512, q & 7, q >> 3, 0, smem); return; }
  t -= 384;
  if (t < 256) { transpose_tile(p.in[35] + (size_t)l * 1024 * 1024, 1024, 1024, (u16*)(p.ws + W_WOUTT) + (size_t)l * 1024 * 1024, t & 15, t >> 4, 0, smem); return; }
  t -= 256;
  if (t < 72) { transpose_tile(p.in[26] + (size_t)l * 384 * 768, 384, 768, (u16*)(p.ws + W_WUQT) + (size_t)l * 768 * 384, t % 6, t / 6, 1, smem); return; }
  t -= 72;
  if (t < 64) { transpose_tile(p.in[28] + (size_t)l * 256 * 1024, 256, 1024, (u16*)(p.ws + W_WUKVT) + (size_t)l * 1024 * 256, t & 3, t >> 2, 0, smem); return; }
  t -= 64;
  if (t < 8) { transpose_tile(p.in[16] + (size_t)l * 64 * 512, 64, 512, (u16*)(p.ws + W_WUPT) + (size_t)l * 512 * 64, 0, t, 0, smem); return; }
  t -= 8;
  transpose_tile(p.in[18] + (size_t)l * 64 * 512, 64, 512, (u16*)(p.ws + W_AUPT) + (size_t)l * 512 * 64, 0, t, 0, smem);
}
DI void mod_task(const Params& p, int task, unsigned char* smem) {
  float* sm = (float*)smem;
  const int tid = TIDX(), l = task / 48, cb = task % 48, kq = tid >> 6, cl = tid & 63, col = cb * 64 + cl;
  __syncthreads();
  for (int e = tid; e < 10240; e += 256) { int r = e >> 10, k = e & 1023; float c = r < 2 ? p.in[8][r * 1024 + k] : p.in[9][(r - 2) * 1024 + k]; sm[e] = siluf_(c); }
  __syncthreads();
  float acc[10];
#pragma unroll
  for (int r = 0; r < 10; r++) acc[r] = 0.f;
  const float* w = p.in[10] + ((size_t)l * 1024 + kq * 256) * 3072 + col;
#pragma unroll 8
  for (int k = 0; k < 256; k++) {
    float wv = w[(size_t)k * 3072];
#pragma unroll
    for (int r = 0; r < 10; r++) acc[r] += sm[r * 1024 + kq * 256 + k] * wv;
  }
  __syncthreads();
#pragma unroll
  for (int r = 0; r < 10; r++) sm[(kq * 10 + r) * 64 + cl] = acc[r];
  __syncthreads();
  if (tid < 64) {
    float* mod = (float*)(p.ws + W_MOD);
    float bb = p.in[11][l * 3072 + col];
#pragma unroll
    for (int r = 0; r < 10; r++) mod[(l * 10 + r) * 3072 + col] = sm[r * 64 + cl] + sm[(10 + r) * 64 + cl] + sm[(20 + r) * 64 + cl] + sm[(30 + r) * 64 + cl] + bb;
  }
}
DI void rope_task(const Params& p, int task) {
  const int tid = TIDX(); const int pos = task * 128 + (tid >> 1);
  float* rope = (float*)(p.ws + W_ROPE);
  for (int ff = 0; ff < 8; ff++) {
    int f = (tid & 1) * 8 + ff;
    double inv = 1.0; for (int j = 0; j < f; j++) inv *= 0.5623413251903491;
    double ang = (double)pos * inv;
    double n = rint(ang * 0.15915494309189535);
    double rr = ang - n * 6.283185307179586 - n * 2.4492935982947064e-16;
    double r2 = rr * rr, sn = rr, cs = 1.0, ts = rr, tc = 1.0;
    for (int k = 1; k <= 15; k++) { tc *= -r2 / (double)((2 * k - 1) * (2 * k)); cs += tc; ts *= -r2 / (double)((2 * k) * (2 * k + 1)); sn += ts; }
    rope[pos * 32 + f] = (float)cs; rope[pos * 32 + 16 + f] = (float)sn;
  }
}
DI void phase0(const Params& p, unsigned char* smem) {
  const int n_tr = WIN_TT + SMALLW_TT, total = n_tr + 192 + 64;
  for (int t = blockIdx.x; t < total; t += gridDim.x) {
    if (t < 192) mod_task(p, t, smem);
    else if (t < 192 + 64) rope_task(p, t - 192);
    else { int q = t - 256; if (q < WIN_TT) win_transpose_task(p, 0, q, smem); else { q -= WIN_TT; smallw_transpose_task(p, 0, q, smem); } }
  }
}

DI const float* xrow_ptr(const Params& p, int l, int row) {
  if (l > 0) return p.out + (size_t)row * D;
  return row < NP ? p.in[0] + (size_t)row * D : p.in[1] + (size_t)(row - NP) * D;
}
DI void phase1(const Params& p, int l) {
  const int lane = TIDX() & 63, wave = TIDX() >> 6;
  const float* mod = (const float*)(p.ws + W_MOD);
  const float* g = p.in[12] + l * 1024;
  u16* H = (u16*)(p.ws + W_H);
  for (int task = blockIdx.x; task < NT / 4; task += gridDim.x) {
    int row = task * 4 + wave;
    const float* x = xrow_ptr(p, l, row);
    const float* md = mod + (l * 10 + bidx_of(row)) * 3072;
    float4 v[4]; float ss = 0.f;
#pragma unroll
    for (int j = 0; j < 4; j++) { v[j] = *(const float4*)(x + (j * 64 + lane) * 4); ss += v[j].x * v[j].x + v[j].y * v[j].y + v[j].z * v[j].z + v[j].w * v[j].w; }
    ss = red64(ss);
    float rstd = rsqrtf(ss * (1.f / 1024.f) + RMS_EPS);
#pragma unroll
    for (int j = 0; j < 4; j++) {
      int c = (j * 64 + lane) * 4;
      float4 gg = *(const float4*)(g + c), sh = *(const float4*)(md + c), sc = *(const float4*)(md + 1024 + c);
      float h0 = v[j].x * rstd * gg.x * (1.f + sc.x) + sh.x, h1 = v[j].y * rstd * gg.y * (1.f + sc.y) + sh.y;
      float h2 = v[j].z * rstd * gg.z * (1.f + sc.z) + sh.z, h3 = v[j].w * rstd * gg.w * (1.f + sc.w) + sh.w;
      uint2 o; o.x = pk2(h0, h1); o.y = pk2(h2, h3);
      *(uint2*)(H + (size_t)row * 1024 + c) = o;
    }
  }
}

DI void phase2(const Params& p, int l, unsigned char* smem) {
  const u16* H = (const u16*)(p.ws + W_H);
  const u16* WinT = (const u16*)(p.ws + W_WINT);
  float* PR = (float*)(p.ws + W_PR);
  u16* Z = (u16*)(p.ws + W_Z);
  float* CQ = (float*)(p.ws + W_CQ); float* CKV = (float*)(p.ws + W_CKV); float* KR = (float*)(p.ws + W_KR);
  u16* SQ = (u16*)(p.ws + W_SQ); u16* SBK = (u16*)(p.ws + W_SBK); u16* SBVT = (u16*)(p.ws + W_SBVT);
  float* out = p.out;
  for (int ts = blockIdx.x; ts < 11 * 512; ts += gridDim.x) {
    int mt, nt;
    {
      const int rd = ts >> 9, bq = ts & 511, sm = bq & 7, j = bq >> 3;
      mt = sm * 16 + (j & 15); nt = rd * 4 + (j >> 4);
      if (nt >= 43) { const int e = sm * 16 + (j & 15); if (e >= 43) continue; mt = 128; nt = e; }
    }
    const int m0 = mt * 128;
    int seg, n0, c0;
    if (nt < 13) { seg = 0; c0 = nt * 128; n0 = c0; }
    else if (nt < 17) { seg = 1; c0 = (nt - 13) * 128; n0 = 1664 + c0; }
    else if (nt < 20) { seg = 2; c0 = (nt - 17) * 128; n0 = 2176 + c0; }
    else if (nt < 22) { seg = 3; c0 = (nt - 20) * 128; n0 = 2560 + c0; }
    else if (nt < 26) { seg = 4; c0 = (nt - 22) * 128; n0 = 2848 + c0; }
    else if (nt < 30) { seg = 5; c0 = (nt - 26) * 128; n0 = 3360 + c0; }
    else if (nt < 34) { seg = 6; c0 = (nt - 30) * 128; n0 = 3872 + c0; }
    else if (nt < 38) { seg = 7; c0 = (nt - 34) * 128; n0 = 4384 + c0; }
    else if (nt < 42) { seg = 8; c0 = (nt - 38) * 128; n0 = 4896 + c0; }
    else { seg = 9; c0 = 0; n0 = 2816; }
    f32x16 acc[2][2]; zero_acc(acc);
    gemm_mainloop(acc, H + (size_t)m0 * 1024, 1024, WinT + (size_t)n0 * 1024, 1024, 1024, smem);
    if (seg == 0) {
      foreach_acc(acc, m0, c0, [&](int row, int col, float v) {
        PR[(size_t)row * 1664 + col] = v;
        if (row < NP) { if ((row & 8191) == 8191) out[O_SHIFT_P + (size_t)(l * 2 + (row >> 13)) * 1664 + col] = v; }
        else { int rr = row - NP; if ((rr & 15) == 15) out[O_SHIFT_S + (size_t)(l * 8 + (rr >> 4)) * 1664 + col] = v; }
      });
    } else if (seg == 1 || seg == 4 || seg == 8) {
      const int g = seg == 1 ? 0 : (seg == 4 ? 1 : 2);
      foreach_acc(acc, m0, c0, [&](int row, int col, float v) { Z[((size_t)g * NT + row) * 512 + col] = f2bf(siluf_(v)); });
    } else if (seg == 2) {
      foreach_acc(acc, m0, c0, [&](int row, int col, float v) { CQ[(size_t)row * 384 + col] = v; });
    } else if (seg == 3) {
      foreach_acc(acc, m0, c0, [&](int row, int col, float v) { CKV[(size_t)row * 256 + col] = v; });
    } else if (seg == 9) {
      foreach_acc(acc, m0, c0, [&](int row, int col, float v) { if (col < 32) KR[(size_t)row * 32 + col] = v; });
    } else if (seg == 5) {
      foreach_acc(acc, m0, c0, [&](int row, int col, float v) { SQ[(size_t)row * 512 + col] = f2bf(v * QSCALE_SB); });
    } else if (seg == 6) {
      foreach_acc(acc, m0, c0, [&](int row, int col, float v) {
        size_t oo = row < NP ? O_SBK_P + ((size_t)l * NP + row) * 512 + col : O_SBK_S + ((size_t)l * NS + (row - NP)) * 512 + col;
        out[oo] = v;
        SBK[(size_t)keyrow_of(row) * 512 + col] = f2bf(v);
      });
    } else {
      foreach_acc(acc, m0, c0, [&](int row, int col, float v) {
        size_t oo = row < NP ? O_SBV_P + ((size_t)l * NP + row) * 512 + col : O_SBV_S + ((size_t)l * NS + (row - NP)) * 512 + col;
        out[oo] = v;
      });
      const int lane = TIDX() & 63, wave = TIDX() >> 6, wm = wave >> 1, wn = wave & 1, r = lane & 31, hl = lane >> 5;
#pragma unroll
      for (int bm = 0; bm < 2; bm++)
#pragma unroll
        for (int bn = 0; bn < 2; bn++)
#pragma unroll
          for (int g4 = 0; g4 < 4; g4++) {
            int row = m0 + wm * 64 + bm * 32 + 8 * g4 + 4 * hl, col = c0 + wn * 64 + bn * 32 + r;
            uint2 o; o.x = pk2(acc[bm][bn][4 * g4], acc[bm][bn][4 * g4 + 1]); o.y = pk2(acc[bm][bn][4 * g4 + 2], acc[bm][bn][4 * g4 + 3]);
            *(uint2*)(SBVT + vt_off(keyrow_of(row), col >> 6, col & 63)) = o;
          }
    }
  }
}

DI const float* prev_ptr(const Params& p, int l, const float* PR, int row) {
  if (row < NP) return (row & 8191) ? PR + (size_t)(row - 1) * 1664 : nullptr;
  int rr = row - NP;
  return (rr & 15) ? PR + (size_t)(row - 1) * 1664 : p.in[3] + (size_t)(l * 8 + (rr >> 4)) * 1664;
}
DI void rwkv_prep_task(const Params& p, int l, int task) {
  const int lane = TIDX() & 63, wave = TIDX() >> 6, r = lane & 31, hl = lane >> 5;
  const int tile = task >> 1, hh = (task & 1) * 4 + wave, row0 = tile * 32;
  const float* PR = (const float*)(p.ws + W_PR);
  const float* mu = p.in[14] + l * 1664;
  f32x16 accW[1][2], accA[1][2];
#pragma unroll
  for (int b_ = 0; b_ < 2; b_++)
#pragma unroll
    for (int i_ = 0; i_ < 16; i_++) { accW[0][b_][i_] = 0.f; accA[0][b_][i_] = 0.f; }
  const u16* WupT = (const u16*)(p.ws + W_WUPT) + (size_t)l * 512 * 64;
  const u16* AupT = (const u16*)(p.ws + W_AUPT) + (size_t)l * 512 * 64;
#pragma unroll 1
  for (int ks = 0; ks < 4; ks++) {
    const int k0 = ks * 16 + hl * 8;
    bf16x8 bw[2], ba[2];
#pragma unroll
    for (int bn = 0; bn < 2; bn++) {
      bw[bn] = *(const bf16x8*)(WupT + (size_t)(hh * 64 + bn * 32 + r) * 64 + k0);
      ba[bn] = *(const bf16x8*)(AupT + (size_t)(hh * 64 + bn * 32 + r) * 64 + k0);
    }
#pragma unroll
    for (int bm = 0; bm < 1; bm++) {
      const int row = row0 + bm * 32 + r;
      const float* pp = PR + (size_t)row * 1664;
      const float* pv = prev_ptr(p, l, PR, row);
      float xw[8], xa[8];
#pragma unroll
      for (int q = 0; q < 2; q++) {
        float4 a = *(const float4*)(pp + 1536 + k0 + 4 * q), b = pv ? *(const float4*)(pv + 1536 + k0 + 4 * q) : make_float4(0, 0, 0, 0), m = *(const float4*)(mu + 1536 + k0 + 4 * q);
        xw[4 * q] = tanhf_(a.x + (b.x - a.x) * m.x); xw[4 * q + 1] = tanhf_(a.y + (b.y - a.y) * m.y); xw[4 * q + 2] = tanhf_(a.z + (b.z - a.z) * m.z); xw[4 * q + 3] = tanhf_(a.w + (b.w - a.w) * m.w);
        a = *(const float4*)(pp + 1600 + k0 + 4 * q); b = pv ? *(const float4*)(pv + 1600 + k0 + 4 * q) : make_float4(0, 0, 0, 0); m = *(const float4*)(mu + 1600 + k0 + 4 * q);
        xa[4 * q] = a.x + (b.x - a.x) * m.x; xa[4 * q + 1] = a.y + (b.y - a.y) * m.y; xa[4 * q + 2] = a.z + (b.z - a.z) * m.z; xa[4 * q + 3] = a.w + (b.w - a.w) * m.w;
      }
      u32x4 uw, ua;
      uw.x = pk2(xw[0], xw[1]); uw.y = pk2(xw[2], xw[3]); uw.z = pk2(xw[4], xw[5]); uw.w = pk2(xw[6], xw[7]);
      ua.x = pk2(xa[0], xa[1]); ua.y = pk2(xa[2], xa[3]); ua.z = pk2(xa[4], xa[5]); ua.w = pk2(xa[6], xa[7]);
      bf16x8 awf = __builtin_bit_cast(bf16x8, uw), aaf = __builtin_bit_cast(bf16x8, ua);
#pragma unroll
      for (int bn = 0; bn < 2; bn++) { accW[bm][bn] = MFMA32(awf, bw[bn], accW[bm][bn]); accA[bm][bn] = MFMA32(aaf, ba[bn], accA[bm][bn]); }
    }
  }
  float* RWW = (float*)(p.ws + W_RWW); u16* RWX = (u16*)(p.ws + W_RWX); float* RHO = (float*)(p.ws + W_RHO);
  float mur[2], muk[2], muv[2], w0[2], a0[2], kk_[2], ka_[2], rk_[2];
#pragma unroll
  for (int bn = 0; bn < 2; bn++) {
    int col = hh * 64 + bn * 32 + r;
    mur[bn] = mu[col]; muk[bn] = mu[512 + col]; muv[bn] = mu[1024 + col];
    w0[bn] = p.in[15][l * 512 + col]; a0[bn] = p.in[17][l * 512 + col]; kk_[bn] = p.in[19][l * 512 + col]; ka_[bn] = p.in[20][l * 512 + col]; rk_[bn] = p.in[21][l * 512 + col];
  }
#pragma unroll
  for (int bm = 0; bm < 1; bm++)
#pragma unroll
    for (int i = 0; i < 16; i++) {
      const int row = row0 + bm * 32 + crow(i, hl);
      const float* pp = PR + (size_t)row * 1664;
      const float* pv = prev_ptr(p, l, PR, row);
      float xr[2], xv[2], kp[2], kkr[2], av[2], dec[2];
      float ssq = 0.f, rho = 0.f;
#pragma unroll
      for (int bn = 0; bn < 2; bn++) {
        int col = hh * 64 + bn * 32 + r;
        float pr_ = pp[col], pk_ = pp[512 + col], pv_ = pp[1024 + col];
        float qr = pv ? pv[col] : 0.f, qk = pv ? pv[512 + col] : 0.f, qv = pv ? pv[1024 + col] : 0.f;
        xr[bn] = pr_ + (qr - pr_) * mur[bn];
        float xk = pk_ + (qk - pk_) * muk[bn];
        xv[bn] = pv_ + (qv - pv_) * muv[bn];
        float wpre = w0[bn] + accW[bm][bn][i];
        float wlog = -softplusf_(-wpre) - 0.5f;
        dec[bn] = __expf(-__expf(wlog));
        av[bn] = sigmoidf_(a0[bn] + accA[bm][bn][i]);
        kkr[bn] = xk * kk_[bn];
        kp[bn] = xk * (1.f + (av[bn] - 1.f) * ka_[bn]);
        ssq += kkr[bn] * kkr[bn];
        rho += xr[bn] * kp[bn] * rk_[bn];
      }
      ssq = red32(ssq); rho = red32(rho);
      float inv = rsqrtf(fmaxf(ssq, 1e-24f));
#pragma unroll
      for (int bn = 0; bn < 2; bn++) {
        int col = hh * 64 + bn * 32 + r;
        float kk = kkr[bn] * inv;
        RWW[(size_t)row * 512 + col] = dec[bn];
        u16* rx = RWX + (size_t)row * 2560 + col;
        rx[0] = f2bf(xr[bn]); rx[512] = f2bf(kp[bn]); rx[1024] = f2bf(xv[bn]); rx[1536] = f2bf(kk); rx[2048] = f2bf(kk * av[bn]);
      }
      if (r == 0) RHO[(size_t)row * 8 + hh] = rho;
    }
}
DI void norm_row_task(const Params& p, int l, int task) {
  const int lane = TIDX() & 63, wave = TIDX() >> 6;
  const int row = task * 4 + wave;
  const float* CQ = (const float*)(p.ws + W_CQ); const float* CKV = (const float*)(p.ws + W_CKV); const float* KR = (const float*)(p.ws + W_KR);
  u16* QN = (u16*)(p.ws + W_QN); u16* CKVN = (u16*)(p.ws + W_CKVN); u16* KF = (u16*)(p.ws + W_KF);
  const int keyrow = keyrow_of(row);
  {
    float v[6], ss = 0.f;
#pragma unroll
    for (int j = 0; j < 6; j++) { v[j] = CQ[(size_t)row * 384 + j * 64 + lane]; ss += v[j] * v[j]; }
    ss = red64(ss); float rstd = rsqrtf(ss * (1.f / 384.f) + RMS_EPS);
#pragma unroll
    for (int j = 0; j < 6; j++) QN[(size_t)row * 384 + j * 64 + lane] = f2bf(v[j] * rstd * p.in[25][l * 384 + j * 64 + lane]);
  }
  {
    float4 v = *(const float4*)(CKV + (size_t)row * 256 + lane * 4);
    float ss = red64(v.x * v.x + v.y * v.y + v.z * v.z + v.w * v.w);
    float rstd = rsqrtf(ss * (1.f / 256.f) + RMS_EPS);
    float4 g = *(const float4*)(p.in[27] + l * 256 + lane * 4);
    float4 o = make_float4(v.x * rstd * g.x, v.y * rstd * g.y, v.z * rstd * g.z, v.w * rstd * g.w);
    size_t oo = row < NP ? O_CKV_P + ((size_t)l * NP + row) * 256 : O_CKV_S + ((size_t)l * NS + (row - NP)) * 256;
    *(float4*)(p.out + oo + lane * 4) = o;
    uint2 ob; ob.x = pk2(o.x, o.y); ob.y = pk2(o.z, o.w);
    *(uint2*)(CKVN + (size_t)keyrow * 256 + lane * 4) = ob;
  }
  {
    float x = lane < 32 ? KR[(size_t)row * 32 + lane] : 0.f;
    float ss = red64(x * x); float rstd = rsqrtf(ss * (1.f / 32.f) + RMS_EPS);
    float xn = x * rstd * p.in[32][l * 32 + (lane & 31)];
    float pt = __shfl_xor(xn, 16);
    const float* rp = (const float*)(p.ws + W_ROPE) + pos_of(row) * 32;
    float cs = rp[lane & 15], sn = rp[16 + (lane & 15)];
    float o = (lane & 16) ? (pt * sn + xn * cs) : (xn * cs - pt * sn);
    if (lane < 32) {
      size_t oo = row < NP ? O_KROPE_P + ((size_t)l * NP + row) * 32 : O_KROPE_S + ((size_t)l * NS + (row - NP)) * 32;
      p.out[oo + lane] = o;
      u16 ob = f2bf(o);
#pragma unroll
      for (int hd = 0; hd < 8; hd++) KF[(size_t)keyrow * 768 + hd * 96 + 64 + lane] = ob;
    }
  }
}
DI void past_convert_task(const Params& p, int l, int task) {
  const int tid = TIDX();
  if (task < 2048) {
    size_t e = ((size_t)task * 256 + tid) * 8; int rowp = (int)(e >> 8), c = (int)(e & 255); int b = rowp >> 11, s = rowp & 2047;
    const float* src = p.in[4] + ((size_t)(l * 8 + b) * PAST + s) * 256 + c;
    float4 a = *(const float4*)src, bq = *(const float4*)(src + 4);
    uint4 o; o.x = pk2(a.x, a.y); o.y = pk2(a.z, a.w); o.z = pk2(bq.x, bq.y); o.w = pk2(bq.z, bq.w);
    *(uint4*)((u16*)(p.ws + W_CKVN) + (size_t)(NP + b * SK + s) * 256 + c) = o; return;
  }
  task -= 2048;
  if (task < 4096) {
    size_t e = ((size_t)task * 256 + tid) * 8; int rowp = (int)(e >> 9), c = (int)(e & 511); int b = rowp >> 11, s = rowp & 2047;
    const float* src = p.in[6] + ((size_t)(l * 8 + b) * PAST + s) * 512 + c;
    float4 a = *(const float4*)src, bq = *(const float4*)(src + 4);
    uint4 o; o.x = pk2(a.x, a.y); o.y = pk2(a.z, a.w); o.z = pk2(bq.x, bq.y); o.w = pk2(bq.z, bq.w);
    *(uint4*)((u16*)(p.ws + W_SBK) + (size_t)(NP + b * SK + s) * 512 + c) = o; return;
  }
  task -= 4096;
  if (task < 4096) {
    int id = task * 256 + tid; int c = id & 511, sg = (id >> 9) & 255, b = id >> 17;
    const float* src = p.in[7] + ((size_t)(l * 8 + b) * PAST + sg * 8) * 512 + c;
    float v[8];
#pragma unroll
    for (int j = 0; j < 8; j++) v[j] = src[(size_t)j * 512];
    uint4 o; o.x = pk2(v[0], v[1]); o.y = pk2(v[2], v[3]); o.z = pk2(v[4], v[5]); o.w = pk2(v[6], v[7]);
    *(uint4*)((u16*)(p.ws + W_SBVT) + VT_S_OFF + ((size_t)((b * 8 + (c >> 6)) * 64 + (c & 63))) * SK + sg * 8) = o; return;
  }
  task -= 4096;
  {
    int id = task * 256 + tid; int ch = id & 7, rowp = id >> 3; int b = rowp >> 11, s = rowp & 2047;
    float4 a = *(const float4*)(p.in[5] + ((size_t)(l * 8 + b) * PAST + s) * 32 + ch * 4);
    uint2 o; o.x = pk2(a.x, a.y); o.y = pk2(a.z, a.w);
    u16* dst = (u16*)(p.ws + W_KF) + (size_t)(NP + b * SK + s) * 768 + 64 + ch * 4;
#pragma unroll
    for (int hd = 0; hd < 8; hd++) *(uint2*)(dst + hd * 96) = o;
  }
}
DI void phase3(const Params& p, int l) {
  const int nA = 1032, nB = NT / 4, nC = 2048 + 4096 + 4096 + 512, total = nA + nB + nC;
  for (int t = blockIdx.x; t < total; t += gridDim.x) {
    if (t < nA) rwkv_prep_task(p, l, t);
    else if (t < nA + nB) norm_row_task(p, l, t - nA);
    else past_convert_task(p, l, t - nA - nB);
  }
}

DI void rwkv_pass1_task(const Params& p, int bh, int seg, int rq, unsigned char* smem);
DI void phase4(const Params& p, int l, unsigned char* smem) {
  const int lane = TIDX() & 63, wave = TIDX() >> 6, wm = wave >> 1, wn = wave & 1, r = lane & 31, hl = lane >> 5;
  const float* rope = (const float*)(p.ws + W_ROPE);
  u16* QF = (u16*)(p.ws + W_QF); u16* KF = (u16*)(p.ws + W_KF); u16* VT = (u16*)(p.ws + W_MLAVT);
  const int nQ = 129 * 6, nKV = 257 * 8;
  __shared__ int s_task4;
  int* ctr4 = (int*)(p.ws + W_CTR) + 8 + l;
  while (true) {
    __syncthreads();
    if (TIDX() == 0) s_task4 = atomicAdd(ctr4, 1);
    __syncthreads();
    const int q4 = s_task4;
    if (q4 >= 448 + nQ + nKV) break;
    const int t0 = q4 < 896 ? ((q4 & 1) ? 448 + (q4 >> 1) : (q4 >> 1)) : q4;
    if (t0 < 448) { int bh = t0 / 28, rem = t0 - bh * 28; rwkv_pass1_task(p, bh, rem >> 2, rem & 3, smem); continue; }
    const int t = t0 - 448;
    f32x16 acc[2][2]; zero_acc(acc);
    if (t < nQ) {
      const int mt = t % 129, nt = t / 129, m0 = mt * 128;
      gemm_mainloop(acc, (const u16*)(p.ws + W_QN) + (size_t)m0 * 384, 384, (const u16*)(p.ws + W_WUQT) + ((size_t)l * 768 + nt * 128) * 384, 384, 384, smem);
      if (nt < 4) {
        const int head = nt * 2 + wn;
        float g0 = p.in[29][l * 64 + r] * QSCALE_MLA, g1 = p.in[29][l * 64 + 32 + r] * QSCALE_MLA;
#pragma unroll
        for (int bm = 0; bm < 2; bm++)
#pragma unroll
          for (int i = 0; i < 16; i++) {
            float a = acc[bm][0][i], b = acc[bm][1][i];
            float ss = red32(a * a + b * b); float rstd = rsqrtf(ss * (1.f / 64.f) + RMS_EPS);
            int row = m0 + wm * 64 + bm * 32 + crow(i, hl);
            u16* q = QF + (size_t)row * 768 + head * 96;
            q[r] = f2bf(a * rstd * g0); q[32 + r] = f2bf(b * rstd * g1);
          }
      } else {
        float g = p.in[30][l * 32 + r] * QSCALE_MLA;
#pragma unroll
        for (int bm = 0; bm < 2; bm++)
#pragma unroll
          for (int bn = 0; bn < 2; bn++)
#pragma unroll
            for (int i = 0; i < 16; i++) {
              const int head = (nt - 4) * 4 + wn * 2 + bn;
              float a = acc[bm][bn][i];
              float ss = red32(a * a); float rstd = rsqrtf(ss * (1.f / 32.f) + RMS_EPS);
              float xn = a * rstd * g; float pt = __shfl_xor(xn, 16);
              int row = m0 + wm * 64 + bm * 32 + crow(i, hl);
              const float* rp = rope + pos_of(row) * 32;
              float cs = rp[r & 15], sn = rp[16 + (r & 15)];
              float o = (r & 16) ? (pt * sn + xn * cs) : (xn * cs - pt * sn);
              QF[(size_t)row * 768 + head * 96 + 64 + r] = f2bf(o);
            }
      }
    } else {
      const int q = t - nQ, mt = q % 257, head = q / 257, m0 = mt * 128;
      gemm_mainloop(acc, (const u16*)(p.ws + W_CKVN) + (size_t)m0 * 256, 256, (const u16*)(p.ws + W_WUKVT) + ((size_t)l * 1024 + head * 128) * 256, 256, 256, smem);
      if (wn == 0) {
        float g0 = p.in[31][l * 64 + r], g1 = p.in[31][l * 64 + 32 + r];
#pragma unroll
        for (int bm = 0; bm < 2; bm++)
#pragma unroll
          for (int i = 0; i < 16; i++) {
            float a = acc[bm][0][i], b = acc[bm][1][i];
            float ss = red32(a * a + b * b); float rstd = rsqrtf(ss * (1.f / 64.f) + RMS_EPS);
            int krow = m0 + wm * 64 + bm * 32 + crow(i, hl);
            u16* k = KF + (size_t)krow * 768 + head * 96;
            k[r] = f2bf(a * rstd * g0); k[32 + r] = f2bf(b * rstd * g1);
          }
      } else {
#pragma unroll
        for (int bm = 0; bm < 2; bm++)
#pragma unroll
          for (int bn = 0; bn < 2; bn++)
#pragma unroll
            for (int g4 = 0; g4 < 4; g4++) {
              int krow = m0 + wm * 64 + bm * 32 + 8 * g4 + 4 * hl, d = bn * 32 + r;
              uint2 o; o.x = pk2(acc[bm][bn][4 * g4], acc[bm][bn][4 * g4 + 1]); o.y = pk2(acc[bm][bn][4 * g4 + 2], acc[bm][bn][4 * g4 + 3]);
              *(uint2*)(VT + vt_off(krow, head, d)) = o;
            }
      }
    }
  }
}

template <int DK, bool SB>
DI void attn_task(const u16* __restrict__ Qp, int qstride, int nq_valid, const u16* __restrict__ Kp, int kstride,
                  const u16* __restrict__ Vtp, int vstride, int nkeys, int qpos0,
                  const u16* __restrict__ Zp, u16* __restrict__ Yp, unsigned char* smem) {
  constexpr int KS = DK / 16, KSTR = DK + 8, KCH = DK / 8, NKL = 64 * KCH / 256;
  constexpr int BUFE = 64 * KSTR + 64 * 72;
  u16* sbase = (u16*)smem;
  const int tid = TIDX(), lane = tid & 63, wave = tid >> 6, r = lane & 31, hl = lane >> 5;
  const int slot = wave * 32 + r;
  const bool wave_active = wave * 32 < nq_valid;
  const int qpos = qpos0 + slot;
  bf16x8 qf[KS];
  {
    const u16* qrow = Qp + (size_t)(slot < nq_valid ? slot : 0) * qstride + hl * 8;
#pragma unroll
    for (int ks = 0; ks < KS; ks++) qf[ks] = *(const bf16x8*)(qrow + ks * 16);
  }
  f32x16 O[2];
#pragma unroll
  for (int b = 0; b < 2; b++)
#pragma unroll
    for (int i = 0; i < 16; i++) O[b][i] = 0.f;
  float m_run = -1e30f, l_run = 0.f, R = 1.f;
  const int last_qpos = qpos0 + nq_valid - 1;
  int ntiles = SB ? (last_qpos - 1) / 64 + 1 : last_qpos / 64 + 1;
  { int mx = (nkeys + 63) >> 6; if (ntiles > mx) ntiles = mx; }
  const int wave_q0 = qpos0 + wave * 32;
  u32x4 rk[NKL], rv[2];
  unsigned offK[NKL], offV[2];
#pragma unroll
  for (int i = 0; i < NKL; i++) { int c = tid + 256 * i; int row = c / KCH, ch = c - row * KCH; offK[i] = (unsigned)((row * kstride + ch * 8) * 2); }
#pragma unroll
  for (int i = 0; i < 2; i++) { int c = tid + 256 * i; int row = c >> 3, ch = c & 7; offV[i] = (unsigned)((row * vstride + ch * 8) * 2); }
  auto prefetch = [&](int kt) {
    const char* kb_ = (const char*)(Kp + (size_t)kt * 64 * kstride);
    const char* vb_ = (const char*)(Vtp + kt * 64);
#pragma unroll
    for (int i = 0; i < NKL; i++) rk[i] = *(const u32x4*)(kb_ + offK[i]);
#pragma unroll
    for (int i = 0; i < 2; i++) rv[i] = *(const u32x4*)(vb_ + offV[i]);
  };
  auto lds_store = [&](int bsel) {
    u16* wK = sbase + bsel * BUFE; u16* wV = wK + 64 * KSTR;
#pragma unroll
    for (int i = 0; i < NKL; i++) { int c = tid + 256 * i; int row = c / KCH, ch = c - row * KCH; *(u32x4*)(wK + row * KSTR + ch * 8) = rk[i]; }
#pragma unroll
    for (int i = 0; i < 2; i++) { int c = tid + 256 * i; int row = c >> 3, ch = c & 7; *(u32x4*)(wV + row * 72 + ch * 8) = rv[i]; }
  };
  prefetch(SB ? ntiles - 1 : 0);
  __syncthreads();
  lds_store(0);
  { int nx = SB ? ntiles - 2 : 1; if (ntiles < 2) nx = SB ? ntiles - 1 : 0; prefetch(nx); }
  __syncthreads();
  for (int it = 0; it < ntiles; it++) {
    const int kt = SB ? ntiles - 1 - it : it;
    const u16* sK = sbase + (it & 1) * BUFE; const u16* sV = sK + 64 * KSTR;
    bool doit;
    if (SB) doit = wave_active && (kt * 64 < wave_q0 + 31);
    else doit = wave_active && (kt <= (wave_q0 >> 6));
    if (doit) {
    f32x16 S[2];
#pragma unroll
    for (int kb = 0; kb < 2; kb++) {
#pragma unroll
      for (int i = 0; i < 16; i++) S[kb][i] = 0.f;
#pragma unroll
      for (int ks = 0; ks < KS; ks++) {
        bf16x8 kf = *(const bf16x8*)(sK + (kb * 32 + r) * KSTR + ks * 16 + hl * 8);
        S[kb] = MFMA32(kf, qf[ks], S[kb]);
      }
    }
    const int key0 = kt * 64 + 4 * hl;
    if (!SB) {
      const bool need_mask = (kt + 1) * 64 > nkeys;
      if (need_mask) {
#pragma unroll
        for (int kb = 0; kb < 2; kb++)
#pragma unroll
          for (int i = 0; i < 16; i++) { int key = key0 + kb * 32 + (i & 3) + 8 * (i >> 2); if (key >= nkeys) S[kb][i] = -1e30f; }
      }
      float tmax = -1e30f;
#pragma unroll
      for (int kb = 0; kb < 2; kb++)
#pragma unroll
        for (int i = 0; i < 16; i++) tmax = fmaxf(tmax, S[kb][i]);
      tmax = fmaxf(tmax, __shfl_xor(tmax, 32));
      float m_new = fmaxf(m_run, tmax);
      float alpha = ex2(m_run - m_new);
      m_run = m_new;
      float ps = 0.f;
#pragma unroll
      for (int kb = 0; kb < 2; kb++)
#pragma unroll
        for (int i = 0; i < 16; i++) { float pv = ex2(S[kb][i] - m_new); S[kb][i] = pv; ps += pv; }
      l_run = l_run * alpha + ps;
#pragma unroll
      for (int b = 0; b < 2; b++)
#pragma unroll
        for (int i = 0; i < 16; i++) O[b][i] *= alpha;
    } else {
      const bool need_mask = (kt * 64 + 63 >= wave_q0) || ((kt + 1) * 64 > nkeys);
#pragma unroll
      for (int kb = 0; kb < 2; kb++)
#pragma unroll
        for (int i = 0; i < 16; i++) {
          float d = __builtin_amdgcn_rcpf(1.f + ex2(S[kb][i]));
          if (need_mask) { int key = key0 + kb * 32 + (i & 3) + 8 * (i >> 2); if (!(key < nkeys && key < qpos)) d = 1.f; }
          S[kb][i] = d;
        }
      float gs[8], pg[8], sa[8];
#pragma unroll
      for (int o = 0; o < 8; o++) { int kb = o >> 2, g = o & 3; gs[o] = (S[kb][4 * g] * S[kb][4 * g + 1]) * (S[kb][4 * g + 2] * S[kb][4 * g + 3]); }
#pragma unroll
      for (int o = 0; o < 8; o++) pg[o] = __shfl_xor(gs[o], 32);
      sa[7] = R;
#pragma unroll
      for (int o = 6; o >= 0; o--) sa[o] = sa[o + 1] * (gs[o + 1] * pg[o + 1]);
      const float total = sa[0] * (gs[0] * pg[0]);
#pragma unroll
      for (int o = 0; o < 8; o++) {
        int kb = o >> 2, g = o & 3;
        float c = hl == 0 ? sa[o] * pg[o] : sa[o];
#pragma unroll
        for (int e = 3; e >= 0; e--) {
          float d = S[kb][4 * g + e];
          S[kb][4 * g + e] = c - d * c;
          c *= d;
        }
      }
      R = total;
    }
#pragma unroll
    for (int kb = 0; kb < 2; kb++)
#pragma unroll
      for (int s2 = 0; s2 < 2; s2++) {
        uint4 u;
        u.x = pk2(S[kb][8 * s2], S[kb][8 * s2 + 1]); u.y = pk2(S[kb][8 * s2 + 2], S[kb][8 * s2 + 3]);
        u.z = pk2(S[kb][8 * s2 + 4], S[kb][8 * s2 + 5]); u.w = pk2(S[kb][8 * s2 + 6], S[kb][8 * s2 + 7]);
        bf16x8 pf = __builtin_bit_cast(bf16x8, u);
#pragma unroll
        for (int bd = 0; bd < 2; bd++) {
          const u16* vp = sV + (bd * 32 + r) * 72 + kb * 32 + s2 * 16 + hl * 4;
          uint2 lo = *(const uint2*)vp, hi = *(const uint2*)(vp + 8);
          uint4 vv; vv.x = lo.x; vv.y = lo.y; vv.z = hi.x; vv.w = hi.y;
          O[bd] = MFMA32(__builtin_bit_cast(bf16x8, vv), pf, O[bd]);
        }
      }
    }
    if (it + 1 < ntiles) {
      lds_store((it + 1) & 1);
      int nx = SB ? kt - 2 : kt + 2; if (it + 2 >= ntiles) nx = kt; prefetch(nx);
    }
    if (SB) {
      const bool lane_done = !wave_active || slot >= nq_valid || R < 1e-30f;
      const int wdone = __all(lane_done);
      if (__syncthreads_and(wdone)) break;
    } else {
      __syncthreads();
    }
  }
  if (wave_active && slot < nq_valid) {
    float sc = 1.f;
    if (!SB) { float lt = l_run + __shfl_xor(l_run, 32); sc = 1.f / lt; }
#pragma unroll
    for (int bd = 0; bd < 2; bd++)
#pragma unroll
      for (int g = 0; g < 4; g++) {
        int d0 = bd * 32 + 8 * g + 4 * hl;
        uint2 zz = *(const uint2*)(Zp + (size_t)slot * 512 + d0);
        uint2 o;
        o.x = pk2(O[bd][4 * g] * sc * bflo(zz.x), O[bd][4 * g + 1] * sc * bfhi(zz.x));
        o.y = pk2(O[bd][4 * g + 2] * sc * bflo(zz.y), O[bd][4 * g + 3] * sc * bfhi(zz.y));
        *(uint2*)(Yp + (size_t)slot * 512 + d0) = o;
      }
  }
}

template <int CTRL> DI float dpp_add(float x) {
  return x + __int_as_float(__builtin_amdgcn_update_dpp(0, __float_as_int(x), CTRL, 0xF, 0xF, true));
}
DI void allreduce16x2(float& a, float& b) {
  a = dpp_add<0xB1>(a); b = dpp_add<0xB1>(b); a = dpp_add<0x4E>(a); b = dpp_add<0x4E>(b);
  a = dpp_add<0x141>(a); b = dpp_add<0x141>(b); a = dpp_add<0x140>(a); b = dpp_add<0x140>(b);
}
#define SCAN_PREFETCH(slot, cc) { int c_ = (cc) < nch ? (cc) : nch - 1; size_t row = (size_t)(srow0 + c_ * 16 + lstep); \
    pw[slot] = *(const f32x4v*)(RWW + row * 512 + h * 64 + lpart); \
    _Pragma("unroll") for (int c = 0; c < 5; c++) px[slot][c] = *(const u32x2*)(RWX + row * 2560 + c * 512 + h * 64 + lpart); }
#define SCAN_STAGE(slot, bsel) { float* o = ops + ((bsel) * 16 + lstep) * 384 + lpart; \
    f32x4v r4 = {bflo(px[slot][0].x), bfhi(px[slot][0].x), bflo(px[slot][0].y), bfhi(px[slot][0].y)}; \
    f32x4v k4 = {bflo(px[slot][1].x), bfhi(px[slot][1].x), bflo(px[slot][1].y), bfhi(px[slot][1].y)}; \
    f32x4v v4 = {bflo(px[slot][2].x), bfhi(px[slot][2].x), bflo(px[slot][2].y), bfhi(px[slot][2].y)}; \
    f32x4v kk4 = {bflo(px[slot][3].x), bfhi(px[slot][3].x), bflo(px[slot][3].y), bfhi(px[slot][3].y)}; \
    f32x4v b4 = {bflo(px[slot][4].x), bfhi(px[slot][4].x), bflo(px[slot][4].y), bfhi(px[slot][4].y)}; \
    *(f32x4v*)(o) = pw[slot]; *(f32x4v*)(o + 64) = pw[slot] * r4; *(f32x4v*)(o + 128) = k4; *(f32x4v*)(o + 192) = v4; *(f32x4v*)(o + 256) = kk4; *(f32x4v*)(o + 320) = b4; \
    float br = b4.x * r4.x + b4.y * r4.y + b4.z * r4.z + b4.w * r4.w; \
    float kr = k4.x * r4.x + k4.y * r4.y + k4.z * r4.z + k4.w * r4.w; \
    allreduce16x2(br, kr); \
    if ((tid & 15) == 0) { sc[((bsel) * 16 + lstep) * 2] = br; sc[((bsel) * 16 + lstep) * 2 + 1] = kr; } }

DI void rwkv_pass1_task(const Params& p, int bh, int seg, int rq, unsigned char* smem) {
  float* ops = (float*)smem; float* sc = ops + 2 * 16 * 384;
  const int tid = TIDX(), i = tid >> 4, cg = tid & 15, cg4 = cg * 4;
  const int Rr = rq * 16 + i, h = bh & 7;
  const int srow0 = (bh >> 3) * TP + seg * 1024;
  const float* RWW = (const float*)(p.ws + W_RWW); const u16* RWX = (const u16*)(p.ws + W_RWX);
  float SL[4] = {0.f, 0.f, 0.f, 0.f}, SP[4];
#pragma unroll
  for (int e = 0; e < 4; e++) SP[e] = (cg4 + e == Rr) ? 1.f : 0.f;
  const int lstep = tid >> 4, lpart = (tid & 15) * 4;
  f32x4v pw[4]; u32x2 px[4][5];
  const int nch = 64;
  SCAN_PREFETCH(0, 0) SCAN_PREFETCH(1, 1) SCAN_PREFETCH(2, 2) SCAN_PREFETCH(3, 3)
  __syncthreads();
  SCAN_STAGE(0, 0)
  __syncthreads();
  __builtin_amdgcn_s_setprio(3);
  for (int cb = 0; cb < nch; cb += 4) {
#pragma unroll
    for (int k = 0; k < 4; k++) {
      const int c0 = cb + k;
      const int bsel = k & 1;
      SCAN_PREFETCH(k, c0 + 4)
#pragma unroll
      for (int st = 0; st < 16; st++) {
        const float* o = ops + (bsel * 16 + st) * 384;
        f32x4v w = *(const f32x4v*)(o + cg4), kp = *(const f32x4v*)(o + 128 + cg4);
        f32x4v kkv = *(const f32x4v*)(o + 256 + cg4), bb = *(const f32x4v*)(o + 320 + cg4);
        float v = o[192 + Rr];
        float d1 = SL[0] * kkv.x + SL[1] * kkv.y + SL[2] * kkv.z + SL[3] * kkv.w;
        float d2 = SP[0] * kkv.x + SP[1] * kkv.y + SP[2] * kkv.z + SP[3] * kkv.w;
        allreduce16x2(d1, d2);
        const float saL = -d1, saP = -d2;
        SL[0] = SL[0] * w.x + (saL * bb.x + v * kp.x); SP[0] = SP[0] * w.x + saP * bb.x;
        SL[1] = SL[1] * w.y + (saL * bb.y + v * kp.y); SP[1] = SP[1] * w.y + saP * bb.y;
        SL[2] = SL[2] * w.z + (saL * bb.z + v * kp.z); SP[2] = SP[2] * w.z + saP * bb.z;
        SL[3] = SL[3] * w.w + (saL * bb.w + v * kp.w); SP[3] = SP[3] * w.w + saP * bb.w;
      }
      SCAN_STAGE(((k + 1) & 3), (bsel ^ 1))
      __syncthreads();
    }
  }
  __builtin_amdgcn_s_setprio(0);
  const size_t so = ((size_t)(bh * 7 + seg)) * 4096 + Rr * 64 + cg4;
  *(float4*)((float*)(p.ws + W_SLOC) + so) = make_float4(SL[0], SL[1], SL[2], SL[3]);
  *(float4*)((float*)(p.ws + W_PMAT) + so) = make_float4(SP[0], SP[1], SP[2], SP[3]);
}

DI void allreduce16x4(float& a, float& b, float& c, float& d) {
  a = dpp_add<0xB1>(a); b = dpp_add<0xB1>(b); c = dpp_add<0xB1>(c); d = dpp_add<0xB1>(d);
  a = dpp_add<0x4E>(a); b = dpp_add<0x4E>(b); c = dpp_add<0x4E>(c); d = dpp_add<0x4E>(d);
  a = dpp_add<0x141>(a); b = dpp_add<0x141>(b); c = dpp_add<0x141>(c); d = dpp_add<0x141>(d);
  a = dpp_add<0x140>(a); b = dpp_add<0x140>(b); c = dpp_add<0x140>(c); d = dpp_add<0x140>(d);
}
DI void rwkv_scan_task(const Params& p, int srow0, int T, int h, int rq, const float* S0, float* Sout, int comb_bh, int comb_seg, unsigned char* smem) {
  if (rq & 1) return;
  float* ops = (float*)smem;
  float* sc = ops + 2 * 16 * 384;
  float* ybuf = sc + 64;
  const int tid = TIDX(), i = tid >> 3, c8 = tid & 7, c0 = c8 * 8;
  const int Rr = rq * 16 + i;
  const float* RWW = (const float*)(p.ws + W_RWW); const u16* RWX = (const u16*)(p.ws + W_RWX); float* YRAW = (float*)(p.ws + W_YRAW);
  f32x4v S[2];
  if (S0) { S[0] = *(const f32x4v*)(S0 + Rr * 64 + c0); S[1] = *(const f32x4v*)(S0 + Rr * 64 + c0 + 4); }
  else { S[0] = (f32x4v){0.f, 0.f, 0.f, 0.f}; S[1] = S[0]; }
  if (comb_bh >= 0 && comb_seg > 0) {
    const float* SLOC = (const float*)(p.ws + W_SLOC) + (size_t)comb_bh * 7 * 4096;
    const float* PMAT = (const float*)(p.ws + W_PMAT) + (size_t)comb_bh * 7 * 4096;
    float* srow = ops;
    S[0] = *(const f32x4v*)(SLOC + Rr * 64 + c0); S[1] = *(const f32x4v*)(SLOC + Rr * 64 + c0 + 4);
    for (int sp = 1; sp < comb_seg; sp++) {
      __syncthreads();
      *(f32x4v*)(srow + i * 64 + c0) = S[0]; *(f32x4v*)(srow + i * 64 + c0 + 4) = S[1];
      __syncthreads();
      f32x4v a0 = *(const f32x4v*)(SLOC + (size_t)sp * 4096 + Rr * 64 + c0), a1 = *(const f32x4v*)(SLOC + (size_t)sp * 4096 + Rr * 64 + c0 + 4);
      const float* P = PMAT + (size_t)sp * 4096 + c0;
#pragma unroll 8
      for (int k = 0; k < 64; k++) {
        const float sv = srow[i * 64 + k];
        a0 += sv * *(const f32x4v*)(P + k * 64); a1 += sv * *(const f32x4v*)(P + k * 64 + 4);
      }
      S[0] = a0; S[1] = a1;
    }
  }
  const int lstep = tid >> 4, lpart = (tid & 15) * 4;
  f32x4v pw[2]; u32x2 px[2][5];
  const int nch = T >> 4;
  SCAN_PREFETCH(0, 0) SCAN_PREFETCH(1, 1)
  __syncthreads();
  SCAN_STAGE(0, 0)
  __syncthreads();
  __builtin_amdgcn_s_setprio(3);
  for (int cb = 0; cb < nch; cb += 4) {
#pragma unroll
    for (int k = 0; k < 4; k++) {
      const int cc = cb + k;
      if (cc < nch) {
        const int bsel = k & 1;
        SCAN_PREFETCH((k & 1), cc + 2)
#pragma unroll
        for (int j = 0; j < 2; j++) {
          float yk = 0.f;
#pragma unroll
          for (int u = 0; u < 8; u++) {
            const float* o = ops + (bsel * 16 + j * 8 + u) * 384;
            const float v = o[192 + Rr];
            const float br = sc[(bsel * 16 + j * 8 + u) * 2], kr = sc[(bsel * 16 + j * 8 + u) * 2 + 1];
            f32x4v d1v = S[0] * *(const f32x4v*)(o + 256 + c0) + S[1] * *(const f32x4v*)(o + 256 + c0 + 4);
            f32x4v d2v = S[0] * *(const f32x4v*)(o + 64 + c0) + S[1] * *(const f32x4v*)(o + 64 + c0 + 4);
            float d1 = (d1v.x + d1v.y) + (d1v.z + d1v.w), d2 = (d2v.x + d2v.y) + (d2v.z + d2v.w);
            d1 = dpp_add<0xB1>(d1); d2 = dpp_add<0xB1>(d2); d1 = dpp_add<0x4E>(d1); d2 = dpp_add<0x4E>(d2);
            d1 = dpp_add<0x141>(d1); d2 = dpp_add<0x141>(d2);
#pragma unroll
            for (int m = 0; m < 2; m++) {
              const f32x4v w = *(const f32x4v*)(o + c0 + 4 * m), kp = *(const f32x4v*)(o + 128 + c0 + 4 * m), bb = *(const f32x4v*)(o + 320 + c0 + 4 * m);
              S[m] = S[m] * w + (kp * v - bb * d1);
            }
            const float y = d2 - d1 * br + v * kr;
            yk = (u == c8) ? y : yk;
          }
          ybuf[bsel * 512 + (j * 8 + c8) * 32 + i] = yk;
        }
        SCAN_STAGE(((k + 1) & 1), (bsel ^ 1))
        __syncthreads();
        if (tid < 128) {
          const int st = tid >> 3, i4 = (tid & 7) * 4;
          *(f32x4v*)(YRAW + (size_t)(srow0 + cc * 16 + st) * 512 + h * 64 + rq * 16 + i4) = *(const f32x4v*)(ybuf + bsel * 512 + st * 32 + i4);
        }
      }
    }
  }
  __builtin_amdgcn_s_setprio(0);
  if (Sout) { *(f32x4v*)(Sout + Rr * 64 + c0) = S[0]; *(f32x4v*)(Sout + Rr * 64 + c0 + 4) = S[1]; }
}
constexpr int PH5_TASKS = 512 + 128 + 2048 + 256;
DI void phase5_task(const Params& p, int l, int task, unsigned char* smem) {
  const u16* Z = (const u16*)(p.ws + W_Z); u16* YG = (u16*)(p.ws + W_YG);
  if (task < 512) {
    int bh = task >> 5, seg = 7 - ((task >> 2) & 7), rq = task & 3, b = bh >> 3, h = bh & 7;
    rwkv_scan_task(p, b * TP + seg * 1024, 1024, h, rq, nullptr, seg == 7 ? p.out + O_WKV_P + ((size_t)((l * 2 + b) * 8 + h)) * 4096 : nullptr, bh, seg, smem);
    return;
  }
  task -= 448;
  if (task < 2240) {
    int which, b, h, row0, nq, qpos0, kbase, nkeys; size_t vto; int vstr;
    if (task < 192) { int j = task - 64; which = j >> 6; int bh = j & 63; b = bh >> 3; h = bh & 7; row0 = NP + b * 16; nq = 16; qpos0 = PAST; kbase = NP + b * SK; nkeys = SK; vto = VT_S_OFF + (size_t)((b * 8 + h) * 64) * SK; vstr = SK; }
    else { int j = task - 192; int qb = 63 - (j >> 5); which = (j >> 4) & 1; int bh = j & 15; b = bh >> 3; h = bh & 7; row0 = b * TP + qb * 128; nq = 128; qpos0 = qb * 128; kbase = b * TP; nkeys = TP; vto = (size_t)((b * 8 + h) * 64) * 8192; vstr = 8192; }
    if (which == 0)
      attn_task<64, true>((const u16*)(p.ws + W_SQ) + (size_t)row0 * 512 + h * 64, 512, nq, (const u16*)(p.ws + W_SBK) + (size_t)kbase * 512 + h * 64, 512,
                          (const u16*)(p.ws + W_SBVT) + vto, vstr, nkeys, qpos0, Z + ((size_t)2 * NT + row0) * 512 + h * 64, YG + ((size_t)2 * NT + row0) * 512 + h * 64, smem);
    else
      attn_task<96, false>((const u16*)(p.ws + W_QF) + (size_t)row0 * 768 + h * 96, 768, nq, (const u16*)(p.ws + W_KF) + (size_t)kbase * 768 + h * 96, 768,
                           (const u16*)(p.ws + W_MLAVT) + vto, vstr, nkeys, qpos0, Z + ((size_t)1 * NT + row0) * 512 + h * 64, YG + ((size_t)1 * NT + row0) * 512 + h * 64, smem);
    return;
  }
  {
    int j = task - 2240; int bh = j >> 2, rq = j & 3, b = bh >> 3, h = bh & 7;
    size_t so = ((size_t)((l * 8 + b) * 8 + h)) * 4096;
    rwkv_scan_task(p, NP + b * 16, 16, h, rq, p.in[2] + so, p.out + O_WKV_S + so, -1, 0, smem);
  }
}
DI void phase5(const Params& p, int l, unsigned char* smem) {
  __shared__ int s_task;
  int* ctr = (int*)(p.ws + W_CTR) + l;
  while (true) {
    __syncthreads();
    if (TIDX() == 0) s_task = atomicAdd(ctr, 1);
    __syncthreads();
    int q = s_task;
    if (q >= PH5_TASKS) break;
    int task = q < 1024 ? ((q & 1) ? 512 + (q >> 1) : (q >> 1)) : q;
    phase5_task(p, l, task, smem);
  }
}
DI void phase5b(const Params& p, int l) {
  const int lane = TIDX() & 63, wave = TIDX() >> 6;
  const float* YRAW = (const float*)(p.ws + W_YRAW); const u16* RWX = (const u16*)(p.ws + W_RWX); const float* RHO = (const float*)(p.ws + W_RHO);
  const u16* Z = (const u16*)(p.ws + W_Z); u16* YG = (u16*)(p.ws + W_YG);
  for (int task = blockIdx.x; task < NT / 4; task += gridDim.x) {
    const int row = task * 4 + wave, c0 = lane * 8;
    float y[8];
    { float4 a = *(const float4*)(YRAW + (size_t)row * 512 + c0), b = *(const float4*)(YRAW + (size_t)row * 512 + c0 + 4);
      y[0] = a.x; y[1] = a.y; y[2] = a.z; y[3] = a.w; y[4] = b.x; y[5] = b.y; y[6] = b.z; y[7] = b.w; }
    float s = 0.f;
#pragma unroll
    for (int j = 0; j < 8; j++) s += y[j];
    s += __shfl_xor(s, 1); s += __shfl_xor(s, 2); s += __shfl_xor(s, 4);
    float mu = s * (1.f / 64.f), vs = 0.f;
#pragma unroll
    for (int j = 0; j < 8; j++) { float d = y[j] - mu; vs += d * d; }
    vs += __shfl_xor(vs, 1); vs += __shfl_xor(vs, 2); vs += __shfl_xor(vs, 4);
    float rstd = rsqrtf(vs * (1.f / 64.f) + GN_EPS);
    float rho = RHO[(size_t)row * 8 + (lane >> 3)];
    uint4 vv = *(const uint4*)(RWX + (size_t)row * 2560 + 1024 + c0);
    uint4 zz = *(const uint4*)(Z + (size_t)row * 512 + c0);
    float vf[8] = {bflo(vv.x), bfhi(vv.x), bflo(vv.y), bfhi(vv.y), bflo(vv.z), bfhi(vv.z), bflo(vv.w), bfhi(vv.w)};
    float zf[8] = {bflo(zz.x), bfhi(zz.x), bflo(zz.y), bfhi(zz.y), bflo(zz.z), bfhi(zz.z), bflo(zz.w), bfhi(zz.w)};
    float o[8];
#pragma unroll
    for (int j = 0; j < 8; j++) o[j] = ((y[j] - mu) * rstd * p.in[22][l * 512 + c0 + j] + p.in[23][l * 512 + c0 + j] + rho * vf[j]) * zf[j];
    uint4 ob; ob.x = pk2(o[0], o[1]); ob.y = pk2(o[2], o[3]); ob.z = pk2(o[4], o[5]); ob.w = pk2(o[6], o[7]);
    *(uint4*)(YG + (size_t)row * 512 + c0) = ob;
  }
}

DI void wave_gemm32(f32x16& acc, const u16* A, int lda, const u16* Bt, int ldb, int K) {
  const int lane = TIDX() & 63, r = lane & 31, hl = lane >> 5;
  const u16* ap = A + (size_t)r * lda + hl * 8; const u16* bp = Bt + (size_t)r * ldb + hl * 8;
#pragma unroll 8
  for (int k = 0; k < K; k += 16) { bf16x8 a = *(const bf16x8*)(ap + k); bf16x8 b = *(const bf16x8*)(bp + k); acc = MFMA32(a, b, acc); }
}
DI void phase6(const Params& p, int l, unsigned char* smem) {
  const u16* H = (const u16*)(p.ws + W_H); const u16* WinT = (const u16*)(p.ws + W_WINT);
  const u16* YG = (const u16*)(p.ws + W_YG); u16* MG = (u16*)(p.ws + W_MG);
  for (int t0 = blockIdx.x; t0 < 32 + 128 * 8; t0 += gridDim.x) {
    if (t0 < 32) {
      const int lane = TIDX() & 63, wave = TIDX() >> 6, r = lane & 31, hl = lane >> 5;
      const int unit = t0 * 4 + wave, row0 = NP + (unit & 3) * 32, n0 = (unit >> 2) * 32;
      f32x16 mm;
#pragma unroll
      for (int i = 0; i < 16; i++) mm[i] = 0.f;
#pragma unroll 1
      for (int g = 0; g < 3; g++) {
        f32x16 ay, ag;
#pragma unroll
        for (int i = 0; i < 16; i++) { ay[i] = 0.f; ag[i] = 0.f; }
        wave_gemm32(ay, YG + ((size_t)g * NT + row0) * 512, 512, (const u16*)(p.ws + W_WBRT) + ((size_t)(l * 3 + g) * 1024 + n0) * 512, 512, 512);
        wave_gemm32(ag, H + (size_t)row0 * 1024, 1024, WinT + (size_t)(5408 + g * 1024 + n0) * 1024, 1024, 1024);
#pragma unroll
        for (int i = 0; i < 16; i++) mm[i] += sigmoidf_(ag[i]) * ay[i];
      }
#pragma unroll
      for (int i = 0; i < 16; i++) MG[(size_t)(row0 + crow(i, hl)) * 1024 + n0 + r] = f2bf(mm[i]);
      continue;
    }
    const int t = t0 - 32;
    const int bq = t & 511, mt = (bq & 7) * 16 + ((bq >> 3) & 15), nt = (t >> 9) * 4 + (bq >> 7), m0 = mt * 128, n0 = nt * 128;

    unsigned mpk[2][2][8];
#pragma unroll
    for (int a = 0; a < 2; a++)
#pragma unroll
      for (int b = 0; b < 2; b++)
#pragma unroll
        for (int j = 0; j < 8; j++) mpk[a][b][j] = 0u;
#pragma unroll 1
    for (int g = 0; g < 3; g++) {
      f32x16 acc[2][2]; zero_acc(acc);
      gemm_mainloop(acc, YG + ((size_t)g * NT + m0) * 512, 512, (const u16*)(p.ws + W_WBRT) + ((size_t)(l * 3 + g) * 1024 + n0) * 512, 512, 512, smem);
      unsigned ypk[2][2][8];
#pragma unroll
      for (int a = 0; a < 2; a++)
#pragma unroll
        for (int b = 0; b < 2; b++)
#pragma unroll
          for (int j = 0; j < 8; j++) ypk[a][b][j] = pk2(acc[a][b][2 * j], acc[a][b][2 * j + 1]);
      zero_acc(acc);
      gemm_mainloop(acc, H + (size_t)m0 * 1024, 1024, WinT + (size_t)(5408 + g * 1024 + n0) * 1024, 1024, 1024, smem);
#pragma unroll
      for (int a = 0; a < 2; a++)
#pragma unroll
        for (int b = 0; b < 2; b++)
#pragma unroll
          for (int j = 0; j < 8; j++) {
            float lo = bflo(mpk[a][b][j]) + sigmoidf_(acc[a][b][2 * j]) * bflo(ypk[a][b][j]);
            float hi = bfhi(mpk[a][b][j]) + sigmoidf_(acc[a][b][2 * j + 1]) * bfhi(ypk[a][b][j]);
            mpk[a][b][j] = pk2(lo, hi);
          }
    }
    {
      const int lane = TIDX() & 63, wave = TIDX() >> 6, wm = wave >> 1, wn = wave & 1, r = lane & 31, hl = lane >> 5;
#pragma unroll
      for (int a = 0; a < 2; a++)
#pragma unroll
        for (int b = 0; b < 2; b++)
#pragma unroll
          for (int j = 0; j < 8; j++) {
            int col = n0 + wn * 64 + b * 32 + r;
            int row0 = m0 + wm * 64 + a * 32;
            MG[(size_t)(row0 + crow(2 * j, hl)) * 1024 + col] = (u16)(mpk[a][b][j] & 0xffffu);
            MG[(size_t)(row0 + crow(2 * j + 1, hl)) * 1024 + col] = (u16)(mpk[a][b][j] >> 16);
          }
    }
  }
}
DI void phase7(const Params& p, int l, unsigned char* smem) {
  const u16* MG = (const u16*)(p.ws + W_MG);
  const float* mod = (const float*)(p.ws + W_MOD);
  const int ntile = 32 + 128 * 8, nextra = (l + 1 < NL) ? WIN_TT + SMALLW_TT : 0;
  for (int t0 = blockIdx.x; t0 < ntile + nextra; t0 += gridDim.x) {
    if (t0 >= ntile + WIN_TT) { smallw_transpose_task(p, l + 1, t0 - ntile - WIN_TT, smem); continue; }
    if (t0 >= ntile) { win_transpose_task(p, l + 1, t0 - ntile, smem); continue; }
    if (t0 < 32) {
      const int lane = TIDX() & 63, wave = TIDX() >> 6, r = lane & 31, hl = lane >> 5;
      const int unit = t0 * 4 + wave, row0 = NP + (unit & 3) * 32, n0 = (unit >> 2) * 32;
      f32x16 a;
#pragma unroll
      for (int i = 0; i < 16; i++) a[i] = 0.f;
      wave_gemm32(a, MG + (size_t)row0 * 1024, 1024, (const u16*)(p.ws + W_WOUTT) + ((size_t)l * 1024 + n0) * 1024, 1024, 1024);
#pragma unroll
      for (int i = 0; i < 16; i++) {
        const int row = row0 + crow(i, hl), col = n0 + r;
        float xo = xrow_ptr(p, l, row)[col];
        float gt = mod[(l * 10 + bidx_of(row)) * 3072 + 2048 + col];
        p.out[(size_t)row * D + col] = xo + gt * a[i];
      }
      continue;
    }
    const int t = t0 - 32;
    const int bq = t & 511, mt = (bq & 7) * 16 + ((bq >> 3) & 15), nt = (t >> 9) * 4 + (bq >> 7), m0 = mt * 128, n0 = nt * 128;

    f32x16 acc[2][2]; zero_acc(acc);
    gemm_mainloop(acc, MG + (size_t)m0 * 1024, 1024, (const u16*)(p.ws + W_WOUTT) + ((size_t)l * 1024 + n0) * 1024, 1024, 1024, smem);
    foreach_acc(acc, m0, n0, [&](int row, int col, float v) {
      float xo = xrow_ptr(p, l, row)[col];
      float gt = mod[(l * 10 + bidx_of(row)) * 3072 + 2048 + col];
      p.out[(size_t)row * D + col] = xo + gt * v;
    });
  }
}

#define XB_TMO      128
#define XB_XCNT(j)  (256  + 64 * (j))
#define XB_XSUB(j)  (1280 + 64 * (j))
#define XB_XGEN(j)  (2304 + 64 * (j))
#define XB_TOP      3328
#define XB_TOPGEN   3392
#define XB_SPIN_CAP (1u << 18)
DI unsigned xb_ld(unsigned* q) { return __hip_atomic_load(q, __ATOMIC_RELAXED, __HIP_MEMORY_SCOPE_AGENT); }
DI unsigned xb_add(unsigned* q, unsigned v) { return __hip_atomic_fetch_add(q, v, __ATOMIC_RELAXED, __HIP_MEMORY_SCOPE_AGENT); }
DI unsigned xb_xcc_id() { return (unsigned)__builtin_amdgcn_s_getreg((3 << 11) | 20) & 0xFu; }
#define XB_SPIN(cond, bar) do { unsigned _sp = 0; while (cond) { __builtin_amdgcn_s_sleep(1); \
    if ((++_sp & 255u) == 0u) { if (xb_ld(&(bar)[XB_TMO])) break; if (_sp > XB_SPIN_CAP) { atomicAdd(&(bar)[XB_TMO], 1u); break; } } } } while (0)
DI void xbar(const Params& p, unsigned* xbst) {
  asm volatile("s_waitcnt vmcnt(0)" ::: "memory");
  __syncthreads();
  if (TIDX() == 0) {
    unsigned* bar = (unsigned*)(p.ws + W_XBAR);
    const unsigned x = xb_xcc_id();
    __builtin_amdgcn_s_waitcnt(0);
    const unsigned nloc = xbst[0], nx = xbst[1];
    const unsigned old = xb_add(&bar[XB_XSUB(x)], 1u);
    const unsigned gen = old / nloc;
    if (old + 1u == (gen + 1u) * nloc) {
      __builtin_amdgcn_fence(__ATOMIC_RELEASE, "agent");
      asm volatile("s_waitcnt vmcnt(0)" ::: "memory");
      const unsigned og = xb_add(&bar[XB_TOP], 1u);
      const unsigned tg = og / nx;
      if (og + 1u == (tg + 1u) * nx) xb_add(&bar[XB_TOPGEN], 1u);
      else XB_SPIN(xb_ld(&bar[XB_TOPGEN]) == tg, bar);
      __builtin_amdgcn_fence(__ATOMIC_ACQUIRE, "agent");
      xb_add(&bar[XB_XGEN(x)], 1u);
      asm volatile("s_waitcnt vmcnt(0)" ::: "memory");
    } else {
      XB_SPIN(xb_ld(&bar[XB_XGEN(x)]) == gen, bar);
      __builtin_amdgcn_fence(__ATOMIC_ACQUIRE, "agent");
      asm volatile("s_waitcnt vmcnt(0)" ::: "memory");
    }
  }
  __syncthreads();
}
DI int opq(int v) { asm volatile("" : "+s"(v)); return v; }
#if MULTI
template <int PH> __global__ void __launch_bounds__(256, 2) phase_kernel(Params p, int l) {
  __shared__ __attribute__((aligned(16))) unsigned char smem[SMEM_BYTES];
  if (PH == 0) phase0(p, smem);
  if (PH == 1) phase1(p, l);
  if (PH == 2) phase2(p, l, smem);
  if (PH == 3) phase3(p, l);
  if (PH == 4) phase4(p, l, smem);
  if (PH == 5) phase5(p, l, smem);
  if (PH == 6) phase5b(p, l);
  if (PH == 7) phase6(p, l, smem);
  if (PH == 8) phase7(p, l, smem);
}
#else
__global__ void __launch_bounds__(256, 2) mega_kernel(Params p_arg) {
  __shared__ __attribute__((aligned(16))) unsigned char smem[SMEM_BYTES];
  const Params& p = *(const Params*)__builtin_amdgcn_kernarg_segment_ptr();
  cg::grid_group grid = cg::this_grid();
  __shared__ unsigned xbst[4];
  if (TIDX() == 0) (void)xb_add((unsigned*)(p.ws + W_XBAR) + XB_XCNT(xb_xcc_id()), 1u);
  phase0(p, smem);
  grid.sync();
  if (TIDX() == 0) {
    unsigned* bar = (unsigned*)(p.ws + W_XBAR);
    const unsigned x = xb_xcc_id();
    unsigned cnt = 0u, mine = 0u;
    for (unsigned j = 0; j < 16; ++j) { const unsigned c = xb_ld(&bar[XB_XCNT(j)]); cnt += (c > 0u) ? 1u : 0u; mine = (j == x) ? c : mine; }
    xbst[0] = mine > 0u ? mine : 1u; xbst[1] = cnt > 0u ? cnt : 1u;
  }
  for (int l = 0; l < NL; l++) {
    phase1(p, opq(l)); xbar(p, xbst);
    phase2(p, opq(l), smem); xbar(p, xbst);
    phase3(p, opq(l)); xbar(p, xbst);
    phase4(p, opq(l), smem); xbar(p, xbst);
    phase5(p, opq(l), smem); xbar(p, xbst);
    phase5b(p, opq(l)); xbar(p, xbst);
    phase6(p, opq(l), smem); xbar(p, xbst);
    phase7(p, opq(l), smem); xbar(p, xbst);
  }
}
#endif

extern "C" void kernel_launch(void* const* d_in, const int* in_sizes, int n_in, void* d_out, int out_size, void* d_ws, size_t ws_size, hipStream_t stream) {
  Params p{};
  for (int i = 0; i < 36; i++) p.in[i] = (const float*)d_in[i];
  p.out = (float*)d_out;
  p.ws = (unsigned char*)d_ws;
  if (ws_size < W_TOTAL) fprintf(stderr, "workspace too small: %zu < %zu\n", ws_size, (size_t)W_TOTAL);
  hipMemsetAsync((unsigned char*)d_ws + W_CTR, 0, 256 + 3456 * 4, stream);
#if MULTI
  const int G = 1024;
  phase_kernel<0><<<G, 256, 0, stream>>>(p, 0);
  for (int l = 0; l < NL; l++) {
    phase_kernel<1><<<G, 256, 0, stream>>>(p, l);
    phase_kernel<2><<<G, 256, 0, stream>>>(p, l);
    phase_kernel<3><<<G, 256, 0, stream>>>(p, l);
    phase_kernel<4><<<G, 256, 0, stream>>>(p, l);
    phase_kernel<5><<<G, 256, 0, stream>>>(p, l);
    phase_kernel<6><<<G, 256, 0, stream>>>(p, l);
    phase_kernel<7><<<G, 256, 0, stream>>>(p, l);
    phase_kernel<8><<<G, 256, 0, stream>>>(p, l);
  }
#else
  static int grid_blocks = 0;
  if (!grid_blocks) {
    int dev = 0, cus = 0, per_cu = 0;
    hipGetDevice(&dev);
    hipDeviceGetAttribute(&cus, hipDeviceAttributeMultiprocessorCount, dev);
    hipOccupancyMaxActiveBlocksPerMultiprocessor(&per_cu, mega_kernel, 256, 0);
    if (per_cu > 2) per_cu = 2;
    grid_blocks = cus * per_cu;
  }
  void* args[] = {&p};
  hipError_t e = hipLaunchCooperativeKernel((void*)mega_kernel, dim3(grid_blocks), dim3(256), args, 0, stream);
  if (e != hipSuccess) fprintf(stderr, "cooperative launch failed: %s (grid %d)\n", hipGetErrorString(e), grid_blocks);
#endif
}
```

```cpp
#include <hip/hip_runtime.h>
#include <hip/hip_cooperative_groups.h>
#include <cstdio>
namespace cg = cooperative_groups;

#ifndef MULTI
#define MULTI 0
#endif

typedef unsigned short u16;
typedef __attribute__((ext_vector_type(8))) short bf16x8;
typedef __attribute__((ext_vector_type(16))) float f32x16;
typedef __attribute__((ext_vector_type(2))) __bf16 bf2_t;
typedef __attribute__((ext_vector_type(2))) float f2_t;
typedef __attribute__((ext_vector_type(4))) unsigned u32x4;
typedef __attribute__((ext_vector_type(2))) unsigned u32x2;
typedef __attribute__((ext_vector_type(4))) float f32x4v;
#define DI __device__ __forceinline__
#define MFMA32(a, b, c) __builtin_amdgcn_mfma_f32_32x32x16_bf16((a), (b), (c), 0, 0, 0)

constexpr int D = 1024, NL = 4, NP = 16384, NS = 128, NT = NP + NS, TP = 8192, TS = 16, PAST = 2048, SK = 2064;
constexpr int NKV = NP + 8 * SK;
constexpr int DIN = 8480;
constexpr float RMS_EPS = 1e-6f, GN_EPS = 64e-5f;
constexpr float LOG2E = 1.4426950408889634f;
constexpr float QSCALE_MLA = 0.10206207261596577f * LOG2E;
constexpr float QSCALE_SB = 0.125f * LOG2E;

constexpr size_t O_Y = 0;
constexpr size_t O_WKV_P = (size_t)NT * D;
constexpr size_t O_SHIFT_P = O_WKV_P + (size_t)NL * 2 * 8 * 4096;
constexpr size_t O_CKV_P = O_SHIFT_P + (size_t)NL * 2 * 1664;
constexpr size_t O_KROPE_P = O_CKV_P + (size_t)NL * NP * 256;
constexpr size_t O_SBK_P = O_KROPE_P + (size_t)NL * NP * 32;
constexpr size_t O_SBV_P = O_SBK_P + (size_t)NL * NP * 512;
constexpr size_t O_WKV_S = O_SBV_P + (size_t)NL * NP * 512;
constexpr size_t O_SHIFT_S = O_WKV_S + (size_t)NL * 8 * 8 * 4096;
constexpr size_t O_CKV_S = O_SHIFT_S + (size_t)NL * 8 * 1664;
constexpr size_t O_KROPE_S = O_CKV_S + (size_t)NL * NS * 256;
constexpr size_t O_SBK_S = O_KROPE_S + (size_t)NL * NS * 32;
constexpr size_t O_SBV_S = O_SBK_S + (size_t)NL * NS * 512;

constexpr size_t al(size_t x) { return (x + 255) & ~(size_t)255; }
constexpr size_t W_WINT = 0;
constexpr size_t W_WBRT = al(W_WINT + (size_t)DIN * 1024 * 2);
constexpr size_t W_WOUTT = al(W_WBRT + (size_t)NL * 3 * 1024 * 512 * 2);
constexpr size_t W_WUQT = al(W_WOUTT + (size_t)NL * 1024 * 1024 * 2);
constexpr size_t W_WUKVT = al(W_WUQT + (size_t)NL * 768 * 384 * 2);
constexpr size_t W_WUPT = al(W_WUKVT + (size_t)NL * 1024 * 256 * 2);
constexpr size_t W_AUPT = al(W_WUPT + (size_t)NL * 512 * 64 * 2);
constexpr size_t W_MOD = al(W_AUPT + (size_t)NL * 512 * 64 * 2);
constexpr size_t W_ROPE = al(W_MOD + (size_t)NL * 10 * 3072 * 4);
constexpr size_t W_CTR = al(W_ROPE + (size_t)8192 * 32 * 4);
constexpr size_t W_XBAR = W_CTR + 256;
constexpr size_t W_H = al(W_XBAR + 3456 * 4);
constexpr size_t W_PR = al(W_H + (size_t)NT * 1024 * 2);
constexpr size_t W_YG = W_PR;
constexpr size_t W_YRAW = al(W_YG + (size_t)3 * NT * 512 * 2);
constexpr size_t W_MG = W_YRAW;
constexpr size_t W_Z = al(W_PR + (size_t)NT * 1664 * 4);
constexpr size_t W_CQ = al(W_Z + (size_t)3 * NT * 512 * 2);
constexpr size_t W_QF = W_CQ;
constexpr size_t W_CKV = al(W_CQ + (size_t)NT * 768 * 2);
constexpr size_t W_KR = al(W_CKV + (size_t)NT * 256 * 4);
constexpr size_t W_QN = al(W_KR + (size_t)NT * 32 * 4);
constexpr size_t W_CKVN = al(W_QN + (size_t)NT * 384 * 2);
constexpr size_t W_SQ = al(W_CKVN + (size_t)(NKV + 64) * 256 * 2);
constexpr size_t W_SBK = al(W_SQ + (size_t)NT * 512 * 2);
constexpr size_t VT_S_OFF = (size_t)16 * 64 * 8192;
constexpr size_t VT_ELEMS = VT_S_OFF + (size_t)64 * 64 * SK + 256;
constexpr size_t W_SBVT = al(W_SBK + (size_t)(NKV + 64) * 512 * 2);
constexpr size_t W_RWW = al(W_SBVT + VT_ELEMS * 2);
constexpr size_t W_RWX = al(W_RWW + (size_t)NT * 512 * 4);
constexpr size_t W_RHO = al(W_RWX + (size_t)NT * 5 * 512 * 2);
constexpr size_t W_KF = al(W_RHO + (size_t)NT * 8 * 4);
constexpr size_t W_MLAVT = al(W_KF + (size_t)(NKV + 64) * 768 * 2);
constexpr size_t W_SLOC = al(W_MLAVT + VT_ELEMS * 2);
constexpr size_t W_PMAT = al(W_SLOC + (size_t)16 * 7 * 4096 * 4);
constexpr size_t W_TOTAL = al(W_PMAT + (size_t)16 * 7 * 4096 * 4);
static_assert((size_t)NT * 384 * 4 <= (size_t)NT * 768 * 2, "alias");
static_assert(W_YRAW + (size_t)NT * 1024 * 2 <= W_Z, "alias overflow");

struct Params {
  const float* in[36];
  float* out;
  unsigned char* ws;
};

constexpr int SMEM_BYTES = 73728;

DI int TIDX() { int t = __builtin_amdgcn_workitem_id_x(); asm volatile("" : "+v"(t)); return t; }
DI u16 f2bf(float x) { return __builtin_bit_cast(u16, (__bf16)x); }
DI unsigned pk2(float a, float b) { f2_t v = {a, b}; return __builtin_bit_cast(unsigned, __builtin_convertvector(v, bf2_t)); }
DI float bf2f(u16 x) { return __uint_as_float((unsigned)x << 16); }
DI float bflo(unsigned x) { return __uint_as_float(x << 16); }
DI float bfhi(unsigned x) { return __uint_as_float(x & 0xffff0000u); }
DI float ex2(float x) { return __builtin_amdgcn_exp2f(x); }
DI float lg2(float x) { return __builtin_amdgcn_logf(x); }
DI float frcp(float x) { return __builtin_amdgcn_rcpf(x); }
DI float sigmoidf_(float x) { return frcp(1.f + __expf(-x)); }
DI float siluf_(float x) { return x * frcp(1.f + __expf(-x)); }
DI float softplusf_(float x) { return fmaxf(x, 0.f) + __logf(1.f + __expf(-fabsf(x))); }
DI float tanhf_(float x) { return 1.f - 2.f * frcp(1.f + __expf(2.f * x)); }
DI int crow(int i, int hl) { return (i & 3) + 8 * (i >> 2) + 4 * hl; }
template <int CTRL> DI float dppf(float x) {
  return __int_as_float(__builtin_amdgcn_update_dpp(__float_as_int(x), __float_as_int(x), CTRL, 0xF, 0xF, false));
}
DI float allreduce16(float x) {
  x += dppf<0xB1>(x); x += dppf<0x4E>(x); x += dppf<0x141>(x); x += dppf<0x140>(x); return x;
}
DI float red32(float x) {
  x += __shfl_xor(x, 1); x += __shfl_xor(x, 2); x += __shfl_xor(x, 4); x += __shfl_xor(x, 8); x += __shfl_xor(x, 16); return x;
}
DI float red64(float x) { x = red32(x); x += __shfl_xor(x, 32); return x; }
DI int bidx_of(int row) { return row < NP ? (row >> 13) : 2 + ((row - NP) >> 4); }
DI int keyrow_of(int row) { return row < NP ? row : NP + ((row - NP) >> 4) * SK + PAST + ((row - NP) & 15); }
DI int pos_of(int row) { return row < NP ? (row & 8191) : PAST + ((row - NP) & 15); }
DI size_t vt_off(int keyrow, int h, int d) {
  if (keyrow < NP) { int b = keyrow >> 13, s = keyrow & 8191; return ((size_t)((b * 8 + h) * 64 + d)) * 8192 + s; }
  int rr = keyrow - NP; int b = rr / SK, s = rr - b * SK; return VT_S_OFF + ((size_t)((b * 8 + h) * 64 + d)) * SK + s;
}

DI void gemm_mainloop(f32x16 (&acc)[2][2], const u16* A, int lda, const u16* Bt, int ldb, int K, unsigned char* smem) {
  u16* s0 = (u16*)smem;
  const int tid = TIDX(), lane = tid & 63, wave = tid >> 6, wm = wave >> 1, wn = wave & 1;
  const int lr = tid >> 3, lc = (tid & 7) * 8;
  unsigned offA[4], offB[4];
#pragma unroll
  for (int i = 0; i < 4; i++) { offA[i] = (unsigned)(((lr + 32 * i) * lda + lc) * 2); offB[i] = (unsigned)(((lr + 32 * i) * ldb + lc) * 2); }
  const char* Ab = (const char*)A;
  const char* Bb = (const char*)Bt;
  u32x4 ra[4], rb[4];
  const int nk = K >> 6;
  const int r = lane & 31, hl = lane >> 5;
#pragma unroll
  for (int i = 0; i < 4; i++) { ra[i] = *(const u32x4*)(Ab + offA[i]); rb[i] = *(const u32x4*)(Bb + offB[i]); }
  __syncthreads();
#pragma unroll
  for (int i = 0; i < 4; i++) { *(u32x4*)(s0 + (lr + 32 * i) * 72 + lc) = ra[i]; *(u32x4*)(s0 + 128 * 72 + (lr + 32 * i) * 72 + lc) = rb[i]; }
  if (nk > 1) { Ab += 128; Bb += 128; }
#pragma unroll
  for (int i = 0; i < 4; i++) { ra[i] = *(const u32x4*)(Ab + offA[i]); rb[i] = *(const u32x4*)(Bb + offB[i]); }
  __syncthreads();
  for (int kt = 0; kt < nk; kt++) {
    u16* sA = s0 + (kt & 1) * (256 * 72); u16* sB = sA + 128 * 72;
    if (kt + 1 < nk) {
      u16* nA = s0 + ((kt + 1) & 1) * (256 * 72); u16* nB = nA + 128 * 72;
#pragma unroll
      for (int i = 0; i < 4; i++) { *(u32x4*)(nA + (lr + 32 * i) * 72 + lc) = ra[i]; *(u32x4*)(nB + (lr + 32 * i) * 72 + lc) = rb[i]; }
    }
    if (kt + 2 < nk) { Ab += 128; Bb += 128; }
#pragma unroll
    for (int i = 0; i < 4; i++) { ra[i] = *(const u32x4*)(Ab + offA[i]); rb[i] = *(const u32x4*)(Bb + offB[i]); }
#pragma unroll
    for (int ks = 0; ks < 4; ks++) {
      bf16x8 af[2], bfr[2];
#pragma unroll
      for (int b = 0; b < 2; b++) {
        af[b] = *(const bf16x8*)(sA + (wm * 64 + b * 32 + r) * 72 + ks * 16 + hl * 8);
        bfr[b] = *(const bf16x8*)(sB + (wn * 64 + b * 32 + r) * 72 + ks * 16 + hl * 8);
      }
#pragma unroll
      for (int bm = 0; bm < 2; bm++)
#pragma unroll
        for (int bn = 0; bn < 2; bn++) acc[bm][bn] = MFMA32(af[bm], bfr[bn], acc[bm][bn]);
    }
    __syncthreads();
  }
}
DI void zero_acc(f32x16 (&acc)[2][2]) {
#pragma unroll
  for (int a = 0; a < 2; a++)
#pragma unroll
    for (int b = 0; b < 2; b++)
#pragma unroll
      for (int i = 0; i < 16; i++) acc[a][b][i] = 0.f;
}
template <class F> DI void foreach_acc(f32x16 (&acc)[2][2], int m0, int n0, F f) {
  const int lane = TIDX() & 63, wave = TIDX() >> 6, wm = wave >> 1, wn = wave & 1, r = lane & 31, hl = lane >> 5;
#pragma unroll
  for (int bm = 0; bm < 2; bm++)
#pragma unroll
    for (int bn = 0; bn < 2; bn++)
#pragma unroll
      for (int i = 0; i < 16; i++) f(m0 + wm * 64 + bm * 32 + crow(i, hl), n0 + wn * 64 + bn * 32 + r, acc[bm][bn][i]);
}

DI void transpose_tile(const float* __restrict__ src, int K, int N, u16* __restrict__ dst, int kt, int nt, int mode, unsigned char* smem) {
  float* tile = (float*)smem;
  const int tid = TIDX(), tx = tid & 63, ty = tid >> 6;
  const int k0 = kt * 64, n0 = nt * 64;
  __syncthreads();
#pragma unroll 4
  for (int i = 0; i < 16; i++) { int k = i * 4 + ty; int n = n0 + tx; tile[k * 65 + tx] = (n < N) ? src[(size_t)(k0 + k) * N + n] : 0.f; }
  __syncthreads();
#pragma unroll 4
  for (int i = 0; i < 16; i++) {
    int nl = i * 4 + ty; int n = n0 + nl;
    if (n < N) {
      int nd = n;
      if (mode == 1) { int hd = n / 96, d = n - hd * 96; nd = d < 64 ? hd * 64 + d : 512 + hd * 32 + (d - 64); }
      dst[(size_t)nd * K + k0 + tx] = f2bf(tile[tx * 65 + nl]);
    }
  }
}
constexpr int WIN_TT = 16 * 133;
DI void win_transpose_task(const Params& p, int l, int t, unsigned char* smem) {
  int kt = t & 15, nt = t >> 4;
  transpose_tile(p.in[13] + (size_t)l * 1024 * DIN, 1024, DIN, (u16*)(p.ws + W_WINT), kt, nt, 0, smem);
}
constexpr int SMALLW_TT = 384 + 256 + 72 + 64 + 8 + 8;
DI void smallw_transpose_task(const Params& p, int l, int t, unsigned char* smem) {
  if (t < 384) { int g = t / 128, q = t % 128; const float* src = p.in[g == 0 ? 24 : (g == 1 ? 33 : 34)] + (size_t)l * 512 * 1024;
    transpose_tile(src, 512, 1024, (u16*)(p.ws + W_WBRT) + ((size_t)(l * 3 + g)) * 1024 * 512, q & 7, q >> 3, 0, smem); return; }
  t -= 384;
  if (t < 256) { transpose_tile(p.in[35] + (size_t)l * 1024 * 1024, 1024, 1024, (u16*)(p.ws + W_WOUTT) + (size_t)l * 1024 * 1024, t & 15, t >> 4, 0, smem); return; }
  t -= 256;
  if (t < 72) { transpose_tile(p.in[26] + (size_t)l * 384 * 768, 384, 768, (u16*)(p.ws + W_WUQT) + (size_t)l * 768 * 384, t % 6, t / 6, 1, smem); return; }
  t -= 72;
  if (t < 64) { transpose_tile(p.in[28] + (size_t)l * 256 * 1024, 256, 1024, (u16*)(p.ws + W_WUKVT) + (size_t)l * 1024 * 256, t & 3, t >> 2, 0, smem); return; }
  t -= 64;
  if (t < 8) { transpose_tile(p.in[16] + (size_t)l * 64 * 512, 64, 512, (u16*)(p.ws + W_WUPT) + (size_t)l * 512 * 64, 0, t, 0, smem); return; }
  t -= 8;
  transpose_tile(p.in[18] + (size_t)l * 64 * 512, 64, 512, (u16*)(p.ws + W_AUPT) + (size_t)l * 512 * 64, 0, t, 0, smem);
}
DI void mod_task(const Params& p, int task, unsigned char* smem) {
  float* sm = (float*)smem;
  const int tid = TIDX(), l = task / 48, cb = task % 48, kq = tid >> 6, cl = tid & 63, col = cb * 64 + cl;
  __syncthreads();
  for (int e = tid; e < 10240; e += 256) { int r = e >> 10, k = e & 1023; float c = r < 2 ? p.in[8][r * 1024 + k] : p.in[9][(r - 2) * 1024 + k]; sm[e] = siluf_(c); }
  __syncthreads();
  float acc[10];
#pragma unroll
  for (int r = 0; r < 10; r++) acc[r] = 0.f;
  const float* w = p.in[10] + ((size_t)l * 1024 + kq * 256) * 3072 + col;
#pragma unroll 8
  for (int k = 0; k < 256; k++) {
    float wv = w[(size_t)k * 3072];
#pragma unroll
    for (int r = 0; r < 10; r++) acc[r] += sm[r * 1024 + kq * 256 + k] * wv;
  }
  __syncthreads();
#pragma unroll
  for (int r = 0; r < 10; r++) sm[(kq * 10 + r) * 64 + cl] = acc[r];
  __syncthreads();
  if (tid < 64) {
    float* mod = (float*)(p.ws + W_MOD);
    float bb = p.in[11][l * 3072 + col];
#pragma unroll
    for (int r = 0; r < 10; r++) mod[(l * 10 + r) * 3072 + col] = sm[r * 64 + cl] + sm[(10 + r) * 64 + cl] + sm[(20 + r) * 64 + cl] + sm[(30 + r) * 64 + cl] + bb;
  }
}
DI void rope_task(const Params& p, int task) {
  const int tid = TIDX(); const int pos = task * 128 + (tid >> 1);
  float* rope = (float*)(p.ws + W_ROPE);
  for (int ff = 0; ff < 8; ff++) {
    int f = (tid & 1) * 8 + ff;
    double inv = 1.0; for (int j = 0; j < f; j++) inv *= 0.5623413251903491;
    double ang = (double)pos * inv;
    double n = rint(ang * 0.15915494309189535);
    double rr = ang - n * 6.283185307179586 - n * 2.4492935982947064e-16;
    double r2 = rr * rr, sn = rr, cs = 1.0, ts = rr, tc = 1.0;
    for (int k = 1; k <= 15; k++) { tc *= -r2 / (double)((2 * k - 1) * (2 * k)); cs += tc; ts *= -r2 / (double)((2 * k) * (2 * k + 1)); sn += ts; }
    rope[pos * 32 + f] = (float)cs; rope[pos * 32 + 16 + f] = (float)sn;
  }
}
DI void phase0(const Params& p, unsigned char* smem) {
  const int n_tr = WIN_TT + SMALLW_TT, total = n_tr + 192 + 64;
  for (int t = blockIdx.x; t < total; t += gridDim.x) {
    if (t < 192) mod_task(p, t, smem);
    else if (t < 192 + 64) rope_task(p, t - 192);
    else { int q = t - 256; if (q < WIN_TT) win_transpose_task(p, 0, q, smem); else { q -= WIN_TT; smallw_transpose_task(p, 0, q, smem); } }
  }
}

DI const float* xrow_ptr(const Params& p, int l, int row) {
  if (l > 0) return p.out + (size_t)row * D;
  return row < NP ? p.in[0] + (size_t)row * D : p.in[1] + (size_t)(row - NP) * D;
}
DI void phase1(const Params& p, int l) {
  const int lane = TIDX() & 63, wave = TIDX() >> 6;
  const float* mod = (const float*)(p.ws + W_MOD);
  const float* g = p.in[12] + l * 1024;
  u16* H = (u16*)(p.ws + W_H);
  for (int task = blockIdx.x; task < NT / 4; task += gridDim.x) {
    int row = task * 4 + wave;
    const float* x = xrow_ptr(p, l, row);
    const float* md = mod + (l * 10 + bidx_of(row)) * 3072;
    float4 v[4]; float ss = 0.f;
#pragma unroll
    for (int j = 0; j < 4; j++) { v[j] = *(const float4*)(x + (j * 64 + lane) * 4); ss += v[j].x * v[j].x + v[j].y * v[j].y + v[j].z * v[j].z + v[j].w * v[j].w; }
    ss = red64(ss);
    float rstd = rsqrtf(ss * (1.f / 1024.f) + RMS_EPS);
#pragma unroll
    for (int j = 0; j < 4; j++) {
      int c = (j * 64 + lane) * 4;
      float4 gg = *(const float4*)(g + c), sh = *(const float4*)(md + c), sc = *(const float4*)(md + 1024 + c);
      float h0 = v[j].x * rstd * gg.x * (1.f + sc.x) + sh.x, h1 = v[j].y * rstd * gg.y * (1.f + sc.y) + sh.y;
      float h2 = v[j].z * rstd * gg.z * (1.f + sc.z) + sh.z, h3 = v[j].w * rstd * gg.w * (1.f + sc.w) + sh.w;
      uint2 o; o.x = pk2(h0, h1); o.y = pk2(h2, h3);
      *(uint2*)(H + (size_t)row * 1024 + c) = o;
    }
  }
}

DI void phase2(const Params& p, int l, unsigned char* smem) {
  const u16* H = (const u16*)(p.ws + W_H);
  const u16* WinT = (const u16*)(p.ws + W_WINT);
  float* PR = (float*)(p.ws + W_PR);
  u16* Z = (u16*)(p.ws + W_Z);
  float* CQ = (float*)(p.ws + W_CQ); float* CKV = (float*)(p.ws + W_CKV); float* KR = (float*)(p.ws + W_KR);
  u16* SQ = (u16*)(p.ws + W_SQ); u16* SBK = (u16*)(p.ws + W_SBK); u16* SBVT = (u16*)(p.ws + W_SBVT);
  float* out = p.out;
  for (int ts = blockIdx.x; ts < 11 * 512; ts += gridDim.x) {
    int mt, nt;
    {
      const int rd = ts >> 9, bq = ts & 511, sm = bq & 7, j = bq >> 3;
      mt = sm * 16 + (j & 15); nt = rd * 4 + (j >> 4);
      if (nt >= 43) { const int e = sm * 16 + (j & 15); if (e >= 43) continue; mt = 128; nt = e; }
    }
    const int m0 = mt * 128;
    int seg, n0, c0;
    if (nt < 13) { seg = 0; c0 = nt * 128; n0 = c0; }
    else if (nt < 17) { seg = 1; c0 = (nt - 13) * 128; n0 = 1664 + c0; }
    else if (nt < 20) { seg = 2; c0 = (nt - 17) * 128; n0 = 2176 + c0; }
    else if (nt < 22) { seg = 3; c0 = (nt - 20) * 128; n0 = 2560 + c0; }
    else if (nt < 26) { seg = 4; c0 = (nt - 22) * 128; n0 = 2848 + c0; }
    else if (nt < 30) { seg = 5; c0 = (nt - 26) * 128; n0 = 3360 + c0; }
    else if (nt < 34) { seg = 6; c0 = (nt - 30) * 128; n0 = 3872 + c0; }
    else if (nt < 38) { seg = 7; c0 = (nt - 34) * 128; n0 = 4384 + c0; }
    else if (nt < 42) { seg = 8; c0 = (nt - 38) * 128; n0 = 4896 + c0; }
    else { seg = 9; c0 = 0; n0 = 2816; }
    f32x16 acc[2][2]; zero_acc(acc);
    gemm_mainloop(acc, H + (size_t)m0 * 1024, 1024, WinT + (size_t)n0 * 1024, 1024, 1024, smem);
    if (seg == 0) {
      foreach_acc(acc, m0, c0, [&](int row, int col, float v) {
        PR[(size_t)row * 1664 + col] = v;
        if (row < NP) { if ((row & 8191) == 8191) out[O_SHIFT_P + (size_t)(l * 2 + (row >> 13)) * 1664 + col] = v; }
        else { int rr = row - NP; if ((rr & 15) == 15) out[O_SHIFT_S + (size_t)(l * 8 + (rr >> 4)) * 1664 + col] = v; }
      });
    } else if (seg == 1 || seg == 4 || seg == 8) {
      const int g = seg == 1 ? 0 : (seg == 4 ? 1 : 2);
      foreach_acc(acc, m0, c0, [&](int row, int col, float v) { Z[((size_t)g * NT + row) * 512 + col] = f2bf(siluf_(v)); });
    } else if (seg == 2) {
      foreach_acc(acc, m0, c0, [&](int row, int col, float v) { CQ[(size_t)row * 384 + col] = v; });
    } else if (seg == 3) {
      foreach_acc(acc, m0, c0, [&](int row, int col, float v) { CKV[(size_t)row * 256 + col] = v; });
    } else if (seg == 9) {
      foreach_acc(acc, m0, c0, [&](int row, int col, float v) { if (col < 32) KR[(size_t)row * 32 + col] = v; });
    } else if (seg == 5) {
      foreach_acc(acc, m0, c0, [&](int row, int col, float v) { SQ[(size_t)row * 512 + col] = f2bf(v * QSCALE_SB); });
    } else if (seg == 6) {
      foreach_acc(acc, m0, c0, [&](int row, int col, float v) {
        size_t oo = row < NP ? O_SBK_P + ((size_t)l * NP + row) * 512 + col : O_SBK_S + ((size_t)l * NS + (row - NP)) * 512 + col;
        out[oo] = v;
        SBK[(size_t)keyrow_of(row) * 512 + col] = f2bf(v);
      });
    } else {
      foreach_acc(acc, m0, c0, [&](int row, int col, float v) {
        size_t oo = row < NP ? O_SBV_P + ((size_t)l * NP + row) * 512 + col : O_SBV_S + ((size_t)l * NS + (row - NP)) * 512 + col;
        out[oo] = v;
      });
      const int lane = TIDX() & 63, wave = TIDX() >> 6, wm = wave >> 1, wn = wave & 1, r = lane & 31, hl = lane >> 5;
#pragma unroll
      for (int bm = 0; bm < 2; bm++)
#pragma unroll
        for (int bn = 0; bn < 2; bn++)
#pragma unroll
          for (int g4 = 0; g4 < 4; g4++) {
            int row = m0 + wm * 64 + bm * 32 + 8 * g4 + 4 * hl, col = c0 + wn * 64 + bn * 32 + r;
            uint2 o; o.x = pk2(acc[bm][bn][4 * g4], acc[bm][bn][4 * g4 + 1]); o.y = pk2(acc[bm][bn][4 * g4 + 2], acc[bm][bn][4 * g4 + 3]);
            *(uint2*)(SBVT + vt_off(keyrow_of(row), col >> 6, col & 63)) = o;
          }
    }
  }
}

DI const float* prev_ptr(const Params& p, int l, const float* PR, int row) {
  if (row < NP) return (row & 8191) ? PR + (size_t)(row - 1) * 1664 : nullptr;
  int rr = row - NP;
  return (rr & 15) ? PR + (size_t)(row - 1) * 1664 : p.in[3] + (size_t)(l * 8 + (rr >> 4)) * 1664;
}
DI void rwkv_prep_task(const Params& p, int l, int task) {
  const int lane = TIDX() & 63, wave = TIDX() >> 6, r = lane & 31, hl = lane >> 5;
  const int tile = task >> 1, hh = (task & 1) * 4 + wave, row0 = tile * 32;
  const float* PR = (const float*)(p.ws + W_PR);
  const float* mu = p.in[14] + l * 1664;
  f32x16 accW[1][2], accA[1][2];
#pragma unroll
  for (int b_ = 0; b_ < 2; b_++)
#pragma unroll
    for (int i_ = 0; i_ < 16; i_++) { accW[0][b_][i_] = 0.f; accA[0][b_][i_] = 0.f; }
  const u16* WupT = (const u16*)(p.ws + W_WUPT) + (size_t)l * 512 * 64;
  const u16* AupT = (const u16*)(p.ws + W_AUPT) + (size_t)l * 512 * 64;
#pragma unroll 1
  for (int ks = 0; ks < 4; ks++) {
    const int k0 = ks * 16 + hl * 8;
    bf16x8 bw[2], ba[2];
#pragma unroll
    for (int bn = 0; bn < 2; bn++) {
      bw[bn] = *(const bf16x8*)(WupT + (size_t)(hh * 64 + bn * 32 + r) * 64 + k0);
      ba[bn] = *(const bf16x8*)(AupT + (size_t)(hh * 64 + bn * 32 + r) * 64 + k0);
    }
#pragma unroll
    for (int bm = 0; bm < 1; bm++) {
      const int row = row0 + bm * 32 + r;
      const float* pp = PR + (size_t)row * 1664;
      const float* pv = prev_ptr(p, l, PR, row);
      float xw[8], xa[8];
#pragma unroll
      for (int q = 0; q < 2; q++) {
        float4 a = *(const float4*)(pp + 1536 + k0 + 4 * q), b = pv ? *(const float4*)(pv + 1536 + k0 + 4 * q) : make_float4(0, 0, 0, 0), m = *(const float4*)(mu + 1536 + k0 + 4 * q);
        xw[4 * q] = tanhf_(a.x + (b.x - a.x) * m.x); xw[4 * q + 1] = tanhf_(a.y + (b.y - a.y) * m.y); xw[4 * q + 2] = tanhf_(a.z + (b.z - a.z) * m.z); xw[4 * q + 3] = tanhf_(a.w + (b.w - a.w) * m.w);
        a = *(const float4*)(pp + 1600 + k0 + 4 * q); b = pv ? *(const float4*)(pv + 1600 + k0 + 4 * q) : make_float4(0, 0, 0, 0); m = *(const float4*)(mu + 1600 + k0 + 4 * q);
        xa[4 * q] = a.x + (b.x - a.x) * m.x; xa[4 * q + 1] = a.y + (b.y - a.y) * m.y; xa[4 * q + 2] = a.z + (b.z - a.z) * m.z; xa[4 * q + 3] = a.w + (b.w - a.w) * m.w;
      }
      u32x4 uw, ua;
      uw.x = pk2(xw[0], xw[1]); uw.y = pk2(xw[2], xw[3]); uw.z = pk2(xw[4], xw[5]); uw.w = pk2(xw[6], xw[7]);
      ua.x = pk2(xa[0], xa[1]); ua.y = pk2(xa[2], xa[3]); ua.z = pk2(xa[4], xa[5]); ua.w = pk2(xa[6], xa[7]);
      bf16x8 awf = __builtin_bit_cast(bf16x8, uw), aaf = __builtin_bit_cast(bf16x8, ua);
#pragma unroll
      for (int bn = 0; bn < 2; bn++) { accW[bm][bn] = MFMA32(awf, bw[bn], accW[bm][bn]); accA[bm][bn] = MFMA32(aaf, ba[bn], accA[bm][bn]); }
    }
  }
  float* RWW = (float*)(p.ws + W_RWW); u16* RWX = (u16*)(p.ws + W_RWX); float* RHO = (float*)(p.ws + W_RHO);
  float mur[2], muk[2], muv[2], w0[2], a0[2], kk_[2], ka_[2], rk_[2];
#pragma unroll
  for (int bn = 0; bn < 2; bn++) {
    int col = hh * 64 + bn * 32 + r;
    mur[bn] = mu[col]; muk[bn] = mu[512 + col]; muv[bn] = mu[1024 + col];
    w0[bn] = p.in[15][l * 512 + col]; a0[bn] = p.in[17][l * 512 + col]; kk_[bn] = p.in[19][l * 512 + col]; ka_[bn] = p.in[20][l * 512 + col]; rk_[bn] = p.in[21][l * 512 + col];
  }
#pragma unroll
  for (int bm = 0; bm < 1; bm++)
#pragma unroll
    for (int i = 0; i < 16; i++) {
      const int row = row0 + bm * 32 + crow(i, hl);
      const float* pp = PR + (size_t)row * 1664;
      const float* pv = prev_ptr(p, l, PR, row);
      float xr[2], xv[2], kp[2], kkr[2], av[2], dec[2];
      float ssq = 0.f, rho = 0.f;
#pragma unroll
      for (int bn = 0; bn < 2; bn++) {
        int col = hh * 64 + bn * 32 + r;
        float pr_ = pp[col], pk_ = pp[512 + col], pv_ = pp[1024 + col];
        float qr = pv ? pv[col] : 0.f, qk = pv ? pv[512 + col] : 0.f, qv = pv ? pv[1024 + col] : 0.f;
        xr[bn] = pr_ + (qr - pr_) * mur[bn];
        float xk = pk_ + (qk - pk_) * muk[bn];
        xv[bn] = pv_ + (qv - pv_) * muv[bn];
        float wpre = w0[bn] + accW[bm][bn][i];
        float wlog = -softplusf_(-wpre) - 0.5f;
        dec[bn] = __expf(-__expf(wlog));
        av[bn] = sigmoidf_(a0[bn] + accA[bm][bn][i]);
        kkr[bn] = xk * kk_[bn];
        kp[bn] = xk * (1.f + (av[bn] - 1.f) * ka_[bn]);
        ssq += kkr[bn] * kkr[bn];
        rho += xr[bn] * kp[bn] * rk_[bn];
      }
      ssq = red32(ssq); rho = red32(rho);
      float inv = rsqrtf(fmaxf(ssq, 1e-24f));
#pragma unroll
      for (int bn = 0; bn < 2; bn++) {
        int col = hh * 64 + bn * 32 + r;
        float kk = kkr[bn] * inv;
        RWW[(size_t)row * 512 + col] = dec[bn];
        u16* rx = RWX + (size_t)row * 2560 + col;
        rx[0] = f2bf(xr[bn]); rx[512] = f2bf(kp[bn]); rx[1024] = f2bf(xv[bn]); rx[1536] = f2bf(kk); rx[2048] = f2bf(kk * av[bn]);
      }
      if (r == 0) RHO[(size_t)row * 8 + hh] = rho;
    }
}
DI void norm_row_task(const Params& p, int l, int task) {
  const int lane = TIDX() & 63, wave = TIDX() >> 6;
  const int row = task * 4 + wave;
  const float* CQ = (const float*)(p.ws + W_CQ); const float* CKV = (const float*)(p.ws + W_CKV); const float* KR = (const float*)(p.ws + W_KR);
  u16* QN = (u16*)(p.ws + W_QN); u16* CKVN = (u16*)(p.ws + W_CKVN); u16* KF = (u16*)(p.ws + W_KF);
  const int keyrow = keyrow_of(row);
  {
    float v[6], ss = 0.f;
#pragma unroll
    for (int j = 0; j < 6; j++) { v[j] = CQ[(size_t)row * 384 + j * 64 + lane]; ss += v[j] * v[j]; }
    ss = red64(ss); float rstd = rsqrtf(ss * (1.f / 384.f) + RMS_EPS);
#pragma unroll
    for (int j = 0; j < 6; j++) QN[(size_t)row * 384 + j * 64 + lane] = f2bf(v[j] * rstd * p.in[25][l * 384 + j * 64 + lane]);
  }
  {
    float4 v = *(const float4*)(CKV + (size_t)row * 256 + lane * 4);
    float ss = red64(v.x * v.x + v.y * v.y + v.z * v.z + v.w * v.w);
    float rstd = rsqrtf(ss * (1.f / 256.f) + RMS_EPS);
    float4 g = *(const float4*)(p.in[27] + l * 256 + lane * 4);
    float4 o = make_float4(v.x * rstd * g.x, v.y * rstd * g.y, v.z * rstd * g.z, v.w * rstd * g.w);
    size_t oo = row < NP ? O_CKV_P + ((size_t)l * NP + row) * 256 : O_CKV_S + ((size_t)l * NS + (row - NP)) * 256;
    *(float4*)(p.out + oo + lane * 4) = o;
    uint2 ob; ob.x = pk2(o.x, o.y); ob.y = pk2(o.z, o.w);
    *(uint2*)(CKVN + (size_t)keyrow * 256 + lane * 4) = ob;
  }
  {
    float x = lane < 32 ? KR[(size_t)row * 32 + lane] : 0.f;
    float ss = red64(x * x); float rstd = rsqrtf(ss * (1.f / 32.f) + RMS_EPS);
    float xn = x * rstd * p.in[32][l * 32 + (lane & 31)];
    float pt = __shfl_xor(xn, 16);
    const float* rp = (const float*)(p.ws + W_ROPE) + pos_of(row) * 32;
    float cs = rp[lane & 15], sn = rp[16 + (lane & 15)];
    float o = (lane & 16) ? (pt * sn + xn * cs) : (xn * cs - pt * sn);
    if (lane < 32) {
      size_t oo = row < NP ? O_KROPE_P + ((size_t)l * NP + row) * 32 : O_KROPE_S + ((size_t)l * NS + (row - NP)) * 32;
      p.out[oo + lane] = o;
      u16 ob = f2bf(o);
#pragma unroll
      for (int hd = 0; hd < 8; hd++) KF[(size_t)keyrow * 768 + hd * 96 + 64 + lane] = ob;
    }
  }
}
DI void past_convert_task(const Params& p, int l, int task) {
  const int tid = TIDX();
  if (task < 2048) {
    size_t e = ((size_t)task * 256 + tid) * 8; int rowp = (int)(e >> 8), c = (int)(e & 255); int b = rowp >> 11, s = rowp & 2047;
    const float* src = p.in[4] + ((size_t)(l * 8 + b) * PAST + s) * 256 + c;
    float4 a = *(const float4*)src, bq = *(const float4*)(src + 4);
    uint4 o; o.x = pk2(a.x, a.y); o.y = pk2(a.z, a.w); o.z = pk2(bq.x, bq.y); o.w = pk2(bq.z, bq.w);
    *(uint4*)((u16*)(p.ws + W_CKVN) + (size_t)(NP + b * SK + s) * 256 + c) = o; return;
  }
  task -= 2048;
  if (task < 4096) {
    size_t e = ((size_t)task * 256 + tid) * 8; int rowp = (int)(e >> 9), c = (int)(e & 511); int b = rowp >> 11, s = rowp & 2047;
    const float* src = p.in[6] + ((size_t)(l * 8 + b) * PAST + s) * 512 + c;
    float4 a = *(const float4*)src, bq = *(const float4*)(src + 4);
    uint4 o; o.x = pk2(a.x, a.y); o.y = pk2(a.z, a.w); o.z = pk2(bq.x, bq.y); o.w = pk2(bq.z, bq.w);
    *(uint4*)((u16*)(p.ws + W_SBK) + (size_t)(NP + b * SK + s) * 512 + c) = o; return;
  }
  task -= 4096;
  if (task < 4096) {
    int id = task * 256 + tid; int c = id & 511, sg = (id >> 9) & 255, b = id >> 17;
    const float* src = p.in[7] + ((size_t)(l * 8 + b) * PAST + sg * 8) * 512 + c;
    float v[8];
#pragma unroll
    for (int j = 0; j < 8; j++) v[j] = src[(size_t)j * 512];
    uint4 o; o.x = pk2(v[0], v[1]); o.y = pk2(v[2], v[3]); o.z = pk2(v[4], v[5]); o.w = pk2(v[6], v[7]);
    *(uint4*)((u16*)(p.ws + W_SBVT) + VT_S_OFF + ((size_t)((b * 8 + (c >> 6)) * 64 + (c & 63))) * SK + sg * 8) = o; return;
  }
  task -= 4096;
  {
    int id = task * 256 + tid; int ch = id & 7, rowp = id >> 3; int b = rowp >> 11, s = rowp & 2047;
    float4 a = *(const float4*)(p.in[5] + ((size_t)(l * 8 + b) * PAST + s) * 32 + ch * 4);
    uint2 o; o.x = pk2(a.x, a.y); o.y = pk2(a.z, a.w);
    u16* dst = (u16*)(p.ws + W_KF) + (size_t)(NP + b * SK + s) * 768 + 64 + ch * 4;
#pragma unroll
    for (int hd = 0; hd < 8; hd++) *(uint2*)(dst + hd * 96) = o;
  }
}
DI void phase3(const Params& p, int l) {
  const int nA = 1032, nB = NT / 4, nC = 2048 + 4096 + 4096 + 512, total = nA + nB + nC;
  for (int t = blockIdx.x; t < total; t += gridDim.x) {
    if (t < nA) rwkv_prep_task(p, l, t);
    else if (t < nA + nB) norm_row_task(p, l, t - nA);
    else past_convert_task(p, l, t - nA - nB);
  }
}

DI void rwkv_pass1_task(const Params& p, int bh, int seg, int rq, unsigned char* smem);
DI void phase4(const Params& p, int l, unsigned char* smem) {
  const int lane = TIDX() & 63, wave = TIDX() >> 6, wm = wave >> 1, wn = wave & 1, r = lane & 31, hl = lane >> 5;
  const float* rope = (const float*)(p.ws + W_ROPE);
  u16* QF = (u16*)(p.ws + W_QF); u16* KF = (u16*)(p.ws + W_KF); u16* VT = (u16*)(p.ws + W_MLAVT);
  const int nQ = 129 * 6, nKV = 257 * 8;
  __shared__ int s_task4;
  int* ctr4 = (int*)(p.ws + W_CTR) + 8 + l;
  while (true) {
    __syncthreads();
    if (TIDX() == 0) s_task4 = atomicAdd(ctr4, 1);
    __syncthreads();
    const int q4 = s_task4;
    if (q4 >= 448 + nQ + nKV) break;
    const int t0 = q4 < 896 ? ((q4 & 1) ? 448 + (q4 >> 1) : (q4 >> 1)) : q4;
    if (t0 < 448) { int bh = t0 / 28, rem = t0 - bh * 28; rwkv_pass1_task(p, bh, rem >> 2, rem & 3, smem); continue; }
    const int t = t0 - 448;
    f32x16 acc[2][2]; zero_acc(acc);
    if (t < nQ) {
      const int mt = t % 129, nt = t / 129, m0 = mt * 128;
      gemm_mainloop(acc, (const u16*)(p.ws + W_QN) + (size_t)m0 * 384, 384, (const u16*)(p.ws + W_WUQT) + ((size_t)l * 768 + nt * 128) * 384, 384, 384, smem);
      if (nt < 4) {
        const int head = nt * 2 + wn;
        float g0 = p.in[29][l * 64 + r] * QSCALE_MLA, g1 = p.in[29][l * 64 + 32 + r] * QSCALE_MLA;
#pragma unroll
        for (int bm = 0; bm < 2; bm++)
#pragma unroll
          for (int i = 0; i < 16; i++) {
            float a = acc[bm][0][i], b = acc[bm][1][i];
            float ss = red32(a * a + b * b); float rstd = rsqrtf(ss * (1.f / 64.f) + RMS_EPS);
            int row = m0 + wm * 64 + bm * 32 + crow(i, hl);
            u16* q = QF + (size_t)row * 768 + head * 96;
            q[r] = f2bf(a * rstd * g0); q[32 + r] = f2bf(b * rstd * g1);
          }
      } else {
        float g = p.in[30][l * 32 + r] * QSCALE_MLA;
#pragma unroll
        for (int bm = 0; bm < 2; bm++)
#pragma unroll
          for (int bn = 0; bn < 2; bn++)
#pragma unroll
            for (int i = 0; i < 16; i++) {
              const int head = (nt - 4) * 4 + wn * 2 + bn;
              float a = acc[bm][bn][i];
              float ss = red32(a * a); float rstd = rsqrtf(ss * (1.f / 32.f) + RMS_EPS);
              float xn = a * rstd * g; float pt = __shfl_xor(xn, 16);
              int row = m0 + wm * 64 + bm * 32 + crow(i, hl);
              const float* rp = rope + pos_of(row) * 32;
              float cs = rp[r & 15], sn = rp[16 + (r & 15)];
              float o = (r & 16) ? (pt * sn + xn * cs) : (xn * cs - pt * sn);
              QF[(size_t)row * 768 + head * 96 + 64 + r] = f2bf(o);
            }
      }
    } else {
      const int q = t - nQ, mt = q % 257, head = q / 257, m0 = mt * 128;
      gemm_mainloop(acc, (const u16*)(p.ws + W_CKVN) + (size_t)m0 * 256, 256, (const u16*)(p.ws + W_WUKVT) + ((size_t)l * 1024 + head * 128) * 256, 256, 256, smem);
      if (wn == 0) {
        float g0 = p.in[31][l * 64 + r], g1 = p.in[31][l * 64 + 32 + r];
#pragma unroll
        for (int bm = 0; bm < 2; bm++)
#pragma unroll
          for (int i = 0; i < 16; i++) {
            float a = acc[bm][0][i], b = acc[bm][1][i];
            float ss = red32(a * a + b * b); float rstd = rsqrtf(ss * (1.f / 64.f) + RMS_EPS);
            int krow = m0 + wm * 64 + bm * 32 + crow(i, hl);
            u16* k = KF + (size_t)krow * 768 + head * 96;
            k[r] = f2bf(a * rstd * g0); k[32 + r] = f2bf(b * rstd * g1);
          }
      } else {
#pragma unroll
        for (int bm = 0; bm < 2; bm++)
#pragma unroll
          for (int bn = 0; bn < 2; bn++)
#pragma unroll
            for (int g4 = 0; g4 < 4; g4++) {
              int krow = m0 + wm * 64 + bm * 32 + 8 * g4 + 4 * hl, d = bn * 32 + r;
              uint2 o; o.x = pk2(acc[bm][bn][4 * g4], acc[bm][bn][4 * g4 + 1]); o.y = pk2(acc[bm][bn][4 * g4 + 2], acc[bm][bn][4 * g4 + 3]);
              *(uint2*)(VT + vt_off(krow, head, d)) = o;
            }
      }
    }
  }
}

template <int DK, bool SB>
DI void attn_task(const u16* __restrict__ Qp, int qstride, int nq_valid, const u16* __restrict__ Kp, int kstride,
                  const u16* __restrict__ Vtp, int vstride, int nkeys, int qpos0,
                  const u16* __restrict__ Zp, u16* __restrict__ Yp, unsigned char* smem) {
  constexpr int KS = DK / 16, KSTR = DK + 8, KCH = DK / 8, NKL = 64 * KCH / 256;
  u16* sK = (u16*)smem; u16* sV = sK + 64 * KSTR;
  const int tid = TIDX(), lane = tid & 63, wave = tid >> 6, r = lane & 31, hl = lane >> 5;
  const int slot = wave * 32 + r;
  const bool wave_active = wave * 32 < nq_valid;
  const int qpos = qpos0 + slot;
  bf16x8 qf[KS];
  {
    const u16* qrow = Qp + (size_t)(slot < nq_valid ? slot : 0) * qstride + hl * 8;
#pragma unroll
    for (int ks = 0; ks < KS; ks++) qf[ks] = *(const bf16x8*)(qrow + ks * 16);
  }
  f32x16 O[2];
#pragma unroll
  for (int b = 0; b < 2; b++)
#pragma unroll
    for (int i = 0; i < 16; i++) O[b][i] = 0.f;
  float m_run = -1e30f, l_run = 0.f, R = 1.f;
  const int last_qpos = qpos0 + nq_valid - 1;
  int ntiles = SB ? (last_qpos - 1) / 64 + 1 : last_qpos / 64 + 1;
  { int mx = (nkeys + 63) >> 6; if (ntiles > mx) ntiles = mx; }
  const int wave_q0 = qpos0 + wave * 32;
  u32x4 rk[NKL], rv[2];
  auto prefetch = [&](int kt) {
#pragma unroll
    for (int i = 0; i < NKL; i++) { int c = tid + 256 * i; int row = c / KCH, ch = c - row * KCH; rk[i] = *(const u32x4*)(Kp + (size_t)(kt * 64 + row) * kstride + ch * 8); }
#pragma unroll
    for (int i = 0; i < 2; i++) { int c = tid + 256 * i; int row = c >> 3, ch = c & 7; rv[i] = *(const u32x4*)(Vtp + (size_t)row * vstride + kt * 64 + ch * 8); }
  };
  prefetch(SB ? ntiles - 1 : 0);
  for (int it = 0; it < ntiles; it++) {
    const int kt = SB ? ntiles - 1 - it : it;
    __syncthreads();
#pragma unroll
    for (int i = 0; i < NKL; i++) { int c = tid + 256 * i; int row = c / KCH, ch = c - row * KCH; *(u32x4*)(sK + row * KSTR + ch * 8) = rk[i]; }
#pragma unroll
    for (int i = 0; i < 2; i++) { int c = tid + 256 * i; int row = c >> 3, ch = c & 7; *(u32x4*)(sV + row * 72 + ch * 8) = rv[i]; }
    __syncthreads();
    { int nx = SB ? kt - 1 : kt + 1; if (it + 1 >= ntiles) nx = kt; prefetch(nx); }
    bool doit;
    if (SB) doit = wave_active && (kt * 64 < wave_q0 + 31);
    else doit = wave_active && (kt <= (wave_q0 >> 6));
    if (doit) {
    f32x16 S[2];
#pragma unroll
    for (int kb = 0; kb < 2; kb++) {
#pragma unroll
      for (int i = 0; i < 16; i++) S[kb][i] = 0.f;
#pragma unroll
      for (int ks = 0; ks < KS; ks++) {
        bf16x8 kf = *(const bf16x8*)(sK + (kb * 32 + r) * KSTR + ks * 16 + hl * 8);
        S[kb] = MFMA32(kf, qf[ks], S[kb]);
      }
    }
    const int key0 = kt * 64 + 4 * hl;
    if (!SB) {
      const bool need_mask = (kt + 1) * 64 > nkeys;
      if (need_mask) {
#pragma unroll
        for (int kb = 0; kb < 2; kb++)
#pragma unroll
          for (int i = 0; i < 16; i++) { int key = key0 + kb * 32 + (i & 3) + 8 * (i >> 2); if (key >= nkeys) S[kb][i] = -1e30f; }
      }
      float tmax = -1e30f;
#pragma unroll
      for (int kb = 0; kb < 2; kb++)
#pragma unroll
        for (int i = 0; i < 16; i++) tmax = fmaxf(tmax, S[kb][i]);
      tmax = fmaxf(tmax, __shfl_xor(tmax, 32));
      float m_new = fmaxf(m_run, tmax);
      float alpha = ex2(m_run - m_new);
      m_run = m_new;
      float ps = 0.f;
#pragma unroll
      for (int kb = 0; kb < 2; kb++)
#pragma unroll
        for (int i = 0; i < 16; i++) { float pv = ex2(S[kb][i] - m_new); S[kb][i] = pv; ps += pv; }
      l_run = l_run * alpha + ps;
#pragma unroll
      for (int b = 0; b < 2; b++)
#pragma unroll
        for (int i = 0; i < 16; i++) O[b][i] *= alpha;
    } else {
      const bool need_mask = (kt * 64 + 63 >= wave_q0) || ((kt + 1) * 64 > nkeys);
#pragma unroll
      for (int kb = 0; kb < 2; kb++)
#pragma unroll
        for (int i = 0; i < 16; i++) {
          float d = __builtin_amdgcn_rcpf(1.f + ex2(S[kb][i]));
          if (need_mask) { int key = key0 + kb * 32 + (i & 3) + 8 * (i >> 2); if (!(key < nkeys && key < qpos)) d = 1.f; }
          S[kb][i] = d;
        }
      float gs[8], pg[8], sa[8];
#pragma unroll
      for (int o = 0; o < 8; o++) { int kb = o >> 2, g = o & 3; gs[o] = (S[kb][4 * g] * S[kb][4 * g + 1]) * (S[kb][4 * g + 2] * S[kb][4 * g + 3]); }
#pragma unroll
      for (int o = 0; o < 8; o++) pg[o] = __shfl_xor(gs[o], 32);
      sa[7] = R;
#pragma unroll
      for (int o = 6; o >= 0; o--) sa[o] = sa[o + 1] * (gs[o + 1] * pg[o + 1]);
      const float total = sa[0] * (gs[0] * pg[0]);
#pragma unroll
      for (int o = 0; o < 8; o++) {
        int kb = o >> 2, g = o & 3;
        float c = hl == 0 ? sa[o] * pg[o] : sa[o];
#pragma unroll
        for (int e = 3; e >= 0; e--) {
          float d = S[kb][4 * g + e];
          S[kb][4 * g + e] = c - d * c;
          c *= d;
        }
      }
      R = total;
    }
#pragma unroll
    for (int kb = 0; kb < 2; kb++)
#pragma unroll
      for (int s2 = 0; s2 < 2; s2++) {
        uint4 u;
        u.x = pk2(S[kb][8 * s2], S[kb][8 * s2 + 1]); u.y = pk2(S[kb][8 * s2 + 2], S[kb][8 * s2 + 3]);
        u.z = pk2(S[kb][8 * s2 + 4], S[kb][8 * s2 + 5]); u.w = pk2(S[kb][8 * s2 + 6], S[kb][8 * s2 + 7]);
        bf16x8 pf = __builtin_bit_cast(bf16x8, u);
#pragma unroll
        for (int bd = 0; bd < 2; bd++) {
          const u16* vp = sV + (bd * 32 + r) * 72 + kb * 32 + s2 * 16 + hl * 4;
          uint2 lo = *(const uint2*)vp, hi = *(const uint2*)(vp + 8);
          uint4 vv; vv.x = lo.x; vv.y = lo.y; vv.z = hi.x; vv.w = hi.y;
          O[bd] = MFMA32(__builtin_bit_cast(bf16x8, vv), pf, O[bd]);
        }
      }
    }
    if (SB) {
      const bool lane_done = !wave_active || slot >= nq_valid || R < 1e-30f;
      const int wdone = __all(lane_done);
      if (__syncthreads_and(wdone)) break;
    }
  }
  if (wave_active && slot < nq_valid) {
    float sc = 1.f;
    if (!SB) { float lt = l_run + __shfl_xor(l_run, 32); sc = 1.f / lt; }
#pragma unroll
    for (int bd = 0; bd < 2; bd++)
#pragma unroll
      for (int g = 0; g < 4; g++) {
        int d0 = bd * 32 + 8 * g + 4 * hl;
        uint2 zz = *(const uint2*)(Zp + (size_t)slot * 512 + d0);
        uint2 o;
        o.x = pk2(O[bd][4 * g] * sc * bflo(zz.x), O[bd][4 * g + 1] * sc * bfhi(zz.x));
        o.y = pk2(O[bd][4 * g + 2] * sc * bflo(zz.y), O[bd][4 * g + 3] * sc * bfhi(zz.y));
        *(uint2*)(Yp + (size_t)slot * 512 + d0) = o;
      }
  }
}

template <int CTRL> DI float dpp_add(float x) {
  return x + __int_as_float(__builtin_amdgcn_update_dpp(0, __float_as_int(x), CTRL, 0xF, 0xF, true));
}
DI void allreduce16x2(float& a, float& b) {
  a = dpp_add<0xB1>(a); b = dpp_add<0xB1>(b); a = dpp_add<0x4E>(a); b = dpp_add<0x4E>(b);
  a = dpp_add<0x141>(a); b = dpp_add<0x141>(b); a = dpp_add<0x140>(a); b = dpp_add<0x140>(b);
}
#define SCAN_PREFETCH(slot, cc) { int c_ = (cc) < nch ? (cc) : nch - 1; size_t row = (size_t)(srow0 + c_ * 16 + lstep); \
    pw[slot] = *(const f32x4v*)(RWW + row * 512 + h * 64 + lpart); \
    _Pragma("unroll") for (int c = 0; c < 5; c++) px[slot][c] = *(const u32x2*)(RWX + row * 2560 + c * 512 + h * 64 + lpart); }
#define SCAN_STAGE(slot, bsel) { float* o = ops + ((bsel) * 16 + lstep) * 384 + lpart; \
    f32x4v r4 = {bflo(px[slot][0].x), bfhi(px[slot][0].x), bflo(px[slot][0].y), bfhi(px[slot][0].y)}; \
    f32x4v k4 = {bflo(px[slot][1].x), bfhi(px[slot][1].x), bflo(px[slot][1].y), bfhi(px[slot][1].y)}; \
    f32x4v v4 = {bflo(px[slot][2].x), bfhi(px[slot][2].x), bflo(px[slot][2].y), bfhi(px[slot][2].y)}; \
    f32x4v kk4 = {bflo(px[slot][3].x), bfhi(px[slot][3].x), bflo(px[slot][3].y), bfhi(px[slot][3].y)}; \
    f32x4v b4 = {bflo(px[slot][4].x), bfhi(px[slot][4].x), bflo(px[slot][4].y), bfhi(px[slot][4].y)}; \
    *(f32x4v*)(o) = pw[slot]; *(f32x4v*)(o + 64) = pw[slot] * r4; *(f32x4v*)(o + 128) = k4; *(f32x4v*)(o + 192) = v4; *(f32x4v*)(o + 256) = kk4; *(f32x4v*)(o + 320) = b4; \
    float br = b4.x * r4.x + b4.y * r4.y + b4.z * r4.z + b4.w * r4.w; \
    float kr = k4.x * r4.x + k4.y * r4.y + k4.z * r4.z + k4.w * r4.w; \
    allreduce16x2(br, kr); \
    if ((tid & 15) == 0) { sc[((bsel) * 16 + lstep) * 2] = br; sc[((bsel) * 16 + lstep) * 2 + 1] = kr; } }

DI void rwkv_pass1_task(const Params& p, int bh, int seg, int rq, unsigned char* smem) {
  float* ops = (float*)smem; float* sc = ops + 2 * 16 * 384;
  const int tid = TIDX(), i = tid >> 4, cg = tid & 15, cg4 = cg * 4;
  const int Rr = rq * 16 + i, h = bh & 7;
  const int srow0 = (bh >> 3) * TP + seg * 1024;
  const float* RWW = (const float*)(p.ws + W_RWW); const u16* RWX = (const u16*)(p.ws + W_RWX);
  float SL[4] = {0.f, 0.f, 0.f, 0.f}, SP[4];
#pragma unroll
  for (int e = 0; e < 4; e++) SP[e] = (cg4 + e == Rr) ? 1.f : 0.f;
  const int lstep = tid >> 4, lpart = (tid & 15) * 4;
  f32x4v pw[4]; u32x2 px[4][5];
  const int nch = 64;
  SCAN_PREFETCH(0, 0) SCAN_PREFETCH(1, 1) SCAN_PREFETCH(2, 2) SCAN_PREFETCH(3, 3)
  __syncthreads();
  SCAN_STAGE(0, 0)
  __syncthreads();
  __builtin_amdgcn_s_setprio(3);
  for (int cb = 0; cb < nch; cb += 4) {
#pragma unroll
    for (int k = 0; k < 4; k++) {
      const int c0 = cb + k;
      const int bsel = k & 1;
      SCAN_PREFETCH(k, c0 + 4)
#pragma unroll
      for (int st = 0; st < 16; st++) {
        const float* o = ops + (bsel * 16 + st) * 384;
        f32x4v w = *(const f32x4v*)(o + cg4), kp = *(const f32x4v*)(o + 128 + cg4);
        f32x4v kkv = *(const f32x4v*)(o + 256 + cg4), bb = *(const f32x4v*)(o + 320 + cg4);
        float v = o[192 + Rr];
        float d1 = SL[0] * kkv.x + SL[1] * kkv.y + SL[2] * kkv.z + SL[3] * kkv.w;
        float d2 = SP[0] * kkv.x + SP[1] * kkv.y + SP[2] * kkv.z + SP[3] * kkv.w;
        allreduce16x2(d1, d2);
        const float saL = -d1, saP = -d2;
        SL[0] = SL[0] * w.x + (saL * bb.x + v * kp.x); SP[0] = SP[0] * w.x + saP * bb.x;
        SL[1] = SL[1] * w.y + (saL * bb.y + v * kp.y); SP[1] = SP[1] * w.y + saP * bb.y;
        SL[2] = SL[2] * w.z + (saL * bb.z + v * kp.z); SP[2] = SP[2] * w.z + saP * bb.z;
        SL[3] = SL[3] * w.w + (saL * bb.w + v * kp.w); SP[3] = SP[3] * w.w + saP * bb.w;
      }
      SCAN_STAGE(((k + 1) & 3), (bsel ^ 1))
      __syncthreads();
    }
  }
  __builtin_amdgcn_s_setprio(0);
  const size_t so = ((size_t)(bh * 7 + seg)) * 4096 + Rr * 64 + cg4;
  *(float4*)((float*)(p.ws + W_SLOC) + so) = make_float4(SL[0], SL[1], SL[2], SL[3]);
  *(float4*)((float*)(p.ws + W_PMAT) + so) = make_float4(SP[0], SP[1], SP[2], SP[3]);
}

DI void allreduce16x4(float& a, float& b, float& c, float& d) {
  a = dpp_add<0xB1>(a); b = dpp_add<0xB1>(b); c = dpp_add<0xB1>(c); d = dpp_add<0xB1>(d);
  a = dpp_add<0x4E>(a); b = dpp_add<0x4E>(b); c = dpp_add<0x4E>(c); d = dpp_add<0x4E>(d);
  a = dpp_add<0x141>(a); b = dpp_add<0x141>(b); c = dpp_add<0x141>(c); d = dpp_add<0x141>(d);
  a = dpp_add<0x140>(a); b = dpp_add<0x140>(b); c = dpp_add<0x140>(c); d = dpp_add<0x140>(d);
}
DI void rwkv_scan_task(const Params& p, int srow0, int T, int h, int rq, const float* S0, float* Sout, int comb_bh, int comb_seg, unsigned char* smem) {
  if (rq & 1) return;
  float* ops = (float*)smem;
  float* sc = ops + 2 * 16 * 384;
  float* ybuf = sc + 64;
  const int tid = TIDX(), i = tid >> 3, c8 = tid & 7, c0 = c8 * 8;
  const int Rr = rq * 16 + i;
  const float* RWW = (const float*)(p.ws + W_RWW); const u16* RWX = (const u16*)(p.ws + W_RWX); float* YRAW = (float*)(p.ws + W_YRAW);
  f32x4v S[2];
  if (S0) { S[0] = *(const f32x4v*)(S0 + Rr * 64 + c0); S[1] = *(const f32x4v*)(S0 + Rr * 64 + c0 + 4); }
  else { S[0] = (f32x4v){0.f, 0.f, 0.f, 0.f}; S[1] = S[0]; }
  if (comb_bh >= 0 && comb_seg > 0) {
    const float* SLOC = (const float*)(p.ws + W_SLOC) + (size_t)comb_bh * 7 * 4096;
    const float* PMAT = (const float*)(p.ws + W_PMAT) + (size_t)comb_bh * 7 * 4096;
    float* srow = ops;
    S[0] = *(const f32x4v*)(SLOC + Rr * 64 + c0); S[1] = *(const f32x4v*)(SLOC + Rr * 64 + c0 + 4);
    for (int sp = 1; sp < comb_seg; sp++) {
      __syncthreads();
      *(f32x4v*)(srow + i * 64 + c0) = S[0]; *(f32x4v*)(srow + i * 64 + c0 + 4) = S[1];
      __syncthreads();
      f32x4v a0 = *(const f32x4v*)(SLOC + (size_t)sp * 4096 + Rr * 64 + c0), a1 = *(const f32x4v*)(SLOC + (size_t)sp * 4096 + Rr * 64 + c0 + 4);
      const float* P = PMAT + (size_t)sp * 4096 + c0;
#pragma unroll 8
      for (int k = 0; k < 64; k++) {
        const float sv = srow[i * 64 + k];
        a0 += sv * *(const f32x4v*)(P + k * 64); a1 += sv * *(const f32x4v*)(P + k * 64 + 4);
      }
      S[0] = a0; S[1] = a1;
    }
  }
  const int lstep = tid >> 4, lpart = (tid & 15) * 4;
  f32x4v pw[2]; u32x2 px[2][5];
  const int nch = T >> 4;
  SCAN_PREFETCH(0, 0) SCAN_PREFETCH(1, 1)
  __syncthreads();
  SCAN_STAGE(0, 0)
  __syncthreads();
  __builtin_amdgcn_s_setprio(3);
  for (int cb = 0; cb < nch; cb += 4) {
#pragma unroll
    for (int k = 0; k < 4; k++) {
      const int cc = cb + k;
      if (cc < nch) {
        const int bsel = k & 1;
        SCAN_PREFETCH((k & 1), cc + 2)
#pragma unroll
        for (int j = 0; j < 2; j++) {
          float yk = 0.f;
#pragma unroll
          for (int u = 0; u < 8; u++) {
            const float* o = ops + (bsel * 16 + j * 8 + u) * 384;
            const float v = o[192 + Rr];
            const float br = sc[(bsel * 16 + j * 8 + u) * 2], kr = sc[(bsel * 16 + j * 8 + u) * 2 + 1];
            f32x4v d1v = S[0] * *(const f32x4v*)(o + 256 + c0) + S[1] * *(const f32x4v*)(o + 256 + c0 + 4);
            f32x4v d2v = S[0] * *(const f32x4v*)(o + 64 + c0) + S[1] * *(const f32x4v*)(o + 64 + c0 + 4);
            float d1 = (d1v.x + d1v.y) + (d1v.z + d1v.w), d2 = (d2v.x + d2v.y) + (d2v.z + d2v.w);
            d1 = dpp_add<0xB1>(d1); d2 = dpp_add<0xB1>(d2); d1 = dpp_add<0x4E>(d1); d2 = dpp_add<0x4E>(d2);
            d1 = dpp_add<0x141>(d1); d2 = dpp_add<0x141>(d2);
#pragma unroll
            for (int m = 0; m < 2; m++) {
              const f32x4v w = *(const f32x4v*)(o + c0 + 4 * m), kp = *(const f32x4v*)(o + 128 + c0 + 4 * m), bb = *(const f32x4v*)(o + 320 + c0 + 4 * m);
              S[m] = S[m] * w + (kp * v - bb * d1);
            }
            const float y = d2 - d1 * br + v * kr;
            yk = (u == c8) ? y : yk;
          }
          ybuf[bsel * 512 + (j * 8 + c8) * 32 + i] = yk;
        }
        SCAN_STAGE(((k + 1) & 1), (bsel ^ 1))
        __syncthreads();
        if (tid < 128) {
          const int st = tid >> 3, i4 = (tid & 7) * 4;
          *(f32x4v*)(YRAW + (size_t)(srow0 + cc * 16 + st) * 512 + h * 64 + rq * 16 + i4) = *(const f32x4v*)(ybuf + bsel * 512 + st * 32 + i4);
        }
      }
    }
  }
  __builtin_amdgcn_s_setprio(0);
  if (Sout) { *(f32x4v*)(Sout + Rr * 64 + c0) = S[0]; *(f32x4v*)(Sout + Rr * 64 + c0 + 4) = S[1]; }
}
constexpr int PH5_TASKS = 512 + 128 + 2048 + 256;
DI void phase5_task(const Params& p, int l, int task, unsigned char* smem) {
  const u16* Z = (const u16*)(p.ws + W_Z); u16* YG = (u16*)(p.ws + W_YG);
  if (task < 512) {
    int bh = task >> 5, seg = 7 - ((task >> 2) & 7), rq = task & 3, b = bh >> 3, h = bh & 7;
    rwkv_scan_task(p, b * TP + seg * 1024, 1024, h, rq, nullptr, seg == 7 ? p.out + O_WKV_P + ((size_t)((l * 2 + b) * 8 + h)) * 4096 : nullptr, bh, seg, smem);
    return;
  }
  task -= 448;
  if (task < 2240) {
    int which, b, h, row0, nq, qpos0, kbase, nkeys; size_t vto; int vstr;
    if (task < 192) { int j = task - 64; which = j >> 6; int bh = j & 63; b = bh >> 3; h = bh & 7; row0 = NP + b * 16; nq = 16; qpos0 = PAST; kbase = NP + b * SK; nkeys = SK; vto = VT_S_OFF + (size_t)((b * 8 + h) * 64) * SK; vstr = SK; }
    else { int j = task - 192; int qb = 63 - (j >> 5); which = (j >> 4) & 1; int bh = j & 15; b = bh >> 3; h = bh & 7; row0 = b * TP + qb * 128; nq = 128; qpos0 = qb * 128; kbase = b * TP; nkeys = TP; vto = (size_t)((b * 8 + h) * 64) * 8192; vstr = 8192; }
    if (which == 0)
      attn_task<64, true>((const u16*)(p.ws + W_SQ) + (size_t)row0 * 512 + h * 64, 512, nq, (const u16*)(p.ws + W_SBK) + (size_t)kbase * 512 + h * 64, 512,
                          (const u16*)(p.ws + W_SBVT) + vto, vstr, nkeys, qpos0, Z + ((size_t)2 * NT + row0) * 512 + h * 64, YG + ((size_t)2 * NT + row0) * 512 + h * 64, smem);
    else
      attn_task<96, false>((const u16*)(p.ws + W_QF) + (size_t)row0 * 768 + h * 96, 768, nq, (const u16*)(p.ws + W_KF) + (size_t)kbase * 768 + h * 96, 768,
                           (const u16*)(p.ws + W_MLAVT) + vto, vstr, nkeys, qpos0, Z + ((size_t)1 * NT + row0) * 512 + h * 64, YG + ((size_t)1 * NT + row0) * 512 + h * 64, smem);
    return;
  }
  {
    int j = task - 2240; int bh = j >> 2, rq = j & 3, b = bh >> 3, h = bh & 7;
    size_t so = ((size_t)((l * 8 + b) * 8 + h)) * 4096;
    rwkv_scan_task(p, NP + b * 16, 16, h, rq, p.in[2] + so, p.out + O_WKV_S + so, -1, 0, smem);
  }
}
DI void phase5(const Params& p, int l, unsigned char* smem) {
  __shared__ int s_task;
  int* ctr = (int*)(p.ws + W_CTR) + l;
  while (true) {
    __syncthreads();
    if (TIDX() == 0) s_task = atomicAdd(ctr, 1);
    __syncthreads();
    int q = s_task;
    if (q >= PH5_TASKS - 256) break;
    int task = q < 512 ? ((q & 1) ? 512 + (q >> 1) : ((q >> 2) * 4 + ((q >> 1) & 1) * 2)) : 512 + (q - 256);
    phase5_task(p, l, task, smem);
  }
}
DI void phase5b(const Params& p, int l) {
  const int lane = TIDX() & 63, wave = TIDX() >> 6;
  const float* YRAW = (const float*)(p.ws + W_YRAW); const u16* RWX = (const u16*)(p.ws + W_RWX); const float* RHO = (const float*)(p.ws + W_RHO);
  const u16* Z = (const u16*)(p.ws + W_Z); u16* YG = (u16*)(p.ws + W_YG);
  for (int task = blockIdx.x; task < NT / 4; task += gridDim.x) {
    const int row = task * 4 + wave, c0 = lane * 8;
    float y[8];
    { float4 a = *(const float4*)(YRAW + (size_t)row * 512 + c0), b = *(const float4*)(YRAW + (size_t)row * 512 + c0 + 4);
      y[0] = a.x; y[1] = a.y; y[2] = a.z; y[3] = a.w; y[4] = b.x; y[5] = b.y; y[6] = b.z; y[7] = b.w; }
    float s = 0.f;
#pragma unroll
    for (int j = 0; j < 8; j++) s += y[j];
    s += __shfl_xor(s, 1); s += __shfl_xor(s, 2); s += __shfl_xor(s, 4);
    float mu = s * (1.f / 64.f), vs = 0.f;
#pragma unroll
    for (int j = 0; j < 8; j++) { float d = y[j] - mu; vs += d * d; }
    vs += __shfl_xor(vs, 1); vs += __shfl_xor(vs, 2); vs += __shfl_xor(vs, 4);
    float rstd = rsqrtf(vs * (1.f / 64.f) + GN_EPS);
    float rho = RHO[(size_t)row * 8 + (lane >> 3)];
    uint4 vv = *(const uint4*)(RWX + (size_t)row * 2560 + 1024 + c0);
    uint4 zz = *(const uint4*)(Z + (size_t)row * 512 + c0);
    float vf[8] = {bflo(vv.x), bfhi(vv.x), bflo(vv.y), bfhi(vv.y), bflo(vv.z), bfhi(vv.z), bflo(vv.w), bfhi(vv.w)};
    float zf[8] = {bflo(zz.x), bfhi(zz.x), bflo(zz.y), bfhi(zz.y), bflo(zz.z), bfhi(zz.z), bflo(zz.w), bfhi(zz.w)};
    float o[8];
#pragma unroll
    for (int j = 0; j < 8; j++) o[j] = ((y[j] - mu) * rstd * p.in[22][l * 512 + c0 + j] + p.in[23][l * 512 + c0 + j] + rho * vf[j]) * zf[j];
    uint4 ob; ob.x = pk2(o[0], o[1]); ob.y = pk2(o[2], o[3]); ob.z = pk2(o[4], o[5]); ob.w = pk2(o[6], o[7]);
    *(uint4*)(YG + (size_t)row * 512 + c0) = ob;
  }
}

DI void wave_gemm32(f32x16& acc, const u16* A, int lda, const u16* Bt, int ldb, int K) {
  const int lane = TIDX() & 63, r = lane & 31, hl = lane >> 5;
  const u16* ap = A + (size_t)r * lda + hl * 8; const u16* bp = Bt + (size_t)r * ldb + hl * 8;
#pragma unroll 8
  for (int k = 0; k < K; k += 16) { bf16x8 a = *(const bf16x8*)(ap + k); bf16x8 b = *(const bf16x8*)(bp + k); acc = MFMA32(a, b, acc); }
}
DI void phase6(const Params& p, int l, unsigned char* smem) {
  const u16* H = (const u16*)(p.ws + W_H); const u16* WinT = (const u16*)(p.ws + W_WINT);
  const u16* YG = (const u16*)(p.ws + W_YG); u16* MG = (u16*)(p.ws + W_MG);
  for (int t0 = blockIdx.x; t0 < 32 + 128 * 8; t0 += gridDim.x) {
    if (t0 < 32) {
      const int lane = TIDX() & 63, wave = TIDX() >> 6, r = lane & 31, hl = lane >> 5;
      const int unit = t0 * 4 + wave, row0 = NP + (unit & 3) * 32, n0 = (unit >> 2) * 32;
      f32x16 mm;
#pragma unroll
      for (int i = 0; i < 16; i++) mm[i] = 0.f;
#pragma unroll 1
      for (int g = 0; g < 3; g++) {
        f32x16 ay, ag;
#pragma unroll
        for (int i = 0; i < 16; i++) { ay[i] = 0.f; ag[i] = 0.f; }
        wave_gemm32(ay, YG + ((size_t)g * NT + row0) * 512, 512, (const u16*)(p.ws + W_WBRT) + ((size_t)(l * 3 + g) * 1024 + n0) * 512, 512, 512);
        wave_gemm32(ag, H + (size_t)row0 * 1024, 1024, WinT + (size_t)(5408 + g * 1024 + n0) * 1024, 1024, 1024);
#pragma unroll
        for (int i = 0; i < 16; i++) mm[i] += sigmoidf_(ag[i]) * ay[i];
      }
#pragma unroll
      for (int i = 0; i < 16; i++) MG[(size_t)(row0 + crow(i, hl)) * 1024 + n0 + r] = f2bf(mm[i]);
      continue;
    }
    const int t = t0 - 32;
    const int bq = t & 511, mt = (bq & 7) * 16 + ((bq >> 3) & 15), nt = (t >> 9) * 4 + (bq >> 7), m0 = mt * 128, n0 = nt * 128;

    unsigned mpk[2][2][8];
#pragma unroll
    for (int a = 0; a < 2; a++)
#pragma unroll
      for (int b = 0; b < 2; b++)
#pragma unroll
        for (int j = 0; j < 8; j++) mpk[a][b][j] = 0u;
#pragma unroll 1
    for (int g = 0; g < 3; g++) {
      f32x16 acc[2][2]; zero_acc(acc);
      gemm_mainloop(acc, YG + ((size_t)g * NT + m0) * 512, 512, (const u16*)(p.ws + W_WBRT) + ((size_t)(l * 3 + g) * 1024 + n0) * 512, 512, 512, smem);
      unsigned ypk[2][2][8];
#pragma unroll
      for (int a = 0; a < 2; a++)
#pragma unroll
        for (int b = 0; b < 2; b++)
#pragma unroll
          for (int j = 0; j < 8; j++) ypk[a][b][j] = pk2(acc[a][b][2 * j], acc[a][b][2 * j + 1]);
      zero_acc(acc);
      gemm_mainloop(acc, H + (size_t)m0 * 1024, 1024, WinT + (size_t)(5408 + g * 1024 + n0) * 1024, 1024, 1024, smem);
#pragma unroll
      for (int a = 0; a < 2; a++)
#pragma unroll
        for (int b = 0; b < 2; b++)
#pragma unroll
          for (int j = 0; j < 8; j++) {
            float lo = bflo(mpk[a][b][j]) + sigmoidf_(acc[a][b][2 * j]) * bflo(ypk[a][b][j]);
            float hi = bfhi(mpk[a][b][j]) + sigmoidf_(acc[a][b][2 * j + 1]) * bfhi(ypk[a][b][j]);
            mpk[a][b][j] = pk2(lo, hi);
          }
    }
    {
      const int lane = TIDX() & 63, wave = TIDX() >> 6, wm = wave >> 1, wn = wave & 1, r = lane & 31, hl = lane >> 5;
#pragma unroll
      for (int a = 0; a < 2; a++)
#pragma unroll
        for (int b = 0; b < 2; b++)
#pragma unroll
          for (int j = 0; j < 8; j++) {
            int col = n0 + wn * 64 + b * 32 + r;
            int row0 = m0 + wm * 64 + a * 32;
            MG[(size_t)(row0 + crow(2 * j, hl)) * 1024 + col] = (u16)(mpk[a][b][j] & 0xffffu);
            MG[(size_t)(row0 + crow(2 * j + 1, hl)) * 1024 + col] = (u16)(mpk[a][b][j] >> 16);
          }
    }
  }
}
DI void phase7(const Params& p, int l, unsigned char* smem) {
  const u16* MG = (const u16*)(p.ws + W_MG);
  const float* mod = (const float*)(p.ws + W_MOD);
  const int ntile = 32 + 128 * 8, nextra = (l + 1 < NL) ? WIN_TT + SMALLW_TT : 0;
  for (int t0 = blockIdx.x; t0 < ntile + nextra; t0 += gridDim.x) {
    if (t0 >= ntile + WIN_TT) { smallw_transpose_task(p, l + 1, t0 - ntile - WIN_TT, smem); continue; }
    if (t0 >= ntile) { win_transpose_task(p, l + 1, t0 - ntile, smem); continue; }
    if (t0 < 32) {
      const int lane = TIDX() & 63, wave = TIDX() >> 6, r = lane & 31, hl = lane >> 5;
      const int unit = t0 * 4 + wave, row0 = NP + (unit & 3) * 32, n0 = (unit >> 2) * 32;
      f32x16 a;
#pragma unroll
      for (int i = 0; i < 16; i++) a[i] = 0.f;
      wave_gemm32(a, MG + (size_t)row0 * 1024, 1024, (const u16*)(p.ws + W_WOUTT) + ((size_t)l * 1024 + n0) * 1024, 1024, 1024);
#pragma unroll
      for (int i = 0; i < 16; i++) {
        const int row = row0 + crow(i, hl), col = n0 + r;
        float xo = xrow_ptr(p, l, row)[col];
        float gt = mod[(l * 10 + bidx_of(row)) * 3072 + 2048 + col];
        p.out[(size_t)row * D + col] = xo + gt * a[i];
      }
      continue;
    }
    const int t = t0 - 32;
    const int bq = t & 511, mt = (bq & 7) * 16 + ((bq >> 3) & 15), nt = (t >> 9) * 4 + (bq >> 7), m0 = mt * 128, n0 = nt * 128;

    f32x16 acc[2][2]; zero_acc(acc);
    gemm_mainloop(acc, MG + (size_t)m0 * 1024, 1024, (const u16*)(p.ws + W_WOUTT) + ((size_t)l * 1024 + n0) * 1024, 1024, 1024, smem);
    foreach_acc(acc, m0, n0, [&](int row, int col, float v) {
      float xo = xrow_ptr(p, l, row)[col];
      float gt = mod[(l * 10 + bidx_of(row)) * 3072 + 2048 + col];
      p.out[(size_t)row * D + col] = xo + gt * v;
    });
  }
}

#define XB_TMO      128
#define XB_XCNT(j)  (256  + 64 * (j))
#define XB_XSUB(j)  (1280 + 64 * (j))
#define XB_XGEN(j)  (2304 + 64 * (j))
#define XB_TOP      3328
#define XB_TOPGEN   3392
#define XB_SPIN_CAP (1u << 18)
DI unsigned xb_ld(unsigned* q) { return __hip_atomic_load(q, __ATOMIC_RELAXED, __HIP_MEMORY_SCOPE_AGENT); }
DI unsigned xb_add(unsigned* q, unsigned v) { return __hip_atomic_fetch_add(q, v, __ATOMIC_RELAXED, __HIP_MEMORY_SCOPE_AGENT); }
DI unsigned xb_xcc_id() { return (unsigned)__builtin_amdgcn_s_getreg((3 << 11) | 20) & 0xFu; }
#define XB_SPIN(cond, bar) do { unsigned _sp = 0; while (cond) { __builtin_amdgcn_s_sleep(1); \
    if ((++_sp & 255u) == 0u) { if (xb_ld(&(bar)[XB_TMO])) break; if (_sp > XB_SPIN_CAP) { atomicAdd(&(bar)[XB_TMO], 1u); break; } } } } while (0)
DI void xbar(const Params& p, unsigned* xbst) {
  asm volatile("s_waitcnt vmcnt(0)" ::: "memory");
  __syncthreads();
  if (TIDX() == 0) {
    unsigned* bar = (unsigned*)(p.ws + W_XBAR);
    const unsigned x = xb_xcc_id();
    __builtin_amdgcn_s_waitcnt(0);
    const unsigned nloc = xbst[0], nx = xbst[1];
    const unsigned old = xb_add(&bar[XB_XSUB(x)], 1u);
    const unsigned gen = old / nloc;
    if (old + 1u == (gen + 1u) * nloc) {
      __builtin_amdgcn_fence(__ATOMIC_RELEASE, "agent");
      asm volatile("s_waitcnt vmcnt(0)" ::: "memory");
      const unsigned og = xb_add(&bar[XB_TOP], 1u);
      const unsigned tg = og / nx;
      if (og + 1u == (tg + 1u) * nx) xb_add(&bar[XB_TOPGEN], 1u);
      else XB_SPIN(xb_ld(&bar[XB_TOPGEN]) == tg, bar);
      __builtin_amdgcn_fence(__ATOMIC_ACQUIRE, "agent");
      xb_add(&bar[XB_XGEN(x)], 1u);
      asm volatile("s_waitcnt vmcnt(0)" ::: "memory");
    } else {
      XB_SPIN(xb_ld(&bar[XB_XGEN(x)]) == gen, bar);
      __builtin_amdgcn_fence(__ATOMIC_ACQUIRE, "agent");
      asm volatile("s_waitcnt vmcnt(0)" ::: "memory");
    }
  }
  __syncthreads();
}
DI int opq(int v) { asm volatile("" : "+s"(v)); return v; }
#if MULTI
template <int PH> __global__ void __launch_bounds__(256, 2) phase_kernel(Params p, int l) {
  __shared__ __attribute__((aligned(16))) unsigned char smem[SMEM_BYTES];
  if (PH == 0) phase0(p, smem);
  if (PH == 1) phase1(p, l);
  if (PH == 2) phase2(p, l, smem);
  if (PH == 3) phase3(p, l);
  if (PH == 4) phase4(p, l, smem);
  if (PH == 5) phase5(p, l, smem);
  if (PH == 6) phase5b(p, l);
  if (PH == 7) phase6(p, l, smem);
  if (PH == 8) phase7(p, l, smem);
}
#else
__global__ void __launch_bounds__(256, 2) mega_kernel(Params p_arg) {
  __shared__ __attribute__((aligned(16))) unsigned char smem[SMEM_BYTES];
  const Params& p = *(const Params*)__builtin_amdgcn_kernarg_segment_ptr();
  cg::grid_group grid = cg::this_grid();
  __shared__ unsigned xbst[4];
  if (TIDX() == 0) (void)xb_add((unsigned*)(p.ws + W_XBAR) + XB_XCNT(xb_xcc_id()), 1u);
  phase0(p, smem);
  grid.sync();
  if (TIDX() == 0) {
    unsigned* bar = (unsigned*)(p.ws + W_XBAR);
    const unsigned x = xb_xcc_id();
    unsigned cnt = 0u, mine = 0u;
    for (unsigned j = 0; j < 16; ++j) { const unsigned c = xb_ld(&bar[XB_XCNT(j)]); cnt += (c > 0u) ? 1u : 0u; mine = (j == x) ? c : mine; }
    xbst[0] = mine > 0u ? mine : 1u; xbst[1] = cnt > 0u ? cnt : 1u;
  }
  for (int l = 0; l < NL; l++) {
    phase1(p, opq(l)); xbar(p, xbst);
    phase2(p, opq(l), smem); xbar(p, xbst);
    phase3(p, opq(l)); xbar(p, xbst);
    phase4(p, opq(l), smem); xbar(p, xbst);
    phase5(p, opq(l), smem); xbar(p, xbst);
    phase5b(p, opq(l)); xbar(p, xbst);
    phase6(p, opq(l), smem); xbar(p, xbst);
    phase7(p, opq(l), smem); xbar(p, xbst);
  }
}
#endif

extern "C" void kernel_launch(void* const* d_in, const int* in_sizes, int n_in, void* d_out, int out_size, void* d_ws, size_t ws_size, hipStream_t stream) {
  Params p{};
  for (int i = 0; i < 36; i++) p.in[i] = (const float*)d_in[i];
  p.out = (float*)d_out;
  p.ws = (unsigned char*)d_ws;
  if (ws_size < W_TOTAL) fprintf(stderr, "workspace too small: %zu < %zu\n", ws_size, (size_t)W_TOTAL);
  hipMemsetAsync((unsigned char*)d_ws + W_CTR, 0, 256 + 3456 * 4, stream);
#if MULTI
  const int G = 1024;
  phase_kernel<0><<<G, 256, 0, stream>>>(p, 0);
  for (int l = 0; l < NL; l++) {
    phase_kernel<1><<<G, 256, 0, stream>>>(p, l);
    phase_kernel<2><<<G, 256, 0, stream>>>(p, l);
    phase_kernel<3><<<G, 256, 0, stream>>>(p, l);
    phase_kernel<4><<<G, 256, 0, stream>>>(p, l);
    phase_kernel<5><<<G, 256, 0, stream>>>(p, l);
    phase_kernel<6><<<G, 256, 0, stream>>>(p, l);
    phase_kernel<7><<<G, 256, 0, stream>>>(p, l);
    phase_kernel<8><<<G, 256, 0, stream>>>(p, l);
  }
#else
  static int grid_blocks = 0;
  if (!grid_blocks) {
    int dev = 0, cus = 0, per_cu = 0;
    hipGetDevice(&dev);
    hipDeviceGetAttribute(&cus, hipDeviceAttributeMultiprocessorCount, dev);
    hipOccupancyMaxActiveBlocksPerMultiprocessor(&per_cu, mega_kernel, 256, 0);
    if (per_cu > 2) per_cu = 2;
    grid_blocks = cus * per_cu;
  }
  void* args[] = {&p};
  hipError_t e = hipLaunchCooperativeKernel((void*)mega_kernel, dim3(grid_blocks), dim3(256), args, 0, stream);
  if (e != hipSuccess) fprintf(stderr, "cooperative launch failed: %s (grid %d)\n", hipGetErrorString(e), grid_blocks);
#endif
}
```

```cpp
#include <hip/hip_runtime.h>
#include <hip/hip_cooperative_groups.h>
#include <cstdio>
namespace cg = cooperative_groups;

#ifndef MULTI
#define MULTI 0
#endif

typedef unsigned short u16;
typedef __attribute__((ext_vector_type(8))) short bf16x8;
typedef __attribute__((ext_vector_type(16))) float f32x16;
typedef __attribute__((ext_vector_type(2))) __bf16 bf2_t;
typedef __attribute__((ext_vector_type(2))) float f2_t;
typedef __attribute__((ext_vector_type(4))) unsigned u32x4;
typedef __attribute__((ext_vector_type(2))) unsigned u32x2;
typedef __attribute__((ext_vector_type(4))) float f32x4v;
#define DI __device__ __forceinline__
#define MFMA32(a, b, c) __builtin_amdgcn_mfma_f32_32x32x16_bf16((a), (b), (c), 0, 0, 0)

constexpr int D = 1024, NL = 4, NP = 16384, NS = 128, NT = NP + NS, TP = 8192, TS = 16, PAST = 2048, SK = 2064;
constexpr int NKV = NP + 8 * SK;
constexpr int DIN = 8480;
constexpr float RMS_EPS = 1e-6f, GN_EPS = 64e-5f;
constexpr float LOG2E = 1.4426950408889634f;
constexpr float QSCALE_MLA = 0.10206207261596577f * LOG2E;
constexpr float QSCALE_SB = 0.125f * LOG2E;

constexpr size_t O_Y = 0;
constexpr size_t O_WKV_P = (size_t)NT * D;
constexpr size_t O_SHIFT_P = O_WKV_P + (size_t)NL * 2 * 8 * 4096;
constexpr size_t O_CKV_P = O_SHIFT_P + (size_t)NL * 2 * 1664;
constexpr size_t O_KROPE_P = O_CKV_P + (size_t)NL * NP * 256;
constexpr size_t O_SBK_P = O_KROPE_P + (size_t)NL * NP * 32;
constexpr size_t O_SBV_P = O_SBK_P + (size_t)NL * NP * 512;
constexpr size_t O_WKV_S = O_SBV_P + (size_t)NL * NP * 512;
constexpr size_t O_SHIFT_S = O_WKV_S + (size_t)NL * 8 * 8 * 4096;
constexpr size_t O_CKV_S = O_SHIFT_S + (size_t)NL * 8 * 1664;
constexpr size_t O_KROPE_S = O_CKV_S + (size_t)NL * NS * 256;
constexpr size_t O_SBK_S = O_KROPE_S + (size_t)NL * NS * 32;
constexpr size_t O_SBV_S = O_SBK_S + (size_t)NL * NS * 512;

constexpr size_t al(size_t x) { return (x + 255) & ~(size_t)255; }
constexpr size_t W_WINT = 0;
constexpr size_t W_WBRT = al(W_WINT + (size_t)DIN * 1024 * 2);
constexpr size_t W_WOUTT = al(W_WBRT + (size_t)NL * 3 * 1024 * 512 * 2);
constexpr size_t W_WUQT = al(W_WOUTT + (size_t)NL * 1024 * 1024 * 2);
constexpr size_t W_WUKVT = al(W_WUQT + (size_t)NL * 768 * 384 * 2);
constexpr size_t W_WUPT = al(W_WUKVT + (size_t)NL * 1024 * 256 * 2);
constexpr size_t W_AUPT = al(W_WUPT + (size_t)NL * 512 * 64 * 2);
constexpr size_t W_MOD = al(W_AUPT + (size_t)NL * 512 * 64 * 2);
constexpr size_t W_ROPE = al(W_MOD + (size_t)NL * 10 * 3072 * 4);
constexpr size_t W_CTR = al(W_ROPE + (size_t)8192 * 32 * 4);
constexpr size_t W_XBAR = W_CTR + 256;
constexpr size_t W_H = al(W_XBAR + 3456 * 4);
constexpr size_t W_PR = al(W_H + (size_t)NT * 1024 * 2);
constexpr size_t W_YG = W_PR;
constexpr size_t W_YRAW = al(W_YG + (size_t)3 * NT * 512 * 2);
constexpr size_t W_MG = W_YRAW;
constexpr size_t W_Z = al(W_PR + (size_t)NT * 1664 * 4);
constexpr size_t W_CQ = al(W_Z + (size_t)3 * NT * 512 * 2);
constexpr size_t W_QF = W_CQ;
constexpr size_t W_CKV = al(W_CQ + (size_t)NT * 768 * 2);
constexpr size_t W_KR = al(W_CKV + (size_t)NT * 256 * 4);
constexpr size_t W_QN = al(W_KR + (size_t)NT * 32 * 4);
constexpr size_t W_CKVN = al(W_QN + (size_t)NT * 384 * 2);
constexpr size_t W_SQ = al(W_CKVN + (size_t)(NKV + 64) * 256 * 2);
constexpr size_t W_SBK = al(W_SQ + (size_t)NT * 512 * 2);
constexpr size_t VT_S_OFF = (size_t)16 * 64 * 8192;
constexpr size_t VT_ELEMS = VT_S_OFF + (size_t)64 * 64 * SK + 256;
constexpr size_t W_SBVT = al(W_SBK + (size_t)(NKV + 64) * 512 * 2);
constexpr size_t W_RWW = al(W_SBVT + VT_ELEMS * 2);
constexpr size_t W_RWX = al(W_RWW + (size_t)NT * 512 * 4);
constexpr size_t W_RHO = al(W_RWX + (size_t)NT * 5 * 512 * 2);
constexpr size_t W_KF = al(W_RHO + (size_t)NT * 8 * 4);
constexpr size_t W_MLAVT = al(W_KF + (size_t)(NKV + 64) * 768 * 2);
constexpr size_t W_SLOC = al(W_MLAVT + VT_ELEMS * 2);
constexpr size_t W_PMAT = al(W_SLOC + (size_t)16 * 7 * 4096 * 4);
constexpr size_t W_TOTAL = al(W_PMAT + (size_t)16 * 7 * 4096 * 4);
static_assert((size_t)NT * 384 * 4 <= (size_t)NT * 768 * 2, "alias");
static_assert(W_YRAW + (size_t)NT * 1024 * 2 <= W_Z, "alias overflow");

struct Params {
  const float* in[36];
  float* out;
  unsigned char* ws;
};

constexpr int SMEM_BYTES = 73728;

DI int TIDX() { int t = __builtin_amdgcn_workitem_id_x(); asm volatile("" : "+v"(t)); return t; }
DI u16 f2bf(float x) { return __builtin_bit_cast(u16, (__bf16)x); }
DI unsigned pk2(float a, float b) { f2_t v = {a, b}; return __builtin_bit_cast(unsigned, __builtin_convertvector(v, bf2_t)); }
DI float bf2f(u16 x) { return __uint_as_float((unsigned)x << 16); }
DI float bflo(unsigned x) { return __uint_as_float(x << 16); }
DI float bfhi(unsigned x) { return __uint_as_float(x & 0xffff0000u); }
DI float ex2(float x) { return __builtin_amdgcn_exp2f(x); }
DI float lg2(float x) { return __builtin_amdgcn_logf(x); }
DI float frcp(float x) { return __builtin_amdgcn_rcpf(x); }
DI float sigmoidf_(float x) { return frcp(1.f + __expf(-x)); }
DI float siluf_(float x) { return x * frcp(1.f + __expf(-x)); }
DI float softplusf_(float x) { return fmaxf(x, 0.f) + __logf(1.f + __expf(-fabsf(x))); }
DI float tanhf_(float x) { return 1.f - 2.f * frcp(1.f + __expf(2.f * x)); }
DI int crow(int i, int hl) { return (i & 3) + 8 * (i >> 2) + 4 * hl; }
template <int CTRL> DI float dppf(float x) {
  return __int_as_float(__builtin_amdgcn_update_dpp(__float_as_int(x), __float_as_int(x), CTRL, 0xF, 0xF, false));
}
DI float allreduce16(float x) {
  x += dppf<0xB1>(x); x += dppf<0x4E>(x); x += dppf<0x141>(x); x += dppf<0x140>(x); return x;
}
DI float red32(float x) {
  x += __shfl_xor(x, 1); x += __shfl_xor(x, 2); x += __shfl_xor(x, 4); x += __shfl_xor(x, 8); x += __shfl_xor(x, 16); return x;
}
DI float red64(float x) { x = red32(x); x += __shfl_xor(x, 32); return x; }
DI int bidx_of(int row) { return row < NP ? (row >> 13) : 2 + ((row - NP) >> 4); }
DI int keyrow_of(int row) { return row < NP ? row : NP + ((row - NP) >> 4) * SK + PAST + ((row - NP) & 15); }
DI int pos_of(int row) { return row < NP ? (row & 8191) : PAST + ((row - NP) & 15); }
DI size_t vt_off(int keyrow, int h, int d) {
  if (keyrow < NP) { int b = keyrow >> 13, s = keyrow & 8191; return ((size_t)((b * 8 + h) * 64 + d)) * 8192 + s; }
  int rr = keyrow - NP; int b = rr / SK, s = rr - b * SK; return VT_S_OFF + ((size_t)((b * 8 + h) * 64 + d)) * SK + s;
}

DI void gemm_mainloop(f32x16 (&acc)[2][2], const u16* A, int lda, const u16* Bt, int ldb, int K, unsigned char* smem) {
  u16* s0 = (u16*)smem;
  const int tid = TIDX(), lane = tid & 63, wave = tid >> 6, wm = wave >> 1, wn = wave & 1;
  const int lr = tid >> 3, lc = (tid & 7) * 8;
  unsigned offA[4], offB[4];
#pragma unroll
  for (int i = 0; i < 4; i++) { offA[i] = (unsigned)(((lr + 32 * i) * lda + lc) * 2); offB[i] = (unsigned)(((lr + 32 * i) * ldb + lc) * 2); }
  const char* Ab = (const char*)A;
  const char* Bb = (const char*)Bt;
  u32x4 ra[4], rb[4];
  const int nk = K >> 6;
  const int r = lane & 31, hl = lane >> 5;
#pragma unroll
  for (int i = 0; i < 4; i++) { ra[i] = *(const u32x4*)(Ab + offA[i]); rb[i] = *(const u32x4*)(Bb + offB[i]); }
  __syncthreads();
#pragma unroll
  for (int i = 0; i < 4; i++) { *(u32x4*)(s0 + (lr + 32 * i) * 72 + lc) = ra[i]; *(u32x4*)(s0 + 128 * 72 + (lr + 32 * i) * 72 + lc) = rb[i]; }
  if (nk > 1) { Ab += 128; Bb += 128; }
#pragma unroll
  for (int i = 0; i < 4; i++) { ra[i] = *(const u32x4*)(Ab + offA[i]); rb[i] = *(const u32x4*)(Bb + offB[i]); }
  __syncthreads();
  for (int kt = 0; kt < nk; kt++) {
    u16* sA = s0 + (kt & 1) * (256 * 72); u16* sB = sA + 128 * 72;
    if (kt + 1 < nk) {
      u16* nA = s0 + ((kt + 1) & 1) * (256 * 72); u16* nB = nA + 128 * 72;
#pragma unroll
      for (int i = 0; i < 4; i++) { *(u32x4*)(nA + (lr + 32 * i) * 72 + lc) = ra[i]; *(u32x4*)(nB + (lr + 32 * i) * 72 + lc) = rb[i]; }
    }
    if (kt + 2 < nk) { Ab += 128; Bb += 128; }
#pragma unroll
    for (int i = 0; i < 4; i++) { ra[i] = *(const u32x4*)(Ab + offA[i]); rb[i] = *(const u32x4*)(Bb + offB[i]); }
#pragma unroll
    for (int ks = 0; ks < 4; ks++) {
      bf16x8 af[2], bfr[2];
#pragma unroll
      for (int b = 0; b < 2; b++) {
        af[b] = *(const bf16x8*)(sA + (wm * 64 + b * 32 + r) * 72 + ks * 16 + hl * 8);
        bfr[b] = *(const bf16x8*)(sB + (wn * 64 + b * 32 + r) * 72 + ks * 16 + hl * 8);
      }
#pragma unroll
      for (int bm = 0; bm < 2; bm++)
#pragma unroll
        for (int bn = 0; bn < 2; bn++) acc[bm][bn] = MFMA32(af[bm], bfr[bn], acc[bm][bn]);
    }
    __syncthreads();
  }
}
DI void zero_acc(f32x16 (&acc)[2][2]) {
#pragma unroll
  for (int a = 0; a < 2; a++)
#pragma unroll
    for (int b = 0; b < 2; b++)
#pragma unroll
      for (int i = 0; i < 16; i++) acc[a][b][i] = 0.f;
}
template <class F> DI void foreach_acc(f32x16 (&acc)[2][2], int m0, int n0, F f) {
  const int lane = TIDX() & 63, wave = TIDX() >> 6, wm = wave >> 1, wn = wave & 1, r = lane & 31, hl = lane >> 5;
#pragma unroll
  for (int bm = 0; bm < 2; bm++)
#pragma unroll
    for (int bn = 0; bn < 2; bn++)
#pragma unroll
      for (int i = 0; i < 16; i++) f(m0 + wm * 64 + bm * 32 + crow(i, hl), n0 + wn * 64 + bn * 32 + r, acc[bm][bn][i]);
}

DI void transpose_tile(const float* __restrict__ src, int K, int N, u16* __restrict__ dst, int kt, int nt, int mode, unsigned char* smem) {
  float* tile = (float*)smem;
  const int tid = TIDX(), tx = tid & 63, ty = tid >> 6;
  const int k0 = kt * 64, n0 = nt * 64;
  __syncthreads();
#pragma unroll 4
  for (int i = 0; i < 16; i++) { int k = i * 4 + ty; int n = n0 + tx; tile[k * 65 + tx] = (n < N) ? src[(size_t)(k0 + k) * N + n] : 0.f; }
  __syncthreads();
#pragma unroll 4
  for (int i = 0; i < 16; i++) {
    int nl = i * 4 + ty; int n = n0 + nl;
    if (n < N) {
      int nd = n;
      if (mode == 1) { int hd = n / 96, d = n - hd * 96; nd = d < 64 ? hd * 64 + d : 512 + hd * 32 + (d - 64); }
      dst[(size_t)nd * K + k0 + tx] = f2bf(tile[tx * 65 + nl]);
    }
  }
}
constexpr int WIN_TT = 16 * 133;
DI void win_transpose_task(const Params& p, int l, int t, unsigned char* smem) {
  int kt = t & 15, nt = t >> 4;
  transpose_tile(p.in[13] + (size_t)l * 1024 * DIN, 1024, DIN, (u16*)(p.ws + W_WINT), kt, nt, 0, smem);
}
constexpr int SMALLW_TT = 384 + 256 + 72 + 64 + 8 + 8;
DI void smallw_transpose_task(const Params& p, int l, int t, unsigned char* smem) {
  if (t < 384) { int g = t / 128, q = t % 128; const float* src = p.in[g == 0 ? 24 : (g == 1 ? 33 : 34)] + (size_t)l * 512 * 1024;
    transpose_tile(src, 512, 1024, (u16*)(p.ws + W_WBRT) + ((size_t)(l * 3 + g)) * 1024 * 512, q & 7, q >> 3, 0, smem); return; }
  t -= 384;
  if (t < 256) { transpose_tile(p.in[35] + (size_t)l * 1024 * 1024, 1024, 1024, (u16*)(p.ws + W_WOUTT) + (size_t)l * 1024 * 1024, t & 15, t >> 4, 0, smem); return; }
  t -= 256;
  if (t < 72) { transpose_tile(p.in[26] + (size_t)l * 384 * 768, 384, 768, (u16*)(p.ws + W_WUQT) + (size_t)l * 768 * 384, t % 6, t / 6, 1, smem); return; }
  t -= 72;
  if (t < 64) { transpose_tile(p.in[28] + (size_t)l * 256 * 1024, 256, 1024, (u16*)(p.ws + W_WUKVT) + (size_t)l * 1024 * 256, t & 3, t >> 2, 0, smem); return; }
  t -= 64;
  if (t < 8) { transpose_tile(p.in[16] + (size_t)l * 64 * 512, 64, 512, (u16*)(p.ws + W_WUPT) + (size_t)l * 512 * 64, 0, t, 0, smem); return; }
  t -= 8;
  transpose_tile(p.in[18] + (size_t)l * 64 * 512, 64, 512, (u16*)(p.ws + W_AUPT) + (size_t)l * 512 * 64, 0, t, 0, smem);
}
DI void mod_task(const Params& p, int task, unsigned char* smem) {
  float* sm = (float*)smem;
  const int tid = TIDX(), l = task / 48, cb = task % 48, kq = tid >> 6, cl = tid & 63, col = cb * 64 + cl;
  __syncthreads();
  for (int e = tid; e < 10240; e += 256) { int r = e >> 10, k = e & 1023; float c = r < 2 ? p.in[8][r * 1024 + k] : p.in[9][(r - 2) * 1024 + k]; sm[e] = siluf_(c); }
  __syncthreads();
  float acc[10];
#pragma unroll
  for (int r = 0; r < 10; r++) acc[r] = 0.f;
  const float* w = p.in[10] + ((size_t)l * 1024 + kq * 256) * 3072 + col;
#pragma unroll 8
  for (int k = 0; k < 256; k++) {
    float wv = w[(size_t)k * 3072];
#pragma unroll
    for (int r = 0; r < 10; r++) acc[r] += sm[r * 1024 + kq * 256 + k] * wv;
  }
  __syncthreads();
#pragma unroll
  for (int r = 0; r < 10; r++) sm[(kq * 10 + r) * 64 + cl] = acc[r];
  __syncthreads();
  if (tid < 64) {
    float* mod = (float*)(p.ws + W_MOD);
    float bb = p.in[11][l * 3072 + col];
#pragma unroll
    for (int r = 0; r < 10; r++) mod[(l * 10 + r) * 3072 + col] = sm[r * 64 + cl] + sm[(10 + r) * 64 + cl] + sm[(20 + r) * 64 + cl] + sm[(30 + r) * 64 + cl] + bb;
  }
}
DI void rope_task(const Params& p, int task) {
  const int tid = TIDX(); const int pos = task * 128 + (tid >> 1);
  float* rope = (float*)(p.ws + W_ROPE);
  for (int ff = 0; ff < 8; ff++) {
    int f = (tid & 1) * 8 + ff;
    double inv = 1.0; for (int j = 0; j < f; j++) inv *= 0.5623413251903491;
    double ang = (double)pos * inv;
    double n = rint(ang * 0.15915494309189535);
    double rr = ang - n * 6.283185307179586 - n * 2.4492935982947064e-16;
    double r2 = rr * rr, sn = rr, cs = 1.0, ts = rr, tc = 1.0;
    for (int k = 1; k <= 15; k++) { tc *= -r2 / (double)((2 * k - 1) * (2 * k)); cs += tc; ts *= -r2 / (double)((2 * k) * (2 * k + 1)); sn += ts; }
    rope[pos * 32 + f] = (float)cs; rope[pos * 32 + 16 + f] = (float)sn;
  }
}
DI void phase0(const Params& p, unsigned char* smem) {
  const int n_tr = WIN_TT + SMALLW_TT, total = n_tr + 192 + 64;
  for (int t = blockIdx.x; t < total; t += gridDim.x) {
    if (t < 192) mod_task(p, t, smem);
    else if (t < 192 + 64) rope_task(p, t - 192);
    else { int q = t - 256; if (q < WIN_TT) win_transpose_task(p, 0, q, smem); else { q -= WIN_TT; smallw_transpose_task(p, 0, q, smem); } }
  }
}

DI const float* xrow_ptr(const Params& p, int l, int row) {
  if (l > 0) return p.out + (size_t)row * D;
  return row < NP ? p.in[0] + (size_t)row * D : p.in[1] + (size_t)(row - NP) * D;
}
DI void phase1(const Params& p, int l) {
  const int lane = TIDX() & 63, wave = TIDX() >> 6;
  const float* mod = (const float*)(p.ws + W_MOD);
  const float* g = p.in[12] + l * 1024;
  u16* H = (u16*)(p.ws + W_H);
  for (int task = blockIdx.x; task < NT / 4; task += gridDim.x) {
    int row = task * 4 + wave;
    const float* x = xrow_ptr(p, l, row);
    const float* md = mod + (l * 10 + bidx_of(row)) * 3072;
    float4 v[4]; float ss = 0.f;
#pragma unroll
    for (int j = 0; j < 4; j++) { v[j] = *(const float4*)(x + (j * 64 + lane) * 4); ss += v[j].x * v[j].x + v[j].y * v[j].y + v[j].z * v[j].z + v[j].w * v[j].w; }
    ss = red64(ss);
    float rstd = rsqrtf(ss * (1.f / 1024.f) + RMS_EPS);
#pragma unroll
    for (int j = 0; j < 4; j++) {
      int c = (j * 64 + lane) * 4;
      float4 gg = *(const float4*)(g + c), sh = *(const float4*)(md + c), sc = *(const float4*)(md + 1024 + c);
      float h0 = v[j].x * rstd * gg.x * (1.f + sc.x) + sh.x, h1 = v[j].y * rstd * gg.y * (1.f + sc.y) + sh.y;
      float h2 = v[j].z * rstd * gg.z * (1.f + sc.z) + sh.z, h3 = v[j].w * rstd * gg.w * (1.f + sc.w) + sh.w;
      uint2 o; o.x = pk2(h0, h1); o.y = pk2(h2, h3);
      *(uint2*)(H + (size_t)row * 1024 + c) = o;
    }
  }
}

DI void phase2(const Params& p, int l, unsigned char* smem) {
  const u16* H = (const u16*)(p.ws + W_H);
  const u16* WinT = (const u16*)(p.ws + W_WINT);
  float* PR = (float*)(p.ws + W_PR);
  u16* Z = (u16*)(p.ws + W_Z);
  float* CQ = (float*)(p.ws + W_CQ); float* CKV = (float*)(p.ws + W_CKV); float* KR = (float*)(p.ws + W_KR);
  u16* SQ = (u16*)(p.ws + W_SQ); u16* SBK = (u16*)(p.ws + W_SBK); u16* SBVT = (u16*)(p.ws + W_SBVT);
  float* out = p.out;
  for (int ts = blockIdx.x; ts < 11 * 512; ts += gridDim.x) {
    int mt, nt;
    {
      const int rd = ts >> 9, bq = ts & 511, sm = bq & 7, j = bq >> 3;
      mt = sm * 16 + (j & 15); nt = rd * 4 + (j >> 4);
      if (nt >= 43) { const int e = sm * 16 + (j & 15); if (e >= 43) continue; mt = 128; nt = e; }
    }
    const int m0 = mt * 128;
    int seg, n0, c0;
    if (nt < 13) { seg = 0; c0 = nt * 128; n0 = c0; }
    else if (nt < 17) { seg = 1; c0 = (nt - 13) * 128; n0 = 1664 + c0; }
    else if (nt < 20) { seg = 2; c0 = (nt - 17) * 128; n0 = 2176 + c0; }
    else if (nt < 22) { seg = 3; c0 = (nt - 20) * 128; n0 = 2560 + c0; }
    else if (nt < 26) { seg = 4; c0 = (nt - 22) * 128; n0 = 2848 + c0; }
    else if (nt < 30) { seg = 5; c0 = (nt - 26) * 128; n0 = 3360 + c0; }
    else if (nt < 34) { seg = 6; c0 = (nt - 30) * 128; n0 = 3872 + c0; }
    else if (nt < 38) { seg = 7; c0 = (nt - 34) * 128; n0 = 4384 + c0; }
    else if (nt < 42) { seg = 8; c0 = (nt - 38) * 128; n0 = 4896 + c0; }
    else { seg = 9; c0 = 0; n0 = 2816; }
    f32x16 acc[2][2]; zero_acc(acc);
    gemm_mainloop(acc, H + (size_t)m0 * 1024, 1024, WinT + (size_t)n0 * 1024, 1024, 1024, smem);
    if (seg == 0) {
      foreach_acc(acc, m0, c0, [&](int row, int col, float v) {
        PR[(size_t)row * 1664 + col] = v;
        if (row < NP) { if ((row & 8191) == 8191) out[O_SHIFT_P + (size_t)(l * 2 + (row >> 13)) * 1664 + col] = v; }
        else { int rr = row - NP; if ((rr & 15) == 15) out[O_SHIFT_S + (size_t)(l * 8 + (rr >> 4)) * 1664 + col] = v; }
      });
    } else if (seg == 1 || seg == 4 || seg == 8) {
      const int g = seg == 1 ? 0 : (seg == 4 ? 1 : 2);
      foreach_acc(acc, m0, c0, [&](int row, int col, float v) { Z[((size_t)g * NT + row) * 512 + col] = f2bf(siluf_(v)); });
    } else if (seg == 2) {
      foreach_acc(acc, m0, c0, [&](int row, int col, float v) { CQ[(size_t)row * 384 + col] = v; });
    } else if (seg == 3) {
      foreach_acc(acc, m0, c0, [&](int row, int col, float v) { CKV[(size_t)row * 256 + col] = v; });
    } else if (seg == 9) {
      foreach_acc(acc, m0, c0, [&](int row, int col, float v) { if (col < 32) KR[(size_t)row * 32 + col] = v; });
    } else if (seg == 5) {
      foreach_acc(acc, m0, c0, [&](int row, int col, float v) { SQ[(size_t)row * 512 + col] = f2bf(v * QSCALE_SB); });
    } else if (seg == 6) {
      foreach_acc(acc, m0, c0, [&](int row, int col, float v) {
        size_t oo = row < NP ? O_SBK_P + ((size_t)l * NP + row) * 512 + col : O_SBK_S + ((size_t)l * NS + (row - NP)) * 512 + col;
        out[oo] = v;
        SBK[(size_t)keyrow_of(row) * 512 + col] = f2bf(v);
      });
    } else {
      foreach_acc(acc, m0, c0, [&](int row, int col, float v) {
        size_t oo = row < NP ? O_SBV_P + ((size_t)l * NP + row) * 512 + col : O_SBV_S + ((size_t)l * NS + (row - NP)) * 512 + col;
        out[oo] = v;
      });
      const int lane = TIDX() & 63, wave = TIDX() >> 6, wm = wave >> 1, wn = wave & 1, r = lane & 31, hl = lane >> 5;
#pragma unroll
      for (int bm = 0; bm < 2; bm++)
#pragma unroll
        for (int bn = 0; bn < 2; bn++)
#pragma unroll
          for (int g4 = 0; g4 < 4; g4++) {
            int row = m0 + wm * 64 + bm * 32 + 8 * g4 + 4 * hl, col = c0 + wn * 64 + bn * 32 + r;
            uint2 o; o.x = pk2(acc[bm][bn][4 * g4], acc[bm][bn][4 * g4 + 1]); o.y = pk2(acc[bm][bn][4 * g4 + 2], acc[bm][bn][4 * g4 + 3]);
            *(uint2*)(SBVT + vt_off(keyrow_of(row), col >> 6, col & 63)) = o;
          }
    }
  }
}

DI const float* prev_ptr(const Params& p, int l, const float* PR, int row) {
  if (row < NP) return (row & 8191) ? PR + (size_t)(row - 1) * 1664 : nullptr;
  int rr = row - NP;
  return (rr & 15) ? PR + (size_t)(row - 1) * 1664 : p.in[3] + (size_t)(l * 8 + (rr >> 4)) * 1664;
}
DI void rwkv_prep_task(const Params& p, int l, int task) {
  const int lane = TIDX() & 63, wave = TIDX() >> 6, r = lane & 31, hl = lane >> 5;
  const int tile = task >> 1, hh = (task & 1) * 4 + wave, row0 = tile * 32;
  const float* PR = (const float*)(p.ws + W_PR);
  const float* mu = p.in[14] + l * 1664;
  f32x16 accW[1][2], accA[1][2];
#pragma unroll
  for (int b_ = 0; b_ < 2; b_++)
#pragma unroll
    for (int i_ = 0; i_ < 16; i_++) { accW[0][b_][i_] = 0.f; accA[0][b_][i_] = 0.f; }
  const u16* WupT = (const u16*)(p.ws + W_WUPT) + (size_t)l * 512 * 64;
  const u16* AupT = (const u16*)(p.ws + W_AUPT) + (size_t)l * 512 * 64;
#pragma unroll 1
  for (int ks = 0; ks < 4; ks++) {
    const int k0 = ks * 16 + hl * 8;
    bf16x8 bw[2], ba[2];
#pragma unroll
    for (int bn = 0; bn < 2; bn++) {
      bw[bn] = *(const bf16x8*)(WupT + (size_t)(hh * 64 + bn * 32 + r) * 64 + k0);
      ba[bn] = *(const bf16x8*)(AupT + (size_t)(hh * 64 + bn * 32 + r) * 64 + k0);
    }
#pragma unroll
    for (int bm = 0; bm < 1; bm++) {
      const int row = row0 + bm * 32 + r;
      const float* pp = PR + (size_t)row * 1664;
      const float* pv = prev_ptr(p, l, PR, row);
      float xw[8], xa[8];
#pragma unroll
      for (int q = 0; q < 2; q++) {
        float4 a = *(const float4*)(pp + 1536 + k0 + 4 * q), b = pv ? *(const float4*)(pv + 1536 + k0 + 4 * q) : make_float4(0, 0, 0, 0), m = *(const float4*)(mu + 1536 + k0 + 4 * q);
        xw[4 * q] = tanhf_(a.x + (b.x - a.x) * m.x); xw[4 * q + 1] = tanhf_(a.y + (b.y - a.y) * m.y); xw[4 * q + 2] = tanhf_(a.z + (b.z - a.z) * m.z); xw[4 * q + 3] = tanhf_(a.w + (b.w - a.w) * m.w);
        a = *(const float4*)(pp + 1600 + k0 + 4 * q); b = pv ? *(const float4*)(pv + 1600 + k0 + 4 * q) : make_float4(0, 0, 0, 0); m = *(const float4*)(mu + 1600 + k0 + 4 * q);
        xa[4 * q] = a.x + (b.x - a.x) * m.x; xa[4 * q + 1] = a.y + (b.y - a.y) * m.y; xa[4 * q + 2] = a.z + (b.z - a.z) * m.z; xa[4 * q + 3] = a.w + (b.w - a.w) * m.w;
      }
      u32x4 uw, ua;
      uw.x = pk2(xw[0], xw[1]); uw.y = pk2(xw[2], xw[3]); uw.z = pk2(xw[4], xw[5]); uw.w = pk2(xw[6], xw[7]);
      ua.x = pk2(xa[0], xa[1]); ua.y = pk2(xa[2], xa[3]); ua.z = pk2(xa[4], xa[5]); ua.w = pk2(xa[6], xa[7]);
      bf16x8 awf = __builtin_bit_cast(bf16x8, uw), aaf = __builtin_bit_cast(bf16x8, ua);
#pragma unroll
      for (int bn = 0; bn < 2; bn++) { accW[bm][bn] = MFMA32(awf, bw[bn], accW[bm][bn]); accA[bm][bn] = MFMA32(aaf, ba[bn], accA[bm][bn]); }
    }
  }
  float* RWW = (float*)(p.ws + W_RWW); u16* RWX = (u16*)(p.ws + W_RWX); float* RHO = (float*)(p.ws + W_RHO);
  float mur[2], muk[2], muv[2], w0[2], a0[2], kk_[2], ka_[2], rk_[2];
#pragma unroll
  for (int bn = 0; bn < 2; bn++) {
    int col = hh * 64 + bn * 32 + r;
    mur[bn] = mu[col]; muk[bn] = mu[512 + col]; muv[bn] = mu[1024 + col];
    w0[bn] = p.in[15][l * 512 + col]; a0[bn] = p.in[17][l * 512 + col]; kk_[bn] = p.in[19][l * 512 + col]; ka_[bn] = p.in[20][l * 512 + col]; rk_[bn] = p.in[21][l * 512 + col];
  }
#pragma unroll
  for (int bm = 0; bm < 1; bm++)
#pragma unroll
    for (int i = 0; i < 16; i++) {
      const int row = row0 + bm * 32 + crow(i, hl);
      const float* pp = PR + (size_t)row * 1664;
      const float* pv = prev_ptr(p, l, PR, row);
      float xr[2], xv[2], kp[2], kkr[2], av[2], dec[2];
      float ssq = 0.f, rho = 0.f;
#pragma unroll
      for (int bn = 0; bn < 2; bn++) {
        int col = hh * 64 + bn * 32 + r;
        float pr_ = pp[col], pk_ = pp[512 + col], pv_ = pp[1024 + col];
        float qr = pv ? pv[col] : 0.f, qk = pv ? pv[512 + col] : 0.f, qv = pv ? pv[1024 + col] : 0.f;
        xr[bn] = pr_ + (qr - pr_) * mur[bn];
        float xk = pk_ + (qk - pk_) * muk[bn];
        xv[bn] = pv_ + (qv - pv_) * muv[bn];
        float wpre = w0[bn] + accW[bm][bn][i];
        float wlog = -softplusf_(-wpre) - 0.5f;
        dec[bn] = __expf(-__expf(wlog));
        av[bn] = sigmoidf_(a0[bn] + accA[bm][bn][i]);
        kkr[bn] = xk * kk_[bn];
        kp[bn] = xk * (1.f + (av[bn] - 1.f) * ka_[bn]);
        ssq += kkr[bn] * kkr[bn];
        rho += xr[bn] * kp[bn] * rk_[bn];
      }
      ssq = red32(ssq); rho = red32(rho);
      float inv = rsqrtf(fmaxf(ssq, 1e-24f));
#pragma unroll
      for (int bn = 0; bn < 2; bn++) {
        int col = hh * 64 + bn * 32 + r;
        float kk = kkr[bn] * inv;
        RWW[(size_t)row * 512 + col] = dec[bn];
        u16* rx = RWX + (size_t)row * 2560 + col;
        rx[0] = f2bf(xr[bn]); rx[512] = f2bf(kp[bn]); rx[1024] = f2bf(xv[bn]); rx[1536] = f2bf(kk); rx[2048] = f2bf(kk * av[bn]);
      }
      if (r == 0) RHO[(size_t)row * 8 + hh] = rho;
    }
}
DI void norm_row_task(const Params& p, int l, int task) {
  const int lane = TIDX() & 63, wave = TIDX() >> 6;
  const int row = task * 4 + wave;
  const float* CQ = (const float*)(p.ws + W_CQ); const float* CKV = (const float*)(p.ws + W_CKV); const float* KR = (const float*)(p.ws + W_KR);
  u16* QN = (u16*)(p.ws + W_QN); u16* CKVN = (u16*)(p.ws + W_CKVN); u16* KF = (u16*)(p.ws + W_KF);
  const int keyrow = keyrow_of(row);
  {
    float v[6], ss = 0.f;
#pragma unroll
    for (int j = 0; j < 6; j++) { v[j] = CQ[(size_t)row * 384 + j * 64 + lane]; ss += v[j] * v[j]; }
    ss = red64(ss); float rstd = rsqrtf(ss * (1.f / 384.f) + RMS_EPS);
#pragma unroll
    for (int j = 0; j < 6; j++) QN[(size_t)row * 384 + j * 64 + lane] = f2bf(v[j] * rstd * p.in[25][l * 384 + j * 64 + lane]);
  }
  {
    float4 v = *(const float4*)(CKV + (size_t)row * 256 + lane * 4);
    float ss = red64(v.x * v.x + v.y * v.y + v.z * v.z + v.w * v.w);
    float rstd = rsqrtf(ss * (1.f / 256.f) + RMS_EPS);
    float4 g = *(const float4*)(p.in[27] + l * 256 + lane * 4);
    float4 o = make_float4(v.x * rstd * g.x, v.y * rstd * g.y, v.z * rstd * g.z, v.w * rstd * g.w);
    size_t oo = row < NP ? O_CKV_P + ((size_t)l * NP + row) * 256 : O_CKV_S + ((size_t)l * NS + (row - NP)) * 256;
    *(float4*)(p.out + oo + lane * 4) = o;
    uint2 ob; ob.x = pk2(o.x, o.y); ob.y = pk2(o.z, o.w);
    *(uint2*)(CKVN + (size_t)keyrow * 256 + lane * 4) = ob;
  }
  {
    float x = lane < 32 ? KR[(size_t)row * 32 + lane] : 0.f;
    float ss = red64(x * x); float rstd = rsqrtf(ss * (1.f / 32.f) + RMS_EPS);
    float xn = x * rstd * p.in[32][l * 32 + (lane & 31)];
    float pt = __shfl_xor(xn, 16);
    const float* rp = (const float*)(p.ws + W_ROPE) + pos_of(row) * 32;
    float cs = rp[lane & 15], sn = rp[16 + (lane & 15)];
    float o = (lane & 16) ? (pt * sn + xn * cs) : (xn * cs - pt * sn);
    if (lane < 32) {
      size_t oo = row < NP ? O_KROPE_P + ((size_t)l * NP + row) * 32 : O_KROPE_S + ((size_t)l * NS + (row - NP)) * 32;
      p.out[oo + lane] = o;
      u16 ob = f2bf(o);
#pragma unroll
      for (int hd = 0; hd < 8; hd++) KF[(size_t)keyrow * 768 + hd * 96 + 64 + lane] = ob;
    }
  }
}
DI void past_convert_task(const Params& p, int l, int task) {
  const int tid = TIDX();
  if (task < 2048) {
    size_t e = ((size_t)task * 256 + tid) * 8; int rowp = (int)(e >> 8), c = (int)(e & 255); int b = rowp >> 11, s = rowp & 2047;
    const float* src = p.in[4] + ((size_t)(l * 8 + b) * PAST + s) * 256 + c;
    float4 a = *(const float4*)src, bq = *(const float4*)(src + 4);
    uint4 o; o.x = pk2(a.x, a.y); o.y = pk2(a.z, a.w); o.z = pk2(bq.x, bq.y); o.w = pk2(bq.z, bq.w);
    *(uint4*)((u16*)(p.ws + W_CKVN) + (size_t)(NP + b * SK + s) * 256 + c) = o; return;
  }
  task -= 2048;
  if (task < 4096) {
    size_t e = ((size_t)task * 256 + tid) * 8; int rowp = (int)(e >> 9), c = (int)(e & 511); int b = rowp >> 11, s = rowp & 2047;
    const float* src = p.in[6] + ((size_t)(l * 8 + b) * PAST + s) * 512 + c;
    float4 a = *(const float4*)src, bq = *(const float4*)(src + 4);
    uint4 o; o.x = pk2(a.x, a.y); o.y = pk2(a.z, a.w); o.z = pk2(bq.x, bq.y); o.w = pk2(bq.z, bq.w);
    *(uint4*)((u16*)(p.ws + W_SBK) + (size_t)(NP + b * SK + s) * 512 + c) = o; return;
  }
  task -= 4096;
  if (task < 4096) {
    int id = task * 256 + tid; int c = id & 511, sg = (id >> 9) & 255, b = id >> 17;
    const float* src = p.in[7] + ((size_t)(l * 8 + b) * PAST + sg * 8) * 512 + c;
    float v[8];
#pragma unroll
    for (int j = 0; j < 8; j++) v[j] = src[(size_t)j * 512];
    uint4 o; o.x = pk2(v[0], v[1]); o.y = pk2(v[2], v[3]); o.z = pk2(v[4], v[5]); o.w = pk2(v[6], v[7]);
    *(uint4*)((u16*)(p.ws + W_SBVT) + VT_S_OFF + ((size_t)((b * 8 + (c >> 6)) * 64 + (c & 63))) * SK + sg * 8) = o; return;
  }
  task -= 4096;
  {
    int id = task * 256 + tid; int ch = id & 7, rowp = id >> 3; int b = rowp >> 11, s = rowp & 2047;
    float4 a = *(const float4*)(p.in[5] + ((size_t)(l * 8 + b) * PAST + s) * 32 + ch * 4);
    uint2 o; o.x = pk2(a.x, a.y); o.y = pk2(a.z, a.w);
    u16* dst = (u16*)(p.ws + W_KF) + (size_t)(NP + b * SK + s) * 768 + 64 + ch * 4;
#pragma unroll
    for (int hd = 0; hd < 8; hd++) *(uint2*)(dst + hd * 96) = o;
  }
}
DI void phase3(const Params& p, int l) {
  const int nA = 1032, nB = NT / 4, nC = 2048 + 4096 + 4096 + 512, total = nA + nB + nC;
  for (int t = blockIdx.x; t < total; t += gridDim.x) {
    if (t < nA) rwkv_prep_task(p, l, t);
    else if (t < nA + nB) norm_row_task(p, l, t - nA);
    else past_convert_task(p, l, t - nA - nB);
  }
}

DI void rwkv_pass1_task(const Params& p, int bh, int seg, int rq, unsigned char* smem);
DI void phase4(const Params& p, int l, unsigned char* smem) {
  const int lane = TIDX() & 63, wave = TIDX() >> 6, wm = wave >> 1, wn = wave & 1, r = lane & 31, hl = lane >> 5;
  const float* rope = (const float*)(p.ws + W_ROPE);
  u16* QF = (u16*)(p.ws + W_QF); u16* KF = (u16*)(p.ws + W_KF); u16* VT = (u16*)(p.ws + W_MLAVT);
  const int nQ = 129 * 6, nKV = 257 * 8;
  __shared__ int s_task4;
  int* ctr4 = (int*)(p.ws + W_CTR) + 8 + l;
  while (true) {
    __syncthreads();
    if (TIDX() == 0) s_task4 = atomicAdd(ctr4, 1);
    __syncthreads();
    const int q4 = s_task4;
    if (q4 >= 448 + nQ + nKV) break;
    const int t0 = q4;
    if (t0 < 448) { int bh = t0 / 28, rem = t0 - bh * 28; rwkv_pass1_task(p, bh, rem >> 2, rem & 3, smem); continue; }
    const int t = t0 - 448;
    f32x16 acc[2][2]; zero_acc(acc);
    if (t < nQ) {
      const int mt = t % 129, nt = t / 129, m0 = mt * 128;
      gemm_mainloop(acc, (const u16*)(p.ws + W_QN) + (size_t)m0 * 384, 384, (const u16*)(p.ws + W_WUQT) + ((size_t)l * 768 + nt * 128) * 384, 384, 384, smem);
      if (nt < 4) {
        const int head = nt * 2 + wn;
        float g0 = p.in[29][l * 64 + r] * QSCALE_MLA, g1 = p.in[29][l * 64 + 32 + r] * QSCALE_MLA;
#pragma unroll
        for (int bm = 0; bm < 2; bm++)
#pragma unroll
          for (int i = 0; i < 16; i++) {
            float a = acc[bm][0][i], b = acc[bm][1][i];
            float ss = red32(a * a + b * b); float rstd = rsqrtf(ss * (1.f / 64.f) + RMS_EPS);
            int row = m0 + wm * 64 + bm * 32 + crow(i, hl);
            u16* q = QF + (size_t)row * 768 + head * 96;
            q[r] = f2bf(a * rstd * g0); q[32 + r] = f2bf(b * rstd * g1);
          }
      } else {
        float g = p.in[30][l * 32 + r] * QSCALE_MLA;
#pragma unroll
        for (int bm = 0; bm < 2; bm++)
#pragma unroll
          for (int bn = 0; bn < 2; bn++)
#pragma unroll
            for (int i = 0; i < 16; i++) {
              const int head = (nt - 4) * 4 + wn * 2 + bn;
              float a = acc[bm][bn][i];
              float ss = red32(a * a); float rstd = rsqrtf(ss * (1.f / 32.f) + RMS_EPS);
              float xn = a * rstd * g; float pt = __shfl_xor(xn, 16);
              int row = m0 + wm * 64 + bm * 32 + crow(i, hl);
              const float* rp = rope + pos_of(row) * 32;
              float cs = rp[r & 15], sn = rp[16 + (r & 15)];
              float o = (r & 16) ? (pt * sn + xn * cs) : (xn * cs - pt * sn);
              QF[(size_t)row * 768 + head * 96 + 64 + r] = f2bf(o);
            }
      }
    } else {
      const int q = t - nQ, mt = q % 257, head = q / 257, m0 = mt * 128;
      gemm_mainloop(acc, (const u16*)(p.ws + W_CKVN) + (size_t)m0 * 256, 256, (const u16*)(p.ws + W_WUKVT) + ((size_t)l * 1024 + head * 128) * 256, 256, 256, smem);
      if (wn == 0) {
        float g0 = p.in[31][l * 64 + r], g1 = p.in[31][l * 64 + 32 + r];
#pragma unroll
        for (int bm = 0; bm < 2; bm++)
#pragma unroll
          for (int i = 0; i < 16; i++) {
            float a = acc[bm][0][i], b = acc[bm][1][i];
            float ss = red32(a * a + b * b); float rstd = rsqrtf(ss * (1.f / 64.f) + RMS_EPS);
            int krow = m0 + wm * 64 + bm * 32 + crow(i, hl);
            u16* k = KF + (size_t)krow * 768 + head * 96;
            k[r] = f2bf(a * rstd * g0); k[32 + r] = f2bf(b * rstd * g1);
          }
      } else {
#pragma unroll
        for (int bm = 0; bm < 2; bm++)
#pragma unroll
          for (int bn = 0; bn < 2; bn++)
#pragma unroll
            for (int g4 = 0; g4 < 4; g4++) {
              int krow = m0 + wm * 64 + bm * 32 + 8 * g4 + 4 * hl, d = bn * 32 + r;
              uint2 o; o.x = pk2(acc[bm][bn][4 * g4], acc[bm][bn][4 * g4 + 1]); o.y = pk2(acc[bm][bn][4 * g4 + 2], acc[bm][bn][4 * g4 + 3]);
              *(uint2*)(VT + vt_off(krow, head, d)) = o;
            }
      }
    }
  }
}

template <int DK, bool SB>
DI void attn_task(const u16* __restrict__ Qp, int qstride, int nq_valid, const u16* __restrict__ Kp, int kstride,
                  const u16* __restrict__ Vtp, int vstride, int nkeys, int qpos0,
                  const u16* __restrict__ Zp, u16* __restrict__ Yp, unsigned char* smem) {
  constexpr int KS = DK / 16, KSTR = DK + 8, KCH = DK / 8, NKL = 64 * KCH / 256;
  u16* sK = (u16*)smem; u16* sV = sK + 64 * KSTR;
  const int tid = TIDX(), lane = tid & 63, wave = tid >> 6, r = lane & 31, hl = lane >> 5;
  const int slot = wave * 32 + r;
  const bool wave_active = wave * 32 < nq_valid;
  const int qpos = qpos0 + slot;
  bf16x8 qf[KS];
  {
    const u16* qrow = Qp + (size_t)(slot < nq_valid ? slot : 0) * qstride + hl * 8;
#pragma unroll
    for (int ks = 0; ks < KS; ks++) qf[ks] = *(const bf16x8*)(qrow + ks * 16);
  }
  f32x16 O[2];
#pragma unroll
  for (int b = 0; b < 2; b++)
#pragma unroll
    for (int i = 0; i < 16; i++) O[b][i] = 0.f;
  float m_run = -1e30f, l_run = 0.f, R = 1.f;
  const int last_qpos = qpos0 + nq_valid - 1;
  int ntiles = SB ? (last_qpos - 1) / 64 + 1 : last_qpos / 64 + 1;
  { int mx = (nkeys + 63) >> 6; if (ntiles > mx) ntiles = mx; }
  const int wave_q0 = qpos0 + wave * 32;
  u32x4 rk[NKL], rv[2];
  auto prefetch = [&](int kt) {
#pragma unroll
    for (int i = 0; i < NKL; i++) { int c = tid + 256 * i; int row = c / KCH, ch = c - row * KCH; rk[i] = *(const u32x4*)(Kp + (size_t)(kt * 64 + row) * kstride + ch * 8); }
#pragma unroll
    for (int i = 0; i < 2; i++) { int c = tid + 256 * i; int row = c >> 3, ch = c & 7; rv[i] = *(const u32x4*)(Vtp + (size_t)row * vstride + kt * 64 + ch * 8); }
  };
  prefetch(SB ? ntiles - 1 : 0);
  for (int it = 0; it < ntiles; it++) {
    const int kt = SB ? ntiles - 1 - it : it;
    __syncthreads();
#pragma unroll
    for (int i = 0; i < NKL; i++) { int c = tid + 256 * i; int row = c / KCH, ch = c - row * KCH; *(u32x4*)(sK + row * KSTR + ch * 8) = rk[i]; }
#pragma unroll
    for (int i = 0; i < 2; i++) { int c = tid + 256 * i; int row = c >> 3, ch = c & 7; *(u32x4*)(sV + row * 72 + ch * 8) = rv[i]; }
    __syncthreads();
    { int nx = SB ? kt - 1 : kt + 1; if (it + 1 >= ntiles) nx = kt; prefetch(nx); }
    bool doit;
    if (SB) doit = wave_active && (kt * 64 < wave_q0 + 31);
    else doit = wave_active && (kt <= (wave_q0 >> 6));
    if (doit) {
    f32x16 S[2];
#pragma unroll
    for (int kb = 0; kb < 2; kb++) {
#pragma unroll
      for (int i = 0; i < 16; i++) S[kb][i] = 0.f;
#pragma unroll
      for (int ks = 0; ks < KS; ks++) {
        bf16x8 kf = *(const bf16x8*)(sK + (kb * 32 + r) * KSTR + ks * 16 + hl * 8);
        S[kb] = MFMA32(kf, qf[ks], S[kb]);
      }
    }
    const int key0 = kt * 64 + 4 * hl;
    if (!SB) {
      const bool need_mask = (kt + 1) * 64 > nkeys;
      if (need_mask) {
#pragma unroll
        for (int kb = 0; kb < 2; kb++)
#pragma unroll
          for (int i = 0; i < 16; i++) { int key = key0 + kb * 32 + (i & 3) + 8 * (i >> 2); if (key >= nkeys) S[kb][i] = -1e30f; }
      }
      float tmax = -1e30f;
#pragma unroll
      for (int kb = 0; kb < 2; kb++)
#pragma unroll
        for (int i = 0; i < 16; i++) tmax = fmaxf(tmax, S[kb][i]);
      tmax = fmaxf(tmax, __shfl_xor(tmax, 32));
      float m_new = fmaxf(m_run, tmax);
      float alpha = ex2(m_run - m_new);
      m_run = m_new;
      float ps = 0.f;
#pragma unroll
      for (int kb = 0; kb < 2; kb++)
#pragma unroll
        for (int i = 0; i < 16; i++) { float pv = ex2(S[kb][i] - m_new); S[kb][i] = pv; ps += pv; }
      l_run = l_run * alpha + ps;
#pragma unroll
      for (int b = 0; b < 2; b++)
#pragma unroll
        for (int i = 0; i < 16; i++) O[b][i] *= alpha;
    } else {
      const bool need_mask = (kt * 64 + 63 >= wave_q0) || ((kt + 1) * 64 > nkeys);
#pragma unroll
      for (int kb = 0; kb < 2; kb++)
#pragma unroll
        for (int i = 0; i < 16; i++) {
          float d = __builtin_amdgcn_rcpf(1.f + ex2(S[kb][i]));
          if (need_mask) { int key = key0 + kb * 32 + (i & 3) + 8 * (i >> 2); if (!(key < nkeys && key < qpos)) d = 1.f; }
          S[kb][i] = d;
        }
      float gs[8], pg[8], sa[8];
#pragma unroll
      for (int o = 0; o < 8; o++) { int kb = o >> 2, g = o & 3; gs[o] = (S[kb][4 * g] * S[kb][4 * g + 1]) * (S[kb][4 * g + 2] * S[kb][4 * g + 3]); }
#pragma unroll
      for (int o = 0; o < 8; o++) pg[o] = __shfl_xor(gs[o], 32);
      sa[7] = R;
#pragma unroll
      for (int o = 6; o >= 0; o--) sa[o] = sa[o + 1] * (gs[o + 1] * pg[o + 1]);
      const float total = sa[0] * (gs[0] * pg[0]);
#pragma unroll
      for (int o = 0; o < 8; o++) {
        int kb = o >> 2, g = o & 3;
        float c = hl == 0 ? sa[o] * pg[o] : sa[o];
#pragma unroll
        for (int e = 3; e >= 0; e--) {
          float d = S[kb][4 * g + e];
          S[kb][4 * g + e] = c - d * c;
          c *= d;
        }
      }
      R = total;
    }
#pragma unroll
    for (int kb = 0; kb < 2; kb++)
#pragma unroll
      for (int s2 = 0; s2 < 2; s2++) {
        uint4 u;
        u.x = pk2(S[kb][8 * s2], S[kb][8 * s2 + 1]); u.y = pk2(S[kb][8 * s2 + 2], S[kb][8 * s2 + 3]);
        u.z = pk2(S[kb][8 * s2 + 4], S[kb][8 * s2 + 5]); u.w = pk2(S[kb][8 * s2 + 6], S[kb][8 * s2 + 7]);
        bf16x8 pf = __builtin_bit_cast(bf16x8, u);
#pragma unroll
        for (int bd = 0; bd < 2; bd++) {
          const u16* vp = sV + (bd * 32 + r) * 72 + kb * 32 + s2 * 16 + hl * 4;
          uint2 lo = *(const uint2*)vp, hi = *(const uint2*)(vp + 8);
          uint4 vv; vv.x = lo.x; vv.y = lo.y; vv.z = hi.x; vv.w = hi.y;
          O[bd] = MFMA32(__builtin_bit_cast(bf16x8, vv), pf, O[bd]);
        }
      }
    }
    if (SB) {
      const bool lane_done = !wave_active || slot >= nq_valid || R < 1e-30f;
      const int wdone = __all(lane_done);
      if (__syncthreads_and(wdone)) break;
    }
  }
  if (wave_active && slot < nq_valid) {
    float sc = 1.f;
    if (!SB) { float lt = l_run + __shfl_xor(l_run, 32); sc = 1.f / lt; }
#pragma unroll
    for (int bd = 0; bd < 2; bd++)
#pragma unroll
      for (int g = 0; g < 4; g++) {
        int d0 = bd * 32 + 8 * g + 4 * hl;
        uint2 zz = *(const uint2*)(Zp + (size_t)slot * 512 + d0);
        uint2 o;
        o.x = pk2(O[bd][4 * g] * sc * bflo(zz.x), O[bd][4 * g + 1] * sc * bfhi(zz.x));
        o.y = pk2(O[bd][4 * g + 2] * sc * bflo(zz.y), O[bd][4 * g + 3] * sc * bfhi(zz.y));
        *(uint2*)(Yp + (size_t)slot * 512 + d0) = o;
      }
  }
}

template <int CTRL> DI float dpp_add(float x) {
  return x + __int_as_float(__builtin_amdgcn_update_dpp(0, __float_as_int(x), CTRL, 0xF, 0xF, true));
}
DI void allreduce16x2(float& a, float& b) {
  a = dpp_add<0xB1>(a); b = dpp_add<0xB1>(b); a = dpp_add<0x4E>(a); b = dpp_add<0x4E>(b);
  a = dpp_add<0x141>(a); b = dpp_add<0x141>(b); a = dpp_add<0x140>(a); b = dpp_add<0x140>(b);
}
#define SCAN_PREFETCH(slot, cc) { int c_ = (cc) < nch ? (cc) : nch - 1; size_t row = (size_t)(srow0 + c_ * 16 + lstep); \
    pw[slot] = *(const f32x4v*)(RWW + row * 512 + h * 64 + lpart); \
    _Pragma("unroll") for (int c = 0; c < 5; c++) px[slot][c] = *(const u32x2*)(RWX + row * 2560 + c * 512 + h * 64 + lpart); }
#define SCAN_STAGE(slot, bsel) { float* o = ops + ((bsel) * 16 + lstep) * 384 + lpart; \
    f32x4v r4 = {bflo(px[slot][0].x), bfhi(px[slot][0].x), bflo(px[slot][0].y), bfhi(px[slot][0].y)}; \
    f32x4v k4 = {bflo(px[slot][1].x), bfhi(px[slot][1].x), bflo(px[slot][1].y), bfhi(px[slot][1].y)}; \
    f32x4v v4 = {bflo(px[slot][2].x), bfhi(px[slot][2].x), bflo(px[slot][2].y), bfhi(px[slot][2].y)}; \
    f32x4v kk4 = {bflo(px[slot][3].x), bfhi(px[slot][3].x), bflo(px[slot][3].y), bfhi(px[slot][3].y)}; \
    f32x4v b4 = {bflo(px[slot][4].x), bfhi(px[slot][4].x), bflo(px[slot][4].y), bfhi(px[slot][4].y)}; \
    *(f32x4v*)(o) = pw[slot]; *(f32x4v*)(o + 64) = pw[slot] * r4; *(f32x4v*)(o + 128) = k4; *(f32x4v*)(o + 192) = v4; *(f32x4v*)(o + 256) = kk4; *(f32x4v*)(o + 320) = b4; \
    float br = b4.x * r4.x + b4.y * r4.y + b4.z * r4.z + b4.w * r4.w; \
    float kr = k4.x * r4.x + k4.y * r4.y + k4.z * r4.z + k4.w * r4.w; \
    allreduce16x2(br, kr); \
    if ((tid & 15) == 0) { sc[((bsel) * 16 + lstep) * 2] = br; sc[((bsel) * 16 + lstep) * 2 + 1] = kr; } }

DI void rwkv_pass1_task(const Params& p, int bh, int seg, int rq, unsigned char* smem) {
  float* ops = (float*)smem; float* sc = ops + 2 * 16 * 384;
  const int tid = TIDX(), i = tid >> 4, cg = tid & 15, cg4 = cg * 4;
  const int Rr = rq * 16 + i, h = bh & 7;
  const int srow0 = (bh >> 3) * TP + seg * 1024;
  const float* RWW = (const float*)(p.ws + W_RWW); const u16* RWX = (const u16*)(p.ws + W_RWX);
  float SL[4] = {0.f, 0.f, 0.f, 0.f}, SP[4];
#pragma unroll
  for (int e = 0; e < 4; e++) SP[e] = (cg4 + e == Rr) ? 1.f : 0.f;
  const int lstep = tid >> 4, lpart = (tid & 15) * 4;
  f32x4v pw[4]; u32x2 px[4][5];
  const int nch = 64;
  SCAN_PREFETCH(0, 0) SCAN_PREFETCH(1, 1) SCAN_PREFETCH(2, 2) SCAN_PREFETCH(3, 3)
  __syncthreads();
  SCAN_STAGE(0, 0)
  __syncthreads();
  __builtin_amdgcn_s_setprio(3);
  for (int cb = 0; cb < nch; cb += 4) {
#pragma unroll
    for (int k = 0; k < 4; k++) {
      const int c0 = cb + k;
      const int bsel = k & 1;
      SCAN_PREFETCH(k, c0 + 4)
#pragma unroll
      for (int st = 0; st < 16; st++) {
        const float* o = ops + (bsel * 16 + st) * 384;
        f32x4v w = *(const f32x4v*)(o + cg4), kp = *(const f32x4v*)(o + 128 + cg4);
        f32x4v kkv = *(const f32x4v*)(o + 256 + cg4), bb = *(const f32x4v*)(o + 320 + cg4);
        float v = o[192 + Rr];
        float d1 = SL[0] * kkv.x + SL[1] * kkv.y + SL[2] * kkv.z + SL[3] * kkv.w;
        float d2 = SP[0] * kkv.x + SP[1] * kkv.y + SP[2] * kkv.z + SP[3] * kkv.w;
        allreduce16x2(d1, d2);
        const float saL = -d1, saP = -d2;
        SL[0] = SL[0] * w.x + (saL * bb.x + v * kp.x); SP[0] = SP[0] * w.x + saP * bb.x;
        SL[1] = SL[1] * w.y + (saL * bb.y + v * kp.y); SP[1] = SP[1] * w.y + saP * bb.y;
        SL[2] = SL[2] * w.z + (saL * bb.z + v * kp.z); SP[2] = SP[2] * w.z + saP * bb.z;
        SL[3] = SL[3] * w.w + (saL * bb.w + v * kp.w); SP[3] = SP[3] * w.w + saP * bb.w;
      }
      SCAN_STAGE(((k + 1) & 3), (bsel ^ 1))
      __syncthreads();
    }
  }
  __builtin_amdgcn_s_setprio(0);
  const size_t so = ((size_t)(bh * 7 + seg)) * 4096 + Rr * 64 + cg4;
  *(float4*)((float*)(p.ws + W_SLOC) + so) = make_float4(SL[0], SL[1], SL[2], SL[3]);
  *(float4*)((float*)(p.ws + W_PMAT) + so) = make_float4(SP[0], SP[1], SP[2], SP[3]);
}

DI void allreduce16x4(float& a, float& b, float& c, float& d) {
  a = dpp_add<0xB1>(a); b = dpp_add<0xB1>(b); c = dpp_add<0xB1>(c); d = dpp_add<0xB1>(d);
  a = dpp_add<0x4E>(a); b = dpp_add<0x4E>(b); c = dpp_add<0x4E>(c); d = dpp_add<0x4E>(d);
  a = dpp_add<0x141>(a); b = dpp_add<0x141>(b); c = dpp_add<0x141>(c); d = dpp_add<0x141>(d);
  a = dpp_add<0x140>(a); b = dpp_add<0x140>(b); c = dpp_add<0x140>(c); d = dpp_add<0x140>(d);
}
DI void rwkv_scan_task(const Params& p, int srow0, int T, int h, int rq, const float* S0, float* Sout, int comb_bh, int comb_seg, unsigned char* smem) {
  if (rq & 1) return;
  float* ops = (float*)smem;
  float* sc = ops + 2 * 16 * 384;
  float* ybuf = sc + 64;
  const int tid = TIDX(), i = tid >> 3, c8 = tid & 7, c0 = c8 * 8;
  const int Rr = rq * 16 + i;
  const float* RWW = (const float*)(p.ws + W_RWW); const u16* RWX = (const u16*)(p.ws + W_RWX); float* YRAW = (float*)(p.ws + W_YRAW);
  f32x4v S[2];
  if (S0) { S[0] = *(const f32x4v*)(S0 + Rr * 64 + c0); S[1] = *(const f32x4v*)(S0 + Rr * 64 + c0 + 4); }
  else { S[0] = (f32x4v){0.f, 0.f, 0.f, 0.f}; S[1] = S[0]; }
  if (comb_bh >= 0 && comb_seg > 0) {
    const float* SLOC = (const float*)(p.ws + W_SLOC) + (size_t)comb_bh * 7 * 4096;
    const float* PMAT = (const float*)(p.ws + W_PMAT) + (size_t)comb_bh * 7 * 4096;
    float* srow = ops;
    S[0] = *(const f32x4v*)(SLOC + Rr * 64 + c0); S[1] = *(const f32x4v*)(SLOC + Rr * 64 + c0 + 4);
    for (int sp = 1; sp < comb_seg; sp++) {
      __syncthreads();
      *(f32x4v*)(srow + i * 64 + c0) = S[0]; *(f32x4v*)(srow + i * 64 + c0 + 4) = S[1];
      __syncthreads();
      f32x4v a0 = *(const f32x4v*)(SLOC + (size_t)sp * 4096 + Rr * 64 + c0), a1 = *(const f32x4v*)(SLOC + (size_t)sp * 4096 + Rr * 64 + c0 + 4);
      const float* P = PMAT + (size_t)sp * 4096 + c0;
#pragma unroll 8
      for (int k = 0; k < 64; k++) {
        const float sv = srow[i * 64 + k];
        a0 += sv * *(const f32x4v*)(P + k * 64); a1 += sv * *(const f32x4v*)(P + k * 64 + 4);
      }
      S[0] = a0; S[1] = a1;
    }
  }
  const int lstep = tid >> 4, lpart = (tid & 15) * 4;
  f32x4v pw[2]; u32x2 px[2][5];
  const int nch = T >> 4;
  SCAN_PREFETCH(0, 0) SCAN_PREFETCH(1, 1)
  __syncthreads();
  SCAN_STAGE(0, 0)
  __syncthreads();
  __builtin_amdgcn_s_setprio(3);
  for (int cb = 0; cb < nch; cb += 4) {
#pragma unroll
    for (int k = 0; k < 4; k++) {
      const int cc = cb + k;
      if (cc < nch) {
        const int bsel = k & 1;
        SCAN_PREFETCH((k & 1), cc + 2)
#pragma unroll
        for (int j = 0; j < 2; j++) {
          float yk = 0.f;
#pragma unroll
          for (int u = 0; u < 8; u++) {
            const float* o = ops + (bsel * 16 + j * 8 + u) * 384;
            const float v = o[192 + Rr];
            const float br = sc[(bsel * 16 + j * 8 + u) * 2], kr = sc[(bsel * 16 + j * 8 + u) * 2 + 1];
            f32x4v d1v = S[0] * *(const f32x4v*)(o + 256 + c0) + S[1] * *(const f32x4v*)(o + 256 + c0 + 4);
            f32x4v d2v = S[0] * *(const f32x4v*)(o + 64 + c0) + S[1] * *(const f32x4v*)(o + 64 + c0 + 4);
            float d1 = (d1v.x + d1v.y) + (d1v.z + d1v.w), d2 = (d2v.x + d2v.y) + (d2v.z + d2v.w);
            d1 = dpp_add<0xB1>(d1); d2 = dpp_add<0xB1>(d2); d1 = dpp_add<0x4E>(d1); d2 = dpp_add<0x4E>(d2);
            d1 = dpp_add<0x141>(d1); d2 = dpp_add<0x141>(d2);
#pragma unroll
            for (int m = 0; m < 2; m++) {
              const f32x4v w = *(const f32x4v*)(o + c0 + 4 * m), kp = *(const f32x4v*)(o + 128 + c0 + 4 * m), bb = *(const f32x4v*)(o + 320 + c0 + 4 * m);
              S[m] = S[m] * w + (kp * v - bb * d1);
            }
            const float y = d2 - d1 * br + v * kr;
            yk = (u == c8) ? y : yk;
          }
          ybuf[bsel * 512 + (j * 8 + c8) * 32 + i] = yk;
        }
        SCAN_STAGE(((k + 1) & 1), (bsel ^ 1))
        __syncthreads();
        if (tid < 128) {
          const int st = tid >> 3, i4 = (tid & 7) * 4;
          *(f32x4v*)(YRAW + (size_t)(srow0 + cc * 16 + st) * 512 + h * 64 + rq * 16 + i4) = *(const f32x4v*)(ybuf + bsel * 512 + st * 32 + i4);
        }
      }
    }
  }
  __builtin_amdgcn_s_setprio(0);
  if (Sout) { *(f32x4v*)(Sout + Rr * 64 + c0) = S[0]; *(f32x4v*)(Sout + Rr * 64 + c0 + 4) = S[1]; }
}
constexpr int PH5_TASKS = 512 + 128 + 2048 + 256;
DI void phase5_task(const Params& p, int l, int task, unsigned char* smem) {
  const u16* Z = (const u16*)(p.ws + W_Z); u16* YG = (u16*)(p.ws + W_YG);
  if (task < 512) {
    int bh = task >> 5, seg = 7 - ((task >> 2) & 7), rq = task & 3, b = bh >> 3, h = bh & 7;
    rwkv_scan_task(p, b * TP + seg * 1024, 1024, h, rq, nullptr, seg == 7 ? p.out + O_WKV_P + ((size_t)((l * 2 + b) * 8 + h)) * 4096 : nullptr, bh, seg, smem);
    return;
  }
  task -= 448;
  if (task < 2240) {
    int which, b, h, row0, nq, qpos0, kbase, nkeys; size_t vto; int vstr;
    if (task < 192) { int j = task - 64; which = j >> 6; int bh = j & 63; b = bh >> 3; h = bh & 7; row0 = NP + b * 16; nq = 16; qpos0 = PAST; kbase = NP + b * SK; nkeys = SK; vto = VT_S_OFF + (size_t)((b * 8 + h) * 64) * SK; vstr = SK; }
    else { int j = task - 192; int qb = 63 - (j >> 5); which = (j >> 4) & 1; int bh = j & 15; b = bh >> 3; h = bh & 7; row0 = b * TP + qb * 128; nq = 128; qpos0 = qb * 128; kbase = b * TP; nkeys = TP; vto = (size_t)((b * 8 + h) * 64) * 8192; vstr = 8192; }
    if (which == 0)
      attn_task<64, true>((const u16*)(p.ws + W_SQ) + (size_t)row0 * 512 + h * 64, 512, nq, (const u16*)(p.ws + W_SBK) + (size_t)kbase * 512 + h * 64, 512,
                          (const u16*)(p.ws + W_SBVT) + vto, vstr, nkeys, qpos0, Z + ((size_t)2 * NT + row0) * 512 + h * 64, YG + ((size_t)2 * NT + row0) * 512 + h * 64, smem);
    else
      attn_task<96, false>((const u16*)(p.ws + W_QF) + (size_t)row0 * 768 + h * 96, 768, nq, (const u16*)(p.ws + W_KF) + (size_t)kbase * 768 + h * 96, 768,
                           (const u16*)(p.ws + W_MLAVT) + vto, vstr, nkeys, qpos0, Z + ((size_t)1 * NT + row0) * 512 + h * 64, YG + ((size_t)1 * NT + row0) * 512 + h * 64, smem);
    return;
  }
  {
    int j = task - 2240; int bh = j >> 2, rq = j & 3, b = bh >> 3, h = bh & 7;
    size_t so = ((size_t)((l * 8 + b) * 8 + h)) * 4096;
    rwkv_scan_task(p, NP + b * 16, 16, h, rq, p.in[2] + so, p.out + O_WKV_S + so, -1, 0, smem);
  }
}
DI void phase5(const Params& p, int l, unsigned char* smem) {
  __shared__ int s_task;
  int* ctr = (int*)(p.ws + W_CTR) + l;
  while (true) {
    __syncthreads();
    if (TIDX() == 0) s_task = atomicAdd(ctr, 1);
    __syncthreads();
    int q = s_task;
    if (q >= PH5_TASKS - 256) break;
    int task = q < 512 ? ((q & 1) ? 512 + (q >> 1) : ((q >> 2) * 4 + ((q >> 1) & 1) * 2)) : 512 + (q - 256);
    phase5_task(p, l, task, smem);
  }
}
DI void phase5b(const Params& p, int l) {
  const int lane = TIDX() & 63, wave = TIDX() >> 6;
  const float* YRAW = (const float*)(p.ws + W_YRAW); const u16* RWX = (const u16*)(p.ws + W_RWX); const float* RHO = (const float*)(p.ws + W_RHO);
  const u16* Z = (const u16*)(p.ws + W_Z); u16* YG = (u16*)(p.ws + W_YG);
  for (int task = blockIdx.x; task < NT / 4; task += gridDim.x) {
    const int row = task * 4 + wave, c0 = lane * 8;
    float y[8];
    { float4 a = *(const float4*)(YRAW + (size_t)row * 512 + c0), b = *(const float4*)(YRAW + (size_t)row * 512 + c0 + 4);
      y[0] = a.x; y[1] = a.y; y[2] = a.z; y[3] = a.w; y[4] = b.x; y[5] = b.y; y[6] = b.z; y[7] = b.w; }
    float s = 0.f;
#pragma unroll
    for (int j = 0; j < 8; j++) s += y[j];
    s += __shfl_xor(s, 1); s += __shfl_xor(s, 2); s += __shfl_xor(s, 4);
    float mu = s * (1.f / 64.f), vs = 0.f;
#pragma unroll
    for (int j = 0; j < 8; j++) { float d = y[j] - mu; vs += d * d; }
    vs += __shfl_xor(vs, 1); vs += __shfl_xor(vs, 2); vs += __shfl_xor(vs, 4);
    float rstd = rsqrtf(vs * (1.f / 64.f) + GN_EPS);
    float rho = RHO[(size_t)row * 8 + (lane >> 3)];
    uint4 vv = *(const uint4*)(RWX + (size_t)row * 2560 + 1024 + c0);
    uint4 zz = *(const uint4*)(Z + (size_t)row * 512 + c0);
    float vf[8] = {bflo(vv.x), bfhi(vv.x), bflo(vv.y), bfhi(vv.y), bflo(vv.z), bfhi(vv.z), bflo(vv.w), bfhi(vv.w)};
    float zf[8] = {bflo(zz.x), bfhi(zz.x), bflo(zz.y), bfhi(zz.y), bflo(zz.z), bfhi(zz.z), bflo(zz.w), bfhi(zz.w)};
    float o[8];
#pragma unroll
    for (int j = 0; j < 8; j++) o[j] = ((y[j] - mu) * rstd * p.in[22][l * 512 + c0 + j] + p.in[23][l * 512 + c0 + j] + rho * vf[j]) * zf[j];
    uint4 ob; ob.x = pk2(o[0], o[1]); ob.y = pk2(o[2], o[3]); ob.z = pk2(o[4], o[5]); ob.w = pk2(o[6], o[7]);
    *(uint4*)(YG + (size_t)row * 512 + c0) = ob;
  }
}

DI void wave_gemm32(f32x16& acc, const u16* A, int lda, const u16* Bt, int ldb, int K) {
  const int lane = TIDX() & 63, r = lane & 31, hl = lane >> 5;
  const u16* ap = A + (size_t)r * lda + hl * 8; const u16* bp = Bt + (size_t)r * ldb + hl * 8;
#pragma unroll 8
  for (int k = 0; k < K; k += 16) { bf16x8 a = *(const bf16x8*)(ap + k); bf16x8 b = *(const bf16x8*)(bp + k); acc = MFMA32(a, b, acc); }
}
DI void phase6(const Params& p, int l, unsigned char* smem) {
  const u16* H = (const u16*)(p.ws + W_H); const u16* WinT = (const u16*)(p.ws + W_WINT);
  const u16* YG = (const u16*)(p.ws + W_YG); u16* MG = (u16*)(p.ws + W_MG);
  for (int t0 = blockIdx.x; t0 < 32 + 128 * 8; t0 += gridDim.x) {
    if (t0 < 32) {
      const int lane = TIDX() & 63, wave = TIDX() >> 6, r = lane & 31, hl = lane >> 5;
      const int unit = t0 * 4 + wave, row0 = NP + (unit & 3) * 32, n0 = (unit >> 2) * 32;
      f32x16 mm;
#pragma unroll
      for (int i = 0; i < 16; i++) mm[i] = 0.f;
#pragma unroll 1
      for (int g = 0; g < 3; g++) {
        f32x16 ay, ag;
#pragma unroll
        for (int i = 0; i < 16; i++) { ay[i] = 0.f; ag[i] = 0.f; }
        wave_gemm32(ay, YG + ((size_t)g * NT + row0) * 512, 512, (const u16*)(p.ws + W_WBRT) + ((size_t)(l * 3 + g) * 1024 + n0) * 512, 512, 512);
        wave_gemm32(ag, H + (size_t)row0 * 1024, 1024, WinT + (size_t)(5408 + g * 1024 + n0) * 1024, 1024, 1024);
#pragma unroll
        for (int i = 0; i < 16; i++) mm[i] += sigmoidf_(ag[i]) * ay[i];
      }
#pragma unroll
      for (int i = 0; i < 16; i++) MG[(size_t)(row0 + crow(i, hl)) * 1024 + n0 + r] = f2bf(mm[i]);
      continue;
    }
    const int t = t0 - 32;
    const int bq = t & 511, mt = (bq & 7) * 16 + ((bq >> 3) & 15), nt = (t >> 9) * 4 + (bq >> 7), m0 = mt * 128, n0 = nt * 128;

    unsigned mpk[2][2][8];
#pragma unroll
    for (int a = 0; a < 2; a++)
#pragma unroll
      for (int b = 0; b < 2; b++)
#pragma unroll
        for (int j = 0; j < 8; j++) mpk[a][b][j] = 0u;
#pragma unroll 1
    for (int g = 0; g < 3; g++) {
      f32x16 acc[2][2]; zero_acc(acc);
      gemm_mainloop(acc, YG + ((size_t)g * NT + m0) * 512, 512, (const u16*)(p.ws + W_WBRT) + ((size_t)(l * 3 + g) * 1024 + n0) * 512, 512, 512, smem);
      unsigned ypk[2][2][8];
#pragma unroll
      for (int a = 0; a < 2; a++)
#pragma unroll
        for (int b = 0; b < 2; b++)
#pragma unroll
          for (int j = 0; j < 8; j++) ypk[a][b][j] = pk2(acc[a][b][2 * j], acc[a][b][2 * j + 1]);
      zero_acc(acc);
      gemm_mainloop(acc, H + (size_t)m0 * 1024, 1024, WinT + (size_t)(5408 + g * 1024 + n0) * 1024, 1024, 1024, smem);
#pragma unroll
      for (int a = 0; a < 2; a++)
#pragma unroll
        for (int b = 0; b < 2; b++)
#pragma unroll
          for (int j = 0; j < 8; j++) {
            float lo = bflo(mpk[a][b][j]) + sigmoidf_(acc[a][b][2 * j]) * bflo(ypk[a][b][j]);
            float hi = bfhi(mpk[a][b][j]) + sigmoidf_(acc[a][b][2 * j + 1]) * bfhi(ypk[a][b][j]);
            mpk[a][b][j] = pk2(lo, hi);
          }
    }
    {
      const int lane = TIDX() & 63, wave = TIDX() >> 6, wm = wave >> 1, wn = wave & 1, r = lane & 31, hl = lane >> 5;
#pragma unroll
      for (int a = 0; a < 2; a++)
#pragma unroll
        for (int b = 0; b < 2; b++)
#pragma unroll
          for (int j = 0; j < 8; j++) {
            int col = n0 + wn * 64 + b * 32 + r;
            int row0 = m0 + wm * 64 + a * 32;
            MG[(size_t)(row0 + crow(2 * j, hl)) * 1024 + col] = (u16)(mpk[a][b][j] & 0xffffu);
            MG[(size_t)(row0 + crow(2 * j + 1, hl)) * 1024 + col] = (u16)(mpk[a][b][j] >> 16);
          }
    }
  }
}
DI void phase7(const Params& p, int l, unsigned char* smem) {
  const u16* MG = (const u16*)(p.ws + W_MG);
  const float* mod = (const float*)(p.ws + W_MOD);
  const int ntile = 32 + 128 * 8, nextra = (l + 1 < NL) ? WIN_TT + SMALLW_TT : 0;
  for (int t0 = blockIdx.x; t0 < ntile + nextra; t0 += gridDim.x) {
    if (t0 >= ntile + WIN_TT) { smallw_transpose_task(p, l + 1, t0 - ntile - WIN_TT, smem); continue; }
    if (t0 >= ntile) { win_transpose_task(p, l + 1, t0 - ntile, smem); continue; }
    if (t0 < 32) {
      const int lane = TIDX() & 63, wave = TIDX() >> 6, r = lane & 31, hl = lane >> 5;
      const int unit = t0 * 4 + wave, row0 = NP + (unit & 3) * 32, n0 = (unit >> 2) * 32;
      f32x16 a;
#pragma unroll
      for (int i = 0; i < 16; i++) a[i] = 0.f;
      wave_gemm32(a, MG + (size_t)row0 * 1024, 1024, (const u16*)(p.ws + W_WOUTT) + ((size_t)l * 1024 + n0) * 1024, 1024, 1024);
#pragma unroll
      for (int i = 0; i < 16; i++) {
        const int row = row0 + crow(i, hl), col = n0 + r;
        float xo = xrow_ptr(p, l, row)[col];
        float gt = mod[(l * 10 + bidx_of(row)) * 3072 + 2048 + col];
        p.out[(size_t)row * D + col] = xo + gt * a[i];
      }
      continue;
    }
    const int t = t0 - 32;
    const int bq = t & 511, mt = (bq & 7) * 16 + ((bq >> 3) & 15), nt = (t >> 9) * 4 + (bq >> 7), m0 = mt * 128, n0 = nt * 128;

    f32x16 acc[2][2]; zero_acc(acc);
    gemm_mainloop(acc, MG + (size_t)m0 * 1024, 1024, (const u16*)(p.ws + W_WOUTT) + ((size_t)l * 1024 + n0) * 1024, 1024, 1024, smem);
    foreach_acc(acc, m0, n0, [&](int row, int col, float v) {
      float xo = xrow_ptr(p, l, row)[col];
      float gt = mod[(l * 10 + bidx_of(row)) * 3072 + 2048 + col];
      p.out[(size_t)row * D + col] = xo + gt * v;
    });
  }
}

#define XB_TMO      128
#define XB_XCNT(j)  (256  + 64 * (j))
#define XB_XSUB(j)  (1280 + 64 * (j))
#define XB_XGEN(j)  (2304 + 64 * (j))
#define XB_TOP      3328
#define XB_TOPGEN   3392
#define XB_SPIN_CAP (1u << 18)
DI unsigned xb_ld(unsigned* q) { return __hip_atomic_load(q, __ATOMIC_RELAXED, __HIP_MEMORY_SCOPE_AGENT); }
DI unsigned xb_add(unsigned* q, unsigned v) { return __hip_atomic_fetch_add(q, v, __ATOMIC_RELAXED, __HIP_MEMORY_SCOPE_AGENT); }
DI unsigned xb_xcc_id() { return (unsigned)__builtin_amdgcn_s_getreg((3 << 11) | 20) & 0xFu; }
#define XB_SPIN(cond, bar) do { unsigned _sp = 0; while (cond) { __builtin_amdgcn_s_sleep(1); \
    if ((++_sp & 255u) == 0u) { if (xb_ld(&(bar)[XB_TMO])) break; if (_sp > XB_SPIN_CAP) { atomicAdd(&(bar)[XB_TMO], 1u); break; } } } } while (0)
DI void xbar(const Params& p, unsigned* xbst) {
  asm volatile("s_waitcnt vmcnt(0)" ::: "memory");
  __syncthreads();
  if (TIDX() == 0) {
    unsigned* bar = (unsigned*)(p.ws + W_XBAR);
    const unsigned x = xb_xcc_id();
    __builtin_amdgcn_s_waitcnt(0);
    const unsigned nloc = xbst[0], nx = xbst[1];
    const unsigned old = xb_add(&bar[XB_XSUB(x)], 1u);
    const unsigned gen = old / nloc;
    if (old + 1u == (gen + 1u) * nloc) {
      __builtin_amdgcn_fence(__ATOMIC_RELEASE, "agent");
      asm volatile("s_waitcnt vmcnt(0)" ::: "memory");
      const unsigned og = xb_add(&bar[XB_TOP], 1u);
      const unsigned tg = og / nx;
      if (og + 1u == (tg + 1u) * nx) xb_add(&bar[XB_TOPGEN], 1u);
      else XB_SPIN(xb_ld(&bar[XB_TOPGEN]) == tg, bar);
      __builtin_amdgcn_fence(__ATOMIC_ACQUIRE, "agent");
      xb_add(&bar[XB_XGEN(x)], 1u);
      asm volatile("s_waitcnt vmcnt(0)" ::: "memory");
    } else {
      XB_SPIN(xb_ld(&bar[XB_XGEN(x)]) == gen, bar);
      __builtin_amdgcn_fence(__ATOMIC_ACQUIRE, "agent");
      asm volatile("s_waitcnt vmcnt(0)" ::: "memory");
    }
  }
  __syncthreads();
}
DI int opq(int v) { asm volatile("" : "+s"(v)); return v; }
#if MULTI
template <int PH> __global__ void __launch_bounds__(256, 2) phase_kernel(Params p, int l) {
  __shared__ __attribute__((aligned(16))) unsigned char smem[SMEM_BYTES];
  if (PH == 0) phase0(p, smem);
  if (PH == 1) phase1(p, l);
  if (PH == 2) phase2(p, l, smem);
  if (PH == 3) phase3(p, l);
  if (PH == 4) phase4(p, l, smem);
  if (PH == 5) phase5(p, l, smem);
  if (PH == 6) phase5b(p, l);
  if (PH == 7) phase6(p, l, smem);
  if (PH == 8) phase7(p, l, smem);
}
#else
__global__ void __launch_bounds__(256, 2) mega_kernel(Params p_arg) {
  __shared__ __attribute__((aligned(16))) unsigned char smem[SMEM_BYTES];
  const Params& p = *(const Params*)__builtin_amdgcn_kernarg_segment_ptr();
  cg::grid_group grid = cg::this_grid();
  __shared__ unsigned xbst[4];
  if (TIDX() == 0) (void)xb_add((unsigned*)(p.ws + W_XBAR) + XB_XCNT(xb_xcc_id()), 1u);
  phase0(p, smem);
  grid.sync();
  if (TIDX() == 0) {
    unsigned* bar = (unsigned*)(p.ws + W_XBAR);
    const unsigned x = xb_xcc_id();
    unsigned cnt = 0u, mine = 0u;
    for (unsigned j = 0; j < 16; ++j) { const unsigned c = xb_ld(&bar[XB_XCNT(j)]); cnt += (c > 0u) ? 1u : 0u; mine = (j == x) ? c : mine; }
    xbst[0] = mine > 0u ? mine : 1u; xbst[1] = cnt > 0u ? cnt : 1u;
  }
  for (int l = 0; l < NL; l++) {
    phase1(p, opq(l)); xbar(p, xbst);
    phase2(p, opq(l), smem); xbar(p, xbst);
    phase3(p, opq(l)); xbar(p, xbst);
    phase4(p, opq(l), smem); xbar(p, xbst);
    phase5(p, opq(l), smem); xbar(p, xbst);
    phase5b(p, opq(l)); xbar(p, xbst);
    phase6(p, opq(l), smem); xbar(p, xbst);
    phase7(p, opq(l), smem); xbar(p, xbst);
  }
}
#endif

extern "C" void kernel_launch(void* const* d_in, const int* in_sizes, int n_in, void* d_out, int out_size, void* d_ws, size_t ws_size, hipStream_t stream) {
  Params p{};
  for (int i = 0; i < 36; i++) p.in[i] = (const float*)d_in[i];
  p.out = (float*)d_out;
  p.ws = (unsigned char*)d_ws;
  if (ws_size < W_TOTAL) fprintf(stderr, "workspace too small: %zu < %zu\n", ws_size, (size_t)W_TOTAL);
  hipMemsetAsync((unsigned char*)d_ws + W_CTR, 0, 256 + 3456 * 4, stream);
#if MULTI
  const int G = 1024;
  phase_kernel<0><<<G, 256, 0, stream>>>(p, 0);
  for (int l = 0; l < NL; l++) {
    phase_kernel<1><<<G, 256, 0, stream>>>(p, l);
    phase_kernel<2><<<G, 256, 0, stream>>>(p, l);
    phase_kernel<3><<<G, 256, 0, stream>>>(p, l);
    phase_kernel<4><<<G, 256, 0, stream>>>(p, l);
    phase_kernel<5><<<G, 256, 0, stream>>>(p, l);
    phase_kernel<6><<<G, 256, 0, stream>>>(p, l);
    phase_kernel<7><<<G, 256, 0, stream>>>(p, l);
    phase_kernel<8><<<G, 256, 0, stream>>>(p, l);
  }
#else
  static int grid_blocks = 0;
  if (!grid_blocks) {
    int dev = 0, cus = 0, per_cu = 0;
    hipGetDevice(&dev);
    hipDeviceGetAttribute(&cus, hipDeviceAttributeMultiprocessorCount, dev);
    hipOccupancyMaxActiveBlocksPerMultiprocessor(&per_cu, mega_kernel, 256, 0);
    if (per_cu > 2) per_cu = 2;
    grid_blocks = cus * per_cu;
  }
  void* args[] = {&p};
  hipError_t e = hipLaunchCooperativeKernel((void*)mega_kernel, dim3(grid_blocks), dim3(256), args, 0, stream);
  if (e != hipSuccess) fprintf(stderr, "cooperative launch failed: %s (grid %d)\n", hipGetErrorString(e), grid_blocks);
#endif
}
```
